# Optimizing an MI355X kernel written in HIP

```python
import jax, jax.numpy as jnp
from jax import lax
import numpy as np

D_MODEL = 2048
BATCH = 4
SEQ = 2048
DEPTH = 1
DEC_BATCH = 128
DEC_SEQ = 8
PAST_LEN = 16384
PAGE_SIZE = 128

MIX_WIDTH = D_MODEL
GLA_WIDTH = MIX_WIDTH // 2
GMLP_WIDTH = MIX_WIDTH - GLA_WIDTH
GLA_HEADS = 4
GLA_DV = GLA_WIDTH // GLA_HEADS
GLA_DK = GLA_DV // 2
GLA_KEY_WIDTH = GLA_HEADS * GLA_DK
GLA_GATE_RANK = 16
GLA_TAU = 16.0
GLA_CHUNK = 64
GMLP_GROUPS = 8
GMLP_GROUP_DIM = GMLP_WIDTH // GMLP_GROUPS
GMLP_CHUNK = 128
D_FF = -(-8 * D_MODEL // (3 * 256)) * 256
PLE_DIM = 256
EPS = 1e-6
IN_SIZES = (GLA_KEY_WIDTH, GLA_KEY_WIDTH, GLA_WIDTH, GLA_WIDTH, GLA_GATE_RANK, GMLP_WIDTH, GMLP_WIDTH)
IN_WIDTH = sum(IN_SIZES)

kernel_name = 'hybrid_gla_gmlp_step'


def rmsnorm(x, g):
    xf = x.astype(jnp.float32)
    y = xf * lax.rsqrt(jnp.mean(xf * xf, axis=-1, keepdims=True) + EPS)
    return (y * g.astype(jnp.float32)).astype(x.dtype)


def layernorm(x, g, b):
    xf = x.astype(jnp.float32)
    mu = jnp.mean(xf, axis=-1, keepdims=True)
    xc = xf - mu
    y = xc * lax.rsqrt(jnp.mean(xc * xc, axis=-1, keepdims=True) + EPS)
    return (y * g.astype(jnp.float32) + b.astype(jnp.float32)).astype(x.dtype)


def split_cols(z, sizes):
    out, start = [], 0
    for s in sizes:
        out.append(z[..., start:start + s])
        start += s
    return out


def gla_recurrence(q, k, v, log_a, s0):
    f32 = jnp.float32
    Bn, T = q.shape[0], q.shape[1]
    C = min(GLA_CHUNK, T)
    n = -(-T // C)
    pad = n * C - T
    def prep(a):
        a = a.astype(f32)
        if pad:
            a = jnp.pad(a, ((0, 0), (0, pad), (0, 0), (0, 0)))
        return a.reshape(Bn, n, C, a.shape[2], a.shape[3]).transpose(1, 0, 3, 2, 4)
    qc, kc, vc, lc = prep(q), prep(k), prep(v), prep(log_a)
    mask = jnp.tril(jnp.ones((C, C), dtype=bool))
    mid = C // 2

    def step(S, inp):
        qb, kb, vb, lb = inp
        b = jnp.cumsum(lb, axis=2)
        b_mid = b[:, :, mid:mid + 1]
        b_last = b[:, :, -1:]
        o_inter = jnp.einsum('bhtk,bhkv->bhtv', qb * jnp.exp(b), S)
        att = jnp.einsum('bhtk,bhsk->bhts', qb * jnp.exp(b - b_mid), kb * jnp.exp(b_mid - b))
        att = jnp.where(mask, att, 0.0)
        o = o_inter + jnp.einsum('bhts,bhsv->bhtv', att, vb)
        S_new = jnp.exp(b_last)[:, :, 0, :, None] * S + jnp.einsum(
            'bhsk,bhsv->bhkv', kb * jnp.exp(b_last - b), vb)
        return S_new, o

    S, o = lax.scan(step, s0.astype(f32), (qc, kc, vc, lc))
    o = o.transpose(1, 0, 3, 2, 4).reshape(Bn, n * C, o.shape[2], o.shape[4])[:, :T]
    return o, S


def chunk_spatial_gate(u, vn, w_s, b_s):
    Bn, T = u.shape[0], u.shape[1]
    C = GMLP_CHUNK
    n = -(-T // C)
    pad = n * C - T
    vp = jnp.pad(vn, ((0, 0), (0, pad), (0, 0), (0, 0))) if pad else vn
    vp = vp.reshape(Bn, n, C, GMLP_GROUPS, GMLP_GROUP_DIM)
    w = jnp.where(jnp.tril(jnp.ones((C, C), dtype=bool))[None], w_s, 0.0).astype(vn.dtype)
    mixed = jnp.einsum('gts,bnsgd->bntgd', w, vp) + b_s.T.astype(vn.dtype)[None, None, :, :, None]
    mixed = mixed.reshape(Bn, n * C, GMLP_GROUPS, GMLP_GROUP_DIM)[:, :T]
    return u * mixed


def hybrid_layer(h, p_l, s0, g_mix, w_in, w_a2, b_a, g_gla_norm, g_gmlp_ln, b_gmlp_ln,
                 w_s, b_s, g_gmlp_out, w_out, g_ffn, w_ffn_in, w_ffn_out,
                 w_ple, g_ple, g_ple_gate, w_ple_gate):
    Bn, T = h.shape[0], h.shape[1]
    a = rmsnorm(h, g_mix)
    z = a @ w_in
    q, k, v, r, alow, u, vg = split_cols(z, IN_SIZES)
    q = q.reshape(Bn, T, GLA_HEADS, GLA_DK) * (GLA_DK ** -0.5)
    k = k.reshape(Bn, T, GLA_HEADS, GLA_DK)
    v = v.reshape(Bn, T, GLA_HEADS, GLA_DV)
    log_a = jax.nn.log_sigmoid((alow @ w_a2 + b_a).astype(jnp.float32)) / GLA_TAU
    log_a = log_a.reshape(Bn, T, GLA_HEADS, GLA_DK)
    o, s_new = gla_recurrence(q, k, v, log_a, s0)
    o = rmsnorm(o.astype(h.dtype), g_gla_norm)
    o = o.reshape(Bn, T, GLA_WIDTH) * jax.nn.silu(r)
    u = jax.nn.gelu(u)
    vn = layernorm(jax.nn.gelu(vg), g_gmlp_ln, b_gmlp_ln)
    m = chunk_spatial_gate(u.reshape(Bn, T, GMLP_GROUPS, GMLP_GROUP_DIM),
                           vn.reshape(Bn, T, GMLP_GROUPS, GMLP_GROUP_DIM), w_s, b_s)
    m = rmsnorm(m.reshape(Bn, T, GMLP_WIDTH), g_gmlp_out)
    h = h + jnp.concatenate([o, m], axis=-1) @ w_out
    f = rmsnorm(h, g_ffn)
    gate, up = split_cols(f @ w_ffn_in, (D_FF, D_FF))
    h = h + (jax.nn.silu(gate) * up) @ w_ffn_out
    pe = rmsnorm(p_l @ w_ple, g_ple)
    h = h + pe * jax.nn.sigmoid(rmsnorm(h, g_ple_gate) @ w_ple_gate)
    return h, s_new, vn


def setup_inputs(seed: int = 0) -> dict:
    key = jax.random.key(seed)
    ks = jax.random.split(key, 26)
    def nrm(k, shape, scale):
        return jax.random.normal(k, shape, jnp.float32) * scale
    def gain(k, shape):
        return 1.0 + nrm(k, shape, 0.02)
    return {
        'x_prompt': nrm(ks[0], (BATCH, SEQ, D_MODEL), 1.0),
        'x_sample': nrm(ks[1], (DEC_BATCH, DEC_SEQ, D_MODEL), 1.0),
        'state_gla': nrm(ks[2], (DEPTH, DEC_BATCH, GLA_HEADS, GLA_DK, GLA_DV), 0.3),
        'p_prompt': nrm(ks[3], (DEPTH, BATCH, SEQ, PLE_DIM), 1.0),
        'p_sample': nrm(ks[4], (DEPTH, DEC_BATCH, DEC_SEQ, PLE_DIM), 1.0),
        'g_mix': gain(ks[5], (DEPTH, D_MODEL)),
        'w_in': nrm(ks[6], (DEPTH, D_MODEL, IN_WIDTH), D_MODEL ** -0.5),
        'w_a2': nrm(ks[7], (DEPTH, GLA_GATE_RANK, GLA_KEY_WIDTH), GLA_GATE_RANK ** -0.5),
        'b_a': nrm(ks[8], (DEPTH, GLA_KEY_WIDTH), 0.1),
        'g_gla_norm': gain(ks[9], (DEPTH, GLA_HEADS, GLA_DV)),
        'g_gmlp_ln': gain(ks[10], (DEPTH, GMLP_WIDTH)),
        'b_gmlp_ln': nrm(ks[11], (DEPTH, GMLP_WIDTH), 0.02),
        'w_s': nrm(ks[12], (DEPTH, GMLP_GROUPS, GMLP_CHUNK, GMLP_CHUNK), 0.5 * GMLP_CHUNK ** -0.5),
        'b_s': 1.0 + nrm(ks[13], (DEPTH, GMLP_GROUPS, GMLP_CHUNK), 0.1),
        'g_gmlp_out': gain(ks[14], (DEPTH, GMLP_WIDTH)),
        'w_out': nrm(ks[15], (DEPTH, MIX_WIDTH, D_MODEL), MIX_WIDTH ** -0.5),
        'g_ffn': gain(ks[16], (DEPTH, D_MODEL)),
        'w_ffn_in': nrm(ks[17], (DEPTH, D_MODEL, 2 * D_FF), D_MODEL ** -0.5),
        'w_ffn_out': nrm(ks[18], (DEPTH, D_FF, D_MODEL), D_FF ** -0.5),
        'w_ple': nrm(ks[19], (DEPTH, PLE_DIM, D_MODEL), PLE_DIM ** -0.5),
        'g_ple': gain(ks[20], (DEPTH, D_MODEL)),
        'g_ple_gate': gain(ks[21], (DEPTH, D_MODEL)),
        'w_ple_gate': nrm(ks[22], (DEPTH, D_MODEL, D_MODEL), D_MODEL ** -0.5),
        'g_final': gain(ks[23], (D_MODEL,)),
    }


def reference(x_prompt, x_sample, state_gla, p_prompt, p_sample, g_mix, w_in, w_a2, b_a,
              g_gla_norm, g_gmlp_ln, b_gmlp_ln, w_s, b_s, g_gmlp_out, w_out, g_ffn,
              w_ffn_in, w_ffn_out, w_ple, g_ple, g_ple_gate, w_ple_gate, g_final):
    hp, hs = x_prompt, x_sample
    sp_list, ss_list, vs_list = [], [], []
    for l in range(DEPTH):
        lw = (g_mix[l], w_in[l], w_a2[l], b_a[l], g_gla_norm[l], g_gmlp_ln[l], b_gmlp_ln[l],
              w_s[l], b_s[l], g_gmlp_out[l], w_out[l], g_ffn[l], w_ffn_in[l], w_ffn_out[l],
              w_ple[l], g_ple[l], g_ple_gate[l], w_ple_gate[l])
        s0_p = jnp.zeros((hp.shape[0], GLA_HEADS, GLA_DK, GLA_DV), jnp.float32)
        hp, sp, _ = hybrid_layer(hp, p_prompt[l], s0_p, *lw)
        hs, ss, vs = hybrid_layer(hs, p_sample[l], state_gla[l], *lw)
        sp_list.append(sp)
        ss_list.append(ss)
        vs_list.append(vs)
    y_prompt = rmsnorm(hp, g_final)
    y_sample = rmsnorm(hs, g_final)
    new_state_gla_prompt = jnp.stack(sp_list, axis=0)
    new_state_gla_sample = jnp.stack(ss_list, axis=0)
    new_gmlp_v_sample = jnp.stack(vs_list, axis=0)
    return (y_prompt, y_sample, new_state_gla_prompt, new_state_gla_sample, new_gmlp_v_sample)
```

```cpp
#include <hip/hip_runtime.h>
#include <hip/hip_cooperative_groups.h>
#include <cstdio>
#include <cstdint>
namespace cg = cooperative_groups;
namespace pg8 {
#define PG8_LAS __attribute__((address_space(3)))
typedef unsigned short bf16_t;
typedef short bf16x8 __attribute__((ext_vector_type(8)));
typedef float f32x4 __attribute__((ext_vector_type(4)));
typedef unsigned u32x4 __attribute__((ext_vector_type(4)));
constexpr int BM = 256, BK = 64, HALF = 128, HTB = HALF * BK * 2  , STAGE_BYTES = 8 * HTB, NXCD = 8, WGM = 8;

__host__ __device__ __forceinline__ int lds_byte(int r, int c) { const int st = (r >> 4) * 2 + (c >> 5), rr = r & 15, cc = c & 31, ob = rr * 64 + cc * 2; return st * 1024 + (ob ^ (((ob >> 9) & 1) << 5)); }
__host__ __device__ __forceinline__ void stage_rc(int b, int& R, int& C) { const int st = b / 1024, sb = b % 1024, swz = sb ^ (((sb >> 9) & 1) << 5); R = (st >> 1) * 16 + swz / 64; C = (st & 1) * 32 + (swz % 64) / 2; }
__host__ __device__ __forceinline__ int perm32(int rho) { const int n = rho >> 4, i = rho & 15; return 8 * (i >> 2) + 4 * n + (i & 3); }

struct Unit { int pm, pn; };
struct Gemm { const bf16_t* A; const bf16_t* Bt; int M, N, K; };

struct StaticOrder {
    int nM, nN, nwg, G, c;
    __host__ __device__ void init(int M, int N, int G_, int c_) { nM = M / BM; nN = N / BM; nwg = nM * nN; G = G_; c = c_; }
    __host__ __device__ bool next(int i, Unit& u) const {
        const long L = (long)i * G + c; if (L >= nwg) return false;
        int wgid = (int)L; { const int q = nwg / NXCD, r = nwg % NXCD, xcd = wgid % NXCD, off = wgid / NXCD; wgid = (xcd < r ? xcd * (q + 1) : r * (q + 1) + (xcd - r) * q) + off; }
        const int nig = WGM * nN, gid = wgid / nig, fm = gid * WGM, gsz = (nM - fm) < WGM ? (nM - fm) : WGM;
        u.pm = fm + ((wgid % nig) % gsz); u.pn = (wgid % nig) / gsz; return true;
    }
    __device__ __forceinline__ void a_ready(const Unit&) const {}
    __device__ __forceinline__ void done(const Unit&) const {}
};
__device__ __forceinline__ unsigned cvt_pk_bf16(float lo, float hi) { unsigned r; asm volatile("v_cvt_pk_bf16_f32 %0, %1, %2" : "=v"(r) : "v"(lo), "v"(hi)); return r; }
typedef float f32x2 __attribute__((ext_vector_type(2)));
template <class Epi, class Sched, bool STAMP = false>
__device__ __forceinline__ void gemm_phase(PG8_LAS unsigned char* lds, const Gemm g, const Sched& S, const Epi& E, unsigned long long* stamps) {
    const int tid = threadIdx.x, wid = __builtin_amdgcn_readfirstlane(tid >> 6), lane = tid & 63, wr = wid >> 2, wc = wid & 3, fr = lane & 15, fq = lane >> 4;
    const int K = g.K, nt = K / BK;
    int ts_lo = 0, ts_hi = 0, nts = 0; const unsigned long long rt_entry = STAMP ? (unsigned long long)wall_clock64() : 0ull;
#define PG8_STAMP() do { if (STAMP && wid == 0 && nts < 64) { const unsigned long long _c = (unsigned long long)clock64(); \
        ts_lo = (lane == nts) ? (int)(unsigned)_c : ts_lo; ts_hi = (lane == nts) ? (int)(unsigned)(_c >> 32) : ts_hi; ++nts; } } while (0)
    PG8_STAMP();
    unsigned voffA[2], voffB[2];
#pragma unroll
    for (int i = 0; i < 2; ++i) { int R, C; stage_rc(tid * 16 + i * 8192, R, C); const int Rb = Epi::PERM ? ((R & ~31) + perm32(R & 31)) : R;
        voffA[i] = (unsigned)(R * K + C) * 2u; voffB[i] = (unsigned)(Rb * K + C) * 2u; }
    const size_t kstep = (size_t)(BK * 2);
    const size_t hstep = (size_t)HALF * K * 2;
    const size_t tstep = 2 * hstep;
    const unsigned ldsw = (unsigned)wid * 1024u;
    const int aoff = lds_byte(wr * 64 + fr, fq * 8), boff = lds_byte(wc * 32 + fr, fq * 8);
#define PG8_SA(b, h) (((b) * 2 + (h)) * HTB)
#define PG8_SB(b, h) ((4 + (b) * 2 + (h)) * HTB)
#define PG8_STAGE(bufoff, gbase, voff) do { _Pragma("unroll") for (int _i = 0; _i < 2; ++_i) \
        __builtin_amdgcn_global_load_lds((const unsigned*)((const char*)(gbase) + (voff)[_i]), (PG8_LAS unsigned*)(lds + (bufoff) + ldsw + _i * 8192), 16, 0, 0); } while (0)
#define PG8_LDA(dst, b, h) do { _Pragma("unroll") for (int m = 0; m < 4; ++m) _Pragma("unroll") for (int k = 0; k < 2; ++k) dst[m][k] = *(const PG8_LAS bf16x8*)(lds + PG8_SA(b, h) + aoff + m * 2048 + k * 1024); } while (0)
#define PG8_LDB(dst, b, h) do { _Pragma("unroll") for (int n = 0; n < 2; ++n) _Pragma("unroll") for (int k = 0; k < 2; ++k) dst[n][k] = *(const PG8_LAS bf16x8*)(lds + PG8_SB(b, h) + boff + n * 2048 + k * 1024); } while (0)
#define PG8_MMA(ai, bj, At, Bt) do { __builtin_amdgcn_s_setprio(1); _Pragma("unroll") for (int m = 0; m < 4; ++m) _Pragma("unroll") for (int n = 0; n < 2; ++n) _Pragma("unroll") for (int k = 0; k < 2; ++k) \
        acc[ai][bj][m][n] = __builtin_amdgcn_mfma_f32_16x16x32_bf16(Bt[n][k], At[m][k], acc[ai][bj][m][n], 0, 0, 0); __builtin_amdgcn_s_setprio(0); } while (0)
#define PG8_WAIT_V(n) asm volatile("s_waitcnt vmcnt(" #n ")" ::: "memory")
#define PG8_WAIT_L(n) asm volatile("s_waitcnt lgkmcnt(" #n ")" ::: "memory")
#define PG8_BAR __builtin_amdgcn_s_barrier()
#define PG8_SCHED __builtin_amdgcn_sched_barrier(0)
    Unit cur, nxt; int ui = 0;
    if (!S.next(0, cur)) return;
    f32x4 acc[2][2][4][2];
#pragma unroll
    for (int a = 0; a < 2; ++a)
#pragma unroll
        for (int b = 0; b < 2; ++b)
#pragma unroll
            for (int m = 0; m < 4; ++m)
#pragma unroll
                for (int n = 0; n < 2; ++n) acc[a][b][m][n] = (f32x4){0.f, 0.f, 0.f, 0.f};
    bf16x8 At[4][2], B0[2][2], B1[2][2];
    const char* cA = (const char*)g.A + (size_t)cur.pm * tstep; const char* cB = (const char*)g.Bt + (size_t)cur.pn * tstep;
    S.a_ready(cur);
    PG8_STAGE(PG8_SB(0, 0), cB, voffB); PG8_STAGE(PG8_SA(0, 0), cA, voffA); PG8_STAGE(PG8_SB(0, 1), cB + hstep, voffB); PG8_STAGE(PG8_SA(0, 1), cA + hstep, voffA);
    if (wr == 1) PG8_BAR;
    PG8_WAIT_V(4); PG8_BAR;
    PG8_STAGE(PG8_SB(1, 0), cB + kstep, voffB); PG8_STAGE(PG8_SA(1, 0), cA + kstep, voffA); PG8_STAGE(PG8_SB(1, 1), cB + hstep + kstep, voffB);
    PG8_WAIT_V(6); PG8_BAR;
    PG8_STAMP();
    for (;;) {
        const bool has_next = S.next(ui + 1, nxt);
        const char* nA = has_next ? (const char*)g.A + (size_t)nxt.pm * tstep : cA; const char* nB = has_next ? (const char*)g.Bt + (size_t)nxt.pn * tstep : cB;
        for (int t = 0; t < nt; t += 2) {
            const bool last = (t == nt - 2);
            const char* a1 = cA + (size_t)(t + 1) * kstep;
            const char* a2 = last ? nA : cA + (size_t)(t + 2) * kstep; const char* b2 = last ? nB : cB + (size_t)(t + 2) * kstep;
            const char* a3 = a2 + kstep; const char* b3 = b2 + kstep;
            if (last && has_next) S.a_ready(nxt);
            PG8_LDB(B0, 0, 0); PG8_SCHED; PG8_LDA(At, 0, 0); PG8_STAGE(PG8_SA(1, 1), a1 + hstep, voffA);
            PG8_WAIT_L(8); PG8_BAR; PG8_WAIT_L(0); PG8_MMA(0, 0, At, B0); PG8_BAR; PG8_SCHED;
            PG8_LDB(B1, 0, 1); PG8_STAGE(PG8_SB(0, 0), b2, voffB);
            PG8_BAR; PG8_WAIT_L(0); PG8_MMA(0, 1, At, B1); PG8_BAR;
            PG8_LDA(At, 0, 1); PG8_STAGE(PG8_SA(0, 0), a2, voffA);
            PG8_BAR; PG8_WAIT_L(0); PG8_MMA(1, 0, At, B0); PG8_BAR; PG8_SCHED;
            PG8_STAGE(PG8_SB(0, 1), b2 + hstep, voffB);
            PG8_WAIT_V(6); PG8_BAR; PG8_MMA(1, 1, At, B1); PG8_BAR;
            PG8_LDB(B0, 1, 0); PG8_SCHED; PG8_LDA(At, 1, 0); PG8_STAGE(PG8_SA(0, 1), a2 + hstep, voffA);
            PG8_WAIT_L(8); PG8_BAR; PG8_WAIT_L(0); PG8_MMA(0, 0, At, B0); PG8_BAR; PG8_SCHED;
            PG8_LDB(B1, 1, 1); PG8_STAGE(PG8_SB(1, 0), b3, voffB);
            PG8_BAR; PG8_WAIT_L(0); PG8_MMA(0, 1, At, B1); PG8_BAR;
            PG8_LDA(At, 1, 1); PG8_STAGE(PG8_SA(1, 0), a3, voffA);
            PG8_BAR; PG8_WAIT_L(0); PG8_MMA(1, 0, At, B0); PG8_BAR; PG8_SCHED;
            PG8_STAGE(PG8_SB(1, 1), b3 + hstep, voffB);
            PG8_WAIT_V(6); PG8_BAR; PG8_MMA(1, 1, At, B1); PG8_BAR;
        }
        PG8_STAMP();
        if constexpr (!Epi::AFTER_DRAIN) { E(acc, cur, wr, wc, fr, fq); S.done(cur); }
        PG8_STAMP();
        if (!has_next) break;
#pragma unroll
        for (int a = 0; a < 2; ++a)
#pragma unroll
            for (int b = 0; b < 2; ++b)
#pragma unroll
                for (int m = 0; m < 4; ++m)
#pragma unroll
                    for (int n = 0; n < 2; ++n) acc[a][b][m][n] = (f32x4){0.f, 0.f, 0.f, 0.f};
        cur = nxt; cA = nA; cB = nB; ++ui;
    }
    PG8_WAIT_V(0);
    if (wr == 0) PG8_BAR;
    PG8_BAR;
    if constexpr (Epi::AFTER_DRAIN) { E.fused(acc, cur, wr, wc, fr, fq, lds, wid, lane); S.done(cur); }
    PG8_STAMP();
    if (STAMP && wid == 0) { stamps[lane] = lane < nts ? (((unsigned long long)(unsigned)ts_hi << 32) | (unsigned)ts_lo) : 0ull;
        if (lane == 62) stamps[62] = rt_entry; if (lane == 63) stamps[63] = (unsigned long long)wall_clock64(); }
#undef PG8_STAMP
#undef PG8_SA
#undef PG8_SB
#undef PG8_STAGE
#undef PG8_LDA
#undef PG8_LDB
#undef PG8_MMA
#undef PG8_WAIT_V
#undef PG8_WAIT_L
#undef PG8_BAR
#undef PG8_SCHED
}
}

#define LAS __attribute__((address_space(3)))
using pg8::bf16_t; using pg8::bf16x8; using pg8::f32x4; using pg8::u32x4; using pg8::Unit;
typedef float f32x16 __attribute__((ext_vector_type(16)));
typedef unsigned u32x2 __attribute__((ext_vector_type(2)));

constexpr int MP = 8192, MS = 1024, MT = 9216, DM = 2048, NZ = 5120, NINP = 5376, DFF = 5632, PLE = 256;
constexpr int LDS_BYTES = 131072;
constexpr size_t OFF_WIN = 0;
constexpr size_t OFF_WOUT = OFF_WIN + (size_t)NINP * DM * 2;
constexpr size_t OFF_WFI = OFF_WOUT + (size_t)DM * DM * 2;
constexpr size_t OFF_WFO = OFF_WFI + (size_t)2 * DFF * DM * 2;
constexpr size_t OFF_WPLE = OFF_WFO + (size_t)DM * DFF * 2;
constexpr size_t OFF_WGT = OFF_WPLE + (size_t)DM * PLE * 2;
constexpr size_t OFF_A0 = OFF_WGT + (size_t)DM * DM * 2;
constexpr size_t OFF_PB = OFF_A0 + (size_t)MT * DM * 2;
constexpr size_t OFF_ALOW = OFF_PB + (size_t)MT * PLE * 2;
constexpr size_t OFF_BIG = OFF_ALOW + (size_t)MT * 16 * 4;
constexpr size_t OFF_Z = OFF_BIG;
constexpr size_t OFF_ORAW = OFF_Z + (size_t)MT * NZ * 2;
constexpr size_t OFF_MRAW = OFF_ORAW + (size_t)MT * 1024 * 4;
constexpr size_t WS_END = OFF_MRAW + (size_t)MT * 1024 * 4;
constexpr size_t OFF_ACT = OFF_BIG;
constexpr size_t OFF_GATEZ = OFF_BIG;
constexpr size_t OFF_PZ = OFF_BIG + (size_t)MT * DM * 4;
constexpr size_t OUT_Y = 0, OUT_SP = (size_t)MT * DM, OUT_SS = OUT_SP + (size_t)4 * 4 * 128 * 256, OUT_VS = OUT_SS + (size_t)128 * 4 * 128 * 256;

struct Params {
    const float *x_prompt, *x_sample, *state_gla, *p_prompt, *p_sample, *g_mix, *w_in, *w_a2, *b_a, *g_gla_norm, *g_gmlp_ln, *b_gmlp_ln, *w_s, *b_s,
        *g_gmlp_out, *w_out, *g_ffn, *w_ffn_in, *w_ffn_out, *w_ple, *g_ple, *g_ple_gate, *w_ple_gate, *g_final;
    float* out;
    unsigned char* ws;
};

__device__ __forceinline__ unsigned pk2(float lo, float hi) { return pg8::cvt_pk_bf16(lo, hi); }
__device__ __forceinline__ bf16_t f2bf(float f) { return (bf16_t)(pk2(f, 0.f) & 0xffffu); }
__device__ __forceinline__ float bf2f(bf16_t b) { return __uint_as_float(((unsigned)b) << 16); }
__device__ __forceinline__ float bflo(unsigned w) { return __uint_as_float(w << 16); }
__device__ __forceinline__ float bfhi(unsigned w) { return __uint_as_float(w & 0xffff0000u); }
template <int CTRL> __device__ __forceinline__ float dpp_f(float v) { return __int_as_float(__builtin_amdgcn_update_dpp(0, __float_as_int(v), CTRL, 0xf, 0xf, true)); }
__device__ __forceinline__ float row16_sum(float v) {
    v += dpp_f<0xB1>(v); v += dpp_f<0x4E>(v); v += dpp_f<0x141>(v); v += dpp_f<0x140>(v); return v;
}
__device__ __forceinline__ float wave_sum(float v) {
    v = row16_sum(v);
    return (__int_as_float(__builtin_amdgcn_readlane(__float_as_int(v), 0)) + __int_as_float(__builtin_amdgcn_readlane(__float_as_int(v), 16))) + (__int_as_float(__builtin_amdgcn_readlane(__float_as_int(v), 32)) + __int_as_float(__builtin_amdgcn_readlane(__float_as_int(v), 48)));
}
__device__ __forceinline__ float sigmoid_f(float x) { return __builtin_amdgcn_rcpf(1.f + __expf(-x)); }
__device__ __forceinline__ float silu_f(float x) { return x * __builtin_amdgcn_rcpf(1.f + __expf(-x)); }
__device__ __forceinline__ float gelu_f(float x) { const float u = 1.5957691216f * (x + 0.044715f * x * x * x); return x * __builtin_amdgcn_rcpf(1.f + __expf(-u)); }
__device__ __forceinline__ float logsigmoid_f(float x) { return fminf(x, 0.f) - __logf(1.f + __expf(-fabsf(x))); }
template <class T> __device__ __forceinline__ T* opaque(T* p) { return p; }
__device__ __forceinline__ const f32x4* row_mid(const float* row, int lane) { return opaque((const f32x4*)row + lane + 256); }
__device__ __forceinline__ f32x4* row_mid(float* row, int lane) { return opaque((f32x4*)row + lane + 256); }
__device__ __forceinline__ void lds_wait() { asm volatile("s_waitcnt lgkmcnt(0)" ::: "memory"); }

struct EpiIn {
    static constexpr bool PERM = true, AFTER_DRAIN = false;
    bf16_t* Z; float* alow;
    __device__ __forceinline__ void operator()(const f32x4 (&acc)[2][2][4][2], const Unit& u, int wr, int wc, int fr, int fq) const {
        const int row0 = u.pm * 256 + wr * 64 + fr, pn = u.pn;
        if (pn == 20) {
            if (wc == 0 && fq < 2) {
#pragma unroll
                for (int ai = 0; ai < 2; ++ai)
#pragma unroll
                    for (int m = 0; m < 4; ++m) { float* p = alow + (size_t)(row0 + ai * 128 + m * 16) * 16 + 8 * fq; *(f32x4*)p = acc[ai][0][m][0]; *(f32x4*)(p + 4) = acc[ai][0][m][1]; }
            }
            return;
        }
        const int kind = pn < 8 ? 0 : (pn < 12 ? 1 : 2); const float qs = pn < 2 ? 0.08838834764831845f : 1.f;
#pragma unroll
        for (int ai = 0; ai < 2; ++ai)
#pragma unroll
            for (int m = 0; m < 4; ++m) { bf16_t* rowp = Z + (size_t)(row0 + ai * 128 + m * 16) * NZ + pn * 256 + wc * 32 + 8 * fq;
#pragma unroll
                for (int bj = 0; bj < 2; ++bj) { f32x4 v0 = acc[ai][bj][m][0], v1 = acc[ai][bj][m][1];
                    if (kind == 0) { v0 *= qs; v1 *= qs; }
                    else if (kind == 1) {
#pragma unroll
                        for (int j = 0; j < 4; ++j) { v0[j] = silu_f(v0[j]); v1[j] = silu_f(v1[j]); } }
                    else {
#pragma unroll
                        for (int j = 0; j < 4; ++j) { v0[j] = gelu_f(v0[j]); v1[j] = gelu_f(v1[j]); } }
                    u32x4 w; w.x = pk2(v0[0], v0[1]); w.y = pk2(v0[2], v0[3]); w.z = pk2(v1[0], v1[1]); w.w = pk2(v1[2], v1[3]);
                    *(u32x4*)(rowp + bj * 128) = w; } }
    }
};
struct EpiRes {
    static constexpr bool PERM = false, AFTER_DRAIN = false;
    const float* res_p; const float* res_s; float* out;
    __device__ __forceinline__ void operator()(const f32x4 (&acc)[2][2][4][2], const Unit& u, int wr, int wc, int fr, int fq) const {
        const int row0 = u.pm * 256 + wr * 64 + fr, col0 = u.pn * 256 + wc * 32 + 4 * fq;
#pragma unroll
        for (int ai = 0; ai < 2; ++ai)
#pragma unroll
            for (int m = 0; m < 4; ++m) { const int row = row0 + ai * 128 + m * 16;
                const float* rp = (row < MP ? res_p + (size_t)row * DM : res_s + (size_t)(row - MP) * DM) + col0; float* op = out + (size_t)row * DM + col0;
#pragma unroll
                for (int bj = 0; bj < 2; ++bj)
#pragma unroll
                    for (int n = 0; n < 2; ++n) { const f32x4 r = *(const f32x4*)(rp + bj * 128 + n * 16); *(f32x4*)(op + bj * 128 + n * 16) = acc[ai][bj][m][n] + r; } }
    }
};
struct EpiSwiglu {
    static constexpr bool PERM = true, AFTER_DRAIN = false;
    bf16_t* act;
    __device__ __forceinline__ void operator()(const f32x4 (&acc)[2][2][4][2], const Unit& u, int wr, int wc, int fr, int fq) const {
        const int row0 = u.pm * 256 + wr * 64 + fr, col0 = u.pn * 128 + wc * 32 + 8 * fq;
#pragma unroll
        for (int ai = 0; ai < 2; ++ai)
#pragma unroll
            for (int m = 0; m < 4; ++m) { float a[8];
#pragma unroll
                for (int n = 0; n < 2; ++n)
#pragma unroll
                    for (int j = 0; j < 4; ++j) a[n * 4 + j] = silu_f(acc[ai][0][m][n][j]) * acc[ai][1][m][n][j];
                u32x4 w; w.x = pk2(a[0], a[1]); w.y = pk2(a[2], a[3]); w.z = pk2(a[4], a[5]); w.w = pk2(a[6], a[7]);
                *(u32x4*)(act + (size_t)(row0 + ai * 128 + m * 16) * DFF + col0) = w; }
    }
};
struct EpiPlain {
    static constexpr bool PERM = false, AFTER_DRAIN = false;
    float* out;
    __device__ __forceinline__ void operator()(const f32x4 (&acc)[2][2][4][2], const Unit& u, int wr, int wc, int fr, int fq) const {
        const int row0 = u.pm * 256 + wr * 64 + fr, col0 = u.pn * 256 + wc * 32 + 4 * fq;
#pragma unroll
        for (int ai = 0; ai < 2; ++ai)
#pragma unroll
            for (int m = 0; m < 4; ++m) { float* op = out + (size_t)(row0 + ai * 128 + m * 16) * DM + col0;
#pragma unroll
                for (int bj = 0; bj < 2; ++bj)
#pragma unroll
                    for (int n = 0; n < 2; ++n) *(f32x4*)(op + bj * 128 + n * 16) = acc[ai][bj][m][n]; }
    }
};

template <class Epi> __device__ __forceinline__ void run_gemm(LAS unsigned char* lds, const bf16_t* A, const bf16_t* Bt, int N, int K, const Epi& E) {
    pg8::Gemm g; g.A = A; g.Bt = Bt; g.M = MT; g.N = N; g.K = K;
    pg8::StaticOrder S; S.init(MT, N, (int)gridDim.x, (int)blockIdx.x);
    pg8::gemm_phase<Epi, pg8::StaticOrder, false>(lds, g, S, E, nullptr);
}

__device__ __forceinline__ void transpose_item(const float* W, int N, bf16_t* WT, int K, int k0, int n0_dst, int n0_src, int nvalid, LAS float* scr, int lane) {
    const int j = lane & 31;
#pragma unroll 8
    for (int i = 0; i < 32; ++i) { const int kk = 2 * i + (lane >> 5); scr[kk * 33 + j] = (j < nvalid) ? W[(size_t)(k0 + kk) * N + n0_src + j] : 0.f; }
    lds_wait();
    const int c = lane & 7;
#pragma unroll
    for (int q = 0; q < 4; ++q) { const int n = (lane >> 3) + 8 * q; const LAS float* s = scr + (8 * c) * 33 + n;
        u32x4 o; o.x = pk2(s[0 * 33], s[1 * 33]); o.y = pk2(s[2 * 33], s[3 * 33]); o.z = pk2(s[4 * 33], s[5 * 33]); o.w = pk2(s[6 * 33], s[7 * 33]);
        *(u32x4*)(WT + (size_t)(n0_dst + n) * K + k0 + 8 * c) = o; }
    lds_wait();
}
__device__ __forceinline__ void rms_row_bf16(const float* src, const float* gain, bf16_t* dst, int lane) {
    f32x4 v[8]; float s = 0.f; const f32x4* sm = row_mid(src, lane); const f32x4* gm = row_mid(gain, lane);
#pragma unroll
    for (int j = 0; j < 8; ++j) { v[j] = sm[64 * (j - 4)]; s += (v[j][0] * v[j][0] + v[j][1] * v[j][1]) + (v[j][2] * v[j][2] + v[j][3] * v[j][3]); }
    const float rinv = rsqrtf(wave_sum(s) * (1.f / DM) + 1e-6f);
    u32x2* dm = opaque((u32x2*)dst + lane);
#pragma unroll
    for (int j = 0; j < 8; ++j) { const f32x4 g = gm[64 * (j - 4)]; u32x2 o; o.x = pk2(v[j][0] * rinv * g[0], v[j][1] * rinv * g[1]); o.y = pk2(v[j][2] * rinv * g[2], v[j][3] * rinv * g[3]);
        dm[64 * j] = o; }
}
__device__ __forceinline__ void phase0(const Params& p, LAS unsigned char* lds) {
    const int tid = threadIdx.x, lane = tid & 63, wave = tid >> 6;
    const int gw = blockIdx.x * 8 + wave, NGW = gridDim.x * 8;
    LAS float* scr = (LAS float*)(lds + wave * 8448);
    bf16_t* win = (bf16_t*)(p.ws + OFF_WIN); bf16_t* wout = (bf16_t*)(p.ws + OFF_WOUT); bf16_t* wfi = (bf16_t*)(p.ws + OFF_WFI);
    bf16_t* wfo = (bf16_t*)(p.ws + OFF_WFO); bf16_t* wple = (bf16_t*)(p.ws + OFF_WPLE); bf16_t* wgt = (bf16_t*)(p.ws + OFF_WGT);
    constexpr int I_IN = (DM / 64) * (NINP / 32), I_OUT = (DM / 64) * (DM / 32), I_FI = (DM / 64) * (2 * DFF / 32), I_FO = (DFF / 64) * (DM / 32), I_PLE = (PLE / 64) * (DM / 32), I_GT = I_OUT;
    constexpr int NITEMS = I_IN + I_OUT + I_FI + I_FO + I_PLE + I_GT;
    for (int it = gw; it < NITEMS; it += NGW) {
        int r = it;
        if (r < I_IN) { const int nblk = NINP / 32, kb = r / nblk, nb = r % nblk, n0d = nb * 32; int src, nv;
            if (n0d < 3072) { src = n0d; nv = 32; } else if (n0d < 5120) { src = n0d + 16; nv = 32; } else if (n0d == 5120) { src = 3072; nv = 16; } else { src = 0; nv = 0; }
            transpose_item(p.w_in, 5136, win, DM, kb * 64, n0d, src, nv, scr, lane); continue; }
        r -= I_IN;
        if (r < I_OUT) { const int nblk = DM / 32, kb = r / nblk, nb = r % nblk; transpose_item(p.w_out, DM, wout, DM, kb * 64, nb * 32, nb * 32, 32, scr, lane); continue; }
        r -= I_OUT;
        if (r < I_FI) { const int nblk = 2 * DFF / 32, kb = r / nblk, nb = r % nblk, n0d = nb * 32, jb = n0d >> 8, within = n0d & 255, up = within >> 7, j0 = jb * 128 + (within & 127);
            transpose_item(p.w_ffn_in, 2 * DFF, wfi, DM, kb * 64, n0d, up * DFF + j0, 32, scr, lane); continue; }
        r -= I_FI;
        if (r < I_FO) { const int nblk = DM / 32, kb = r / nblk, nb = r % nblk; transpose_item(p.w_ffn_out, DM, wfo, DFF, kb * 64, nb * 32, nb * 32, 32, scr, lane); continue; }
        r -= I_FO;
        if (r < I_PLE) { const int nblk = DM / 32, kb = r / nblk, nb = r % nblk; transpose_item(p.w_ple, DM, wple, PLE, kb * 64, nb * 32, nb * 32, 32, scr, lane); continue; }
        r -= I_PLE;
        { const int nblk = DM / 32, kb = r / nblk, nb = r % nblk; transpose_item(p.w_ple_gate, DM, wgt, DM, kb * 64, nb * 32, nb * 32, 32, scr, lane); }
    }
    bf16_t* a0 = (bf16_t*)(p.ws + OFF_A0); bf16_t* pb = (bf16_t*)(p.ws + OFF_PB);
    for (int r = gw; r < MT; r += NGW) {
        const float* xr = r < MP ? p.x_prompt + (size_t)r * DM : p.x_sample + (size_t)(r - MP) * DM;
        rms_row_bf16(xr, p.g_mix, a0 + (size_t)r * DM, lane);
        const float* pr = r < MP ? p.p_prompt + (size_t)r * PLE : p.p_sample + (size_t)(r - MP) * PLE;
        const f32x4 v = ((const f32x4*)pr)[lane]; u32x2 o; o.x = pk2(v[0], v[1]); o.y = pk2(v[2], v[3]); ((u32x2*)(pb + (size_t)r * PLE))[lane] = o;
    }
}

__device__ __forceinline__ f32x16 mfma32(bf16x8 a, bf16x8 b, f32x16 c) { return __builtin_amdgcn_mfma_f32_32x32x16_bf16(a, b, c, 0, 0, 0); }
__device__ __forceinline__ void mma32(f32x16& acc, const LAS bf16_t* A, int lda, const LAS bf16_t* B, int ldb, int kk, int lane) {
    const int r = lane & 31, h = lane >> 5; const LAS bf16_t* ap = A + r * lda + 8 * h; const LAS bf16_t* bp = B + r * ldb + 8 * h;
    for (int k = 0; k < kk; k += 16) { const bf16x8 a = *(const LAS bf16x8*)(ap + k); const bf16x8 b = *(const LAS bf16x8*)(bp + k); acc = mfma32(a, b, acc); }
}
constexpr int LQ = 136, LS = 72;
constexpr int G_QE = 0, G_QM = 17408, G_KM = 34816, G_ST = 52224, G_KLT = 69632, G_VT = 88064, G_ATT = 97280, G_ALOW = 106496, G_GSUM = 110592, G_BMID = 112640, G_BLAST = 113152;

__device__ __forceinline__ void gla_item(const Params& p, LAS unsigned char* lds, int rowbase, int h, int slice, int nchunks, int T, const float* S0, float* Sout) {
    const int tid = threadIdx.x, lane = tid & 63, wave = tid >> 6;
    const bf16_t* Z = (const bf16_t*)(p.ws + OFF_Z); const float* alowg = (const float*)(p.ws + OFF_ALOW); float* oraw = (float*)(p.ws + OFF_ORAW);
    LAS bf16_t* Qe = (LAS bf16_t*)(lds + G_QE); LAS bf16_t* Qm = (LAS bf16_t*)(lds + G_QM); LAS bf16_t* Km = (LAS bf16_t*)(lds + G_KM); LAS bf16_t* ST = (LAS bf16_t*)(lds + G_ST);
    LAS bf16_t* KlT = (LAS bf16_t*)(lds + G_KLT); LAS bf16_t* VT = (LAS bf16_t*)(lds + G_VT); LAS bf16_t* ATT = (LAS bf16_t*)(lds + G_ATT);
    LAS float* alowL = (LAS float*)(lds + G_ALOW); LAS float* gsum = (LAS float*)(lds + G_GSUM); LAS float* bmidL = (LAS float*)(lds + G_BMID); LAS float* blastL = (LAS float*)(lds + G_BLAST);
    const int c = tid & 127, tg = tid >> 7;
    float wa[16];
#pragma unroll
    for (int j = 0; j < 16; ++j) wa[j] = p.w_a2[j * 512 + h * 128 + c];
    const float ba = p.b_a[h * 128 + c];
    const int cblk = wave >> 1, vblk = wave & 1, l31 = lane & 31, hh = lane >> 5;
    f32x16 S;
    if (S0) {
#pragma unroll
        for (int i = 0; i < 16; ++i) S[i] = S0[(size_t)(cblk * 32 + (i & 3) + 8 * (i >> 2) + 4 * hh) * 256 + slice * 64 + vblk * 32 + l31];
    } else {
#pragma unroll
        for (int i = 0; i < 16; ++i) S[i] = 0.f;
    }
    for (int ch = 0; ch < nchunks; ++ch) {
        const int rb = rowbase + ch * 64;
        for (int idx = tid; idx < 1024; idx += 512) { const int t = idx >> 4; alowL[idx] = (t < T) ? alowg[(size_t)(rb + t) * 16 + (idx & 15)] : 0.f; }
        float qv[16], kv[16];
#pragma unroll
        for (int i = 0; i < 16; ++i) { const int t = tg * 16 + i; const bool ok = t < T; const bf16_t* zr = Z + (size_t)(rb + t) * NZ + h * 128 + c;
            qv[i] = ok ? bf2f(zr[0]) : 0.f; kv[i] = ok ? bf2f(zr[512]) : 0.f; }
        const int vs_ = tid & 63, v8 = (tid >> 6) * 8;
        u32x4 vraw = (u32x4){0u, 0u, 0u, 0u};
        if (vs_ < T) vraw = *(const u32x4*)(Z + (size_t)(rb + vs_) * NZ + 1024 + h * 256 + slice * 64 + v8);
        __syncthreads();
        float b[16]; float run = 0.f;
#pragma unroll
        for (int i = 0; i < 16; ++i) { const int t = tg * 16 + i; float pre = ba;
#pragma unroll
            for (int j4 = 0; j4 < 4; ++j4) { const f32x4 a4 = *(const LAS f32x4*)(alowL + t * 16 + j4 * 4); pre += a4[0] * wa[j4 * 4] + a4[1] * wa[j4 * 4 + 1] + a4[2] * wa[j4 * 4 + 2] + a4[3] * wa[j4 * 4 + 3]; }
            const float la = (t < T) ? logsigmoid_f(pre) * 0.0625f : 0.f; run += la; b[i] = run; }
        gsum[tg * 128 + c] = run;
        __syncthreads();
        const float g0 = gsum[c], g1 = gsum[128 + c], g2 = gsum[256 + c], g3 = gsum[384 + c];
        const float pref = tg == 0 ? 0.f : (tg == 1 ? g0 : (tg == 2 ? g0 + g1 : g0 + g1 + g2));
        const float blast = ((g0 + g1) + g2) + g3;
#pragma unroll
        for (int i = 0; i < 16; ++i) b[i] += pref;
        if (tg == 2) bmidL[c] = b[0];
        if (tg == 0) blastL[c] = blast;
        __syncthreads();
        const float bm = bmidL[c];
        {
            unsigned klp[8];
#pragma unroll
            for (int i = 0; i < 16; i += 2) {
                const int t = tg * 16 + i;
                const float e0 = __expf(b[i]), e1 = __expf(b[i + 1]);
                Qe[t * LQ + c] = f2bf(qv[i] * e0); Qe[(t + 1) * LQ + c] = f2bf(qv[i + 1] * e1);
                Qm[t * LQ + c] = f2bf(qv[i] * __expf(b[i] - bm)); Qm[(t + 1) * LQ + c] = f2bf(qv[i + 1] * __expf(b[i + 1] - bm));
                Km[t * LQ + c] = f2bf(kv[i] * __expf(bm - b[i])); Km[(t + 1) * LQ + c] = f2bf(kv[i + 1] * __expf(bm - b[i + 1]));
                klp[i >> 1] = pk2(kv[i] * __expf(blast - b[i]), kv[i + 1] * __expf(blast - b[i + 1]));
            }
            LAS u32x4* kd = (LAS u32x4*)(KlT + c * LS + tg * 16);
            kd[0] = (u32x4){klp[0], klp[1], klp[2], klp[3]}; kd[1] = (u32x4){klp[4], klp[5], klp[6], klp[7]};
            VT[(v8 + 0) * LS + vs_] = (bf16_t)(vraw.x & 0xffffu); VT[(v8 + 1) * LS + vs_] = (bf16_t)(vraw.x >> 16);
            VT[(v8 + 2) * LS + vs_] = (bf16_t)(vraw.y & 0xffffu); VT[(v8 + 3) * LS + vs_] = (bf16_t)(vraw.y >> 16);
            VT[(v8 + 4) * LS + vs_] = (bf16_t)(vraw.z & 0xffffu); VT[(v8 + 5) * LS + vs_] = (bf16_t)(vraw.z >> 16);
            VT[(v8 + 6) * LS + vs_] = (bf16_t)(vraw.w & 0xffffu); VT[(v8 + 7) * LS + vs_] = (bf16_t)(vraw.w >> 16);
#pragma unroll
            for (int g = 0; g < 4; ++g) { u32x2 w; w.x = pk2(S[4 * g], S[4 * g + 1]); w.y = pk2(S[4 * g + 2], S[4 * g + 3]);
                *(LAS u32x2*)(ST + (vblk * 32 + l31) * LQ + cblk * 32 + 8 * g + 4 * hh) = w; }
        }
        __syncthreads();
        f32x16 o;
#pragma unroll
        for (int i = 0; i < 16; ++i) o[i] = 0.f;
        const int w4 = wave & 3, t_i = w4 >> 1, v_i = w4 & 1;
        if (wave < 4) {
            const int si = w4 >> 1, ti = w4 & 1;
            if (si <= ti) {
                mma32(o, Km + si * 32 * LQ, LQ, Qm + ti * 32 * LQ, LQ, 128, lane);
                const int tl = ti * 32 + l31;
#pragma unroll
                for (int g = 0; g < 4; ++g) { const int s0 = si * 32 + 8 * g + 4 * hh; float a0 = o[4 * g], a1 = o[4 * g + 1], a2 = o[4 * g + 2], a3 = o[4 * g + 3];
                    a0 = (s0 <= tl) ? a0 : 0.f; a1 = (s0 + 1 <= tl) ? a1 : 0.f; a2 = (s0 + 2 <= tl) ? a2 : 0.f; a3 = (s0 + 3 <= tl) ? a3 : 0.f;
                    u32x2 w; w.x = pk2(a0, a1); w.y = pk2(a2, a3); *(LAS u32x2*)(ATT + tl * LS + s0) = w; }
            }
        } else {
            mma32(o, Qe + t_i * 32 * LQ, LQ, ST + v_i * 32 * LQ, LQ, 128, lane);
        }
        {
#pragma unroll
            for (int g = 0; g < 4; ++g) { const f32x4 bl = *(const LAS f32x4*)(blastL + cblk * 32 + 8 * g + 4 * hh);
                S[4 * g] *= __expf(bl[0]); S[4 * g + 1] *= __expf(bl[1]); S[4 * g + 2] *= __expf(bl[2]); S[4 * g + 3] *= __expf(bl[3]); }
            mma32(S, KlT + cblk * 32 * LS, LS, VT + vblk * 32 * LS, LS, 64, lane);
        }
        __syncthreads();
        if (wave >= 4) {
            mma32(o, ATT + t_i * 32 * LS, LS, VT + v_i * 32 * LS, LS, (t_i + 1) * 32, lane);
#pragma unroll
            for (int i = 0; i < 16; ++i) { const int t = t_i * 32 + (i & 3) + 8 * (i >> 2) + 4 * hh;
                if (t < T) oraw[(size_t)(rb + t) * 1024 + h * 256 + slice * 64 + v_i * 32 + l31] = o[i]; }
        }
    }
#pragma unroll
    for (int i = 0; i < 16; ++i) Sout[(size_t)(cblk * 32 + (i & 3) + 8 * (i >> 2) + 4 * hh) * 256 + slice * 64 + vblk * 32 + l31] = S[i];
    __syncthreads();
}

constexpr int M_W = 0, M_V = 34816, M_STAT = 69632;
__device__ __forceinline__ void gmlp_item(const Params& p, LAS unsigned char* lds, int rowbase, int T, int g, float* vs_out) {
    const int tid = threadIdx.x, lane = tid & 63, wave = tid >> 6;
    const bf16_t* Z = (const bf16_t*)(p.ws + OFF_Z); float* mraw = (float*)(p.ws + OFF_MRAW);
    LAS bf16_t* LW = (LAS bf16_t*)(lds + M_W); LAS bf16_t* LV = (LAS bf16_t*)(lds + M_V); LAS float* stat = (LAS float*)(lds + M_STAT);
    for (int i = 0; i < 16; ++i) { const int t = wave * 16 + i; float mean = 0.f, rstd = 0.f;
        if (t < T) { const bf16_t* zr = Z + (size_t)(rowbase + t) * NZ + 4096; const u32x4 r0 = *(const u32x4*)(zr + lane * 8), r1 = *(const u32x4*)(zr + 512 + lane * 8);
            float x[16] = {bflo(r0.x), bfhi(r0.x), bflo(r0.y), bfhi(r0.y), bflo(r0.z), bfhi(r0.z), bflo(r0.w), bfhi(r0.w), bflo(r1.x), bfhi(r1.x), bflo(r1.y), bfhi(r1.y), bflo(r1.z), bfhi(r1.z), bflo(r1.w), bfhi(r1.w)};
            float s = 0.f;
#pragma unroll
            for (int j = 0; j < 16; ++j) s += x[j];
            mean = wave_sum(s) * (1.f / 1024.f); float q = 0.f;
#pragma unroll
            for (int j = 0; j < 16; ++j) { const float d = x[j] - mean; q += d * d; }
            rstd = rsqrtf(wave_sum(q) * (1.f / 1024.f) + 1e-6f); }
        if (lane == 0) { stat[2 * t] = mean; stat[2 * t + 1] = rstd; } }
    for (int idx = tid; idx < 4096; idx += 512) { const int t = idx >> 5, s4 = (idx & 31) * 4; const f32x4 w = *(const f32x4*)(p.w_s + ((size_t)g * 128 + t) * 128 + s4);
        u32x2 o; o.x = pk2(s4 <= t ? w[0] : 0.f, s4 + 1 <= t ? w[1] : 0.f); o.y = pk2(s4 + 2 <= t ? w[2] : 0.f, s4 + 3 <= t ? w[3] : 0.f);
        *(LAS u32x2*)(LW + t * LQ + s4) = o; }
    __syncthreads();
    { const int s = tid & 127, dq = tid >> 7; const float mean = stat[2 * s], rstd = stat[2 * s + 1];
#pragma unroll
        for (int ps = 0; ps < 4; ++ps) { const int d8 = (dq * 4 + ps) * 8; float vn[8];
            if (s < T) { const u32x4 r = *(const u32x4*)(Z + (size_t)(rowbase + s) * NZ + 4096 + g * 128 + d8);
                const float x[8] = {bflo(r.x), bfhi(r.x), bflo(r.y), bfhi(r.y), bflo(r.z), bfhi(r.z), bflo(r.w), bfhi(r.w)};
                const f32x4 ga = *(const f32x4*)(p.g_gmlp_ln + g * 128 + d8), gb = *(const f32x4*)(p.g_gmlp_ln + g * 128 + d8 + 4);
                const f32x4 ba = *(const f32x4*)(p.b_gmlp_ln + g * 128 + d8), bb = *(const f32x4*)(p.b_gmlp_ln + g * 128 + d8 + 4);
#pragma unroll
                for (int j = 0; j < 4; ++j) { vn[j] = (x[j] - mean) * rstd * ga[j] + ba[j]; vn[4 + j] = (x[4 + j] - mean) * rstd * gb[j] + bb[j]; }
                if (vs_out) { float* vp = vs_out + (size_t)s * 1024 + g * 128 + d8; *(f32x4*)vp = (f32x4){vn[0], vn[1], vn[2], vn[3]}; *(f32x4*)(vp + 4) = (f32x4){vn[4], vn[5], vn[6], vn[7]}; }
            } else {
#pragma unroll
                for (int j = 0; j < 8; ++j) vn[j] = 0.f;
            }
#pragma unroll
            for (int j = 0; j < 8; ++j) LV[(d8 + j) * LQ + s] = f2bf(vn[j]); } }
    __syncthreads();
#pragma unroll 1
    for (int q = 0; q < 2; ++q) { const int id = wave * 2 + q, ti = id >> 2, di = id & 3;
        if (ti * 32 < T) { f32x16 acc;
#pragma unroll
            for (int i = 0; i < 16; ++i) acc[i] = 0.f;
            mma32(acc, LW + ti * 32 * LQ, LQ, LV + di * 32 * LQ, LQ, (ti + 1) * 32, lane);
            const int d = di * 32 + (lane & 31);
#pragma unroll
            for (int i = 0; i < 16; ++i) { const int t = ti * 32 + (i & 3) + 8 * (i >> 2) + 4 * (lane >> 5);
                if (t < T) { const float uval = bf2f(Z[(size_t)(rowbase + t) * NZ + 3072 + g * 128 + d]);
                    mraw[(size_t)(rowbase + t) * 1024 + g * 128 + d] = uval * (acc[i] + p.b_s[g * 128 + t]); } } } }
    __syncthreads();
}

__device__ __forceinline__ void phase2(const Params& p, LAS unsigned char* lds) {
    const int nb = gridDim.x, bid = blockIdx.x;
    constexpr int NLONG = 64, N_GP = 512, N_GS = 2048, N_MS = 1024;
    const int nlb = nb > 2 * NLONG ? NLONG : (nb > 1 ? nb / 2 : 0);
    if (bid < nlb || nlb == 0) {
        for (int j = (nlb ? bid : 0); j < NLONG; j += (nlb ? nlb : 1)) { const int chain = j >> 2, slice = j & 3, b = chain >> 2, h = chain & 3;
            gla_item(p, lds, b * 2048, h, slice, 32, 64, nullptr, p.out + OUT_SP + (size_t)chain * 32768); }
    }
    if (bid >= nlb) {
        const int ob = bid - nlb, onb = nb - nlb;
        for (int j = ob; j < N_GP + N_GS + N_MS; j += onb) {
            if (j < N_GP) { gmlp_item(p, lds, (j >> 3) * 128, 128, j & 7, nullptr); }
            else if (j < N_GP + N_GS) { const int k = j - N_GP, chain = k >> 2, slice = k & 3, b = chain >> 2, h = chain & 3;
                gla_item(p, lds, MP + b * 8, h, slice, 1, 8, p.state_gla + (size_t)chain * 32768, p.out + OUT_SS + (size_t)chain * 32768); }
            else { const int k = j - N_GP - N_GS, b = k >> 3; gmlp_item(p, lds, MP + b * 8, 8, k & 7, p.out + OUT_VS + (size_t)b * 8 * 1024); }
        }
    }
}

__device__ __forceinline__ void phase2b(const Params& p) {
    const int lane = threadIdx.x & 63, gw = blockIdx.x * 8 + (threadIdx.x >> 6), NGW = gridDim.x * 8;
    const bf16_t* Z = (const bf16_t*)(p.ws + OFF_Z); const float* oraw = (const float*)(p.ws + OFF_ORAW); const float* mraw = (const float*)(p.ws + OFF_MRAW); bf16_t* cat = (bf16_t*)(p.ws + OFF_A0);
    for (int r = gw; r < MT; r += NGW) {
        const int col = lane * 16;
        { f32x4 v[4]; float s = 0.f;
#pragma unroll
            for (int j = 0; j < 4; ++j) { v[j] = *(const f32x4*)(oraw + (size_t)r * 1024 + col + 4 * j); s += (v[j][0] * v[j][0] + v[j][1] * v[j][1]) + (v[j][2] * v[j][2] + v[j][3] * v[j][3]); }
            s = row16_sum(s);
            const float rinv = rsqrtf(s * (1.f / 256.f) + 1e-6f);
            const u32x4 r0 = *(const u32x4*)(Z + (size_t)r * NZ + 2048 + col), r1 = *(const u32x4*)(Z + (size_t)r * NZ + 2048 + col + 8);
            const float sr[16] = {bflo(r0.x), bfhi(r0.x), bflo(r0.y), bfhi(r0.y), bflo(r0.z), bfhi(r0.z), bflo(r0.w), bfhi(r0.w), bflo(r1.x), bfhi(r1.x), bflo(r1.y), bfhi(r1.y), bflo(r1.z), bfhi(r1.z), bflo(r1.w), bfhi(r1.w)};
            unsigned w[8];
#pragma unroll
            for (int j = 0; j < 4; ++j) { const f32x4 g = *(const f32x4*)(p.g_gla_norm + col + 4 * j);
                w[2 * j] = pk2(v[j][0] * rinv * g[0] * sr[4 * j], v[j][1] * rinv * g[1] * sr[4 * j + 1]); w[2 * j + 1] = pk2(v[j][2] * rinv * g[2] * sr[4 * j + 2], v[j][3] * rinv * g[3] * sr[4 * j + 3]); }
            u32x4* dp = (u32x4*)(cat + (size_t)r * DM + col); dp[0] = (u32x4){w[0], w[1], w[2], w[3]}; dp[1] = (u32x4){w[4], w[5], w[6], w[7]}; }
        { f32x4 v[4]; float s = 0.f;
#pragma unroll
            for (int j = 0; j < 4; ++j) { v[j] = *(const f32x4*)(mraw + (size_t)r * 1024 + col + 4 * j); s += (v[j][0] * v[j][0] + v[j][1] * v[j][1]) + (v[j][2] * v[j][2] + v[j][3] * v[j][3]); }
            const float rinv = rsqrtf(wave_sum(s) * (1.f / 1024.f) + 1e-6f);
            unsigned w[8];
#pragma unroll
            for (int j = 0; j < 4; ++j) { const f32x4 g = *(const f32x4*)(p.g_gmlp_out + col + 4 * j);
                w[2 * j] = pk2(v[j][0] * rinv * g[0], v[j][1] * rinv * g[1]); w[2 * j + 1] = pk2(v[j][2] * rinv * g[2], v[j][3] * rinv * g[3]); }
            u32x4* dp = (u32x4*)(cat + (size_t)r * DM + 1024 + col); dp[0] = (u32x4){w[0], w[1], w[2], w[3]}; dp[1] = (u32x4){w[4], w[5], w[6], w[7]}; }
    }
}
__device__ __forceinline__ void phase_norm(const Params& p, const float* gain) {
    const int lane = threadIdx.x & 63, gw = blockIdx.x * 8 + (threadIdx.x >> 6), NGW = gridDim.x * 8; bf16_t* a0 = (bf16_t*)(p.ws + OFF_A0);
    for (int r = gw; r < MT; r += NGW) rms_row_bf16(p.out + OUT_Y + (size_t)r * DM, gain, a0 + (size_t)r * DM, lane);
}
__device__ __forceinline__ void phase7(const Params& p) {
    const int lane = threadIdx.x & 63, gw = blockIdx.x * 8 + (threadIdx.x >> 6), NGW = gridDim.x * 8;
    const float* gz = (const float*)(p.ws + OFF_GATEZ); const float* pz = (const float*)(p.ws + OFF_PZ);
#pragma unroll 1
    for (int r = gw; r < MT; r += NGW) {
        f32x4 v[8]; float s = 0.f;
        const f32x4* pm = row_mid(pz + (size_t)r * DM, lane);
#pragma unroll
        for (int j = 0; j < 8; ++j) { v[j] = pm[64 * (j - 4)]; s += (v[j][0] * v[j][0] + v[j][1] * v[j][1]) + (v[j][2] * v[j][2] + v[j][3] * v[j][3]); }
        const float rp = rsqrtf(wave_sum(s) * (1.f / DM) + 1e-6f); float s3 = 0.f;
        f32x4* om = row_mid(p.out + OUT_Y + (size_t)r * DM, lane); const f32x4* zm = row_mid(gz + (size_t)r * DM, lane); const f32x4* gpm = row_mid(p.g_ple, lane);
#pragma unroll
        for (int j = 0; j < 8; ++j) { const f32x4 g = gpm[64 * (j - 4)], hh = om[64 * (j - 4)], z = zm[64 * (j - 4)];
#pragma unroll
            for (int k = 0; k < 4; ++k) { const float h3 = hh[k] + v[j][k] * rp * g[k] * sigmoid_f(z[k]); v[j][k] = h3; s3 += h3 * h3; } }
        const float r3 = rsqrtf(wave_sum(s3) * (1.f / DM) + 1e-6f);
        const f32x4* gfm = row_mid(p.g_final, lane);
#pragma unroll
        for (int j = 0; j < 8; ++j) { const f32x4 g = gfm[64 * (j - 4)]; om[64 * (j - 4)] = (f32x4){v[j][0] * r3 * g[0], v[j][1] * r3 * g[1], v[j][2] * r3 * g[2], v[j][3] * r3 * g[3]}; }
    }
}

__global__ void __launch_bounds__(512, 2) fwd_kernel(Params p) {
    extern __shared__ __attribute__((aligned(16))) unsigned char shm[];
    LAS unsigned char* lds = (LAS unsigned char*)shm;
    cg::grid_group grid = cg::this_grid();
    bf16_t* a0 = (bf16_t*)(p.ws + OFF_A0);
    phase0(p, lds);
    grid.sync();
    { EpiIn E; E.Z = (bf16_t*)(p.ws + OFF_Z); E.alow = (float*)(p.ws + OFF_ALOW); run_gemm(lds, a0, (const bf16_t*)(p.ws + OFF_WIN), NINP, DM, E); }
    grid.sync();
    phase2(p, lds);
    grid.sync();
    phase2b(p);
    grid.sync();
    { EpiRes E; E.res_p = p.x_prompt; E.res_s = p.x_sample; E.out = p.out + OUT_Y; run_gemm(lds, a0, (const bf16_t*)(p.ws + OFF_WOUT), DM, DM, E); }
    grid.sync();
    phase_norm(p, p.g_ffn);
    grid.sync();
    { EpiSwiglu E; E.act = (bf16_t*)(p.ws + OFF_ACT); run_gemm(lds, a0, (const bf16_t*)(p.ws + OFF_WFI), 2 * DFF, DM, E); }
    grid.sync();
    { EpiRes E; E.res_p = p.out + OUT_Y; E.res_s = p.out + OUT_Y + (size_t)MP * DM; E.out = p.out + OUT_Y; run_gemm(lds, (const bf16_t*)(p.ws + OFF_ACT), (const bf16_t*)(p.ws + OFF_WFO), DM, DFF, E); }
    grid.sync();
    phase_norm(p, p.g_ple_gate);
    grid.sync();
    { EpiPlain E; E.out = (float*)(p.ws + OFF_GATEZ); run_gemm(lds, a0, (const bf16_t*)(p.ws + OFF_WGT), DM, DM, E); }
    { EpiPlain E; E.out = (float*)(p.ws + OFF_PZ); pg8::Gemm g; g.A = (const bf16_t*)(p.ws + OFF_PB); g.Bt = (const bf16_t*)(p.ws + OFF_WPLE); g.M = MT; g.N = DM; g.K = PLE;
      pg8::StaticOrder S; S.init(MT, DM, (int)gridDim.x, (int)((blockIdx.x + 32) % gridDim.x)); pg8::gemm_phase<EpiPlain, pg8::StaticOrder, false>(lds, g, S, E, nullptr); }
    grid.sync();
    phase7(p);
}

extern "C" void kernel_launch(void* const* d_in, const int* in_sizes, int n_in, void* d_out, int out_size, void* d_ws, size_t ws_size, hipStream_t stream) {
    static int grid = 0;
    if (grid == 0) {
        if (n_in != 24 || ws_size < WS_END) { fprintf(stderr, "kernel_launch: unexpected n_in %d or ws_size %zu (< %zu)\n", n_in, ws_size, (size_t)WS_END); grid = -1; return; }
        int dev = 0, cus = 0, per_cu = 0;
        if (hipGetDevice(&dev) != hipSuccess || hipDeviceGetAttribute(&cus, hipDeviceAttributeMultiprocessorCount, dev) != hipSuccess) { grid = -1; return; }
        if (hipFuncSetAttribute((const void*)fwd_kernel, hipFuncAttributeMaxDynamicSharedMemorySize, LDS_BYTES) != hipSuccess) { fprintf(stderr, "kernel_launch: hipFuncSetAttribute failed\n"); grid = -1; return; }
        if (hipOccupancyMaxActiveBlocksPerMultiprocessor(&per_cu, (const void*)fwd_kernel, 512, LDS_BYTES) != hipSuccess || per_cu < 1) { fprintf(stderr, "kernel_launch: occupancy query says %d blocks per CU\n", per_cu); grid = -1; (void)hipGetLastError(); return; }
        grid = cus;
    }
    if (grid < 0) return;
    Params p{};
    const float** f = (const float**)&p;
    for (int i = 0; i < 24; ++i) f[i] = (const float*)d_in[i];
    p.out = (float*)d_out; p.ws = (unsigned char*)d_ws;
    void* args[] = {&p};
    hipError_t e = hipLaunchCooperativeKernel((const void*)fwd_kernel, dim3(grid), dim3(512), args, LDS_BYTES, stream);
    if (e != hipSuccess) fprintf(stderr, "cooperative launch failed: %s (grid %d)\n", hipGetErrorString(e), grid);
}
```

```cpp
#include <hip/hip_runtime.h>
#include <hip/hip_cooperative_groups.h>
#include <cstdio>
#include <cstdint>
namespace cg = cooperative_groups;
namespace pg8 {
#define PG8_LAS __attribute__((address_space(3)))
typedef unsigned short bf16_t;
typedef short bf16x8 __attribute__((ext_vector_type(8)));
typedef float f32x4 __attribute__((ext_vector_type(4)));
typedef unsigned u32x4 __attribute__((ext_vector_type(4)));
constexpr int BM = 256, BK = 64, HALF = 128, HTB = HALF * BK * 2  , STAGE_BYTES = 8 * HTB, NXCD = 8, WGM = 8;

__host__ __device__ __forceinline__ int lds_byte(int r, int c) { const int st = (r >> 4) * 2 + (c >> 5), rr = r & 15, cc = c & 31, ob = rr * 64 + cc * 2; return st * 1024 + (ob ^ (((ob >> 9) & 1) << 5)); }
__host__ __device__ __forceinline__ void stage_rc(int b, int& R, int& C) { const int st = b / 1024, sb = b % 1024, swz = sb ^ (((sb >> 9) & 1) << 5); R = (st >> 1) * 16 + swz / 64; C = (st & 1) * 32 + (swz % 64) / 2; }
__host__ __device__ __forceinline__ int perm32(int rho) { const int n = rho >> 4, i = rho & 15; return 8 * (i >> 2) + 4 * n + (i & 3); }

struct Unit { int pm, pn, ks, koff; };
struct Gemm { const bf16_t* A; const bf16_t* Bt; int M, N, K, Klen; };

struct StaticOrder {
    int nM, nN, nwg, G, c;
    __host__ __device__ void init(int M, int N, int G_, int c_) { nM = M / BM; nN = N / BM; nwg = nM * nN; G = G_; c = c_; }
    __host__ __device__ bool next(int i, Unit& u) const {
        const long L = (long)i * G + c; if (L >= nwg) return false;
        int wgid = (int)L; { const int q = nwg / NXCD, r = nwg % NXCD, xcd = wgid % NXCD, off = wgid / NXCD; wgid = (xcd < r ? xcd * (q + 1) : r * (q + 1) + (xcd - r) * q) + off; }
        const int nig = WGM * nN, gid = wgid / nig, fm = gid * WGM, gsz = (nM - fm) < WGM ? (nM - fm) : WGM;
        u.pm = fm + ((wgid % nig) % gsz); u.pn = (wgid % nig) / gsz; u.ks = 0; u.koff = 0; return true;
    }
    __device__ __forceinline__ void a_ready(const Unit&) const {}
    __device__ __forceinline__ void done(const Unit&) const {}
};
__device__ __forceinline__ unsigned cvt_pk_bf16(float lo, float hi) { unsigned r; asm volatile("v_cvt_pk_bf16_f32 %0, %1, %2" : "=v"(r) : "v"(lo), "v"(hi)); return r; }
typedef float f32x2 __attribute__((ext_vector_type(2)));
template <class Epi, class Sched, bool STAMP = false>
__device__ __forceinline__ void gemm_phase(PG8_LAS unsigned char* lds, const Gemm g, const Sched& S, const Epi& E, unsigned long long* stamps) {
    int tid_ = threadIdx.x; asm volatile("" : "+v"(tid_));
    const int tid = tid_, wid = __builtin_amdgcn_readfirstlane(tid >> 6), lane = tid & 63, wr = wid >> 2, wc = wid & 3, fr = lane & 15, fq = lane >> 4;
    const int K = g.K, nt = g.Klen / BK;
    int ts_lo = 0, ts_hi = 0, nts = 0; const unsigned long long rt_entry = STAMP ? (unsigned long long)wall_clock64() : 0ull;
#define PG8_STAMP() do { if (STAMP && wid == 0 && nts < 64) { const unsigned long long _c = (unsigned long long)clock64(); \
        ts_lo = (lane == nts) ? (int)(unsigned)_c : ts_lo; ts_hi = (lane == nts) ? (int)(unsigned)(_c >> 32) : ts_hi; ++nts; } } while (0)
    PG8_STAMP();
    unsigned voffA[2], voffB[2];
#pragma unroll
    for (int i = 0; i < 2; ++i) { int R, C; stage_rc(tid * 16 + i * 8192, R, C); const int Rb = Epi::PERM ? ((R & ~31) + perm32(R & 31)) : R;
        voffA[i] = (unsigned)(R * K + C) * 2u; voffB[i] = (unsigned)(Rb * K + C) * 2u; }
    const size_t kstep = (size_t)(BK * 2);
    const size_t hstep = (size_t)HALF * K * 2;
    const size_t tstep = 2 * hstep;
    const unsigned ldsw = (unsigned)wid * 1024u;
    const int aoff = lds_byte(wr * 64 + fr, fq * 8), boff = lds_byte(wc * 32 + fr, fq * 8);
#define PG8_SA(b, h) (((b) * 2 + (h)) * HTB)
#define PG8_SB(b, h) ((4 + (b) * 2 + (h)) * HTB)
#define PG8_STAGE(bufoff, gbase, voff) do { _Pragma("unroll") for (int _i = 0; _i < 2; ++_i) \
        __builtin_amdgcn_global_load_lds((const unsigned*)((const char*)(gbase) + (voff)[_i]), (PG8_LAS unsigned*)(lds + (bufoff) + ldsw + _i * 8192), 16, 0, 0); } while (0)
#define PG8_LDA(dst, b, h) do { _Pragma("unroll") for (int m = 0; m < 4; ++m) _Pragma("unroll") for (int k = 0; k < 2; ++k) dst[m][k] = *(const PG8_LAS bf16x8*)(lds + PG8_SA(b, h) + aoff + m * 2048 + k * 1024); } while (0)
#define PG8_LDB(dst, b, h) do { _Pragma("unroll") for (int n = 0; n < 2; ++n) _Pragma("unroll") for (int k = 0; k < 2; ++k) dst[n][k] = *(const PG8_LAS bf16x8*)(lds + PG8_SB(b, h) + boff + n * 2048 + k * 1024); } while (0)
#define PG8_MMA(ai, bj, At, Bt) do { __builtin_amdgcn_s_setprio(1); _Pragma("unroll") for (int m = 0; m < 4; ++m) _Pragma("unroll") for (int n = 0; n < 2; ++n) _Pragma("unroll") for (int k = 0; k < 2; ++k) \
        acc[ai][bj][m][n] = __builtin_amdgcn_mfma_f32_16x16x32_bf16(Bt[n][k], At[m][k], acc[ai][bj][m][n], 0, 0, 0); __builtin_amdgcn_s_setprio(0); } while (0)
#define PG8_WAIT_V(n) asm volatile("s_waitcnt vmcnt(" #n ")" ::: "memory")
#define PG8_WAIT_L(n) asm volatile("s_waitcnt lgkmcnt(" #n ")" ::: "memory")
#define PG8_BAR __builtin_amdgcn_s_barrier()
#define PG8_SCHED __builtin_amdgcn_sched_barrier(0)
    Unit cur, nxt; int ui = 0;
    if (!S.next(0, cur)) return;
    f32x4 acc[2][2][4][2];
#pragma unroll
    for (int a = 0; a < 2; ++a)
#pragma unroll
        for (int b = 0; b < 2; ++b)
#pragma unroll
            for (int m = 0; m < 4; ++m)
#pragma unroll
                for (int n = 0; n < 2; ++n) acc[a][b][m][n] = (f32x4){0.f, 0.f, 0.f, 0.f};
    bf16x8 At[4][2], B0[2][2], B1[2][2];
    const char* cA = (const char*)g.A + (size_t)cur.pm * tstep + (size_t)cur.koff * 2; const char* cB = (const char*)g.Bt + (size_t)cur.pn * tstep + (size_t)cur.koff * 2;
    S.a_ready(cur);
    PG8_STAGE(PG8_SB(0, 0), cB, voffB); PG8_STAGE(PG8_SB(0, 1), cB + hstep, voffB); PG8_STAGE(PG8_SA(0, 0), cA, voffA); PG8_STAGE(PG8_SA(0, 1), cA + hstep, voffA);
    if (wr == 1) PG8_BAR;
    PG8_WAIT_V(2); PG8_BAR;
    PG8_STAGE(PG8_SB(1, 0), cB + kstep, voffB); PG8_STAGE(PG8_SA(1, 0), cA + kstep, voffA); PG8_STAGE(PG8_SB(1, 1), cB + hstep + kstep, voffB);
    PG8_WAIT_V(6); PG8_BAR;
    PG8_STAMP();
    for (;;) {
        const bool has_next = S.next(ui + 1, nxt);
        const char* nA = has_next ? (const char*)g.A + (size_t)nxt.pm * tstep + (size_t)nxt.koff * 2 : cA; const char* nB = has_next ? (const char*)g.Bt + (size_t)nxt.pn * tstep + (size_t)nxt.koff * 2 : cB;
        for (int t = 0; t < nt; t += 2) {
            const bool last = (t == nt - 2);
            const char* a1 = cA + (size_t)(t + 1) * kstep;
            const char* a2 = last ? nA : cA + (size_t)(t + 2) * kstep; const char* b2 = last ? nB : cB + (size_t)(t + 2) * kstep;
            const char* a3 = a2 + kstep; const char* b3 = b2 + kstep;
            if (last && has_next) S.a_ready(nxt);
            PG8_LDB(B0, 0, 0); PG8_LDB(B1, 0, 1); PG8_SCHED; PG8_LDA(At, 0, 0); PG8_STAGE(PG8_SA(1, 1), a1 + hstep, voffA);
            PG8_WAIT_V(8); PG8_WAIT_L(0); PG8_BAR; PG8_MMA(0, 0, At, B0); PG8_MMA(0, 1, At, B1); PG8_BAR; PG8_SCHED;
            PG8_LDA(At, 0, 1); PG8_STAGE(PG8_SB(0, 0), b2, voffB); PG8_STAGE(PG8_SB(0, 1), b2 + hstep, voffB); PG8_STAGE(PG8_SA(0, 0), a2, voffA);
            PG8_WAIT_V(8); PG8_WAIT_L(0); PG8_BAR; PG8_MMA(1, 0, At, B0); PG8_MMA(1, 1, At, B1); PG8_BAR; PG8_SCHED;
            PG8_LDB(B0, 1, 0); PG8_LDB(B1, 1, 1); PG8_SCHED; PG8_LDA(At, 1, 0); PG8_STAGE(PG8_SA(0, 1), a2 + hstep, voffA);
            PG8_WAIT_V(8); PG8_WAIT_L(0); PG8_BAR; PG8_MMA(0, 0, At, B0); PG8_MMA(0, 1, At, B1); PG8_BAR; PG8_SCHED;
            PG8_LDA(At, 1, 1); PG8_STAGE(PG8_SB(1, 0), b3, voffB); PG8_STAGE(PG8_SB(1, 1), b3 + hstep, voffB); PG8_STAGE(PG8_SA(1, 0), a3, voffA);
            PG8_WAIT_V(8); PG8_WAIT_L(0); PG8_BAR; PG8_MMA(1, 0, At, B0); PG8_MMA(1, 1, At, B1); PG8_BAR; PG8_SCHED;
        }
        PG8_STAMP();
        if (wr == 0) PG8_BAR;
        if constexpr (!Epi::AFTER_DRAIN) { E(acc, cur, wr, wc, fr, fq); S.done(cur); }
        PG8_STAMP();
        if (!has_next) break;
#pragma unroll
        for (int a = 0; a < 2; ++a)
#pragma unroll
            for (int b = 0; b < 2; ++b)
#pragma unroll
                for (int m = 0; m < 4; ++m)
#pragma unroll
                    for (int n = 0; n < 2; ++n) acc[a][b][m][n] = (f32x4){0.f, 0.f, 0.f, 0.f};
        cur = nxt; cA = nA; cB = nB; ++ui;
        if (wr == 1) PG8_BAR;
    }
    PG8_WAIT_V(0);
    PG8_BAR;
    if constexpr (Epi::AFTER_DRAIN) { E.fused(acc, cur, wr, wc, fr, fq, lds, wid, lane); S.done(cur); }
    PG8_STAMP();
    if (STAMP && wid == 0) { stamps[lane] = lane < nts ? (((unsigned long long)(unsigned)ts_hi << 32) | (unsigned)ts_lo) : 0ull;
        if (lane == 62) stamps[62] = rt_entry; if (lane == 63) stamps[63] = (unsigned long long)wall_clock64(); }
#undef PG8_STAMP
#undef PG8_SA
#undef PG8_SB
#undef PG8_STAGE
#undef PG8_LDA
#undef PG8_LDB
#undef PG8_MMA
#undef PG8_WAIT_V
#undef PG8_WAIT_L
#undef PG8_BAR
#undef PG8_SCHED
}
}
#define LAS __attribute__((address_space(3)))
#define XB_TMO      128
#define XB_XCNT(j)  (256  + 64 * (j))
#define XB_XSUB(j)  (1280 + 64 * (j))
#define XB_XGEN(j)  (2304 + 64 * (j))
#define XB_TOP      3328
#define XB_TOPGEN   3392
#define XCD_BAR_WORDS 3456
#define XB_SPIN_CAP (1u << 18)

__device__ __forceinline__ unsigned xb_ld(unsigned* p)              { return __hip_atomic_load(p, __ATOMIC_RELAXED, __HIP_MEMORY_SCOPE_AGENT); }
__device__ __forceinline__ unsigned xb_add(unsigned* p, unsigned v) { return __hip_atomic_fetch_add(p, v, __ATOMIC_RELAXED, __HIP_MEMORY_SCOPE_AGENT); }
__device__ __forceinline__ unsigned xb_xcc_id() { return (unsigned)__builtin_amdgcn_s_getreg((3 << 11) | 20) & 0xFu; }
#define XB_SPIN(cond, bar) do { unsigned _sp = 0; while (cond) { __builtin_amdgcn_s_sleep(1); \
    if ((++_sp & 255u) == 0u) { if (xb_ld(&(bar)[XB_TMO])) break; if (_sp > XB_SPIN_CAP) { atomicAdd(&(bar)[XB_TMO], 1u); break; } } } } while (0)

struct XcdBarrier {
    unsigned* bar; unsigned x;
    volatile LAS unsigned* st;
};

__device__ __forceinline__ XcdBarrier xcd_barrier_post(unsigned* bar, volatile LAS unsigned* st) {
    XcdBarrier b; b.bar = bar; b.x = xb_xcc_id(); b.st = st;
    if (threadIdx.x == 0) (void)xb_add(&bar[XB_XCNT(b.x)], 1u);
    return b;
}
__device__ __forceinline__ void xcd_barrier_complete(unsigned* bar, unsigned x, unsigned& nloc, unsigned& nx) {
    const unsigned G = gridDim.x * gridDim.y * gridDim.z;
    unsigned sum, cnt, mine, sp = 0u;
    for (;;) {
        sum = 0u; cnt = 0u; mine = 0u;
#pragma unroll
        for (unsigned j = 0; j < 16; ++j) { const unsigned c = xb_ld(&bar[XB_XCNT(j)]); sum += c; cnt += (c > 0u) ? 1u : 0u; mine = (j == x) ? c : mine; }
        if (sum == G) break;
        __builtin_amdgcn_s_sleep(1);
        if ((++sp & 255u) == 0u) { if (xb_ld(&bar[XB_TMO])) break; if (sp > XB_SPIN_CAP) { atomicAdd(&bar[XB_TMO], 1u); break; } }
    }
    nloc = mine > 0u ? mine : 1u; nx = cnt > 0u ? cnt : 1u;
}

__device__ __forceinline__ void xcd_barrier(const XcdBarrier& b) {
    asm volatile("s_waitcnt vmcnt(0)" ::: "memory");
    __syncthreads();
    if (threadIdx.x == 0) {
        unsigned* bar = b.bar;
        __builtin_amdgcn_s_waitcnt(0);
        unsigned nloc = b.st[0], nx = b.st[1];
        if (nloc == 0u) { xcd_barrier_complete(bar, b.x, nloc, nx); b.st[0] = nloc; b.st[1] = nx; }
        const unsigned old = xb_add(&bar[XB_XSUB(b.x)], 1u);
        const unsigned gen = old / nloc;
        if (old + 1u == (gen + 1u) * nloc) {
            __builtin_amdgcn_fence(__ATOMIC_RELEASE, "agent");
            asm volatile("s_waitcnt vmcnt(0)" ::: "memory");
            const unsigned og = xb_add(&bar[XB_TOP], 1u);
            const unsigned tg = og / nx;
            if (og + 1u == (tg + 1u) * nx) xb_add(&bar[XB_TOPGEN], 1u);
            else XB_SPIN(xb_ld(&bar[XB_TOPGEN]) == tg, bar);
            __builtin_amdgcn_fence(__ATOMIC_ACQUIRE, "agent");
            xb_add(&bar[XB_XGEN(b.x)], 1u);
            asm volatile("s_waitcnt vmcnt(0)" ::: "memory");
        } else {
            XB_SPIN(xb_ld(&bar[XB_XGEN(b.x)]) == gen, bar);
            __builtin_amdgcn_fence(__ATOMIC_ACQUIRE, "agent");
            asm volatile("s_waitcnt vmcnt(0)" ::: "memory");
        }
    }
    __syncthreads();
}


using pg8::bf16_t; using pg8::bf16x8; using pg8::f32x4; using pg8::u32x4; using pg8::Unit;
typedef float f32x16 __attribute__((ext_vector_type(16)));
typedef unsigned u32x2 __attribute__((ext_vector_type(2)));
typedef float f32x2 __attribute__((ext_vector_type(2)));

constexpr int MP = 8192, MS = 1024, MT = 9216, DM = 2048, NZ = 5120, NINP = 5376, DFF = 5632, PLE = 256;
constexpr int LDS_BYTES = 131072 + 16;
constexpr size_t OFF_BAR = 0;
constexpr size_t OFF_WIN = 16384;
constexpr size_t OFF_WOUT = OFF_WIN + (size_t)NINP * DM * 2;
constexpr size_t OFF_WFI = OFF_WOUT + (size_t)DM * DM * 2;
constexpr size_t OFF_WFO = OFF_WFI + (size_t)2 * DFF * DM * 2;
constexpr size_t OFF_WPLE = OFF_WFO + (size_t)DM * DFF * 2;
constexpr size_t OFF_WGT = OFF_WPLE + (size_t)DM * PLE * 2;
constexpr size_t OFF_A0 = OFF_WGT + (size_t)DM * DM * 2;
constexpr size_t OFF_PB = OFF_A0 + (size_t)MT * DM * 2;
constexpr size_t OFF_ALOW = OFF_PB + (size_t)MT * PLE * 2;
constexpr size_t OFF_STAT = OFF_ALOW + (size_t)MT * 16 * 4;
constexpr size_t OFF_BIG = OFF_STAT + (size_t)MT * 2 * 4;
constexpr size_t OFF_Z = OFF_BIG;
constexpr size_t OFF_ORAW = OFF_Z + (size_t)MT * NZ * 2;
constexpr size_t OFF_MRAW = OFF_ORAW + (size_t)MT * 1024 * 4;
constexpr size_t OFF_IMG = OFF_BIG + (size_t)MT * DFF * 2 + (size_t)MT * DM * 4;
constexpr size_t WS_END = OFF_IMG + (size_t)4 * 1024 * 2048 * 4;
constexpr size_t OFF_ACT = OFF_BIG;
constexpr size_t OFF_GATEZ = OFF_BIG;
constexpr size_t OFF_PZ = OFF_BIG + (size_t)MT * DFF * 2;
constexpr size_t OUT_Y = 0, OUT_SP = (size_t)MT * DM, OUT_SS = OUT_SP + (size_t)4 * 4 * 128 * 256, OUT_VS = OUT_SS + (size_t)128 * 4 * 128 * 256;

struct Params {
    const float *x_prompt, *x_sample, *state_gla, *p_prompt, *p_sample, *g_mix, *w_in, *w_a2, *b_a, *g_gla_norm, *g_gmlp_ln, *b_gmlp_ln, *w_s, *b_s,
        *g_gmlp_out, *w_out, *g_ffn, *w_ffn_in, *w_ffn_out, *w_ple, *g_ple, *g_ple_gate, *w_ple_gate, *g_final;
    float* out;
    unsigned char* ws;
};

__device__ __forceinline__ unsigned pk2(float lo, float hi) { return pg8::cvt_pk_bf16(lo, hi); }
__device__ __forceinline__ bf16_t f2bf(float f) { return (bf16_t)(pk2(f, 0.f) & 0xffffu); }
__device__ __forceinline__ float bf2f(bf16_t b) { return __uint_as_float(((unsigned)b) << 16); }
__device__ __forceinline__ float bflo(unsigned w) { return __uint_as_float(w << 16); }
__device__ __forceinline__ float bfhi(unsigned w) { return __uint_as_float(w & 0xffff0000u); }
__device__ __forceinline__ f32x4 unpack4(u32x2 w) { return (f32x4){bflo(w.x), bfhi(w.x), bflo(w.y), bfhi(w.y)}; }
template <int CTRL> __device__ __forceinline__ float dpp_f(float v) { return __int_as_float(__builtin_amdgcn_update_dpp(0, __float_as_int(v), CTRL, 0xf, 0xf, true)); }
__device__ __forceinline__ float row16_sum(float v) {
    v += dpp_f<0xB1>(v); v += dpp_f<0x4E>(v); v += dpp_f<0x141>(v); v += dpp_f<0x140>(v); return v;
}
__device__ __forceinline__ float wave_sum(float v) {
    v = row16_sum(v);
    return (__int_as_float(__builtin_amdgcn_readlane(__float_as_int(v), 0)) + __int_as_float(__builtin_amdgcn_readlane(__float_as_int(v), 16))) + (__int_as_float(__builtin_amdgcn_readlane(__float_as_int(v), 32)) + __int_as_float(__builtin_amdgcn_readlane(__float_as_int(v), 48)));
}
__device__ __forceinline__ float sigmoid_f(float x) { return __builtin_amdgcn_rcpf(1.f + __expf(-x)); }
__device__ __forceinline__ float silu_f(float x) { return x * __builtin_amdgcn_rcpf(1.f + __expf(-x)); }
__device__ __forceinline__ float gelu_f(float x) { const float u = 1.5957691216f * (x + 0.044715f * x * x * x); return x * __builtin_amdgcn_rcpf(1.f + __expf(-u)); }
__device__ __forceinline__ float logsigmoid_f(float x) { return fminf(x, 0.f) - __logf(1.f + __expf(-fabsf(x))); }
template <class T> __device__ __forceinline__ T* opaque(T* p) { return p; }
__device__ __forceinline__ const f32x4* row_mid(const float* row, int lane) { return opaque((const f32x4*)row + lane + 256); }
__device__ __forceinline__ f32x4* row_mid(float* row, int lane) { return opaque((f32x4*)row + lane + 256); }
__device__ __forceinline__ int otid() { int t = threadIdx.x; asm volatile("" : "+v"(t)); return t; }
__device__ __forceinline__ void lds_wait() { asm volatile("s_waitcnt lgkmcnt(0)" ::: "memory"); }

struct EpiIn {
    static constexpr bool PERM = true, AFTER_DRAIN = false;
    bf16_t* Z; float* alow;
    __device__ __forceinline__ void operator()(const f32x4 (&acc)[2][2][4][2], const Unit& u, int wr, int wc, int fr, int fq) const {
        const int row0 = u.pm * 256 + wr * 64 + fr, pn = u.pn;
        if (pn == 20) {
            if (wc == 0 && fq < 2) {
#pragma unroll
                for (int ai = 0; ai < 2; ++ai)
#pragma unroll
                    for (int m = 0; m < 4; ++m) { float* p = alow + (size_t)(row0 + ai * 128 + m * 16) * 16 + 8 * fq; *(f32x4*)p = acc[ai][0][m][0]; *(f32x4*)(p + 4) = acc[ai][0][m][1]; }
            }
            return;
        }
        const int kind = pn < 8 ? 0 : (pn < 12 ? 1 : 2); const float qs = pn < 2 ? 0.08838834764831845f : 1.f;
#pragma unroll
        for (int ai = 0; ai < 2; ++ai)
#pragma unroll
            for (int m = 0; m < 4; ++m) { bf16_t* rowp = Z + (size_t)(row0 + ai * 128 + m * 16) * NZ + pn * 256 + wc * 32 + 8 * fq;
#pragma unroll
                for (int bj = 0; bj < 2; ++bj) { f32x4 v0 = acc[ai][bj][m][0], v1 = acc[ai][bj][m][1];
                    if (kind == 0) { v0 *= qs; v1 *= qs; }
                    else if (kind == 1) {
#pragma unroll
                        for (int j = 0; j < 4; ++j) { v0[j] = silu_f(v0[j]); v1[j] = silu_f(v1[j]); } }
                    else {
#pragma unroll
                        for (int j = 0; j < 4; ++j) { v0[j] = gelu_f(v0[j]); v1[j] = gelu_f(v1[j]); } }
                    u32x4 w; w.x = pk2(v0[0], v0[1]); w.y = pk2(v0[2], v0[3]); w.z = pk2(v1[0], v1[1]); w.w = pk2(v1[2], v1[3]);
                    *(u32x4*)(rowp + bj * 128) = w; } }
    }
};
struct EpiRes {
    static constexpr bool PERM = false, AFTER_DRAIN = false;
    const float* res_p; const float* res_s; float* out;
    __device__ __forceinline__ void operator()(const f32x4 (&acc)[2][2][4][2], const Unit& u, int wr, int wc, int fr, int fq) const {
        const int row0 = u.pm * 256 + wr * 64 + fr, col0 = u.pn * 256 + wc * 32 + 4 * fq;
#pragma unroll
        for (int ai = 0; ai < 2; ++ai)
#pragma unroll
            for (int m = 0; m < 4; ++m) { const int row = row0 + ai * 128 + m * 16;
                const float* rp = (row < MP ? res_p + (size_t)row * DM : res_s + (size_t)(row - MP) * DM) + col0; float* op = out + (size_t)row * DM + col0;
#pragma unroll
                for (int bj = 0; bj < 2; ++bj)
#pragma unroll
                    for (int n = 0; n < 2; ++n) { const f32x4 r = *(const f32x4*)(rp + bj * 128 + n * 16); *(f32x4*)(op + bj * 128 + n * 16) = acc[ai][bj][m][n] + r; } }
    }
};
struct EpiSwiglu {
    static constexpr bool PERM = true, AFTER_DRAIN = false;
    bf16_t* act;
    __device__ __forceinline__ void operator()(const f32x4 (&acc)[2][2][4][2], const Unit& u, int wr, int wc, int fr, int fq) const {
        const int row0 = u.pm * 256 + wr * 64 + fr, col0 = u.pn * 128 + wc * 32 + 8 * fq;
#pragma unroll
        for (int ai = 0; ai < 2; ++ai)
#pragma unroll
            for (int m = 0; m < 4; ++m) { float a[8];
#pragma unroll
                for (int n = 0; n < 2; ++n)
#pragma unroll
                    for (int j = 0; j < 4; ++j) a[n * 4 + j] = silu_f(acc[ai][0][m][n][j]) * acc[ai][1][m][n][j];
                u32x4 w; w.x = pk2(a[0], a[1]); w.y = pk2(a[2], a[3]); w.z = pk2(a[4], a[5]); w.w = pk2(a[6], a[7]);
                *(u32x4*)(act + (size_t)(row0 + ai * 128 + m * 16) * DFF + col0) = w; }
    }
};
struct EpiBfN {
    static constexpr bool PERM = false, AFTER_DRAIN = false;
    bf16_t* out;
    __device__ __forceinline__ void operator()(const f32x4 (&acc)[2][2][4][2], const Unit& u, int wr, int wc, int fr, int fq) const {
        const int row0 = u.pm * 256 + wr * 64 + fr, col0 = u.pn * 256 + wc * 32 + 4 * fq;
#pragma unroll
        for (int ai = 0; ai < 2; ++ai)
#pragma unroll
            for (int m = 0; m < 4; ++m) { bf16_t* op = out + (size_t)(row0 + ai * 128 + m * 16) * DM + col0;
#pragma unroll
                for (int bj = 0; bj < 2; ++bj)
#pragma unroll
                    for (int n = 0; n < 2; ++n) { const f32x4 v = acc[ai][bj][m][n]; u32x2 w; w.x = pk2(v[0], v[1]); w.y = pk2(v[2], v[3]); *(u32x2*)(op + bj * 128 + n * 16) = w; } }
    }
};
struct EpiPlain {
    static constexpr bool PERM = false, AFTER_DRAIN = false;
    float* out;
    __device__ __forceinline__ void operator()(const f32x4 (&acc)[2][2][4][2], const Unit& u, int wr, int wc, int fr, int fq) const {
        const int row0 = u.pm * 256 + wr * 64 + fr, col0 = u.pn * 256 + wc * 32 + 4 * fq;
#pragma unroll
        for (int ai = 0; ai < 2; ++ai)
#pragma unroll
            for (int m = 0; m < 4; ++m) { float* op = out + (size_t)(row0 + ai * 128 + m * 16) * DM + col0;
#pragma unroll
                for (int bj = 0; bj < 2; ++bj)
#pragma unroll
                    for (int n = 0; n < 2; ++n) *(f32x4*)(op + bj * 128 + n * 16) = acc[ai][bj][m][n]; }
    }
};

template <class Epi> __device__ __forceinline__ void run_gemm(LAS unsigned char* lds, const bf16_t* A, const bf16_t* Bt, int M, int N, int K, const Epi& E) {
    pg8::Gemm g; g.A = A; g.Bt = Bt; g.M = M; g.N = N; g.K = K; g.Klen = K;
    pg8::StaticOrder S; S.init(M, N, (int)gridDim.x, (int)blockIdx.x);
    pg8::gemm_phase<Epi, pg8::StaticOrder, false>(lds, g, S, E, nullptr);
}
struct SplitOrderK {
    int nN, G, c, klen, ns, kbase, ksoff;
    __device__ __forceinline__ bool next(int i, Unit& u) const { const int L = i * G + c; if (L >= 4 * ns * nN) return false;
        const int sp = L % ns, tile = L / ns; u.ks = ksoff + sp; u.pn = tile % nN; u.pm = 32 + tile / nN; u.koff = kbase + sp * klen; return true; }
    __device__ __forceinline__ void a_ready(const Unit&) const {}
    __device__ __forceinline__ void done(const Unit&) const {}
};
struct EpiPart {
    static constexpr bool PERM = false, AFTER_DRAIN = false;
    bf16_t* part;
    __device__ __forceinline__ void operator()(const f32x4 (&acc)[2][2][4][2], const Unit& u, int wr, int wc, int fr, int fq) const {
        const int row0 = (u.pm - 32) * 256 + wr * 64 + fr, col0 = u.pn * 256 + wc * 32 + 4 * fq; bf16_t* pb = part + (size_t)u.ks * MS * DM;
#pragma unroll
        for (int ai = 0; ai < 2; ++ai)
#pragma unroll
            for (int m = 0; m < 4; ++m) { bf16_t* op = pb + (size_t)(row0 + ai * 128 + m * 16) * DM + col0;
#pragma unroll
                for (int bj = 0; bj < 2; ++bj)
#pragma unroll
                    for (int n = 0; n < 2; ++n) { const f32x4 v = acc[ai][bj][m][n]; u32x2 w; w.x = pk2(v[0], v[1]); w.y = pk2(v[2], v[3]); *(u32x2*)(op + bj * 128 + n * 16) = w; } }
    }
};
__device__ __forceinline__ void run_split(LAS unsigned char* lds, const bf16_t* A, const bf16_t* Bt, int K, bf16_t* part, int ns, int klen, int kbase, int ksoff, int c) {
    pg8::Gemm g; g.A = A; g.Bt = Bt; g.M = MT; g.N = DM; g.K = K; g.Klen = klen;
    SplitOrderK S; S.nN = DM / 256; S.G = (int)gridDim.x; S.c = c; S.klen = klen; S.ns = ns; S.kbase = kbase; S.ksoff = ksoff;
    EpiPart P; P.part = part;
    pg8::gemm_phase<EpiPart, SplitOrderK, false>(lds, g, S, P, nullptr);
}
template <class Epi> __device__ __forceinline__ void run_gemm_n2048(LAS unsigned char* lds, const bf16_t* A, const bf16_t* Bt, int K, const Epi& E, bf16_t* part) {
    run_gemm(lds, A, Bt, MP, DM, K, E);
    run_split(lds, A, Bt, K, part, 8, K / 8, 0, 0, (int)blockIdx.x);
}

__device__ __forceinline__ void transpose_item(const float* W, int N, bf16_t* WT, int K, int k0, int n0_dst, int n0_src, int nvalid, LAS float* scr, int lane) {
    const int j = lane & 31;
#pragma unroll 8
    for (int i = 0; i < 32; ++i) { const int kk = 2 * i + (lane >> 5); scr[kk * 33 + j] = (j < nvalid) ? W[(size_t)(k0 + kk) * N + n0_src + j] : 0.f; }
    lds_wait();
    const int c = lane & 7;
#pragma unroll
    for (int q = 0; q < 4; ++q) { const int n = (lane >> 3) + 8 * q; const LAS float* s = scr + (8 * c) * 33 + n;
        u32x4 o; o.x = pk2(s[0 * 33], s[1 * 33]); o.y = pk2(s[2 * 33], s[3 * 33]); o.z = pk2(s[4 * 33], s[5 * 33]); o.w = pk2(s[6 * 33], s[7 * 33]);
        *(u32x4*)(WT + (size_t)(n0_dst + n) * K + k0 + 8 * c) = o; }
    lds_wait();
}
struct Row8 { f32x4 v[8]; };
__device__ __forceinline__ void row_load(Row8& a, const float* src, int lane) { const f32x4* sm = row_mid(src, lane);
#pragma unroll
    for (int j = 0; j < 8; ++j) a.v[j] = sm[64 * (j - 4)]; }
__device__ __forceinline__ void rms_finish_bf16(const Row8& a, const float* gain, bf16_t* dst, int lane) {
    float s = 0.f;
#pragma unroll
    for (int j = 0; j < 8; ++j) s += (a.v[j][0] * a.v[j][0] + a.v[j][1] * a.v[j][1]) + (a.v[j][2] * a.v[j][2] + a.v[j][3] * a.v[j][3]);
    const float rinv = rsqrtf(wave_sum(s) * (1.f / DM) + 1e-6f);
    const f32x4* gm = row_mid(gain, lane); u32x2* dm = (u32x2*)dst + lane;
#pragma unroll
    for (int j = 0; j < 8; ++j) { const f32x4 g = gm[64 * (j - 4)]; u32x2 o; o.x = pk2(a.v[j][0] * rinv * g[0], a.v[j][1] * rinv * g[1]); o.y = pk2(a.v[j][2] * rinv * g[2], a.v[j][3] * rinv * g[3]);
        dm[64 * j] = o; }
}
__device__ __forceinline__ void rms_row_bf16(const float* src, const float* gain, bf16_t* dst, int lane) { Row8 a; row_load(a, src, lane); rms_finish_bf16(a, gain, dst, lane); }
namespace cv { constexpr int I_IN = (DM / 64) * (NINP / 32), I_OUT = (DM / 64) * (DM / 32), I_FI = (DM / 64) * (2 * DFF / 32), I_FO = (DFF / 64) * (DM / 32), I_PLE = (PLE / 64) * (DM / 32), I_GT = I_OUT;
    constexpr int E_IN = I_IN, E_OUT = E_IN + I_OUT, E_FI = E_OUT + I_FI, E_FO = E_FI + I_FO, E_PLE = E_FO + I_PLE, E_GT = E_PLE + I_GT; }
__device__ __forceinline__ void convert_range(const Params& p, LAS unsigned char* lds, int lo, int hi, int gw, int NGW) {
    const int tid = otid(), lane = tid & 63, wave = tid >> 6;
    LAS float* scr = (LAS float*)(lds + wave * 8448);
    bf16_t* win = (bf16_t*)(p.ws + OFF_WIN); bf16_t* wout = (bf16_t*)(p.ws + OFF_WOUT); bf16_t* wfi = (bf16_t*)(p.ws + OFF_WFI);
    bf16_t* wfo = (bf16_t*)(p.ws + OFF_WFO); bf16_t* wple = (bf16_t*)(p.ws + OFF_WPLE); bf16_t* wgt = (bf16_t*)(p.ws + OFF_WGT);
    for (int it = lo + gw; it < hi; it += NGW) {
        int r = it;
        if (r < cv::E_IN) { const int nblk = NINP / 32, kb = r / nblk, nb = r % nblk, n0d = nb * 32; int src, nv;
            if (n0d < 3072) { src = n0d; nv = 32; } else if (n0d < 5120) { src = n0d + 16; nv = 32; } else if (n0d == 5120) { src = 3072; nv = 16; } else { src = 0; nv = 0; }
            transpose_item(p.w_in, 5136, win, DM, kb * 64, n0d, src, nv, scr, lane); continue; }
        if (r < cv::E_OUT) { r -= cv::E_IN; const int nblk = DM / 32, kb = r / nblk, nb = r % nblk; transpose_item(p.w_out, DM, wout, DM, kb * 64, nb * 32, nb * 32, 32, scr, lane); continue; }
        if (r < cv::E_FI) { r -= cv::E_OUT; const int nblk = 2 * DFF / 32, kb = r / nblk, nb = r % nblk, n0d = nb * 32, jb = n0d >> 8, within = n0d & 255, up = within >> 7, j0 = jb * 128 + (within & 127);
            transpose_item(p.w_ffn_in, 2 * DFF, wfi, DM, kb * 64, n0d, up * DFF + j0, 32, scr, lane); continue; }
        if (r < cv::E_FO) { r -= cv::E_FI; const int nblk = DM / 32, kb = r / nblk, nb = r % nblk; transpose_item(p.w_ffn_out, DM, wfo, DFF, kb * 64, nb * 32, nb * 32, 32, scr, lane); continue; }
        if (r < cv::E_PLE) { r -= cv::E_FO; const int nblk = DM / 32, kb = r / nblk, nb = r % nblk; transpose_item(p.w_ple, DM, wple, PLE, kb * 64, nb * 32, nb * 32, 32, scr, lane); continue; }
        { r -= cv::E_PLE; const int nblk = DM / 32, kb = r / nblk, nb = r % nblk; transpose_item(p.w_ple_gate, DM, wgt, DM, kb * 64, nb * 32, nb * 32, 32, scr, lane); }
    }
}
__device__ __forceinline__ void phase0(const Params& p, LAS unsigned char* lds) {
    const int tid = otid(), lane = tid & 63, wave = tid >> 6;
    const int gw = blockIdx.x * 8 + wave, NGW = gridDim.x * 8;
    convert_range(p, lds, 0, cv::E_IN, gw, NGW);
    bf16_t* a0 = (bf16_t*)(p.ws + OFF_A0); bf16_t* pb = (bf16_t*)(p.ws + OFF_PB);
    for (int r = gw; r < MT; r += 2 * NGW) {
        const int r2 = r + NGW; const bool has2 = r2 < MT; const int q2 = has2 ? r2 : r;
        const float* x1 = r < MP ? p.x_prompt + (size_t)r * DM : p.x_sample + (size_t)(r - MP) * DM; const float* x2 = q2 < MP ? p.x_prompt + (size_t)q2 * DM : p.x_sample + (size_t)(q2 - MP) * DM;
        const float* p1 = r < MP ? p.p_prompt + (size_t)r * PLE : p.p_sample + (size_t)(r - MP) * PLE; const float* p2 = q2 < MP ? p.p_prompt + (size_t)q2 * PLE : p.p_sample + (size_t)(q2 - MP) * PLE;
        Row8 a, b; row_load(a, x1, lane); row_load(b, x2, lane);
        const f32x4 pv1 = ((const f32x4*)p1)[lane], pv2 = ((const f32x4*)p2)[lane];
        rms_finish_bf16(a, p.g_mix, a0 + (size_t)r * DM, lane);
        { u32x2 o; o.x = pk2(pv1[0], pv1[1]); o.y = pk2(pv1[2], pv1[3]); ((u32x2*)(pb + (size_t)r * PLE))[lane] = o; }
        if (has2) { rms_finish_bf16(b, p.g_mix, a0 + (size_t)r2 * DM, lane);
            u32x2 o; o.x = pk2(pv2[0], pv2[1]); o.y = pk2(pv2[2], pv2[3]); ((u32x2*)(pb + (size_t)r2 * PLE))[lane] = o; }
    }
}

__device__ __forceinline__ f32x16 mfma32(bf16x8 a, bf16x8 b, f32x16 c) { return __builtin_amdgcn_mfma_f32_32x32x16_bf16(a, b, c, 0, 0, 0); }
__device__ __forceinline__ void mma32(f32x16& acc, const LAS bf16_t* A, int lda, const LAS bf16_t* B, int ldb, int kk, int lane) {
    const int r = lane & 31, h = lane >> 5; const LAS bf16_t* ap = A + r * lda + 8 * h; const LAS bf16_t* bp = B + r * ldb + 8 * h;
    for (int k = 0; k < kk; k += 16) { const bf16x8 a = *(const LAS bf16x8*)(ap + k); const bf16x8 b = *(const LAS bf16x8*)(bp + k); acc = mfma32(a, b, acc); }
}
constexpr int LQ = 136, LS = 72;
constexpr int R_QE = 0, R_KLT = 17408, R_ATT = 35840, R_DEC = 45056, IMG_BYTES = 45568, R_VT = 45568, R_QM = 82432, R_KM = 99840, R_ALOW = 117248, R_GSUM = 121344, R_BMID = 123392;
constexpr int IMG_V4 = IMG_BYTES / 16;

__device__ __forceinline__ void gla_prep(const Params& p, LAS unsigned char* lds, int rb, int h, int T) {
    const int tid = otid(), lane = tid & 63, wave = tid >> 6;
    const bf16_t* Z = (const bf16_t*)(p.ws + OFF_Z); const float* alowg = (const float*)(p.ws + OFF_ALOW);
    LAS bf16_t* Qe = (LAS bf16_t*)(lds + R_QE); LAS bf16_t* Qm = (LAS bf16_t*)(lds + R_QM); LAS bf16_t* Km = (LAS bf16_t*)(lds + R_KM);
    LAS bf16_t* KlT = (LAS bf16_t*)(lds + R_KLT); LAS bf16_t* ATT = (LAS bf16_t*)(lds + R_ATT); LAS float* DEC = (LAS float*)(lds + R_DEC);
    LAS float* alowL = (LAS float*)(lds + R_ALOW); LAS float* gsum = (LAS float*)(lds + R_GSUM); LAS float* bmidL = (LAS float*)(lds + R_BMID);
    const int c = tid & 127, tg = tid >> 7;
    float wa[16];
#pragma unroll
    for (int j = 0; j < 16; ++j) wa[j] = p.w_a2[j * 512 + h * 128 + c];
    const float ba = p.b_a[h * 128 + c];
    for (int idx = tid; idx < 1024; idx += 512) { const int t = idx >> 4; alowL[idx] = (t < T) ? alowg[(size_t)(rb + t) * 16 + (idx & 15)] : 0.f; }
    float qv[16], kv[16];
#pragma unroll
    for (int i = 0; i < 16; ++i) { const int t = tg * 16 + i; const bool ok = t < T; const bf16_t* zr = Z + (size_t)(rb + t) * NZ + h * 128 + c;
        qv[i] = ok ? bf2f(zr[0]) : 0.f; kv[i] = ok ? bf2f(zr[512]) : 0.f; }
    __syncthreads();
    float b[16]; float run = 0.f;
#pragma unroll
    for (int i = 0; i < 16; ++i) { const int t = tg * 16 + i; float pre = ba;
#pragma unroll
        for (int j4 = 0; j4 < 4; ++j4) { const f32x4 a4 = *(const LAS f32x4*)(alowL + t * 16 + j4 * 4); pre += a4[0] * wa[j4 * 4] + a4[1] * wa[j4 * 4 + 1] + a4[2] * wa[j4 * 4 + 2] + a4[3] * wa[j4 * 4 + 3]; }
        const float la = (t < T) ? logsigmoid_f(pre) * 0.0625f : 0.f; run += la; b[i] = run; }
    gsum[tg * 128 + c] = run;
    __syncthreads();
    const float g0 = gsum[c], g1 = gsum[128 + c], g2 = gsum[256 + c], g3 = gsum[384 + c];
    const float pref = tg == 0 ? 0.f : (tg == 1 ? g0 : (tg == 2 ? g0 + g1 : g0 + g1 + g2));
    const float blast = ((g0 + g1) + g2) + g3;
#pragma unroll
    for (int i = 0; i < 16; ++i) b[i] += pref;
    if (tg == 2) bmidL[c] = b[0];
    if (tg == 0) DEC[c] = __expf(blast);
    __syncthreads();
    const float bm = bmidL[c];
    {
        unsigned klp[8];
#pragma unroll
        for (int i = 0; i < 16; i += 2) {
            const int t = tg * 16 + i;
            Qe[t * LQ + c] = f2bf(qv[i] * __expf(b[i])); Qe[(t + 1) * LQ + c] = f2bf(qv[i + 1] * __expf(b[i + 1]));
            Qm[t * LQ + c] = f2bf(qv[i] * __expf(b[i] - bm)); Qm[(t + 1) * LQ + c] = f2bf(qv[i + 1] * __expf(b[i + 1] - bm));
            Km[t * LQ + c] = f2bf(kv[i] * __expf(bm - b[i])); Km[(t + 1) * LQ + c] = f2bf(kv[i + 1] * __expf(bm - b[i + 1]));
            klp[i >> 1] = pk2(kv[i] * __expf(blast - b[i]), kv[i + 1] * __expf(blast - b[i + 1]));
        }
        LAS u32x4* kd = (LAS u32x4*)(KlT + c * LS + tg * 16);
        kd[0] = (u32x4){klp[0], klp[1], klp[2], klp[3]}; kd[1] = (u32x4){klp[4], klp[5], klp[6], klp[7]};
    }
    __syncthreads();
    if (wave < 3) {
        const int si = wave >> 1, ti = wave == 0 ? 0 : 1, l31 = lane & 31, hh = lane >> 5;
        f32x16 o;
#pragma unroll
        for (int i = 0; i < 16; ++i) o[i] = 0.f;
        mma32(o, Km + si * 32 * LQ, LQ, Qm + ti * 32 * LQ, LQ, 128, lane);
        const int tl = ti * 32 + l31;
#pragma unroll
        for (int g = 0; g < 4; ++g) { const int s0 = si * 32 + 8 * g + 4 * hh; float a0 = o[4 * g], a1 = o[4 * g + 1], a2 = o[4 * g + 2], a3 = o[4 * g + 3];
            a0 = (s0 <= tl) ? a0 : 0.f; a1 = (s0 + 1 <= tl) ? a1 : 0.f; a2 = (s0 + 2 <= tl) ? a2 : 0.f; a3 = (s0 + 3 <= tl) ? a3 : 0.f;
            u32x2 w; w.x = pk2(a0, a1); w.y = pk2(a2, a3); *(LAS u32x2*)(ATT + tl * LS + s0) = w; }
    }
    __syncthreads();
}
struct VRegs { u32x4 r[4]; };
__device__ __forceinline__ void v_load(const Params& p, VRegs& v, int rb, int h, int T) {
    const int tid = otid(), s = tid & 63, vg = tid >> 6; const bf16_t* Z = (const bf16_t*)(p.ws + OFF_Z);
#pragma unroll
    for (int k = 0; k < 4; ++k) v.r[k] = (s < T) ? *(const u32x4*)(Z + (size_t)(rb + s) * NZ + 1024 + h * 256 + vg * 32 + 8 * k) : (u32x4){0u, 0u, 0u, 0u};
}
__device__ __forceinline__ void v_store_t(LAS unsigned char* lds, const VRegs& v) {
    const int tid = otid(), s = tid & 63, vg = tid >> 6; LAS bf16_t* VT = (LAS bf16_t*)(lds + R_VT) + (vg * 32) * LS + s;
#pragma unroll
    for (int k = 0; k < 4; ++k) {
        VT[(8 * k + 0) * LS] = (bf16_t)(v.r[k].x & 0xffffu); VT[(8 * k + 1) * LS] = (bf16_t)(v.r[k].x >> 16);
        VT[(8 * k + 2) * LS] = (bf16_t)(v.r[k].y & 0xffffu); VT[(8 * k + 3) * LS] = (bf16_t)(v.r[k].y >> 16);
        VT[(8 * k + 4) * LS] = (bf16_t)(v.r[k].z & 0xffffu); VT[(8 * k + 5) * LS] = (bf16_t)(v.r[k].z >> 16);
        VT[(8 * k + 6) * LS] = (bf16_t)(v.r[k].w & 0xffffu); VT[(8 * k + 7) * LS] = (bf16_t)(v.r[k].w >> 16); }
}
__device__ __forceinline__ void gla_step(const Params& p, LAS unsigned char* lds, f32x16 (&S)[4], int rb, int h, int T, int vb, int vtrow) {
    const int lane = otid() & 63, l31 = lane & 31, hh = lane >> 5;
    LAS bf16_t* Qe = (LAS bf16_t*)(lds + R_QE); LAS bf16_t* KlT = (LAS bf16_t*)(lds + R_KLT); LAS bf16_t* ATT = (LAS bf16_t*)(lds + R_ATT); LAS float* DEC = (LAS float*)(lds + R_DEC);
    LAS bf16_t* VT = (LAS bf16_t*)(lds + R_VT);
    bf16_t* oraw = (bf16_t*)(p.ws + OFF_ORAW);
    f32x16 Za[2], Zb[2];
#pragma unroll
    for (int tt = 0; tt < 2; ++tt)
#pragma unroll
        for (int i = 0; i < 16; ++i) { Za[tt][i] = 0.f; Zb[tt][i] = 0.f; }
    bf16x8 sa[4][2];
#pragma unroll
    for (int cb = 0; cb < 4; ++cb)
#pragma unroll
        for (int s = 0; s < 2; ++s) { u32x4 aw; aw.x = pk2(S[cb][8 * s], S[cb][8 * s + 1]); aw.y = pk2(S[cb][8 * s + 2], S[cb][8 * s + 3]); aw.z = pk2(S[cb][8 * s + 4], S[cb][8 * s + 5]); aw.w = pk2(S[cb][8 * s + 6], S[cb][8 * s + 7]);
            sa[cb][s] = __builtin_bit_cast(bf16x8, aw); }
    bf16x8 vt[4];
    const LAS bf16_t* vp = VT + (vtrow + l31) * LS + 8 * hh;
#pragma unroll
    for (int ks = 0; ks < 4; ++ks) vt[ks] = *(const LAS bf16x8*)(vp + 16 * ks);
#pragma unroll
    for (int cb = 0; cb < 4; ++cb)
#pragma unroll
        for (int g = 0; g < 4; ++g) { const f32x4 d = *(const LAS f32x4*)(DEC + cb * 32 + 8 * g + 4 * hh);
            S[cb][4 * g] *= d[0]; S[cb][4 * g + 1] *= d[1]; S[cb][4 * g + 2] *= d[2]; S[cb][4 * g + 3] *= d[3]; }
#pragma unroll
    for (int ks = 0; ks < 4; ++ks)
#pragma unroll
        for (int cb = 0; cb < 4; ++cb) { const bf16x8 a = *(const LAS bf16x8*)(KlT + (32 * cb + l31) * LS + 16 * ks + 8 * hh); S[cb] = mfma32(a, vt[ks], S[cb]); }
#pragma unroll
    for (int cb = 0; cb < 4; ++cb)
#pragma unroll
        for (int s = 0; s < 2; ++s)
#pragma unroll
            for (int tt = 0; tt < 2; ++tt) { const LAS bf16_t* qp = Qe + (32 * tt + l31) * LQ + 32 * cb + 16 * s + 4 * hh;
                const u32x2 q0 = *(const LAS u32x2*)qp, q1 = *(const LAS u32x2*)(qp + 8); const u32x4 bw = (u32x4){q0.x, q0.y, q1.x, q1.y};
                Za[tt] = mfma32(sa[cb][s], __builtin_bit_cast(bf16x8, bw), Za[tt]); }
#pragma unroll
    for (int ks = 0; ks < 4; ++ks)
#pragma unroll
        for (int tt = 0; tt < 2; ++tt) if (ks < 2 * (tt + 1)) { const bf16x8 bq = *(const LAS bf16x8*)(ATT + (32 * tt + l31) * LS + 16 * ks + 8 * hh); Zb[tt] = mfma32(vt[ks], bq, Zb[tt]); }
#pragma unroll
    for (int tt = 0; tt < 2; ++tt) { const int t = 32 * tt + l31;
        if (t < T) { bf16_t* op = oraw + (size_t)(rb + t) * 1024 + h * 256 + 32 * vb + 4 * hh;
#pragma unroll
            for (int g = 0; g < 4; ++g) { u32x2 w; w.x = pk2(Za[tt][4 * g] + Zb[tt][4 * g], Za[tt][4 * g + 1] + Zb[tt][4 * g + 1]); w.y = pk2(Za[tt][4 * g + 2] + Zb[tt][4 * g + 2], Za[tt][4 * g + 3] + Zb[tt][4 * g + 3]); *(u32x2*)(op + 8 * g) = w; } } }
}
__device__ __forceinline__ size_t s_index(int cb, int i, int hh, int wave, int l31) { return (size_t)(cb * 32 + (i & 3) + 8 * (i >> 2) + 4 * hh) * 256 + 32 * wave + l31; }

__device__ __forceinline__ void gla_prep_item(const Params& p, LAS unsigned char* lds, int chain, int ch) {
    const int b = chain >> 2, h = chain & 3;
    gla_prep(p, lds, b * 2048 + ch * 64, h, 64);
    u32x4* img = (u32x4*)(p.ws + OFF_IMG + (size_t)(chain * 32 + ch) * IMG_BYTES);
    for (int i = otid(); i < IMG_V4; i += 512) img[i] = ((const LAS u32x4*)lds)[i];
    __syncthreads();
}
constexpr int SG_TAB = 0, SG_ALOW = 20480, SG_PART = 24576;
__device__ __forceinline__ void gla_sample_pair(const Params& p, LAS unsigned char* lds, int item) {
    const int tid = otid(), lane = tid & 63, wave = tid >> 6, q = wave & 3, grp = wave >> 2, chain = item * 2 + grp;
    const int b = chain >> 2, h = chain & 3, rb = MP + b * 8;
    LAS float* tab = (LAS float*)(lds + SG_TAB + wave * 2560); LAS float* alw = (LAS float*)(lds + SG_ALOW + wave * 512); LAS float* part = (LAS float*)(lds + SG_PART);
    const bf16_t* Z = (const bf16_t*)(p.ws + OFF_Z); const float* alowg = (const float*)(p.ws + OFF_ALOW); bf16_t* oraw = (bf16_t*)(p.ws + OFF_ORAW);
    alw[lane] = alowg[(size_t)rb * 16 + lane]; alw[lane + 64] = alowg[(size_t)rb * 16 + 64 + lane];
    float qe[8][2], kv[8][2]; f32x4 V[8];
#pragma unroll
    for (int t = 0; t < 8; ++t) { const bf16_t* zr = Z + (size_t)(rb + t) * NZ; const unsigned qw = *(const unsigned*)(zr + h * 128 + 2 * lane), kw = *(const unsigned*)(zr + 512 + h * 128 + 2 * lane);
        const u32x2 vw = *(const u32x2*)(zr + 1024 + h * 256 + 4 * lane);
        qe[t][0] = bflo(qw); qe[t][1] = bfhi(qw); kv[t][0] = bflo(kw); kv[t][1] = bfhi(kw); V[t] = (f32x4){bflo(vw.x), bfhi(vw.x), bflo(vw.y), bfhi(vw.y)}; }
    float bc[8][2];
    {   f32x2 wa[16];
#pragma unroll
        for (int j = 0; j < 16; ++j) wa[j] = *(const f32x2*)(p.w_a2 + j * 512 + h * 128 + 2 * lane);
        const f32x2 ba = *(const f32x2*)(p.b_a + h * 128 + 2 * lane);
        lds_wait();
        float run0 = 0.f, run1 = 0.f;
#pragma unroll
        for (int t = 0; t < 8; ++t) { float p0 = ba.x, p1 = ba.y;
#pragma unroll
            for (int j4 = 0; j4 < 4; ++j4) { const f32x4 a4 = *(const LAS f32x4*)(alw + t * 16 + 4 * j4);
#pragma unroll
                for (int k = 0; k < 4; ++k) { p0 += a4[k] * wa[4 * j4 + k].x; p1 += a4[k] * wa[4 * j4 + k].y; } }
            run0 += logsigmoid_f(p0) * 0.0625f; run1 += logsigmoid_f(p1) * 0.0625f; bc[t][0] = run0; bc[t][1] = run1; } }
    float ki[8][2];
#pragma unroll
    for (int t = 0; t < 8; ++t) { qe[t][0] *= __expf(bc[t][0]); qe[t][1] *= __expf(bc[t][1]); ki[t][0] = kv[t][0] * __expf(-bc[t][0]); ki[t][1] = kv[t][1] * __expf(-bc[t][1]); }
    lds_wait();
#pragma unroll
    for (int t = 0; t < 8; ++t)
#pragma unroll
        for (int s = 0; s <= t; ++s) { const float a = wave_sum(qe[t][0] * ki[s][0] + qe[t][1] * ki[s][1]); if (lane == 0) alw[t * (t + 1) / 2 + s] = a; }
    if ((lane >> 4) == q) { const float e0 = __expf(bc[7][0]), e1 = __expf(bc[7][1]); LAS float* r0 = tab + (2 * lane - 32 * q) * 20; LAS float* r1 = r0 + 20;
        *(LAS f32x4*)(r0) = (f32x4){qe[0][0], qe[1][0], qe[2][0], qe[3][0]}; *(LAS f32x4*)(r0 + 4) = (f32x4){qe[4][0], qe[5][0], qe[6][0], qe[7][0]};
        *(LAS f32x4*)(r1) = (f32x4){qe[0][1], qe[1][1], qe[2][1], qe[3][1]}; *(LAS f32x4*)(r1 + 4) = (f32x4){qe[4][1], qe[5][1], qe[6][1], qe[7][1]};
        *(LAS f32x4*)(r0 + 8) = (f32x4){ki[0][0] * e0, ki[1][0] * e0, ki[2][0] * e0, ki[3][0] * e0}; *(LAS f32x4*)(r0 + 12) = (f32x4){ki[4][0] * e0, ki[5][0] * e0, ki[6][0] * e0, ki[7][0] * e0};
        *(LAS f32x4*)(r1 + 8) = (f32x4){ki[0][1] * e1, ki[1][1] * e1, ki[2][1] * e1, ki[3][1] * e1}; *(LAS f32x4*)(r1 + 12) = (f32x4){ki[4][1] * e1, ki[5][1] * e1, ki[6][1] * e1, ki[7][1] * e1};
        r0[16] = e0; r1[16] = e1; }
    lds_wait();
    f32x4 o[8];
#pragma unroll
    for (int t = 0; t < 8; ++t) o[t] = (f32x4){0.f, 0.f, 0.f, 0.f};
    const f32x4* S0 = (const f32x4*)(p.state_gla + (size_t)chain * 32768 + (size_t)(32 * q) * 256) + lane; f32x4* So = (f32x4*)(p.out + OUT_SS + (size_t)chain * 32768 + (size_t)(32 * q) * 256) + lane;
#pragma unroll 1
    for (int cc = 0; cc < 32; cc += 16) { f32x4 s[16];
#pragma unroll
        for (int u = 0; u < 16; ++u) s[u] = S0[(cc + u) * 64];
#pragma unroll
        for (int u = 0; u < 16; ++u) { const LAS float* row = tab + (cc + u) * 20; const f32x4 qa = *(const LAS f32x4*)row, qb = *(const LAS f32x4*)(row + 4), ka = *(const LAS f32x4*)(row + 8), kb = *(const LAS f32x4*)(row + 12); const float d = row[16];
            o[0] += qa[0] * s[u]; o[1] += qa[1] * s[u]; o[2] += qa[2] * s[u]; o[3] += qa[3] * s[u]; o[4] += qb[0] * s[u]; o[5] += qb[1] * s[u]; o[6] += qb[2] * s[u]; o[7] += qb[3] * s[u];
            f32x4 sn = d * s[u]; sn += ka[0] * V[0]; sn += ka[1] * V[1]; sn += ka[2] * V[2]; sn += ka[3] * V[3]; sn += kb[0] * V[4]; sn += kb[1] * V[5]; sn += kb[2] * V[6]; sn += kb[3] * V[7];
            So[(cc + u) * 64] = sn; } }
#pragma unroll
    for (int t = 0; t < 8; ++t) *(LAS f32x4*)(part + (wave * 8 + t) * 256 + 4 * lane) = o[t];
    __syncthreads();
#pragma unroll
    for (int tt = 0; tt < 2; ++tt) { const int t = 2 * q + tt; f32x4 acc = (f32x4){0.f, 0.f, 0.f, 0.f};
#pragma unroll
        for (int w = 0; w < 4; ++w) acc += *(const LAS f32x4*)(part + ((grp * 4 + w) * 8 + t) * 256 + 4 * lane);
#pragma unroll
        for (int s = 0; s < 8; ++s) { const float a = (s <= t) ? alw[t * (t + 1) / 2 + s] : 0.f; acc += a * V[s]; }
        { u32x2 w; w.x = pk2(acc[0], acc[1]); w.y = pk2(acc[2], acc[3]); *(u32x2*)(oraw + (size_t)(rb + t) * 1024 + h * 256 + 4 * lane) = w; } }
    __syncthreads();
}
struct VRegs2 { u32x4 r[2]; };
__device__ __forceinline__ void v_load_half(const Params& p, VRegs2& v, int rb, int h, int vhalf) {
    const int tid = otid(), s = tid & 63, vg = tid >> 6; const bf16_t* Z = (const bf16_t*)(p.ws + OFF_Z);
#pragma unroll
    for (int k = 0; k < 2; ++k) v.r[k] = *(const u32x4*)(Z + (size_t)(rb + s) * NZ + 1024 + h * 256 + vhalf * 128 + vg * 16 + 8 * k);
}
__device__ __forceinline__ void v_store_half_t(LAS unsigned char* lds, const VRegs2& v) {
    const int tid = otid(), s = tid & 63, vg = tid >> 6; LAS bf16_t* VT = (LAS bf16_t*)(lds + R_VT) + (vg * 16) * LS + s;
#pragma unroll
    for (int k = 0; k < 2; ++k) {
        VT[(8 * k + 0) * LS] = (bf16_t)(v.r[k].x & 0xffffu); VT[(8 * k + 1) * LS] = (bf16_t)(v.r[k].x >> 16);
        VT[(8 * k + 2) * LS] = (bf16_t)(v.r[k].y & 0xffffu); VT[(8 * k + 3) * LS] = (bf16_t)(v.r[k].y >> 16);
        VT[(8 * k + 4) * LS] = (bf16_t)(v.r[k].z & 0xffffu); VT[(8 * k + 5) * LS] = (bf16_t)(v.r[k].z >> 16);
        VT[(8 * k + 6) * LS] = (bf16_t)(v.r[k].w & 0xffffu); VT[(8 * k + 7) * LS] = (bf16_t)(v.r[k].w >> 16); }
}
constexpr int CH_BUF = 64000;
template <int NTHR> __device__ __forceinline__ void chain_stage(const Params& p, LAS unsigned char* buf, const u32x4* img, int rb, int h, int vhalf, int t) {
    const bf16_t* Z = (const bf16_t*)(p.ws + OFF_Z);
    constexpr int NI = (IMG_V4 + NTHR - 1) / NTHR, NV = 512 / NTHR;
    u32x4 im[NI], v0[NV], v1[NV];
#pragma unroll
    for (int k = 0; k < NI; ++k) { const int i = t + NTHR * k; im[k] = (i < IMG_V4) ? img[i] : (u32x4){0u, 0u, 0u, 0u}; }
#pragma unroll
    for (int k = 0; k < NV; ++k) { const int e = t + NTHR * k, s = e & 63, vg = e >> 6; const bf16_t* zp = Z + (size_t)(rb + s) * NZ + 1024 + h * 256 + vhalf * 128 + vg * 16; v0[k] = *(const u32x4*)zp; v1[k] = *(const u32x4*)(zp + 8); }
#pragma unroll
    for (int k = 0; k < NI; ++k) { const int i = t + NTHR * k; if (i < IMG_V4) ((LAS u32x4*)buf)[i] = im[k]; }
#pragma unroll
    for (int k = 0; k < NV; ++k) { const int e = t + NTHR * k, s = e & 63, vg = e >> 6; const u32x4 r0 = v0[k], r1 = v1[k];
        LAS bf16_t* VT = (LAS bf16_t*)(buf + R_VT) + (vg * 16) * LS + s;
        VT[0 * LS] = (bf16_t)(r0.x & 0xffffu); VT[1 * LS] = (bf16_t)(r0.x >> 16); VT[2 * LS] = (bf16_t)(r0.y & 0xffffu); VT[3 * LS] = (bf16_t)(r0.y >> 16);
        VT[4 * LS] = (bf16_t)(r0.z & 0xffffu); VT[5 * LS] = (bf16_t)(r0.z >> 16); VT[6 * LS] = (bf16_t)(r0.w & 0xffffu); VT[7 * LS] = (bf16_t)(r0.w >> 16);
        VT[8 * LS] = (bf16_t)(r1.x & 0xffffu); VT[9 * LS] = (bf16_t)(r1.x >> 16); VT[10 * LS] = (bf16_t)(r1.y & 0xffffu); VT[11 * LS] = (bf16_t)(r1.y >> 16);
        VT[12 * LS] = (bf16_t)(r1.z & 0xffffu); VT[13 * LS] = (bf16_t)(r1.z >> 16); VT[14 * LS] = (bf16_t)(r1.w & 0xffffu); VT[15 * LS] = (bf16_t)(r1.w >> 16); }
}
__device__ __forceinline__ void gla_chain_item(const Params& p, LAS unsigned char* lds, int chain, int vhalf) {
    const int tid = otid(), lane = tid & 63, wave = tid >> 6, l31 = lane & 31, hh = lane >> 5;
    const int b = chain >> 2, h = chain & 3, vb = vhalf * 4 + (wave & 3);
    f32x16 S[4];
#pragma unroll
    for (int cb = 0; cb < 4; ++cb)
#pragma unroll
        for (int i = 0; i < 16; ++i) S[cb][i] = 0.f;
    const u32x4* img = (const u32x4*)(p.ws + OFF_IMG + (size_t)(chain * 32) * IMG_BYTES);
    chain_stage<512>(p, lds, img, b * 2048, h, vhalf, tid);
    __syncthreads();
#pragma unroll 1
    for (int ch = 0; ch < 32; ++ch) {
        const int rb = b * 2048 + ch * 64;
        if (wave >= 4) { if (ch + 1 < 32) chain_stage<256>(p, lds + ((ch + 1) & 1) * CH_BUF, img + (size_t)(ch + 1) * IMG_V4, rb + 64, h, vhalf, tid - 256); }
        else gla_step(p, lds + (ch & 1) * CH_BUF, S, rb, h, 64, vb, 32 * wave);
        __syncthreads();
    }
    if (wave < 4) {
        float* Sout = p.out + OUT_SP + (size_t)chain * 32768;
#pragma unroll
        for (int cb = 0; cb < 4; ++cb)
#pragma unroll
            for (int i = 0; i < 16; ++i) Sout[s_index(cb, i, hh, vb, l31)] = S[cb][i];
    }
}

constexpr int M_W = 0, M_V = 34816, M_STAT = 69632;
__device__ __forceinline__ void gmlp_item(const Params& p, LAS unsigned char* lds, int rowbase, int T, int g, float* vs_out) {
    const int tid = otid(), lane = tid & 63, wave = tid >> 6;
    const bf16_t* Z = (const bf16_t*)(p.ws + OFF_Z); bf16_t* mraw = (bf16_t*)(p.ws + OFF_MRAW);
    LAS bf16_t* LW = (LAS bf16_t*)(lds + M_W); LAS bf16_t* LV = (LAS bf16_t*)(lds + M_V); LAS float* stat = (LAS float*)(lds + M_STAT);
    if (tid < 128) { const f32x2 st = (tid < T) ? *(const f32x2*)((const float*)(p.ws + OFF_STAT) + (size_t)(rowbase + tid) * 2) : (f32x2){0.f, 0.f}; stat[2 * tid] = st.x; stat[2 * tid + 1] = st.y; }
    for (int idx = tid; idx < 4096; idx += 512) { const int t = idx >> 5, s4 = (idx & 31) * 4; const f32x4 w = *(const f32x4*)(p.w_s + ((size_t)g * 128 + t) * 128 + s4);
        u32x2 o; o.x = pk2(s4 <= t ? w[0] : 0.f, s4 + 1 <= t ? w[1] : 0.f); o.y = pk2(s4 + 2 <= t ? w[2] : 0.f, s4 + 3 <= t ? w[3] : 0.f);
        *(LAS u32x2*)(LW + t * LQ + s4) = o; }
    __syncthreads();
    { const int s = tid & 127, dq = tid >> 7; const float mean = stat[2 * s], rstd = stat[2 * s + 1];
#pragma unroll
        for (int ps = 0; ps < 4; ++ps) { const int d8 = (dq * 4 + ps) * 8; float vn[8];
            if (s < T) { const u32x4 r = *(const u32x4*)(Z + (size_t)(rowbase + s) * NZ + 4096 + g * 128 + d8);
                const float x[8] = {bflo(r.x), bfhi(r.x), bflo(r.y), bfhi(r.y), bflo(r.z), bfhi(r.z), bflo(r.w), bfhi(r.w)};
                const f32x4 ga = *(const f32x4*)(p.g_gmlp_ln + g * 128 + d8), gb = *(const f32x4*)(p.g_gmlp_ln + g * 128 + d8 + 4);
                const f32x4 ba = *(const f32x4*)(p.b_gmlp_ln + g * 128 + d8), bb = *(const f32x4*)(p.b_gmlp_ln + g * 128 + d8 + 4);
#pragma unroll
                for (int j = 0; j < 4; ++j) { vn[j] = (x[j] - mean) * rstd * ga[j] + ba[j]; vn[4 + j] = (x[4 + j] - mean) * rstd * gb[j] + bb[j]; }
                if (vs_out) { float* vp = vs_out + (size_t)s * 1024 + g * 128 + d8; *(f32x4*)vp = (f32x4){vn[0], vn[1], vn[2], vn[3]}; *(f32x4*)(vp + 4) = (f32x4){vn[4], vn[5], vn[6], vn[7]}; }
            } else {
#pragma unroll
                for (int j = 0; j < 8; ++j) vn[j] = 0.f;
            }
#pragma unroll
            for (int j = 0; j < 8; ++j) LV[(d8 + j) * LQ + s] = f2bf(vn[j]); } }
    __syncthreads();
#pragma unroll 1
    for (int q = 0; q < 2; ++q) { const int id = wave * 2 + q, ti = id >> 2, di = id & 3;
        if (ti * 32 < T) { f32x16 acc;
#pragma unroll
            for (int i = 0; i < 16; ++i) acc[i] = 0.f;
            mma32(acc, LW + ti * 32 * LQ, LQ, LV + di * 32 * LQ, LQ, (ti + 1) * 32, lane);
            const int d = di * 32 + (lane & 31);
#pragma unroll
            for (int i = 0; i < 16; ++i) { const int t = ti * 32 + (i & 3) + 8 * (i >> 2) + 4 * (lane >> 5);
                if (t < T) { const float uval = bf2f(Z[(size_t)(rowbase + t) * NZ + 3072 + g * 128 + d]);
                    mraw[(size_t)(rowbase + t) * 1024 + g * 128 + d] = f2bf(uval * (acc[i] + p.b_s[g * 128 + t])); } } } }
    __syncthreads();
}

__device__ __forceinline__ void gmlp_sample_item(const Params& p, int b) {
    const int tid = otid(), d2 = tid * 2, g = __builtin_amdgcn_readfirstlane(tid >> 6), rb = MP + b * 8;
    const bf16_t* Z = (const bf16_t*)(p.ws + OFF_Z); bf16_t* mraw = (bf16_t*)(p.ws + OFF_MRAW); const float* st = (const float*)(p.ws + OFF_STAT) + (size_t)rb * 2;
    float* vs_out = p.out + OUT_VS + (size_t)b * 8 * 1024;
    const f32x2 ga = *(const f32x2*)(p.g_gmlp_ln + d2), be = *(const f32x2*)(p.b_gmlp_ln + d2);
    unsigned xv[8], uv[8];
#pragma unroll
    for (int s_ = 0; s_ < 8; ++s_) { xv[s_] = *(const unsigned*)(Z + (size_t)(rb + s_) * NZ + 4096 + d2); uv[s_] = *(const unsigned*)(Z + (size_t)(rb + s_) * NZ + 3072 + d2); }
    float v0[8], v1[8];
#pragma unroll
    for (int s_ = 0; s_ < 8; ++s_) { const float mean = st[2 * s_], rstd = st[2 * s_ + 1];
        v0[s_] = (bflo(xv[s_]) - mean) * rstd * ga.x + be.x; v1[s_] = (bfhi(xv[s_]) - mean) * rstd * ga.y + be.y;
        *(f32x2*)(vs_out + (size_t)s_ * 1024 + d2) = (f32x2){v0[s_], v1[s_]}; }
    const float* wg = p.w_s + (size_t)g * 128 * 128; const float* bs = p.b_s + g * 128;
#pragma unroll
    for (int t = 0; t < 8; ++t) { float m0 = bs[t], m1 = m0;
#pragma unroll
        for (int s_ = 0; s_ <= t; ++s_) { const float w = wg[t * 128 + s_]; m0 += w * v0[s_]; m1 += w * v1[s_]; }
        *(unsigned*)(mraw + (size_t)(rb + t) * 1024 + d2) = pk2(bflo(uv[t]) * m0, bfhi(uv[t]) * m1); }
}
__device__ __forceinline__ void phase2a(const Params& p, LAS unsigned char* lds) {
    {   const int tid = otid(), lane = tid & 63, gw = blockIdx.x * 8 + (tid >> 6), NGW = gridDim.x * 8;
        const bf16_t* Z = (const bf16_t*)(p.ws + OFF_Z); float* st = (float*)(p.ws + OFF_STAT);
        for (int r = gw; r < MT; r += NGW) {
            const bf16_t* zr = Z + (size_t)r * NZ + 4096; const u32x4 r0 = *(const u32x4*)(zr + lane * 8), r1 = *(const u32x4*)(zr + 512 + lane * 8);
            const float x[16] = {bflo(r0.x), bfhi(r0.x), bflo(r0.y), bfhi(r0.y), bflo(r0.z), bfhi(r0.z), bflo(r0.w), bfhi(r0.w), bflo(r1.x), bfhi(r1.x), bflo(r1.y), bfhi(r1.y), bflo(r1.z), bfhi(r1.z), bflo(r1.w), bfhi(r1.w)};
            float s = 0.f;
#pragma unroll
            for (int j = 0; j < 16; ++j) s += x[j];
            const float mean = wave_sum(s) * (1.f / 1024.f); float q = 0.f;
#pragma unroll
            for (int j = 0; j < 16; ++j) { const float d = x[j] - mean; q += d * d; }
            const float rstd = rsqrtf(wave_sum(q) * (1.f / 1024.f) + 1e-6f);
            if (lane == 0) *(f32x2*)(st + (size_t)r * 2) = (f32x2){mean, rstd};
        }
    }
    for (int j = blockIdx.x; j < 512; j += gridDim.x) gla_prep_item(p, lds, j >> 5, j & 31);
    for (int j = blockIdx.x; j < 256; j += gridDim.x) gla_sample_pair(p, lds, j);
    { const int gw = blockIdx.x * 8 + (otid() >> 6), NGW = gridDim.x * 8; convert_range(p, lds, cv::E_IN, cv::E_OUT, gw, NGW); convert_range(p, lds, cv::E_FO, cv::E_PLE, gw, NGW); }
}
__device__ __forceinline__ void phase2c(const Params& p, LAS unsigned char* lds) {
    const int nb = gridDim.x, bid = blockIdx.x;
    constexpr int NCH = 32, N_GP = 512, N_GS = 0, N_MS = 128;
    const int nlb = nb > 2 * NCH ? NCH : (nb > 1 ? nb / 2 : 0);
    if (bid < nlb || nlb == 0) { for (int j = (nlb ? bid : 0); j < NCH; j += (nlb ? nlb : 1)) gla_chain_item(p, lds, j >> 1, j & 1); }
    if (bid >= nlb) {
        const int ob = bid - nlb, onb = nb - nlb;
        for (int j = ob; j < N_GP + N_GS + N_MS; j += onb) {
            if (j < N_GP) gmlp_item(p, lds, (j >> 3) * 128, 128, j & 7, nullptr);
            else gmlp_sample_item(p, j - N_GP - N_GS);
        }
        __syncthreads();
        convert_range(p, lds, cv::E_OUT, cv::E_FI, ob * 8 + (otid() >> 6), onb * 8);
    }
}

struct Mix10 { f32x4 o[4], m[4]; u32x4 r0, r1; };
__device__ __forceinline__ void mix_load(Mix10& a, const Params& p, int r, int col) {
    const bf16_t* Z = (const bf16_t*)(p.ws + OFF_Z); const bf16_t* oraw = (const bf16_t*)(p.ws + OFF_ORAW); const bf16_t* mraw = (const bf16_t*)(p.ws + OFF_MRAW);
#pragma unroll
    for (int j = 0; j < 2; ++j) { const u32x4 ow = *(const u32x4*)(oraw + (size_t)r * 1024 + col + 8 * j), mw = *(const u32x4*)(mraw + (size_t)r * 1024 + col + 8 * j);
        a.o[2 * j] = (f32x4){bflo(ow.x), bfhi(ow.x), bflo(ow.y), bfhi(ow.y)}; a.o[2 * j + 1] = (f32x4){bflo(ow.z), bfhi(ow.z), bflo(ow.w), bfhi(ow.w)};
        a.m[2 * j] = (f32x4){bflo(mw.x), bfhi(mw.x), bflo(mw.y), bfhi(mw.y)}; a.m[2 * j + 1] = (f32x4){bflo(mw.z), bfhi(mw.z), bflo(mw.w), bfhi(mw.w)}; }
    a.r0 = *(const u32x4*)(Z + (size_t)r * NZ + 2048 + col); a.r1 = *(const u32x4*)(Z + (size_t)r * NZ + 2048 + col + 8);
}
__device__ __forceinline__ void mix_finish(const Mix10& a, const Params& p, int r, int col) {
    bf16_t* cat = (bf16_t*)(p.ws + OFF_A0);
    { float s = 0.f;
#pragma unroll
        for (int j = 0; j < 4; ++j) s += (a.o[j][0] * a.o[j][0] + a.o[j][1] * a.o[j][1]) + (a.o[j][2] * a.o[j][2] + a.o[j][3] * a.o[j][3]);
        s = row16_sum(s);
        const float rinv = rsqrtf(s * (1.f / 256.f) + 1e-6f);
        const float sr[16] = {bflo(a.r0.x), bfhi(a.r0.x), bflo(a.r0.y), bfhi(a.r0.y), bflo(a.r0.z), bfhi(a.r0.z), bflo(a.r0.w), bfhi(a.r0.w), bflo(a.r1.x), bfhi(a.r1.x), bflo(a.r1.y), bfhi(a.r1.y), bflo(a.r1.z), bfhi(a.r1.z), bflo(a.r1.w), bfhi(a.r1.w)};
        unsigned w[8];
#pragma unroll
        for (int j = 0; j < 4; ++j) { const f32x4 g = *(const f32x4*)(p.g_gla_norm + col + 4 * j);
            w[2 * j] = pk2(a.o[j][0] * rinv * g[0] * sr[4 * j], a.o[j][1] * rinv * g[1] * sr[4 * j + 1]); w[2 * j + 1] = pk2(a.o[j][2] * rinv * g[2] * sr[4 * j + 2], a.o[j][3] * rinv * g[3] * sr[4 * j + 3]); }
        u32x4* dp = (u32x4*)(cat + (size_t)r * DM + col); dp[0] = (u32x4){w[0], w[1], w[2], w[3]}; dp[1] = (u32x4){w[4], w[5], w[6], w[7]}; }
    { float s = 0.f;
#pragma unroll
        for (int j = 0; j < 4; ++j) s += (a.m[j][0] * a.m[j][0] + a.m[j][1] * a.m[j][1]) + (a.m[j][2] * a.m[j][2] + a.m[j][3] * a.m[j][3]);
        const float rinv = rsqrtf(wave_sum(s) * (1.f / 1024.f) + 1e-6f);
        unsigned w[8];
#pragma unroll
        for (int j = 0; j < 4; ++j) { const f32x4 g = *(const f32x4*)(p.g_gmlp_out + col + 4 * j);
            w[2 * j] = pk2(a.m[j][0] * rinv * g[0], a.m[j][1] * rinv * g[1]); w[2 * j + 1] = pk2(a.m[j][2] * rinv * g[2], a.m[j][3] * rinv * g[3]); }
        u32x4* dp = (u32x4*)(cat + (size_t)r * DM + 1024 + col); dp[0] = (u32x4){w[0], w[1], w[2], w[3]}; dp[1] = (u32x4){w[4], w[5], w[6], w[7]}; }
}
__device__ __forceinline__ void phase2b(const Params& p) {
    const int lane = otid() & 63, gw = blockIdx.x * 8 + (otid() >> 6), NGW = gridDim.x * 8, col = lane * 16;
    for (int r = gw; r < MT; r += 2 * NGW) {
        const int r2 = r + NGW; const bool has2 = r2 < MT;
        Mix10 a, b; mix_load(a, p, r, col); mix_load(b, p, has2 ? r2 : r, col);
        mix_finish(a, p, r, col);
        if (has2) mix_finish(b, p, r2, col);
    }
}
template <int NS> __device__ __forceinline__ void phase_norm(const Params& p, const float* gain, const float* base_s) {
    const int lane = otid() & 63, gw = blockIdx.x * 8 + (otid() >> 6), NGW = gridDim.x * 8; bf16_t* a0 = (bf16_t*)(p.ws + OFF_A0); const bf16_t* part = (const bf16_t*)(p.ws + OFF_IMG);
    for (int r = gw; r < MP; r += 4 * NGW) {
        const int r2 = r + NGW, r3 = r + 2 * NGW, r4 = r + 3 * NGW; const bool h2 = r2 < MP, h3 = r3 < MP, h4 = r4 < MP;
        Row8 a, b, c4, d; row_load(a, p.out + OUT_Y + (size_t)r * DM, lane); row_load(b, p.out + OUT_Y + (size_t)(h2 ? r2 : r) * DM, lane);
        row_load(c4, p.out + OUT_Y + (size_t)(h3 ? r3 : r) * DM, lane); row_load(d, p.out + OUT_Y + (size_t)(h4 ? r4 : r) * DM, lane);
        rms_finish_bf16(a, gain, a0 + (size_t)r * DM, lane);
        if (h2) rms_finish_bf16(b, gain, a0 + (size_t)r2 * DM, lane);
        if (h3) rms_finish_bf16(c4, gain, a0 + (size_t)r3 * DM, lane);
        if (h4) rms_finish_bf16(d, gain, a0 + (size_t)r4 * DM, lane);
    }
    for (int r = MP + gw; r < MT; r += NGW) {
        f32x4 v[8]; float s = 0.f; const f32x4* sm = row_mid(base_s + (size_t)(r - MP) * DM, lane); const f32x4* gm = row_mid(gain, lane);
        const u32x2* pm0 = (const u32x2*)(part + (size_t)(r - MP) * DM) + lane; f32x4* om = row_mid(p.out + OUT_Y + (size_t)r * DM, lane);
#pragma unroll
        for (int j = 0; j < 8; ++j) v[j] = sm[64 * (j - 4)];
#pragma unroll 4
        for (int k = 0; k < NS; ++k) { const u32x2* pk = pm0 + (size_t)k * (MS * DM / 4);
#pragma unroll
            for (int j = 0; j < 8; ++j) v[j] += unpack4(pk[64 * j]); }
#pragma unroll
        for (int j = 0; j < 8; ++j) { om[64 * (j - 4)] = v[j]; s += (v[j][0] * v[j][0] + v[j][1] * v[j][1]) + (v[j][2] * v[j][2] + v[j][3] * v[j][3]); }
        const float rinv = rsqrtf(wave_sum(s) * (1.f / DM) + 1e-6f);
        u32x2* dm = (u32x2*)(a0 + (size_t)r * DM) + lane;
#pragma unroll
        for (int j = 0; j < 8; ++j) { const f32x4 g = gm[64 * (j - 4)]; u32x2 o; o.x = pk2(v[j][0] * rinv * g[0], v[j][1] * rinv * g[1]); o.y = pk2(v[j][2] * rinv * g[2], v[j][3] * rinv * g[3]);
            dm[64 * j] = o; }
    }
}
#define P7_TAIL() \
        float s = 0.f; \
        _Pragma("unroll") for (int j = 0; j < 8; ++j) s += (v.v[j][0] * v.v[j][0] + v.v[j][1] * v.v[j][1]) + (v.v[j][2] * v.v[j][2] + v.v[j][3] * v.v[j][3]); \
        const float rp = rsqrtf(wave_sum(s) * (1.f / DM) + 1e-6f); float s3 = 0.f; \
        const f32x4* gpm = row_mid(p.g_ple, lane); \
        _Pragma("unroll") for (int j = 0; j < 8; ++j) { const f32x4 g = gpm[64 * (j - 4)]; \
            _Pragma("unroll") for (int k = 0; k < 4; ++k) { const float h3 = hh.v[j][k] + v.v[j][k] * rp * g[k] * sigmoid_f(z.v[j][k]); v.v[j][k] = h3; s3 += h3 * h3; } } \
        const float r3 = rsqrtf(wave_sum(s3) * (1.f / DM) + 1e-6f); \
        const f32x4* gfm = row_mid(p.g_final, lane); \
        _Pragma("unroll") for (int j = 0; j < 8; ++j) { const f32x4 g = gfm[64 * (j - 4)]; om[64 * (j - 4)] = (f32x4){v.v[j][0] * r3 * g[0], v.v[j][1] * r3 * g[1], v.v[j][2] * r3 * g[2], v.v[j][3] * r3 * g[3]}; }
__device__ __forceinline__ void phase7(const Params& p) {
    const int lane = otid() & 63, gw = blockIdx.x * 8 + (otid() >> 6), NGW = gridDim.x * 8;
    const bf16_t* gz = (const bf16_t*)(p.ws + OFF_GATEZ); const bf16_t* pz = (const bf16_t*)(p.ws + OFF_PZ);
#pragma unroll 1
    for (int r = gw; r < MP; r += NGW) {
        f32x4* om = row_mid(p.out + OUT_Y + (size_t)r * DM, lane);
        const u32x2* pzr = (const u32x2*)(pz + (size_t)r * DM) + lane; const u32x2* zb = (const u32x2*)(gz + (size_t)r * DM) + lane;
        Row8 v, hh, z;
#pragma unroll
        for (int j = 0; j < 8; ++j) { const u32x2 w = pzr[64 * j], zw = zb[64 * j]; v.v[j] = (f32x4){bflo(w.x), bfhi(w.x), bflo(w.y), bfhi(w.y)}; z.v[j] = (f32x4){bflo(zw.x), bfhi(zw.x), bflo(zw.y), bfhi(zw.y)}; hh.v[j] = om[64 * (j - 4)]; }
        P7_TAIL()
    }
#pragma unroll 1
    for (int r = MP + gw; r < MT; r += NGW) {
        f32x4* om = row_mid(p.out + OUT_Y + (size_t)r * DM, lane);
        const u32x2* pzr = (const u32x2*)(pz + (size_t)r * DM) + lane; const u32x2* zm = (const u32x2*)((const bf16_t*)(p.ws + OFF_IMG) + (size_t)(r - MP) * DM) + lane;
        Row8 v, hh, z;
#pragma unroll
        for (int j = 0; j < 8; ++j) { const u32x2 w = pzr[64 * j]; v.v[j] = unpack4(w); hh.v[j] = om[64 * (j - 4)]; z.v[j] = (f32x4){0.f, 0.f, 0.f, 0.f}; }
#pragma unroll 4
        for (int k = 0; k < 8; ++k) { const u32x2* pk = zm + (size_t)k * (MS * DM / 4);
#pragma unroll
            for (int j = 0; j < 8; ++j) z.v[j] += unpack4(pk[64 * j]); }
        P7_TAIL()
    }
}
#undef P7_TAIL

__global__ void __launch_bounds__(512, 2) fwd_kernel(Params p) {
    extern __shared__ __attribute__((aligned(16))) unsigned char shm[];
    LAS unsigned char* lds = (LAS unsigned char*)shm;
    cg::grid_group grid = cg::this_grid();
    if (threadIdx.x == 0) { *(volatile LAS unsigned*)(lds + 131072) = 0u; *(volatile LAS unsigned*)(lds + 131076) = 0u; }
    __syncthreads();
    const XcdBarrier xb = xcd_barrier_post((unsigned*)(p.ws + OFF_BAR), (volatile LAS unsigned*)(lds + 131072));
    bf16_t* a0 = (bf16_t*)(p.ws + OFF_A0);
    phase0(p, lds);
    if (p.ws == nullptr) grid.sync();
    xcd_barrier(xb);
    { EpiIn E; E.Z = (bf16_t*)(p.ws + OFF_Z); E.alow = (float*)(p.ws + OFF_ALOW); run_gemm(lds, a0, (const bf16_t*)(p.ws + OFF_WIN), MT, NINP, DM, E); }
    xcd_barrier(xb);
    phase2a(p, lds);
    xcd_barrier(xb);
    phase2c(p, lds);
    xcd_barrier(xb);
    phase2b(p);
    xcd_barrier(xb);
    bf16_t* part = (bf16_t*)(p.ws + OFF_IMG);
    { EpiRes E; E.res_p = p.x_prompt; E.res_s = p.x_sample; E.out = p.out + OUT_Y; run_gemm_n2048(lds, a0, (const bf16_t*)(p.ws + OFF_WOUT), DM, E, part); }
    xcd_barrier(xb);
    phase_norm<8>(p, p.g_ffn, p.x_sample);
    xcd_barrier(xb);
    { EpiSwiglu E; E.act = (bf16_t*)(p.ws + OFF_ACT); run_gemm(lds, a0, (const bf16_t*)(p.ws + OFF_WFI), MT, 2 * DFF, DM, E); }
    {
        const int G = (int)gridDim.x, extra = ((MT / 256) * (2 * DFF / 256)) % G, cb = (int)blockIdx.x;
        if (extra == 0 || cb >= extra) { EpiBfN E; E.out = (bf16_t*)(p.ws + OFF_PZ); pg8::Gemm g; g.A = (const bf16_t*)(p.ws + OFF_PB); g.Bt = (const bf16_t*)(p.ws + OFF_WPLE); g.M = MT; g.N = DM; g.K = PLE; g.Klen = PLE;
            pg8::StaticOrder S; S.init(MT, DM, extra ? G - extra : G, extra ? cb - extra : cb); pg8::gemm_phase<EpiBfN, pg8::StaticOrder, false>(lds, g, S, E, nullptr);
            { const int ob = extra ? cb - extra : cb, onb = extra ? G - extra : G, gw = ob * 8 + (otid() >> 6); convert_range(p, lds, cv::E_FI, cv::E_FO, gw, onb * 8); convert_range(p, lds, cv::E_PLE, cv::E_GT, gw, onb * 8); } }
    }
    xcd_barrier(xb);
    { EpiRes E; E.res_p = p.out + OUT_Y; E.res_s = p.out + OUT_Y + (size_t)MP * DM; E.out = p.out + OUT_Y;
      const bf16_t* A = (const bf16_t*)(p.ws + OFF_ACT); const bf16_t* Bt = (const bf16_t*)(p.ws + OFF_WFO); const int G = (int)gridDim.x, hb = (int)((blockIdx.x + G / 2) % G);
      run_gemm(lds, A, Bt, MP, DM, DFF, E);
      run_split(lds, A, Bt, DFF, part, 4, 768, 0, 0, hb);
      run_split(lds, A, Bt, DFF, part, 4, 640, 3072, 4, (int)blockIdx.x); }
    xcd_barrier(xb);
    phase_norm<8>(p, p.g_ple_gate, p.out + OUT_Y + (size_t)MP * DM);
    xcd_barrier(xb);
    { EpiBfN E; E.out = (bf16_t*)(p.ws + OFF_GATEZ); run_gemm_n2048(lds, a0, (const bf16_t*)(p.ws + OFF_WGT), DM, E, part); }
    xcd_barrier(xb);
    phase7(p);
}

extern "C" void kernel_launch(void* const* d_in, const int* in_sizes, int n_in, void* d_out, int out_size, void* d_ws, size_t ws_size, hipStream_t stream) {
    static int grid = 0;
    if (grid == 0) {
        if (n_in != 24 || ws_size < WS_END) { fprintf(stderr, "kernel_launch: unexpected n_in %d or ws_size %zu (< %zu)\n", n_in, ws_size, (size_t)WS_END); grid = -1; return; }
        int dev = 0, cus = 0, per_cu = 0;
        if (hipGetDevice(&dev) != hipSuccess || hipDeviceGetAttribute(&cus, hipDeviceAttributeMultiprocessorCount, dev) != hipSuccess) { grid = -1; return; }
        if (hipFuncSetAttribute((const void*)fwd_kernel, hipFuncAttributeMaxDynamicSharedMemorySize, LDS_BYTES) != hipSuccess) { fprintf(stderr, "kernel_launch: hipFuncSetAttribute failed\n"); grid = -1; return; }
        if (hipOccupancyMaxActiveBlocksPerMultiprocessor(&per_cu, (const void*)fwd_kernel, 512, LDS_BYTES) != hipSuccess || per_cu < 1) { fprintf(stderr, "kernel_launch: occupancy query says %d blocks per CU\n", per_cu); grid = -1; (void)hipGetLastError(); return; }
        grid = cus;
    }
    if (grid < 0) return;
    if (hipMemsetAsync(d_ws, 0, XCD_BAR_WORDS * sizeof(unsigned), stream) != hipSuccess) { fprintf(stderr, "kernel_launch: memset failed\n"); return; }
    Params p{};
    const float** f = (const float**)&p;
    for (int i = 0; i < 24; ++i) f[i] = (const float*)d_in[i];
    p.out = (float*)d_out; p.ws = (unsigned char*)d_ws;
    void* args[] = {&p};
    hipError_t e = hipLaunchCooperativeKernel((const void*)fwd_kernel, dim3(grid), dim3(512), args, LDS_BYTES, stream);
    if (e != hipSuccess) fprintf(stderr, "cooperative launch failed: %s (grid %d)\n", hipGetErrorString(e), grid);
}
```

```cpp
#include <hip/hip_runtime.h>
#include <hip/hip_cooperative_groups.h>
#include <cstdio>
#include <cstdint>
namespace cg = cooperative_groups;
namespace pg8 {
#define PG8_LAS __attribute__((address_space(3)))
typedef unsigned short bf16_t;
typedef short bf16x8 __attribute__((ext_vector_type(8)));
typedef float f32x4 __attribute__((ext_vector_type(4)));
typedef unsigned u32x4 __attribute__((ext_vector_type(4)));
constexpr int BM = 256, BK = 64, HALF = 128, HTB = HALF * BK * 2  , STAGE_BYTES = 8 * HTB, NXCD = 8, WGM = 8;

__host__ __device__ __forceinline__ int lds_byte(int r, int c) { const int st = (r >> 4) * 2 + (c >> 5), rr = r & 15, cc = c & 31, ob = rr * 64 + cc * 2; return st * 1024 + (ob ^ (((ob >> 9) & 1) << 5)); }
__host__ __device__ __forceinline__ void stage_rc(int b, int& R, int& C) { const int st = b / 1024, sb = b % 1024, swz = sb ^ (((sb >> 9) & 1) << 5); R = (st >> 1) * 16 + swz / 64; C = (st & 1) * 32 + (swz % 64) / 2; }
__host__ __device__ __forceinline__ int perm32(int rho) { const int n = rho >> 4, i = rho & 15; return 8 * (i >> 2) + 4 * n + (i & 3); }

struct Unit { int pm, pn, ks, koff; };
struct Gemm { const bf16_t* A; const bf16_t* Bt; int M, N, K, Klen; };

struct StaticOrder {
    int nM, nN, nwg, G, c;
    __host__ __device__ void init(int M, int N, int G_, int c_) { nM = M / BM; nN = N / BM; nwg = nM * nN; G = G_; c = c_; }
    __host__ __device__ bool next(int i, Unit& u) const {
        const long L = (long)i * G + c; if (L >= nwg) return false;
        int wgid = (int)L; { const int q = nwg / NXCD, r = nwg % NXCD, xcd = wgid % NXCD, off = wgid / NXCD; wgid = (xcd < r ? xcd * (q + 1) : r * (q + 1) + (xcd - r) * q) + off; }
        const int nig = WGM * nN, gid = wgid / nig, fm = gid * WGM, gsz = (nM - fm) < WGM ? (nM - fm) : WGM;
        u.pm = fm + ((wgid % nig) % gsz); u.pn = (wgid % nig) / gsz; u.ks = 0; u.koff = 0; return true;
    }
    __device__ __forceinline__ void a_ready(const Unit&) const {}
    __device__ __forceinline__ void done(const Unit&) const {}
};
__device__ __forceinline__ unsigned cvt_pk_bf16(float lo, float hi) { unsigned r; asm volatile("v_cvt_pk_bf16_f32 %0, %1, %2" : "=v"(r) : "v"(lo), "v"(hi)); return r; }
typedef float f32x2 __attribute__((ext_vector_type(2)));
template <class Epi, class Sched, bool STAMP = false>
__device__ __forceinline__ void gemm_phase(PG8_LAS unsigned char* lds, const Gemm g, const Sched& S, const Epi& E, unsigned long long* stamps) {
    int tid_ = threadIdx.x; asm volatile("" : "+v"(tid_));
    const int tid = tid_, wid = __builtin_amdgcn_readfirstlane(tid >> 6), lane = tid & 63, wr = wid >> 2, wc = wid & 3, fr = lane & 15, fq = lane >> 4;
    const int K = g.K, nt = g.Klen / BK;
    int ts_lo = 0, ts_hi = 0, nts = 0; const unsigned long long rt_entry = STAMP ? (unsigned long long)wall_clock64() : 0ull;
#define PG8_STAMP() do { if (STAMP && wid == 0 && nts < 64) { const unsigned long long _c = (unsigned long long)clock64(); \
        ts_lo = (lane == nts) ? (int)(unsigned)_c : ts_lo; ts_hi = (lane == nts) ? (int)(unsigned)(_c >> 32) : ts_hi; ++nts; } } while (0)
    PG8_STAMP();
    unsigned voffA[2], voffB[2];
#pragma unroll
    for (int i = 0; i < 2; ++i) { int R, C; stage_rc(tid * 16 + i * 8192, R, C); const int Rb = Epi::PERM ? ((R & ~31) + perm32(R & 31)) : R;
        voffA[i] = (unsigned)(R * K + C) * 2u; voffB[i] = (unsigned)(Rb * K + C) * 2u; }
    const size_t kstep = (size_t)(BK * 2);
    const size_t hstep = (size_t)HALF * K * 2;
    const size_t tstep = 2 * hstep;
    const unsigned ldsw = (unsigned)wid * 1024u;
    const int aoff = lds_byte(wr * 64 + fr, fq * 8), boff = lds_byte(wc * 32 + fr, fq * 8);
#define PG8_SA(b, h) (((b) * 2 + (h)) * HTB)
#define PG8_SB(b, h) ((4 + (b) * 2 + (h)) * HTB)
#define PG8_STAGE(bufoff, gbase, voff) do { _Pragma("unroll") for (int _i = 0; _i < 2; ++_i) \
        __builtin_amdgcn_global_load_lds((const unsigned*)((const char*)(gbase) + (voff)[_i]), (PG8_LAS unsigned*)(lds + (bufoff) + ldsw + _i * 8192), 16, 0, 0); } while (0)
#define PG8_LDA(dst, b, h) do { _Pragma("unroll") for (int m = 0; m < 4; ++m) _Pragma("unroll") for (int k = 0; k < 2; ++k) dst[m][k] = *(const PG8_LAS bf16x8*)(lds + PG8_SA(b, h) + aoff + m * 2048 + k * 1024); } while (0)
#define PG8_LDB(dst, b, h) do { _Pragma("unroll") for (int n = 0; n < 2; ++n) _Pragma("unroll") for (int k = 0; k < 2; ++k) dst[n][k] = *(const PG8_LAS bf16x8*)(lds + PG8_SB(b, h) + boff + n * 2048 + k * 1024); } while (0)
#define PG8_MMA(ai, bj, At, Bt) do { __builtin_amdgcn_s_setprio(1); _Pragma("unroll") for (int m = 0; m < 4; ++m) _Pragma("unroll") for (int n = 0; n < 2; ++n) _Pragma("unroll") for (int k = 0; k < 2; ++k) \
        acc[ai][bj][m][n] = __builtin_amdgcn_mfma_f32_16x16x32_bf16(Bt[n][k], At[m][k], acc[ai][bj][m][n], 0, 0, 0); __builtin_amdgcn_s_setprio(0); } while (0)
#define PG8_WAIT_V(n) asm volatile("s_waitcnt vmcnt(" #n ")" ::: "memory")
#define PG8_WAIT_L(n) asm volatile("s_waitcnt lgkmcnt(" #n ")" ::: "memory")
#define PG8_BAR __builtin_amdgcn_s_barrier()
#define PG8_SCHED __builtin_amdgcn_sched_barrier(0)
    Unit cur, nxt; int ui = 0;
    if (!S.next(0, cur)) return;
    f32x4 acc[2][2][4][2];
#pragma unroll
    for (int a = 0; a < 2; ++a)
#pragma unroll
        for (int b = 0; b < 2; ++b)
#pragma unroll
            for (int m = 0; m < 4; ++m)
#pragma unroll
                for (int n = 0; n < 2; ++n) acc[a][b][m][n] = (f32x4){0.f, 0.f, 0.f, 0.f};
    bf16x8 At[4][2], B0[2][2], B1[2][2];
    const char* cA = (const char*)g.A + (size_t)cur.pm * tstep + (size_t)cur.koff * 2; const char* cB = (const char*)g.Bt + (size_t)cur.pn * tstep + (size_t)cur.koff * 2;
    S.a_ready(cur);
    PG8_STAGE(PG8_SB(0, 0), cB, voffB); PG8_STAGE(PG8_SB(0, 1), cB + hstep, voffB); PG8_STAGE(PG8_SA(0, 0), cA, voffA); PG8_STAGE(PG8_SA(0, 1), cA + hstep, voffA);
    if (wr == 1) PG8_BAR;
    PG8_WAIT_V(2); PG8_BAR;
    PG8_STAGE(PG8_SB(1, 0), cB + kstep, voffB); PG8_STAGE(PG8_SA(1, 0), cA + kstep, voffA); PG8_STAGE(PG8_SB(1, 1), cB + hstep + kstep, voffB);
    PG8_WAIT_V(6); PG8_BAR;
    PG8_STAMP();
    for (;;) {
        const bool has_next = S.next(ui + 1, nxt);
        const char* nA = has_next ? (const char*)g.A + (size_t)nxt.pm * tstep + (size_t)nxt.koff * 2 : cA; const char* nB = has_next ? (const char*)g.Bt + (size_t)nxt.pn * tstep + (size_t)nxt.koff * 2 : cB;
        for (int t = 0; t < nt; t += 2) {
            const bool last = (t == nt - 2);
            const char* a1 = cA + (size_t)(t + 1) * kstep;
            const char* a2 = last ? nA : cA + (size_t)(t + 2) * kstep; const char* b2 = last ? nB : cB + (size_t)(t + 2) * kstep;
            const char* a3 = a2 + kstep; const char* b3 = b2 + kstep;
            if (last && has_next) S.a_ready(nxt);
            PG8_LDB(B0, 0, 0); PG8_LDB(B1, 0, 1); PG8_SCHED; PG8_LDA(At, 0, 0); PG8_STAGE(PG8_SA(1, 1), a1 + hstep, voffA);
            PG8_WAIT_V(8); PG8_WAIT_L(0); PG8_BAR; PG8_MMA(0, 0, At, B0); PG8_MMA(0, 1, At, B1); PG8_BAR; PG8_SCHED;
            PG8_LDA(At, 0, 1); PG8_STAGE(PG8_SB(0, 0), b2, voffB); PG8_STAGE(PG8_SB(0, 1), b2 + hstep, voffB); PG8_STAGE(PG8_SA(0, 0), a2, voffA);
            PG8_WAIT_V(8); PG8_WAIT_L(0); PG8_BAR; PG8_MMA(1, 0, At, B0); PG8_MMA(1, 1, At, B1); PG8_BAR; PG8_SCHED;
            PG8_LDB(B0, 1, 0); PG8_LDB(B1, 1, 1); PG8_SCHED; PG8_LDA(At, 1, 0); PG8_STAGE(PG8_SA(0, 1), a2 + hstep, voffA);
            PG8_WAIT_V(8); PG8_WAIT_L(0); PG8_BAR; PG8_MMA(0, 0, At, B0); PG8_MMA(0, 1, At, B1); PG8_BAR; PG8_SCHED;
            PG8_LDA(At, 1, 1); PG8_STAGE(PG8_SB(1, 0), b3, voffB); PG8_STAGE(PG8_SB(1, 1), b3 + hstep, voffB); PG8_STAGE(PG8_SA(1, 0), a3, voffA);
            PG8_WAIT_V(8); PG8_WAIT_L(0); PG8_BAR; PG8_MMA(1, 0, At, B0); PG8_MMA(1, 1, At, B1); PG8_BAR; PG8_SCHED;
        }
        PG8_STAMP();
        if (wr == 0) PG8_BAR;
        if constexpr (!Epi::AFTER_DRAIN) { E(acc, cur, wr, wc, fr, fq); S.done(cur); }
        PG8_STAMP();
        if (!has_next) break;
#pragma unroll
        for (int a = 0; a < 2; ++a)
#pragma unroll
            for (int b = 0; b < 2; ++b)
#pragma unroll
                for (int m = 0; m < 4; ++m)
#pragma unroll
                    for (int n = 0; n < 2; ++n) acc[a][b][m][n] = (f32x4){0.f, 0.f, 0.f, 0.f};
        cur = nxt; cA = nA; cB = nB; ++ui;
        if (wr == 1) PG8_BAR;
    }
    PG8_WAIT_V(0);
    PG8_BAR;
    if constexpr (Epi::AFTER_DRAIN) { E.fused(acc, cur, wr, wc, fr, fq, lds, wid, lane); S.done(cur); }
    PG8_STAMP();
    if (STAMP && wid == 0) { stamps[lane] = lane < nts ? (((unsigned long long)(unsigned)ts_hi << 32) | (unsigned)ts_lo) : 0ull;
        if (lane == 62) stamps[62] = rt_entry; if (lane == 63) stamps[63] = (unsigned long long)wall_clock64(); }
#undef PG8_STAMP
#undef PG8_SA
#undef PG8_SB
#undef PG8_STAGE
#undef PG8_LDA
#undef PG8_LDB
#undef PG8_MMA
#undef PG8_WAIT_V
#undef PG8_WAIT_L
#undef PG8_BAR
#undef PG8_SCHED
}
}
#define LAS __attribute__((address_space(3)))
#define XB_TMO      128
#define XB_XCNT(j)  (256  + 64 * (j))
#define XB_XSUB(j)  (1280 + 64 * (j))
#define XB_XGEN(j)  (2304 + 64 * (j))
#define XB_TOP      3328
#define XB_TOPGEN   3392
#define XCD_BAR_WORDS 3456
#define XB_SPIN_CAP (1u << 18)

__device__ __forceinline__ unsigned xb_ld(unsigned* p)              { return __hip_atomic_load(p, __ATOMIC_RELAXED, __HIP_MEMORY_SCOPE_AGENT); }
__device__ __forceinline__ unsigned xb_add(unsigned* p, unsigned v) { return __hip_atomic_fetch_add(p, v, __ATOMIC_RELAXED, __HIP_MEMORY_SCOPE_AGENT); }
__device__ __forceinline__ unsigned xb_xcc_id() { return (unsigned)__builtin_amdgcn_s_getreg((3 << 11) | 20) & 0xFu; }
#define XB_SPIN(cond, bar) do { unsigned _sp = 0; while (cond) { __builtin_amdgcn_s_sleep(1); \
    if ((++_sp & 255u) == 0u) { if (xb_ld(&(bar)[XB_TMO])) break; if (_sp > XB_SPIN_CAP) { atomicAdd(&(bar)[XB_TMO], 1u); break; } } } } while (0)

struct XcdBarrier {
    unsigned* bar; unsigned x;
    volatile LAS unsigned* st;
};

__device__ __forceinline__ XcdBarrier xcd_barrier_post(unsigned* bar, volatile LAS unsigned* st) {
    XcdBarrier b; b.bar = bar; b.x = xb_xcc_id(); b.st = st;
    if (threadIdx.x == 0) (void)xb_add(&bar[XB_XCNT(b.x)], 1u);
    return b;
}
__device__ __forceinline__ void xcd_barrier_complete(unsigned* bar, unsigned x, unsigned& nloc, unsigned& nx) {
    const unsigned G = gridDim.x * gridDim.y * gridDim.z;
    unsigned sum, cnt, mine, sp = 0u;
    for (;;) {
        sum = 0u; cnt = 0u; mine = 0u;
#pragma unroll
        for (unsigned j = 0; j < 16; ++j) { const unsigned c = xb_ld(&bar[XB_XCNT(j)]); sum += c; cnt += (c > 0u) ? 1u : 0u; mine = (j == x) ? c : mine; }
        if (sum == G) break;
        __builtin_amdgcn_s_sleep(1);
        if ((++sp & 255u) == 0u) { if (xb_ld(&bar[XB_TMO])) break; if (sp > XB_SPIN_CAP) { atomicAdd(&bar[XB_TMO], 1u); break; } }
    }
    nloc = mine > 0u ? mine : 1u; nx = cnt > 0u ? cnt : 1u;
}

__device__ __forceinline__ void xcd_barrier(const XcdBarrier& b) {
    asm volatile("s_waitcnt vmcnt(0)" ::: "memory");
    __syncthreads();
    if (threadIdx.x == 0) {
        unsigned* bar = b.bar;
        __builtin_amdgcn_s_waitcnt(0);
        unsigned nloc = b.st[0], nx = b.st[1];
        if (nloc == 0u) { xcd_barrier_complete(bar, b.x, nloc, nx); b.st[0] = nloc; b.st[1] = nx; }
        const unsigned old = xb_add(&bar[XB_XSUB(b.x)], 1u);
        const unsigned gen = old / nloc;
        if (old + 1u == (gen + 1u) * nloc) {
            __builtin_amdgcn_fence(__ATOMIC_RELEASE, "agent");
            asm volatile("s_waitcnt vmcnt(0)" ::: "memory");
            const unsigned og = xb_add(&bar[XB_TOP], 1u);
            const unsigned tg = og / nx;
            if (og + 1u == (tg + 1u) * nx) xb_add(&bar[XB_TOPGEN], 1u);
            else XB_SPIN(xb_ld(&bar[XB_TOPGEN]) == tg, bar);
            __builtin_amdgcn_fence(__ATOMIC_ACQUIRE, "agent");
            xb_add(&bar[XB_XGEN(b.x)], 1u);
            asm volatile("s_waitcnt vmcnt(0)" ::: "memory");
        } else {
            XB_SPIN(xb_ld(&bar[XB_XGEN(b.x)]) == gen, bar);
            __builtin_amdgcn_fence(__ATOMIC_ACQUIRE, "agent");
            asm volatile("s_waitcnt vmcnt(0)" ::: "memory");
        }
    }
    __syncthreads();
}


using pg8::bf16_t; using pg8::bf16x8; using pg8::f32x4; using pg8::u32x4; using pg8::Unit;
typedef float f32x16 __attribute__((ext_vector_type(16)));
typedef unsigned u32x2 __attribute__((ext_vector_type(2)));
typedef float f32x2 __attribute__((ext_vector_type(2)));

constexpr int MP = 8192, MS = 1024, MT = 9216, DM = 2048, NZ = 5120, NINP = 5376, DFF = 5632, PLE = 256;
constexpr int LDS_BYTES = 131072 + 16;
constexpr size_t OFF_BAR = 0;
constexpr size_t OFF_WIN = 16384;
constexpr size_t OFF_WOUT = OFF_WIN + (size_t)NINP * DM * 2;
constexpr size_t OFF_WFI = OFF_WOUT + (size_t)DM * DM * 2;
constexpr size_t OFF_WFO = OFF_WFI + (size_t)2 * DFF * DM * 2;
constexpr size_t OFF_WPLE = OFF_WFO + (size_t)DM * DFF * 2;
constexpr size_t OFF_WGT = OFF_WPLE + (size_t)DM * PLE * 2;
constexpr size_t OFF_A0 = OFF_WGT + (size_t)DM * DM * 2;
constexpr size_t OFF_PB = OFF_A0 + (size_t)MT * DM * 2;
constexpr size_t OFF_ALOW = OFF_PB + (size_t)MT * PLE * 2;
constexpr size_t OFF_STAT = OFF_ALOW + (size_t)MT * 16 * 4;
constexpr size_t OFF_BIG = OFF_STAT + (size_t)MT * 2 * 4;
constexpr size_t OFF_Z = OFF_BIG;
constexpr size_t OFF_ORAW = OFF_Z + (size_t)MT * NZ * 2;
constexpr size_t OFF_MRAW = OFF_ORAW + (size_t)MT * 1024 * 4;
constexpr size_t OFF_IMG = OFF_BIG + (size_t)MT * DFF * 2 + (size_t)MT * DM * 4;
constexpr size_t WS_END = OFF_IMG + (size_t)4 * 1024 * 2048 * 4;
constexpr size_t OFF_ACT = OFF_BIG;
constexpr size_t OFF_GATEZ = OFF_BIG;
constexpr size_t OFF_PZ = OFF_BIG + (size_t)MT * DFF * 2;
constexpr size_t OUT_Y = 0, OUT_SP = (size_t)MT * DM, OUT_SS = OUT_SP + (size_t)4 * 4 * 128 * 256, OUT_VS = OUT_SS + (size_t)128 * 4 * 128 * 256;

struct Params {
    const float *x_prompt, *x_sample, *state_gla, *p_prompt, *p_sample, *g_mix, *w_in, *w_a2, *b_a, *g_gla_norm, *g_gmlp_ln, *b_gmlp_ln, *w_s, *b_s,
        *g_gmlp_out, *w_out, *g_ffn, *w_ffn_in, *w_ffn_out, *w_ple, *g_ple, *g_ple_gate, *w_ple_gate, *g_final;
    float* out;
    unsigned char* ws;
};

__device__ __forceinline__ unsigned pk2(float lo, float hi) { return pg8::cvt_pk_bf16(lo, hi); }
__device__ __forceinline__ bf16_t f2bf(float f) { return (bf16_t)(pk2(f, 0.f) & 0xffffu); }
__device__ __forceinline__ float bf2f(bf16_t b) { return __uint_as_float(((unsigned)b) << 16); }
__device__ __forceinline__ float bflo(unsigned w) { return __uint_as_float(w << 16); }
__device__ __forceinline__ float bfhi(unsigned w) { return __uint_as_float(w & 0xffff0000u); }
__device__ __forceinline__ f32x4 unpack4(u32x2 w) { return (f32x4){bflo(w.x), bfhi(w.x), bflo(w.y), bfhi(w.y)}; }
template <int CTRL> __device__ __forceinline__ float dpp_f(float v) { return __int_as_float(__builtin_amdgcn_update_dpp(0, __float_as_int(v), CTRL, 0xf, 0xf, true)); }
__device__ __forceinline__ float row16_sum(float v) {
    v += dpp_f<0xB1>(v); v += dpp_f<0x4E>(v); v += dpp_f<0x141>(v); v += dpp_f<0x140>(v); return v;
}
__device__ __forceinline__ float wave_sum(float v) {
    v = row16_sum(v);
    return (__int_as_float(__builtin_amdgcn_readlane(__float_as_int(v), 0)) + __int_as_float(__builtin_amdgcn_readlane(__float_as_int(v), 16))) + (__int_as_float(__builtin_amdgcn_readlane(__float_as_int(v), 32)) + __int_as_float(__builtin_amdgcn_readlane(__float_as_int(v), 48)));
}
__device__ __forceinline__ float sigmoid_f(float x) { return __builtin_amdgcn_rcpf(1.f + __expf(-x)); }
__device__ __forceinline__ float silu_f(float x) { return x * __builtin_amdgcn_rcpf(1.f + __expf(-x)); }
__device__ __forceinline__ float gelu_f(float x) { const float u = 1.5957691216f * (x + 0.044715f * x * x * x); return x * __builtin_amdgcn_rcpf(1.f + __expf(-u)); }
__device__ __forceinline__ float logsigmoid_f(float x) { return fminf(x, 0.f) - __logf(1.f + __expf(-fabsf(x))); }
template <class T> __device__ __forceinline__ T* opaque(T* p) { return p; }
__device__ __forceinline__ const f32x4* row_mid(const float* row, int lane) { return opaque((const f32x4*)row + lane + 256); }
__device__ __forceinline__ f32x4* row_mid(float* row, int lane) { return opaque((f32x4*)row + lane + 256); }
__device__ __forceinline__ int otid() { int t = threadIdx.x; asm volatile("" : "+v"(t)); return t; }
template <class T> __device__ __forceinline__ T ldnt(const T* p) { return __builtin_nontemporal_load(p); }
template <class T> __device__ __forceinline__ void stnt(T* p, T v) { __builtin_nontemporal_store(v, p); }
__device__ __forceinline__ void lds_wait() { asm volatile("s_waitcnt lgkmcnt(0)" ::: "memory"); }

struct EpiIn {
    static constexpr bool PERM = true, AFTER_DRAIN = false;
    bf16_t* Z; float* alow;
    __device__ __forceinline__ void operator()(const f32x4 (&acc)[2][2][4][2], const Unit& u, int wr, int wc, int fr, int fq) const {
        const int row0 = u.pm * 256 + wr * 64 + fr, pn = u.pn;
        if (pn == 20) {
            if (wc == 0 && fq < 2) {
#pragma unroll
                for (int ai = 0; ai < 2; ++ai)
#pragma unroll
                    for (int m = 0; m < 4; ++m) { float* p = alow + (size_t)(row0 + ai * 128 + m * 16) * 16 + 8 * fq; *(f32x4*)p = acc[ai][0][m][0]; *(f32x4*)(p + 4) = acc[ai][0][m][1]; }
            }
            return;
        }
        const int kind = pn < 8 ? 0 : (pn < 12 ? 1 : 2); const float qs = pn < 2 ? 0.08838834764831845f : 1.f;
#pragma unroll
        for (int ai = 0; ai < 2; ++ai)
#pragma unroll
            for (int m = 0; m < 4; ++m) { bf16_t* rowp = Z + (size_t)(row0 + ai * 128 + m * 16) * NZ + pn * 256 + wc * 32 + 8 * fq;
#pragma unroll
                for (int bj = 0; bj < 2; ++bj) { f32x4 v0 = acc[ai][bj][m][0], v1 = acc[ai][bj][m][1];
                    if (kind == 0) { v0 *= qs; v1 *= qs; }
                    else if (kind == 1) {
#pragma unroll
                        for (int j = 0; j < 4; ++j) { v0[j] = silu_f(v0[j]); v1[j] = silu_f(v1[j]); } }
                    else {
#pragma unroll
                        for (int j = 0; j < 4; ++j) { v0[j] = gelu_f(v0[j]); v1[j] = gelu_f(v1[j]); } }
                    u32x4 w; w.x = pk2(v0[0], v0[1]); w.y = pk2(v0[2], v0[3]); w.z = pk2(v1[0], v1[1]); w.w = pk2(v1[2], v1[3]);
                    *(u32x4*)(rowp + bj * 128) = w; } }
    }
};
struct EpiRes {
    static constexpr bool PERM = false, AFTER_DRAIN = false;
    const float* res_p; const float* res_s; float* out;
    __device__ __forceinline__ void operator()(const f32x4 (&acc)[2][2][4][2], const Unit& u, int wr, int wc, int fr, int fq) const {
        const int row0 = u.pm * 256 + wr * 64 + fr, col0 = u.pn * 256 + wc * 32 + 4 * fq;
#pragma unroll
        for (int ai = 0; ai < 2; ++ai)
#pragma unroll
            for (int m = 0; m < 4; ++m) { const int row = row0 + ai * 128 + m * 16;
                const float* rp = (row < MP ? res_p + (size_t)row * DM : res_s + (size_t)(row - MP) * DM) + col0; float* op = out + (size_t)row * DM + col0;
#pragma unroll
                for (int bj = 0; bj < 2; ++bj)
#pragma unroll
                    for (int n = 0; n < 2; ++n) { const f32x4 r = *(const f32x4*)(rp + bj * 128 + n * 16); *(f32x4*)(op + bj * 128 + n * 16) = acc[ai][bj][m][n] + r; } }
    }
};
struct EpiSwiglu {
    static constexpr bool PERM = true, AFTER_DRAIN = false;
    bf16_t* act;
    __device__ __forceinline__ void operator()(const f32x4 (&acc)[2][2][4][2], const Unit& u, int wr, int wc, int fr, int fq) const {
        const int row0 = u.pm * 256 + wr * 64 + fr, col0 = u.pn * 128 + wc * 32 + 8 * fq;
#pragma unroll
        for (int ai = 0; ai < 2; ++ai)
#pragma unroll
            for (int m = 0; m < 4; ++m) { float a[8];
#pragma unroll
                for (int n = 0; n < 2; ++n)
#pragma unroll
                    for (int j = 0; j < 4; ++j) a[n * 4 + j] = silu_f(acc[ai][0][m][n][j]) * acc[ai][1][m][n][j];
                u32x4 w; w.x = pk2(a[0], a[1]); w.y = pk2(a[2], a[3]); w.z = pk2(a[4], a[5]); w.w = pk2(a[6], a[7]);
                *(u32x4*)(act + (size_t)(row0 + ai * 128 + m * 16) * DFF + col0) = w; }
    }
};
struct EpiBfN {
    static constexpr bool PERM = false, AFTER_DRAIN = false;
    bf16_t* out;
    __device__ __forceinline__ void operator()(const f32x4 (&acc)[2][2][4][2], const Unit& u, int wr, int wc, int fr, int fq) const {
        const int row0 = u.pm * 256 + wr * 64 + fr, col0 = u.pn * 256 + wc * 32 + 4 * fq;
#pragma unroll
        for (int ai = 0; ai < 2; ++ai)
#pragma unroll
            for (int m = 0; m < 4; ++m) { bf16_t* op = out + (size_t)(row0 + ai * 128 + m * 16) * DM + col0;
#pragma unroll
                for (int bj = 0; bj < 2; ++bj)
#pragma unroll
                    for (int n = 0; n < 2; ++n) { const f32x4 v = acc[ai][bj][m][n]; u32x2 w; w.x = pk2(v[0], v[1]); w.y = pk2(v[2], v[3]); *(u32x2*)(op + bj * 128 + n * 16) = w; } }
    }
};
struct EpiPlain {
    static constexpr bool PERM = false, AFTER_DRAIN = false;
    float* out;
    __device__ __forceinline__ void operator()(const f32x4 (&acc)[2][2][4][2], const Unit& u, int wr, int wc, int fr, int fq) const {
        const int row0 = u.pm * 256 + wr * 64 + fr, col0 = u.pn * 256 + wc * 32 + 4 * fq;
#pragma unroll
        for (int ai = 0; ai < 2; ++ai)
#pragma unroll
            for (int m = 0; m < 4; ++m) { float* op = out + (size_t)(row0 + ai * 128 + m * 16) * DM + col0;
#pragma unroll
                for (int bj = 0; bj < 2; ++bj)
#pragma unroll
                    for (int n = 0; n < 2; ++n) *(f32x4*)(op + bj * 128 + n * 16) = acc[ai][bj][m][n]; }
    }
};

template <class Epi> __device__ __forceinline__ void run_gemm(LAS unsigned char* lds, const bf16_t* A, const bf16_t* Bt, int M, int N, int K, const Epi& E) {
    pg8::Gemm g; g.A = A; g.Bt = Bt; g.M = M; g.N = N; g.K = K; g.Klen = K;
    pg8::StaticOrder S; S.init(M, N, (int)gridDim.x, (int)blockIdx.x);
    pg8::gemm_phase<Epi, pg8::StaticOrder, false>(lds, g, S, E, nullptr);
}
struct SplitOrderK {
    int nN, G, c, klen, ns, kbase, ksoff;
    __device__ __forceinline__ bool next(int i, Unit& u) const { const int L = i * G + c; if (L >= 4 * ns * nN) return false;
        const int sp = L % ns, tile = L / ns; u.ks = ksoff + sp; u.pn = tile % nN; u.pm = 32 + tile / nN; u.koff = kbase + sp * klen; return true; }
    __device__ __forceinline__ void a_ready(const Unit&) const {}
    __device__ __forceinline__ void done(const Unit&) const {}
};
struct EpiPart {
    static constexpr bool PERM = false, AFTER_DRAIN = false;
    bf16_t* part;
    __device__ __forceinline__ void operator()(const f32x4 (&acc)[2][2][4][2], const Unit& u, int wr, int wc, int fr, int fq) const {
        const int row0 = (u.pm - 32) * 256 + wr * 64 + fr, col0 = u.pn * 256 + wc * 32 + 4 * fq; bf16_t* pb = part + (size_t)u.ks * MS * DM;
#pragma unroll
        for (int ai = 0; ai < 2; ++ai)
#pragma unroll
            for (int m = 0; m < 4; ++m) { bf16_t* op = pb + (size_t)(row0 + ai * 128 + m * 16) * DM + col0;
#pragma unroll
                for (int bj = 0; bj < 2; ++bj)
#pragma unroll
                    for (int n = 0; n < 2; ++n) { const f32x4 v = acc[ai][bj][m][n]; u32x2 w; w.x = pk2(v[0], v[1]); w.y = pk2(v[2], v[3]); *(u32x2*)(op + bj * 128 + n * 16) = w; } }
    }
};
__device__ __forceinline__ void run_split(LAS unsigned char* lds, const bf16_t* A, const bf16_t* Bt, int K, bf16_t* part, int ns, int klen, int kbase, int ksoff, int c) {
    pg8::Gemm g; g.A = A; g.Bt = Bt; g.M = MT; g.N = DM; g.K = K; g.Klen = klen;
    SplitOrderK S; S.nN = DM / 256; S.G = (int)gridDim.x; S.c = c; S.klen = klen; S.ns = ns; S.kbase = kbase; S.ksoff = ksoff;
    EpiPart P; P.part = part;
    pg8::gemm_phase<EpiPart, SplitOrderK, false>(lds, g, S, P, nullptr);
}
template <class Epi> __device__ __forceinline__ void run_gemm_n2048(LAS unsigned char* lds, const bf16_t* A, const bf16_t* Bt, int K, const Epi& E, bf16_t* part) {
    run_gemm(lds, A, Bt, MP, DM, K, E);
    run_split(lds, A, Bt, K, part, 8, K / 8, 0, 0, (int)blockIdx.x);
}

__device__ __forceinline__ void transpose_item(const float* W, int N, bf16_t* WT, int K, int k0, int n0_dst, int n0_src, int nvalid, LAS float* scr, int lane) {
    const int j = lane & 31;
#pragma unroll 8
    for (int i = 0; i < 32; ++i) { const int kk = 2 * i + (lane >> 5); scr[kk * 33 + j] = (j < nvalid) ? ldnt(W + (size_t)(k0 + kk) * N + n0_src + j) : 0.f; }
    lds_wait();
    const int c = lane & 7;
#pragma unroll
    for (int q = 0; q < 4; ++q) { const int n = (lane >> 3) + 8 * q; const LAS float* s = scr + (8 * c) * 33 + n;
        u32x4 o; o.x = pk2(s[0 * 33], s[1 * 33]); o.y = pk2(s[2 * 33], s[3 * 33]); o.z = pk2(s[4 * 33], s[5 * 33]); o.w = pk2(s[6 * 33], s[7 * 33]);
        *(u32x4*)(WT + (size_t)(n0_dst + n) * K + k0 + 8 * c) = o; }
    lds_wait();
}
struct Row8 { f32x4 v[8]; };
__device__ __forceinline__ void row_load_nt(Row8& a, const float* src, int lane) { const f32x4* sm = row_mid(src, lane);
#pragma unroll
    for (int j = 0; j < 8; ++j) a.v[j] = ldnt(sm + 64 * (j - 4)); }
__device__ __forceinline__ void row_load(Row8& a, const float* src, int lane) { const f32x4* sm = row_mid(src, lane);
#pragma unroll
    for (int j = 0; j < 8; ++j) a.v[j] = sm[64 * (j - 4)]; }
__device__ __forceinline__ void rms_finish_bf16(const Row8& a, const float* gain, bf16_t* dst, int lane) {
    float s = 0.f;
#pragma unroll
    for (int j = 0; j < 8; ++j) s += (a.v[j][0] * a.v[j][0] + a.v[j][1] * a.v[j][1]) + (a.v[j][2] * a.v[j][2] + a.v[j][3] * a.v[j][3]);
    const float rinv = rsqrtf(wave_sum(s) * (1.f / DM) + 1e-6f);
    const f32x4* gm = row_mid(gain, lane); u32x2* dm = (u32x2*)dst + lane;
#pragma unroll
    for (int j = 0; j < 8; ++j) { const f32x4 g = gm[64 * (j - 4)]; u32x2 o; o.x = pk2(a.v[j][0] * rinv * g[0], a.v[j][1] * rinv * g[1]); o.y = pk2(a.v[j][2] * rinv * g[2], a.v[j][3] * rinv * g[3]);
        dm[64 * j] = o; }
}
__device__ __forceinline__ void rms_row_bf16(const float* src, const float* gain, bf16_t* dst, int lane) { Row8 a; row_load(a, src, lane); rms_finish_bf16(a, gain, dst, lane); }
namespace cv { constexpr int I_IN = (DM / 64) * (NINP / 32), I_OUT = (DM / 64) * (DM / 32), I_FI = (DM / 64) * (2 * DFF / 32), I_FO = (DFF / 64) * (DM / 32), I_PLE = (PLE / 64) * (DM / 32), I_GT = I_OUT;
    constexpr int E_IN = I_IN, E_OUT = E_IN + I_OUT, E_FI = E_OUT + I_FI, E_FO = E_FI + I_FO, E_PLE = E_FO + I_PLE, E_GT = E_PLE + I_GT; }
__device__ __forceinline__ void convert_range(const Params& p, LAS unsigned char* lds, int lo, int hi, int gw, int NGW) {
    const int tid = otid(), lane = tid & 63, wave = tid >> 6;
    LAS float* scr = (LAS float*)(lds + wave * 8448);
    bf16_t* win = (bf16_t*)(p.ws + OFF_WIN); bf16_t* wout = (bf16_t*)(p.ws + OFF_WOUT); bf16_t* wfi = (bf16_t*)(p.ws + OFF_WFI);
    bf16_t* wfo = (bf16_t*)(p.ws + OFF_WFO); bf16_t* wple = (bf16_t*)(p.ws + OFF_WPLE); bf16_t* wgt = (bf16_t*)(p.ws + OFF_WGT);
    for (int it = lo + gw; it < hi; it += NGW) {
        int r = it;
        if (r < cv::E_IN) { const int nblk = NINP / 32, kb = r / nblk, nb = r % nblk, n0d = nb * 32; int src, nv;
            if (n0d < 3072) { src = n0d; nv = 32; } else if (n0d < 5120) { src = n0d + 16; nv = 32; } else if (n0d == 5120) { src = 3072; nv = 16; } else { src = 0; nv = 0; }
            transpose_item(p.w_in, 5136, win, DM, kb * 64, n0d, src, nv, scr, lane); continue; }
        if (r < cv::E_OUT) { r -= cv::E_IN; const int nblk = DM / 32, kb = r / nblk, nb = r % nblk; transpose_item(p.w_out, DM, wout, DM, kb * 64, nb * 32, nb * 32, 32, scr, lane); continue; }
        if (r < cv::E_FI) { r -= cv::E_OUT; const int nblk = 2 * DFF / 32, kb = r / nblk, nb = r % nblk, n0d = nb * 32, jb = n0d >> 8, within = n0d & 255, up = within >> 7, j0 = jb * 128 + (within & 127);
            transpose_item(p.w_ffn_in, 2 * DFF, wfi, DM, kb * 64, n0d, up * DFF + j0, 32, scr, lane); continue; }
        if (r < cv::E_FO) { r -= cv::E_FI; const int nblk = DM / 32, kb = r / nblk, nb = r % nblk; transpose_item(p.w_ffn_out, DM, wfo, DFF, kb * 64, nb * 32, nb * 32, 32, scr, lane); continue; }
        if (r < cv::E_PLE) { r -= cv::E_FO; const int nblk = DM / 32, kb = r / nblk, nb = r % nblk; transpose_item(p.w_ple, DM, wple, PLE, kb * 64, nb * 32, nb * 32, 32, scr, lane); continue; }
        { r -= cv::E_PLE; const int nblk = DM / 32, kb = r / nblk, nb = r % nblk; transpose_item(p.w_ple_gate, DM, wgt, DM, kb * 64, nb * 32, nb * 32, 32, scr, lane); }
    }
}
__device__ __forceinline__ void phase0(const Params& p, LAS unsigned char* lds) {
    const int tid = otid(), lane = tid & 63, wave = tid >> 6;
    const int gw = blockIdx.x * 8 + wave, NGW = gridDim.x * 8;
    convert_range(p, lds, 0, cv::E_IN, gw, NGW);
    bf16_t* a0 = (bf16_t*)(p.ws + OFF_A0); bf16_t* pb = (bf16_t*)(p.ws + OFF_PB);
    for (int r = gw; r < MT; r += 2 * NGW) {
        const int r2 = r + NGW; const bool has2 = r2 < MT; const int q2 = has2 ? r2 : r;
        const float* x1 = r < MP ? p.x_prompt + (size_t)r * DM : p.x_sample + (size_t)(r - MP) * DM; const float* x2 = q2 < MP ? p.x_prompt + (size_t)q2 * DM : p.x_sample + (size_t)(q2 - MP) * DM;
        const float* p1 = r < MP ? p.p_prompt + (size_t)r * PLE : p.p_sample + (size_t)(r - MP) * PLE; const float* p2 = q2 < MP ? p.p_prompt + (size_t)q2 * PLE : p.p_sample + (size_t)(q2 - MP) * PLE;
        Row8 a, b; row_load_nt(a, x1, lane); row_load_nt(b, x2, lane);
        const f32x4 pv1 = ldnt((const f32x4*)p1 + lane), pv2 = ldnt((const f32x4*)p2 + lane);
        rms_finish_bf16(a, p.g_mix, a0 + (size_t)r * DM, lane);
        { u32x2 o; o.x = pk2(pv1[0], pv1[1]); o.y = pk2(pv1[2], pv1[3]); ((u32x2*)(pb + (size_t)r * PLE))[lane] = o; }
        if (has2) { rms_finish_bf16(b, p.g_mix, a0 + (size_t)r2 * DM, lane);
            u32x2 o; o.x = pk2(pv2[0], pv2[1]); o.y = pk2(pv2[2], pv2[3]); ((u32x2*)(pb + (size_t)r2 * PLE))[lane] = o; }
    }
}

__device__ __forceinline__ f32x16 mfma32(bf16x8 a, bf16x8 b, f32x16 c) { return __builtin_amdgcn_mfma_f32_32x32x16_bf16(a, b, c, 0, 0, 0); }
__device__ __forceinline__ void mma32(f32x16& acc, const LAS bf16_t* A, int lda, const LAS bf16_t* B, int ldb, int kk, int lane) {
    const int r = lane & 31, h = lane >> 5; const LAS bf16_t* ap = A + r * lda + 8 * h; const LAS bf16_t* bp = B + r * ldb + 8 * h;
    for (int k = 0; k < kk; k += 16) { const bf16x8 a = *(const LAS bf16x8*)(ap + k); const bf16x8 b = *(const LAS bf16x8*)(bp + k); acc = mfma32(a, b, acc); }
}
constexpr int LQ = 136, LS = 72;
constexpr int R_QE = 0, R_KLT = 17408, R_ATT = 35840, R_DEC = 45056, IMG_BYTES = 45568, R_VT = 45568, R_QM = 82432, R_KM = 99840, R_ALOW = 117248, R_GSUM = 121344, R_BMID = 123392;
constexpr int IMG_V4 = IMG_BYTES / 16;

__device__ __forceinline__ void gla_prep(const Params& p, LAS unsigned char* lds, int rb, int h, int T) {
    const int tid = otid(), lane = tid & 63, wave = tid >> 6;
    const bf16_t* Z = (const bf16_t*)(p.ws + OFF_Z); const float* alowg = (const float*)(p.ws + OFF_ALOW);
    LAS bf16_t* Qe = (LAS bf16_t*)(lds + R_QE); LAS bf16_t* Qm = (LAS bf16_t*)(lds + R_QM); LAS bf16_t* Km = (LAS bf16_t*)(lds + R_KM);
    LAS bf16_t* KlT = (LAS bf16_t*)(lds + R_KLT); LAS bf16_t* ATT = (LAS bf16_t*)(lds + R_ATT); LAS float* DEC = (LAS float*)(lds + R_DEC);
    LAS float* alowL = (LAS float*)(lds + R_ALOW); LAS float* gsum = (LAS float*)(lds + R_GSUM); LAS float* bmidL = (LAS float*)(lds + R_BMID);
    const int c = tid & 127, tg = tid >> 7;
    float wa[16];
#pragma unroll
    for (int j = 0; j < 16; ++j) wa[j] = p.w_a2[j * 512 + h * 128 + c];
    const float ba = p.b_a[h * 128 + c];
    for (int idx = tid; idx < 1024; idx += 512) { const int t = idx >> 4; alowL[idx] = (t < T) ? alowg[(size_t)(rb + t) * 16 + (idx & 15)] : 0.f; }
    float qv[16], kv[16];
#pragma unroll
    for (int i = 0; i < 16; ++i) { const int t = tg * 16 + i; const bool ok = t < T; const bf16_t* zr = Z + (size_t)(rb + t) * NZ + h * 128 + c;
        qv[i] = ok ? bf2f(zr[0]) : 0.f; kv[i] = ok ? bf2f(zr[512]) : 0.f; }
    __syncthreads();
    float b[16]; float run = 0.f;
#pragma unroll
    for (int i = 0; i < 16; ++i) { const int t = tg * 16 + i; float pre = ba;
#pragma unroll
        for (int j4 = 0; j4 < 4; ++j4) { const f32x4 a4 = *(const LAS f32x4*)(alowL + t * 16 + j4 * 4); pre += a4[0] * wa[j4 * 4] + a4[1] * wa[j4 * 4 + 1] + a4[2] * wa[j4 * 4 + 2] + a4[3] * wa[j4 * 4 + 3]; }
        const float la = (t < T) ? logsigmoid_f(pre) * 0.0625f : 0.f; run += la; b[i] = run; }
    gsum[tg * 128 + c] = run;
    __syncthreads();
    const float g0 = gsum[c], g1 = gsum[128 + c], g2 = gsum[256 + c], g3 = gsum[384 + c];
    const float pref = tg == 0 ? 0.f : (tg == 1 ? g0 : (tg == 2 ? g0 + g1 : g0 + g1 + g2));
    const float blast = ((g0 + g1) + g2) + g3;
#pragma unroll
    for (int i = 0; i < 16; ++i) b[i] += pref;
    if (tg == 2) bmidL[c] = b[0];
    if (tg == 0) DEC[c] = __expf(blast);
    __syncthreads();
    const float bm = bmidL[c];
    {
        unsigned klp[8];
#pragma unroll
        for (int i = 0; i < 16; i += 2) {
            const int t = tg * 16 + i;
            Qe[t * LQ + c] = f2bf(qv[i] * __expf(b[i])); Qe[(t + 1) * LQ + c] = f2bf(qv[i + 1] * __expf(b[i + 1]));
            Qm[t * LQ + c] = f2bf(qv[i] * __expf(b[i] - bm)); Qm[(t + 1) * LQ + c] = f2bf(qv[i + 1] * __expf(b[i + 1] - bm));
            Km[t * LQ + c] = f2bf(kv[i] * __expf(bm - b[i])); Km[(t + 1) * LQ + c] = f2bf(kv[i + 1] * __expf(bm - b[i + 1]));
            klp[i >> 1] = pk2(kv[i] * __expf(blast - b[i]), kv[i + 1] * __expf(blast - b[i + 1]));
        }
        LAS u32x4* kd = (LAS u32x4*)(KlT + c * LS + tg * 16);
        kd[0] = (u32x4){klp[0], klp[1], klp[2], klp[3]}; kd[1] = (u32x4){klp[4], klp[5], klp[6], klp[7]};
    }
    __syncthreads();
    if (wave < 3) {
        const int si = wave >> 1, ti = wave == 0 ? 0 : 1, l31 = lane & 31, hh = lane >> 5;
        f32x16 o;
#pragma unroll
        for (int i = 0; i < 16; ++i) o[i] = 0.f;
        mma32(o, Km + si * 32 * LQ, LQ, Qm + ti * 32 * LQ, LQ, 128, lane);
        const int tl = ti * 32 + l31;
#pragma unroll
        for (int g = 0; g < 4; ++g) { const int s0 = si * 32 + 8 * g + 4 * hh; float a0 = o[4 * g], a1 = o[4 * g + 1], a2 = o[4 * g + 2], a3 = o[4 * g + 3];
            a0 = (s0 <= tl) ? a0 : 0.f; a1 = (s0 + 1 <= tl) ? a1 : 0.f; a2 = (s0 + 2 <= tl) ? a2 : 0.f; a3 = (s0 + 3 <= tl) ? a3 : 0.f;
            u32x2 w; w.x = pk2(a0, a1); w.y = pk2(a2, a3); *(LAS u32x2*)(ATT + tl * LS + s0) = w; }
    }
    __syncthreads();
}
struct VRegs { u32x4 r[4]; };
__device__ __forceinline__ void v_load(const Params& p, VRegs& v, int rb, int h, int T) {
    const int tid = otid(), s = tid & 63, vg = tid >> 6; const bf16_t* Z = (const bf16_t*)(p.ws + OFF_Z);
#pragma unroll
    for (int k = 0; k < 4; ++k) v.r[k] = (s < T) ? *(const u32x4*)(Z + (size_t)(rb + s) * NZ + 1024 + h * 256 + vg * 32 + 8 * k) : (u32x4){0u, 0u, 0u, 0u};
}
__device__ __forceinline__ void v_store_t(LAS unsigned char* lds, const VRegs& v) {
    const int tid = otid(), s = tid & 63, vg = tid >> 6; LAS bf16_t* VT = (LAS bf16_t*)(lds + R_VT) + (vg * 32) * LS + s;
#pragma unroll
    for (int k = 0; k < 4; ++k) {
        VT[(8 * k + 0) * LS] = (bf16_t)(v.r[k].x & 0xffffu); VT[(8 * k + 1) * LS] = (bf16_t)(v.r[k].x >> 16);
        VT[(8 * k + 2) * LS] = (bf16_t)(v.r[k].y & 0xffffu); VT[(8 * k + 3) * LS] = (bf16_t)(v.r[k].y >> 16);
        VT[(8 * k + 4) * LS] = (bf16_t)(v.r[k].z & 0xffffu); VT[(8 * k + 5) * LS] = (bf16_t)(v.r[k].z >> 16);
        VT[(8 * k + 6) * LS] = (bf16_t)(v.r[k].w & 0xffffu); VT[(8 * k + 7) * LS] = (bf16_t)(v.r[k].w >> 16); }
}
__device__ __forceinline__ void gla_step(const Params& p, LAS unsigned char* lds, f32x16 (&S)[4], int rb, int h, int T, int vb, int vtrow) {
    const int lane = otid() & 63, l31 = lane & 31, hh = lane >> 5;
    LAS bf16_t* Qe = (LAS bf16_t*)(lds + R_QE); LAS bf16_t* KlT = (LAS bf16_t*)(lds + R_KLT); LAS bf16_t* ATT = (LAS bf16_t*)(lds + R_ATT); LAS float* DEC = (LAS float*)(lds + R_DEC);
    LAS bf16_t* VT = (LAS bf16_t*)(lds + R_VT);
    bf16_t* oraw = (bf16_t*)(p.ws + OFF_ORAW);
    f32x16 Za[2], Zb[2];
#pragma unroll
    for (int tt = 0; tt < 2; ++tt)
#pragma unroll
        for (int i = 0; i < 16; ++i) { Za[tt][i] = 0.f; Zb[tt][i] = 0.f; }
    bf16x8 sa[4][2];
#pragma unroll
    for (int cb = 0; cb < 4; ++cb)
#pragma unroll
        for (int s = 0; s < 2; ++s) { u32x4 aw; aw.x = pk2(S[cb][8 * s], S[cb][8 * s + 1]); aw.y = pk2(S[cb][8 * s + 2], S[cb][8 * s + 3]); aw.z = pk2(S[cb][8 * s + 4], S[cb][8 * s + 5]); aw.w = pk2(S[cb][8 * s + 6], S[cb][8 * s + 7]);
            sa[cb][s] = __builtin_bit_cast(bf16x8, aw); }
    bf16x8 vt[4];
    const LAS bf16_t* vp = VT + (vtrow + l31) * LS + 8 * hh;
#pragma unroll
    for (int ks = 0; ks < 4; ++ks) vt[ks] = *(const LAS bf16x8*)(vp + 16 * ks);
#pragma unroll
    for (int cb = 0; cb < 4; ++cb)
#pragma unroll
        for (int g = 0; g < 4; ++g) { const f32x4 d = *(const LAS f32x4*)(DEC + cb * 32 + 8 * g + 4 * hh);
            S[cb][4 * g] *= d[0]; S[cb][4 * g + 1] *= d[1]; S[cb][4 * g + 2] *= d[2]; S[cb][4 * g + 3] *= d[3]; }
#pragma unroll
    for (int ks = 0; ks < 4; ++ks)
#pragma unroll
        for (int cb = 0; cb < 4; ++cb) { const bf16x8 a = *(const LAS bf16x8*)(KlT + (32 * cb + l31) * LS + 16 * ks + 8 * hh); S[cb] = mfma32(a, vt[ks], S[cb]); }
#pragma unroll
    for (int cb = 0; cb < 4; ++cb)
#pragma unroll
        for (int s = 0; s < 2; ++s)
#pragma unroll
            for (int tt = 0; tt < 2; ++tt) { const LAS bf16_t* qp = Qe + (32 * tt + l31) * LQ + 32 * cb + 16 * s + 4 * hh;
                const u32x2 q0 = *(const LAS u32x2*)qp, q1 = *(const LAS u32x2*)(qp + 8); const u32x4 bw = (u32x4){q0.x, q0.y, q1.x, q1.y};
                Za[tt] = mfma32(sa[cb][s], __builtin_bit_cast(bf16x8, bw), Za[tt]); }
#pragma unroll
    for (int ks = 0; ks < 4; ++ks)
#pragma unroll
        for (int tt = 0; tt < 2; ++tt) if (ks < 2 * (tt + 1)) { const bf16x8 bq = *(const LAS bf16x8*)(ATT + (32 * tt + l31) * LS + 16 * ks + 8 * hh); Zb[tt] = mfma32(vt[ks], bq, Zb[tt]); }
#pragma unroll
    for (int tt = 0; tt < 2; ++tt) { const int t = 32 * tt + l31;
        if (t < T) { bf16_t* op = oraw + (size_t)(rb + t) * 1024 + h * 256 + 32 * vb + 4 * hh;
#pragma unroll
            for (int g = 0; g < 4; ++g) { u32x2 w; w.x = pk2(Za[tt][4 * g] + Zb[tt][4 * g], Za[tt][4 * g + 1] + Zb[tt][4 * g + 1]); w.y = pk2(Za[tt][4 * g + 2] + Zb[tt][4 * g + 2], Za[tt][4 * g + 3] + Zb[tt][4 * g + 3]); *(u32x2*)(op + 8 * g) = w; } } }
}
__device__ __forceinline__ size_t s_index(int cb, int i, int hh, int wave, int l31) { return (size_t)(cb * 32 + (i & 3) + 8 * (i >> 2) + 4 * hh) * 256 + 32 * wave + l31; }

__device__ __forceinline__ void gla_prep_item(const Params& p, LAS unsigned char* lds, int chain, int ch) {
    const int b = chain >> 2, h = chain & 3;
    gla_prep(p, lds, b * 2048 + ch * 64, h, 64);
    u32x4* img = (u32x4*)(p.ws + OFF_IMG + (size_t)(chain * 32 + ch) * IMG_BYTES);
    for (int i = otid(); i < IMG_V4; i += 512) img[i] = ((const LAS u32x4*)lds)[i];
    __syncthreads();
}
constexpr int SG_TAB = 0, SG_ALOW = 20480, SG_PART = 24576;
__device__ __forceinline__ void gla_sample_pair(const Params& p, LAS unsigned char* lds, int item) {
    const int tid = otid(), lane = tid & 63, wave = tid >> 6, q = wave & 3, grp = wave >> 2, chain = item * 2 + grp;
    const int b = chain >> 2, h = chain & 3, rb = MP + b * 8;
    LAS float* tab = (LAS float*)(lds + SG_TAB + wave * 2560); LAS float* alw = (LAS float*)(lds + SG_ALOW + wave * 512); LAS float* part = (LAS float*)(lds + SG_PART);
    const bf16_t* Z = (const bf16_t*)(p.ws + OFF_Z); const float* alowg = (const float*)(p.ws + OFF_ALOW); bf16_t* oraw = (bf16_t*)(p.ws + OFF_ORAW);
    alw[lane] = alowg[(size_t)rb * 16 + lane]; alw[lane + 64] = alowg[(size_t)rb * 16 + 64 + lane];
    float qe[8][2], kv[8][2]; f32x4 V[8];
#pragma unroll
    for (int t = 0; t < 8; ++t) { const bf16_t* zr = Z + (size_t)(rb + t) * NZ; const unsigned qw = *(const unsigned*)(zr + h * 128 + 2 * lane), kw = *(const unsigned*)(zr + 512 + h * 128 + 2 * lane);
        const u32x2 vw = *(const u32x2*)(zr + 1024 + h * 256 + 4 * lane);
        qe[t][0] = bflo(qw); qe[t][1] = bfhi(qw); kv[t][0] = bflo(kw); kv[t][1] = bfhi(kw); V[t] = (f32x4){bflo(vw.x), bfhi(vw.x), bflo(vw.y), bfhi(vw.y)}; }
    float bc[8][2];
    {   f32x2 wa[16];
#pragma unroll
        for (int j = 0; j < 16; ++j) wa[j] = *(const f32x2*)(p.w_a2 + j * 512 + h * 128 + 2 * lane);
        const f32x2 ba = *(const f32x2*)(p.b_a + h * 128 + 2 * lane);
        lds_wait();
        float run0 = 0.f, run1 = 0.f;
#pragma unroll
        for (int t = 0; t < 8; ++t) { float p0 = ba.x, p1 = ba.y;
#pragma unroll
            for (int j4 = 0; j4 < 4; ++j4) { const f32x4 a4 = *(const LAS f32x4*)(alw + t * 16 + 4 * j4);
#pragma unroll
                for (int k = 0; k < 4; ++k) { p0 += a4[k] * wa[4 * j4 + k].x; p1 += a4[k] * wa[4 * j4 + k].y; } }
            run0 += logsigmoid_f(p0) * 0.0625f; run1 += logsigmoid_f(p1) * 0.0625f; bc[t][0] = run0; bc[t][1] = run1; } }
    float ki[8][2];
#pragma unroll
    for (int t = 0; t < 8; ++t) { qe[t][0] *= __expf(bc[t][0]); qe[t][1] *= __expf(bc[t][1]); ki[t][0] = kv[t][0] * __expf(-bc[t][0]); ki[t][1] = kv[t][1] * __expf(-bc[t][1]); }
    lds_wait();
#pragma unroll
    for (int t = 0; t < 8; ++t)
#pragma unroll
        for (int s = 0; s <= t; ++s) { const float a = wave_sum(qe[t][0] * ki[s][0] + qe[t][1] * ki[s][1]); if (lane == 0) alw[t * (t + 1) / 2 + s] = a; }
    if ((lane >> 4) == q) { const float e0 = __expf(bc[7][0]), e1 = __expf(bc[7][1]); LAS float* r0 = tab + (2 * lane - 32 * q) * 20; LAS float* r1 = r0 + 20;
        *(LAS f32x4*)(r0) = (f32x4){qe[0][0], qe[1][0], qe[2][0], qe[3][0]}; *(LAS f32x4*)(r0 + 4) = (f32x4){qe[4][0], qe[5][0], qe[6][0], qe[7][0]};
        *(LAS f32x4*)(r1) = (f32x4){qe[0][1], qe[1][1], qe[2][1], qe[3][1]}; *(LAS f32x4*)(r1 + 4) = (f32x4){qe[4][1], qe[5][1], qe[6][1], qe[7][1]};
        *(LAS f32x4*)(r0 + 8) = (f32x4){ki[0][0] * e0, ki[1][0] * e0, ki[2][0] * e0, ki[3][0] * e0}; *(LAS f32x4*)(r0 + 12) = (f32x4){ki[4][0] * e0, ki[5][0] * e0, ki[6][0] * e0, ki[7][0] * e0};
        *(LAS f32x4*)(r1 + 8) = (f32x4){ki[0][1] * e1, ki[1][1] * e1, ki[2][1] * e1, ki[3][1] * e1}; *(LAS f32x4*)(r1 + 12) = (f32x4){ki[4][1] * e1, ki[5][1] * e1, ki[6][1] * e1, ki[7][1] * e1};
        r0[16] = e0; r1[16] = e1; }
    lds_wait();
    f32x4 o[8];
#pragma unroll
    for (int t = 0; t < 8; ++t) o[t] = (f32x4){0.f, 0.f, 0.f, 0.f};
    const f32x4* S0 = (const f32x4*)(p.state_gla + (size_t)chain * 32768 + (size_t)(32 * q) * 256) + lane; f32x4* So = (f32x4*)(p.out + OUT_SS + (size_t)chain * 32768 + (size_t)(32 * q) * 256) + lane;
#pragma unroll 1
    for (int cc = 0; cc < 32; cc += 16) { f32x4 s[16];
#pragma unroll
        for (int u = 0; u < 16; ++u) s[u] = ldnt(S0 + (cc + u) * 64);
#pragma unroll
        for (int u = 0; u < 16; ++u) { const LAS float* row = tab + (cc + u) * 20; const f32x4 qa = *(const LAS f32x4*)row, qb = *(const LAS f32x4*)(row + 4), ka = *(const LAS f32x4*)(row + 8), kb = *(const LAS f32x4*)(row + 12); const float d = row[16];
            o[0] += qa[0] * s[u]; o[1] += qa[1] * s[u]; o[2] += qa[2] * s[u]; o[3] += qa[3] * s[u]; o[4] += qb[0] * s[u]; o[5] += qb[1] * s[u]; o[6] += qb[2] * s[u]; o[7] += qb[3] * s[u];
            f32x4 sn = d * s[u]; sn += ka[0] * V[0]; sn += ka[1] * V[1]; sn += ka[2] * V[2]; sn += ka[3] * V[3]; sn += kb[0] * V[4]; sn += kb[1] * V[5]; sn += kb[2] * V[6]; sn += kb[3] * V[7];
            stnt(So + (cc + u) * 64, sn); } }
#pragma unroll
    for (int t = 0; t < 8; ++t) *(LAS f32x4*)(part + (wave * 8 + t) * 256 + 4 * lane) = o[t];
    __syncthreads();
#pragma unroll
    for (int tt = 0; tt < 2; ++tt) { const int t = 2 * q + tt; f32x4 acc = (f32x4){0.f, 0.f, 0.f, 0.f};
#pragma unroll
        for (int w = 0; w < 4; ++w) acc += *(const LAS f32x4*)(part + ((grp * 4 + w) * 8 + t) * 256 + 4 * lane);
#pragma unroll
        for (int s = 0; s < 8; ++s) { const float a = (s <= t) ? alw[t * (t + 1) / 2 + s] : 0.f; acc += a * V[s]; }
        { u32x2 w; w.x = pk2(acc[0], acc[1]); w.y = pk2(acc[2], acc[3]); *(u32x2*)(oraw + (size_t)(rb + t) * 1024 + h * 256 + 4 * lane) = w; } }
    __syncthreads();
}
struct VRegs2 { u32x4 r[2]; };
__device__ __forceinline__ void v_load_half(const Params& p, VRegs2& v, int rb, int h, int vhalf) {
    const int tid = otid(), s = tid & 63, vg = tid >> 6; const bf16_t* Z = (const bf16_t*)(p.ws + OFF_Z);
#pragma unroll
    for (int k = 0; k < 2; ++k) v.r[k] = *(const u32x4*)(Z + (size_t)(rb + s) * NZ + 1024 + h * 256 + vhalf * 128 + vg * 16 + 8 * k);
}
__device__ __forceinline__ void v_store_half_t(LAS unsigned char* lds, const VRegs2& v) {
    const int tid = otid(), s = tid & 63, vg = tid >> 6; LAS bf16_t* VT = (LAS bf16_t*)(lds + R_VT) + (vg * 16) * LS + s;
#pragma unroll
    for (int k = 0; k < 2; ++k) {
        VT[(8 * k + 0) * LS] = (bf16_t)(v.r[k].x & 0xffffu); VT[(8 * k + 1) * LS] = (bf16_t)(v.r[k].x >> 16);
        VT[(8 * k + 2) * LS] = (bf16_t)(v.r[k].y & 0xffffu); VT[(8 * k + 3) * LS] = (bf16_t)(v.r[k].y >> 16);
        VT[(8 * k + 4) * LS] = (bf16_t)(v.r[k].z & 0xffffu); VT[(8 * k + 5) * LS] = (bf16_t)(v.r[k].z >> 16);
        VT[(8 * k + 6) * LS] = (bf16_t)(v.r[k].w & 0xffffu); VT[(8 * k + 7) * LS] = (bf16_t)(v.r[k].w >> 16); }
}
constexpr int CH_BUF = 64000;
template <int NTHR> __device__ __forceinline__ void chain_stage(const Params& p, LAS unsigned char* buf, const u32x4* img, int rb, int h, int vhalf, int t) {
    const bf16_t* Z = (const bf16_t*)(p.ws + OFF_Z);
    constexpr int NI = (IMG_V4 + NTHR - 1) / NTHR, NV = 512 / NTHR;
    u32x4 im[NI], v0[NV], v1[NV];
#pragma unroll
    for (int k = 0; k < NI; ++k) { const int i = t + NTHR * k; im[k] = (i < IMG_V4) ? img[i] : (u32x4){0u, 0u, 0u, 0u}; }
#pragma unroll
    for (int k = 0; k < NV; ++k) { const int e = t + NTHR * k, s = e & 63, vg = e >> 6; const bf16_t* zp = Z + (size_t)(rb + s) * NZ + 1024 + h * 256 + vhalf * 128 + vg * 16; v0[k] = *(const u32x4*)zp; v1[k] = *(const u32x4*)(zp + 8); }
#pragma unroll
    for (int k = 0; k < NI; ++k) { const int i = t + NTHR * k; if (i < IMG_V4) ((LAS u32x4*)buf)[i] = im[k]; }
#pragma unroll
    for (int k = 0; k < NV; ++k) { const int e = t + NTHR * k, s = e & 63, vg = e >> 6; const u32x4 r0 = v0[k], r1 = v1[k];
        LAS bf16_t* VT = (LAS bf16_t*)(buf + R_VT) + (vg * 16) * LS + s;
        VT[0 * LS] = (bf16_t)(r0.x & 0xffffu); VT[1 * LS] = (bf16_t)(r0.x >> 16); VT[2 * LS] = (bf16_t)(r0.y & 0xffffu); VT[3 * LS] = (bf16_t)(r0.y >> 16);
        VT[4 * LS] = (bf16_t)(r0.z & 0xffffu); VT[5 * LS] = (bf16_t)(r0.z >> 16); VT[6 * LS] = (bf16_t)(r0.w & 0xffffu); VT[7 * LS] = (bf16_t)(r0.w >> 16);
        VT[8 * LS] = (bf16_t)(r1.x & 0xffffu); VT[9 * LS] = (bf16_t)(r1.x >> 16); VT[10 * LS] = (bf16_t)(r1.y & 0xffffu); VT[11 * LS] = (bf16_t)(r1.y >> 16);
        VT[12 * LS] = (bf16_t)(r1.z & 0xffffu); VT[13 * LS] = (bf16_t)(r1.z >> 16); VT[14 * LS] = (bf16_t)(r1.w & 0xffffu); VT[15 * LS] = (bf16_t)(r1.w >> 16); }
}
__device__ __forceinline__ void gla_chain_item(const Params& p, LAS unsigned char* lds, int chain, int vhalf) {
    const int tid = otid(), lane = tid & 63, wave = tid >> 6, l31 = lane & 31, hh = lane >> 5;
    const int b = chain >> 2, h = chain & 3, vb = vhalf * 4 + (wave & 3);
    f32x16 S[4];
#pragma unroll
    for (int cb = 0; cb < 4; ++cb)
#pragma unroll
        for (int i = 0; i < 16; ++i) S[cb][i] = 0.f;
    const u32x4* img = (const u32x4*)(p.ws + OFF_IMG + (size_t)(chain * 32) * IMG_BYTES);
    chain_stage<512>(p, lds, img, b * 2048, h, vhalf, tid);
    __syncthreads();
#pragma unroll 1
    for (int ch = 0; ch < 32; ++ch) {
        const int rb = b * 2048 + ch * 64;
        if (wave >= 4) { if (ch + 1 < 32) chain_stage<256>(p, lds + ((ch + 1) & 1) * CH_BUF, img + (size_t)(ch + 1) * IMG_V4, rb + 64, h, vhalf, tid - 256); }
        else gla_step(p, lds + (ch & 1) * CH_BUF, S, rb, h, 64, vb, 32 * wave);
        __syncthreads();
    }
    if (wave < 4) {
        float* Sout = p.out + OUT_SP + (size_t)chain * 32768;
#pragma unroll
        for (int cb = 0; cb < 4; ++cb)
#pragma unroll
            for (int i = 0; i < 16; ++i) Sout[s_index(cb, i, hh, vb, l31)] = S[cb][i];
    }
}

constexpr int M_W = 0, M_V = 34816, M_STAT = 69632;
__device__ __forceinline__ void gmlp_item(const Params& p, LAS unsigned char* lds, int rowbase, int T, int g, float* vs_out) {
    const int tid = otid(), lane = tid & 63, wave = tid >> 6;
    const bf16_t* Z = (const bf16_t*)(p.ws + OFF_Z); bf16_t* mraw = (bf16_t*)(p.ws + OFF_MRAW);
    LAS bf16_t* LW = (LAS bf16_t*)(lds + M_W); LAS bf16_t* LV = (LAS bf16_t*)(lds + M_V); LAS float* stat = (LAS float*)(lds + M_STAT);
    if (tid < 128) { const f32x2 st = (tid < T) ? *(const f32x2*)((const float*)(p.ws + OFF_STAT) + (size_t)(rowbase + tid) * 2) : (f32x2){0.f, 0.f}; stat[2 * tid] = st.x; stat[2 * tid + 1] = st.y; }
    for (int idx = tid; idx < 4096; idx += 512) { const int t = idx >> 5, s4 = (idx & 31) * 4; const f32x4 w = *(const f32x4*)(p.w_s + ((size_t)g * 128 + t) * 128 + s4);
        u32x2 o; o.x = pk2(s4 <= t ? w[0] : 0.f, s4 + 1 <= t ? w[1] : 0.f); o.y = pk2(s4 + 2 <= t ? w[2] : 0.f, s4 + 3 <= t ? w[3] : 0.f);
        *(LAS u32x2*)(LW + t * LQ + s4) = o; }
    __syncthreads();
    { const int s = tid & 127, dq = tid >> 7; const float mean = stat[2 * s], rstd = stat[2 * s + 1];
#pragma unroll
        for (int ps = 0; ps < 4; ++ps) { const int d8 = (dq * 4 + ps) * 8; float vn[8];
            if (s < T) { const u32x4 r = *(const u32x4*)(Z + (size_t)(rowbase + s) * NZ + 4096 + g * 128 + d8);
                const float x[8] = {bflo(r.x), bfhi(r.x), bflo(r.y), bfhi(r.y), bflo(r.z), bfhi(r.z), bflo(r.w), bfhi(r.w)};
                const f32x4 ga = *(const f32x4*)(p.g_gmlp_ln + g * 128 + d8), gb = *(const f32x4*)(p.g_gmlp_ln + g * 128 + d8 + 4);
                const f32x4 ba = *(const f32x4*)(p.b_gmlp_ln + g * 128 + d8), bb = *(const f32x4*)(p.b_gmlp_ln + g * 128 + d8 + 4);
#pragma unroll
                for (int j = 0; j < 4; ++j) { vn[j] = (x[j] - mean) * rstd * ga[j] + ba[j]; vn[4 + j] = (x[4 + j] - mean) * rstd * gb[j] + bb[j]; }
                if (vs_out) { float* vp = vs_out + (size_t)s * 1024 + g * 128 + d8; *(f32x4*)vp = (f32x4){vn[0], vn[1], vn[2], vn[3]}; *(f32x4*)(vp + 4) = (f32x4){vn[4], vn[5], vn[6], vn[7]}; }
            } else {
#pragma unroll
                for (int j = 0; j < 8; ++j) vn[j] = 0.f;
            }
#pragma unroll
            for (int j = 0; j < 8; ++j) LV[(d8 + j) * LQ + s] = f2bf(vn[j]); } }
    __syncthreads();
#pragma unroll 1
    for (int q = 0; q < 2; ++q) { const int id = wave * 2 + q, ti = id >> 2, di = id & 3;
        if (ti * 32 < T) { f32x16 acc;
#pragma unroll
            for (int i = 0; i < 16; ++i) acc[i] = 0.f;
            mma32(acc, LW + ti * 32 * LQ, LQ, LV + di * 32 * LQ, LQ, (ti + 1) * 32, lane);
            const int d = di * 32 + (lane & 31);
#pragma unroll
            for (int i = 0; i < 16; ++i) { const int t = ti * 32 + (i & 3) + 8 * (i >> 2) + 4 * (lane >> 5);
                if (t < T) { const float uval = bf2f(Z[(size_t)(rowbase + t) * NZ + 3072 + g * 128 + d]);
                    mraw[(size_t)(rowbase + t) * 1024 + g * 128 + d] = f2bf(uval * (acc[i] + p.b_s[g * 128 + t])); } } } }
    __syncthreads();
}

__device__ __forceinline__ void gmlp_sample_item(const Params& p, int b) {
    const int tid = otid(), d2 = tid * 2, g = __builtin_amdgcn_readfirstlane(tid >> 6), rb = MP + b * 8;
    const bf16_t* Z = (const bf16_t*)(p.ws + OFF_Z); bf16_t* mraw = (bf16_t*)(p.ws + OFF_MRAW); const float* st = (const float*)(p.ws + OFF_STAT) + (size_t)rb * 2;
    float* vs_out = p.out + OUT_VS + (size_t)b * 8 * 1024;
    const f32x2 ga = *(const f32x2*)(p.g_gmlp_ln + d2), be = *(const f32x2*)(p.b_gmlp_ln + d2);
    unsigned xv[8], uv[8];
#pragma unroll
    for (int s_ = 0; s_ < 8; ++s_) { xv[s_] = *(const unsigned*)(Z + (size_t)(rb + s_) * NZ + 4096 + d2); uv[s_] = *(const unsigned*)(Z + (size_t)(rb + s_) * NZ + 3072 + d2); }
    float v0[8], v1[8];
#pragma unroll
    for (int s_ = 0; s_ < 8; ++s_) { const float mean = st[2 * s_], rstd = st[2 * s_ + 1];
        v0[s_] = (bflo(xv[s_]) - mean) * rstd * ga.x + be.x; v1[s_] = (bfhi(xv[s_]) - mean) * rstd * ga.y + be.y;
        *(f32x2*)(vs_out + (size_t)s_ * 1024 + d2) = (f32x2){v0[s_], v1[s_]}; }
    const float* wg = p.w_s + (size_t)g * 128 * 128; const float* bs = p.b_s + g * 128;
#pragma unroll
    for (int t = 0; t < 8; ++t) { float m0 = bs[t], m1 = m0;
#pragma unroll
        for (int s_ = 0; s_ <= t; ++s_) { const float w = wg[t * 128 + s_]; m0 += w * v0[s_]; m1 += w * v1[s_]; }
        *(unsigned*)(mraw + (size_t)(rb + t) * 1024 + d2) = pk2(bflo(uv[t]) * m0, bfhi(uv[t]) * m1); }
}
__device__ __forceinline__ void phase2a(const Params& p, LAS unsigned char* lds) {
    {   const int tid = otid(), lane = tid & 63, gw = blockIdx.x * 8 + (tid >> 6), NGW = gridDim.x * 8;
        const bf16_t* Z = (const bf16_t*)(p.ws + OFF_Z); float* st = (float*)(p.ws + OFF_STAT);
        for (int r = gw; r < MT; r += NGW) {
            const bf16_t* zr = Z + (size_t)r * NZ + 4096; const u32x4 r0 = *(const u32x4*)(zr + lane * 8), r1 = *(const u32x4*)(zr + 512 + lane * 8);
            const float x[16] = {bflo(r0.x), bfhi(r0.x), bflo(r0.y), bfhi(r0.y), bflo(r0.z), bfhi(r0.z), bflo(r0.w), bfhi(r0.w), bflo(r1.x), bfhi(r1.x), bflo(r1.y), bfhi(r1.y), bflo(r1.z), bfhi(r1.z), bflo(r1.w), bfhi(r1.w)};
            float s = 0.f;
#pragma unroll
            for (int j = 0; j < 16; ++j) s += x[j];
            const float mean = wave_sum(s) * (1.f / 1024.f); float q = 0.f;
#pragma unroll
            for (int j = 0; j < 16; ++j) { const float d = x[j] - mean; q += d * d; }
            const float rstd = rsqrtf(wave_sum(q) * (1.f / 1024.f) + 1e-6f);
            if (lane == 0) *(f32x2*)(st + (size_t)r * 2) = (f32x2){mean, rstd};
        }
    }
    for (int j = blockIdx.x; j < 512; j += gridDim.x) gla_prep_item(p, lds, j >> 5, j & 31);
    for (int j = blockIdx.x; j < 256; j += gridDim.x) gla_sample_pair(p, lds, j);
    { const int gw = blockIdx.x * 8 + (otid() >> 6), NGW = gridDim.x * 8; convert_range(p, lds, cv::E_IN, cv::E_OUT, gw, NGW); convert_range(p, lds, cv::E_FO, cv::E_PLE, gw, NGW); }
}
__device__ __forceinline__ void phase2c(const Params& p, LAS unsigned char* lds) {
    const int nb = gridDim.x, bid = blockIdx.x;
    constexpr int NCH = 32, N_GP = 512, N_GS = 0, N_MS = 128;
    const int nlb = nb > 2 * NCH ? NCH : (nb > 1 ? nb / 2 : 0);
    if (bid < nlb || nlb == 0) { for (int j = (nlb ? bid : 0); j < NCH; j += (nlb ? nlb : 1)) gla_chain_item(p, lds, j >> 1, j & 1); }
    if (bid >= nlb) {
        const int ob = bid - nlb, onb = nb - nlb;
        for (int j = ob; j < N_GP + N_GS + N_MS; j += onb) {
            if (j < N_GP) gmlp_item(p, lds, (j >> 3) * 128, 128, j & 7, nullptr);
            else gmlp_sample_item(p, j - N_GP - N_GS);
        }
        __syncthreads();
        convert_range(p, lds, cv::E_OUT, cv::E_FI, ob * 8 + (otid() >> 6), onb * 8);
    }
}

struct Mix10 { f32x4 o[4], m[4]; u32x4 r0, r1; };
__device__ __forceinline__ void mix_load(Mix10& a, const Params& p, int r, int col) {
    const bf16_t* Z = (const bf16_t*)(p.ws + OFF_Z); const bf16_t* oraw = (const bf16_t*)(p.ws + OFF_ORAW); const bf16_t* mraw = (const bf16_t*)(p.ws + OFF_MRAW);
#pragma unroll
    for (int j = 0; j < 2; ++j) { const u32x4 ow = ldnt((const u32x4*)(oraw + (size_t)r * 1024 + col + 8 * j)), mw = ldnt((const u32x4*)(mraw + (size_t)r * 1024 + col + 8 * j));
        a.o[2 * j] = (f32x4){bflo(ow.x), bfhi(ow.x), bflo(ow.y), bfhi(ow.y)}; a.o[2 * j + 1] = (f32x4){bflo(ow.z), bfhi(ow.z), bflo(ow.w), bfhi(ow.w)};
        a.m[2 * j] = (f32x4){bflo(mw.x), bfhi(mw.x), bflo(mw.y), bfhi(mw.y)}; a.m[2 * j + 1] = (f32x4){bflo(mw.z), bfhi(mw.z), bflo(mw.w), bfhi(mw.w)}; }
    a.r0 = ldnt((const u32x4*)(Z + (size_t)r * NZ + 2048 + col)); a.r1 = ldnt((const u32x4*)(Z + (size_t)r * NZ + 2048 + col + 8));
}
__device__ __forceinline__ void mix_finish(const Mix10& a, const Params& p, int r, int col) {
    bf16_t* cat = (bf16_t*)(p.ws + OFF_A0);
    { float s = 0.f;
#pragma unroll
        for (int j = 0; j < 4; ++j) s += (a.o[j][0] * a.o[j][0] + a.o[j][1] * a.o[j][1]) + (a.o[j][2] * a.o[j][2] + a.o[j][3] * a.o[j][3]);
        s = row16_sum(s);
        const float rinv = rsqrtf(s * (1.f / 256.f) + 1e-6f);
        const float sr[16] = {bflo(a.r0.x), bfhi(a.r0.x), bflo(a.r0.y), bfhi(a.r0.y), bflo(a.r0.z), bfhi(a.r0.z), bflo(a.r0.w), bfhi(a.r0.w), bflo(a.r1.x), bfhi(a.r1.x), bflo(a.r1.y), bfhi(a.r1.y), bflo(a.r1.z), bfhi(a.r1.z), bflo(a.r1.w), bfhi(a.r1.w)};
        unsigned w[8];
#pragma unroll
        for (int j = 0; j < 4; ++j) { const f32x4 g = *(const f32x4*)(p.g_gla_norm + col + 4 * j);
            w[2 * j] = pk2(a.o[j][0] * rinv * g[0] * sr[4 * j], a.o[j][1] * rinv * g[1] * sr[4 * j + 1]); w[2 * j + 1] = pk2(a.o[j][2] * rinv * g[2] * sr[4 * j + 2], a.o[j][3] * rinv * g[3] * sr[4 * j + 3]); }
        u32x4* dp = (u32x4*)(cat + (size_t)r * DM + col); dp[0] = (u32x4){w[0], w[1], w[2], w[3]}; dp[1] = (u32x4){w[4], w[5], w[6], w[7]}; }
    { float s = 0.f;
#pragma unroll
        for (int j = 0; j < 4; ++j) s += (a.m[j][0] * a.m[j][0] + a.m[j][1] * a.m[j][1]) + (a.m[j][2] * a.m[j][2] + a.m[j][3] * a.m[j][3]);
        const float rinv = rsqrtf(wave_sum(s) * (1.f / 1024.f) + 1e-6f);
        unsigned w[8];
#pragma unroll
        for (int j = 0; j < 4; ++j) { const f32x4 g = *(const f32x4*)(p.g_gmlp_out + col + 4 * j);
            w[2 * j] = pk2(a.m[j][0] * rinv * g[0], a.m[j][1] * rinv * g[1]); w[2 * j + 1] = pk2(a.m[j][2] * rinv * g[2], a.m[j][3] * rinv * g[3]); }
        u32x4* dp = (u32x4*)(cat + (size_t)r * DM + 1024 + col); dp[0] = (u32x4){w[0], w[1], w[2], w[3]}; dp[1] = (u32x4){w[4], w[5], w[6], w[7]}; }
}
__device__ __forceinline__ void phase2b(const Params& p) {
    const int lane = otid() & 63, gw = blockIdx.x * 8 + (otid() >> 6), NGW = gridDim.x * 8, col = lane * 16;
    for (int r = gw; r < MT; r += 2 * NGW) {
        const int r2 = r + NGW; const bool has2 = r2 < MT;
        Mix10 a, b; mix_load(a, p, r, col); mix_load(b, p, has2 ? r2 : r, col);
        mix_finish(a, p, r, col);
        if (has2) mix_finish(b, p, r2, col);
    }
}
template <int NS> __device__ __forceinline__ void phase_norm(const Params& p, const float* gain, const float* base_s) {
    const int lane = otid() & 63, gw = blockIdx.x * 8 + (otid() >> 6), NGW = gridDim.x * 8; bf16_t* a0 = (bf16_t*)(p.ws + OFF_A0); const bf16_t* part = (const bf16_t*)(p.ws + OFF_IMG);
    for (int r = gw; r < MP; r += 4 * NGW) {
        const int r2 = r + NGW, r3 = r + 2 * NGW, r4 = r + 3 * NGW; const bool h2 = r2 < MP, h3 = r3 < MP, h4 = r4 < MP;
        Row8 a, b, c4, d; row_load(a, p.out + OUT_Y + (size_t)r * DM, lane); row_load(b, p.out + OUT_Y + (size_t)(h2 ? r2 : r) * DM, lane);
        row_load(c4, p.out + OUT_Y + (size_t)(h3 ? r3 : r) * DM, lane); row_load(d, p.out + OUT_Y + (size_t)(h4 ? r4 : r) * DM, lane);
        rms_finish_bf16(a, gain, a0 + (size_t)r * DM, lane);
        if (h2) rms_finish_bf16(b, gain, a0 + (size_t)r2 * DM, lane);
        if (h3) rms_finish_bf16(c4, gain, a0 + (size_t)r3 * DM, lane);
        if (h4) rms_finish_bf16(d, gain, a0 + (size_t)r4 * DM, lane);
    }
    for (int r = MP + gw; r < MT; r += NGW) {
        f32x4 v[8]; float s = 0.f; const f32x4* sm = row_mid(base_s + (size_t)(r - MP) * DM, lane); const f32x4* gm = row_mid(gain, lane);
        const u32x2* pm0 = (const u32x2*)(part + (size_t)(r - MP) * DM) + lane; f32x4* om = row_mid(p.out + OUT_Y + (size_t)r * DM, lane);
#pragma unroll
        for (int j = 0; j < 8; ++j) v[j] = sm[64 * (j - 4)];
#pragma unroll 4
        for (int k = 0; k < NS; ++k) { const u32x2* pk = pm0 + (size_t)k * (MS * DM / 4);
#pragma unroll
            for (int j = 0; j < 8; ++j) v[j] += unpack4(pk[64 * j]); }
#pragma unroll
        for (int j = 0; j < 8; ++j) { om[64 * (j - 4)] = v[j]; s += (v[j][0] * v[j][0] + v[j][1] * v[j][1]) + (v[j][2] * v[j][2] + v[j][3] * v[j][3]); }
        const float rinv = rsqrtf(wave_sum(s) * (1.f / DM) + 1e-6f);
        u32x2* dm = (u32x2*)(a0 + (size_t)r * DM) + lane;
#pragma unroll
        for (int j = 0; j < 8; ++j) { const f32x4 g = gm[64 * (j - 4)]; u32x2 o; o.x = pk2(v[j][0] * rinv * g[0], v[j][1] * rinv * g[1]); o.y = pk2(v[j][2] * rinv * g[2], v[j][3] * rinv * g[3]);
            dm[64 * j] = o; }
    }
}
#define P7_TAIL() \
        float s = 0.f; \
        _Pragma("unroll") for (int j = 0; j < 8; ++j) s += (v.v[j][0] * v.v[j][0] + v.v[j][1] * v.v[j][1]) + (v.v[j][2] * v.v[j][2] + v.v[j][3] * v.v[j][3]); \
        const float rp = rsqrtf(wave_sum(s) * (1.f / DM) + 1e-6f); float s3 = 0.f; \
        const f32x4* gpm = row_mid(p.g_ple, lane); \
        _Pragma("unroll") for (int j = 0; j < 8; ++j) { const f32x4 g = gpm[64 * (j - 4)]; \
            _Pragma("unroll") for (int k = 0; k < 4; ++k) { const float h3 = hh.v[j][k] + v.v[j][k] * rp * g[k] * sigmoid_f(z.v[j][k]); v.v[j][k] = h3; s3 += h3 * h3; } } \
        const float r3 = rsqrtf(wave_sum(s3) * (1.f / DM) + 1e-6f); \
        const f32x4* gfm = row_mid(p.g_final, lane); \
        _Pragma("unroll") for (int j = 0; j < 8; ++j) { const f32x4 g = gfm[64 * (j - 4)]; stnt(om + 64 * (j - 4), (f32x4){v.v[j][0] * r3 * g[0], v.v[j][1] * r3 * g[1], v.v[j][2] * r3 * g[2], v.v[j][3] * r3 * g[3]}); }
__device__ __forceinline__ void phase7(const Params& p) {
    const int lane = otid() & 63, gw = blockIdx.x * 8 + (otid() >> 6), NGW = gridDim.x * 8;
    const bf16_t* gz = (const bf16_t*)(p.ws + OFF_GATEZ); const bf16_t* pz = (const bf16_t*)(p.ws + OFF_PZ);
#pragma unroll 1
    for (int r = gw; r < MP; r += NGW) {
        f32x4* om = row_mid(p.out + OUT_Y + (size_t)r * DM, lane);
        const u32x2* pzr = (const u32x2*)(pz + (size_t)r * DM) + lane; const u32x2* zb = (const u32x2*)(gz + (size_t)r * DM) + lane;
        Row8 v, hh, z;
#pragma unroll
        for (int j = 0; j < 8; ++j) { const u32x2 w = ldnt(pzr + 64 * j), zw = ldnt(zb + 64 * j); v.v[j] = (f32x4){bflo(w.x), bfhi(w.x), bflo(w.y), bfhi(w.y)}; z.v[j] = (f32x4){bflo(zw.x), bfhi(zw.x), bflo(zw.y), bfhi(zw.y)}; hh.v[j] = ldnt(om + 64 * (j - 4)); }
        P7_TAIL()
    }
#pragma unroll 1
    for (int r = MP + gw; r < MT; r += NGW) {
        f32x4* om = row_mid(p.out + OUT_Y + (size_t)r * DM, lane);
        const u32x2* pzr = (const u32x2*)(pz + (size_t)r * DM) + lane; const u32x2* zm = (const u32x2*)((const bf16_t*)(p.ws + OFF_IMG) + (size_t)(r - MP) * DM) + lane;
        Row8 v, hh, z;
#pragma unroll
        for (int j = 0; j < 8; ++j) { const u32x2 w = ldnt(pzr + 64 * j); v.v[j] = unpack4(w); hh.v[j] = ldnt(om + 64 * (j - 4)); z.v[j] = (f32x4){0.f, 0.f, 0.f, 0.f}; }
#pragma unroll 4
        for (int k = 0; k < 8; ++k) { const u32x2* pk = zm + (size_t)k * (MS * DM / 4);
#pragma unroll
            for (int j = 0; j < 8; ++j) z.v[j] += unpack4(ldnt(pk + 64 * j)); }
        P7_TAIL()
    }
}
#undef P7_TAIL

__global__ void __launch_bounds__(512, 2) fwd_kernel(Params p) {
    extern __shared__ __attribute__((aligned(16))) unsigned char shm[];
    LAS unsigned char* lds = (LAS unsigned char*)shm;
    cg::grid_group grid = cg::this_grid();
    if (threadIdx.x == 0) { *(volatile LAS unsigned*)(lds + 131072) = 0u; *(volatile LAS unsigned*)(lds + 131076) = 0u; }
    __syncthreads();
    const XcdBarrier xb = xcd_barrier_post((unsigned*)(p.ws + OFF_BAR), (volatile LAS unsigned*)(lds + 131072));
    bf16_t* a0 = (bf16_t*)(p.ws + OFF_A0);
    phase0(p, lds);
    if (p.ws == nullptr) grid.sync();
    xcd_barrier(xb);
    { EpiIn E; E.Z = (bf16_t*)(p.ws + OFF_Z); E.alow = (float*)(p.ws + OFF_ALOW); run_gemm(lds, a0, (const bf16_t*)(p.ws + OFF_WIN), MT, NINP, DM, E); }
    xcd_barrier(xb);
    phase2a(p, lds);
    xcd_barrier(xb);
    phase2c(p, lds);
    xcd_barrier(xb);
    phase2b(p);
    xcd_barrier(xb);
    bf16_t* part = (bf16_t*)(p.ws + OFF_IMG);
    { EpiRes E; E.res_p = p.x_prompt; E.res_s = p.x_sample; E.out = p.out + OUT_Y; run_gemm_n2048(lds, a0, (const bf16_t*)(p.ws + OFF_WOUT), DM, E, part); }
    xcd_barrier(xb);
    phase_norm<8>(p, p.g_ffn, p.x_sample);
    xcd_barrier(xb);
    { EpiSwiglu E; E.act = (bf16_t*)(p.ws + OFF_ACT); run_gemm(lds, a0, (const bf16_t*)(p.ws + OFF_WFI), MT, 2 * DFF, DM, E); }
    {
        const int G = (int)gridDim.x, extra = ((MT / 256) * (2 * DFF / 256)) % G, cb = (int)blockIdx.x;
        if (extra == 0 || cb >= extra) { EpiBfN E; E.out = (bf16_t*)(p.ws + OFF_PZ); pg8::Gemm g; g.A = (const bf16_t*)(p.ws + OFF_PB); g.Bt = (const bf16_t*)(p.ws + OFF_WPLE); g.M = MT; g.N = DM; g.K = PLE; g.Klen = PLE;
            pg8::StaticOrder S; S.init(MT, DM, extra ? G - extra : G, extra ? cb - extra : cb); pg8::gemm_phase<EpiBfN, pg8::StaticOrder, false>(lds, g, S, E, nullptr);
            { const int ob = extra ? cb - extra : cb, onb = extra ? G - extra : G, gw = ob * 8 + (otid() >> 6); convert_range(p, lds, cv::E_FI, cv::E_FO, gw, onb * 8); convert_range(p, lds, cv::E_PLE, cv::E_GT, gw, onb * 8); } }
    }
    xcd_barrier(xb);
    { EpiRes E; E.res_p = p.out + OUT_Y; E.res_s = p.out + OUT_Y + (size_t)MP * DM; E.out = p.out + OUT_Y;
      const bf16_t* A = (const bf16_t*)(p.ws + OFF_ACT); const bf16_t* Bt = (const bf16_t*)(p.ws + OFF_WFO); const int G = (int)gridDim.x, hb = (int)((blockIdx.x + G / 2) % G);
      run_gemm(lds, A, Bt, MP, DM, DFF, E);
      run_split(lds, A, Bt, DFF, part, 4, 768, 0, 0, hb);
      run_split(lds, A, Bt, DFF, part, 4, 640, 3072, 4, (int)blockIdx.x); }
    xcd_barrier(xb);
    phase_norm<8>(p, p.g_ple_gate, p.out + OUT_Y + (size_t)MP * DM);
    xcd_barrier(xb);
    { EpiBfN E; E.out = (bf16_t*)(p.ws + OFF_GATEZ); run_gemm_n2048(lds, a0, (const bf16_t*)(p.ws + OFF_WGT), DM, E, part); }
    xcd_barrier(xb);
    phase7(p);
}

extern "C" void kernel_launch(void* const* d_in, const int* in_sizes, int n_in, void* d_out, int out_size, void* d_ws, size_t ws_size, hipStream_t stream) {
    static int grid = 0;
    if (grid == 0) {
        if (n_in != 24 || ws_size < WS_END) { fprintf(stderr, "kernel_launch: unexpected n_in %d or ws_size %zu (< %zu)\n", n_in, ws_size, (size_t)WS_END); grid = -1; return; }
        int dev = 0, cus = 0, per_cu = 0;
        if (hipGetDevice(&dev) != hipSuccess || hipDeviceGetAttribute(&cus, hipDeviceAttributeMultiprocessorCount, dev) != hipSuccess) { grid = -1; return; }
        if (hipFuncSetAttribute((const void*)fwd_kernel, hipFuncAttributeMaxDynamicSharedMemorySize, LDS_BYTES) != hipSuccess) { fprintf(stderr, "kernel_launch: hipFuncSetAttribute failed\n"); grid = -1; return; }
        if (hipOccupancyMaxActiveBlocksPerMultiprocessor(&per_cu, (const void*)fwd_kernel, 512, LDS_BYTES) != hipSuccess || per_cu < 1) { fprintf(stderr, "kernel_launch: occupancy query says %d blocks per CU\n", per_cu); grid = -1; (void)hipGetLastError(); return; }
        grid = cus;
    }
    if (grid < 0) return;
    if (hipMemsetAsync(d_ws, 0, XCD_BAR_WORDS * sizeof(unsigned), stream) != hipSuccess) { fprintf(stderr, "kernel_launch: memset failed\n"); return; }
    Params p{};
    const float** f = (const float**)&p;
    for (int i = 0; i < 24; ++i) f[i] = (const float*)d_in[i];
    p.out = (float*)d_out; p.ws = (unsigned char*)d_ws;
    void* args[] = {&p};
    hipError_t e = hipLaunchCooperativeKernel((const void*)fwd_kernel, dim3(grid), dim3(512), args, LDS_BYTES, stream);
    if (e != hipSuccess) fprintf(stderr, "cooperative launch failed: %s (grid %d)\n", hipGetErrorString(e), grid);
}
```

```cpp
#include <hip/hip_runtime.h>
#include <hip/hip_cooperative_groups.h>
#include <cstdio>
#include <cstdint>
namespace cg = cooperative_groups;
namespace pg8 {
#define PG8_LAS __attribute__((address_space(3)))
typedef unsigned short bf16_t;
typedef short bf16x8 __attribute__((ext_vector_type(8)));
typedef float f32x4 __attribute__((ext_vector_type(4)));
typedef unsigned u32x4 __attribute__((ext_vector_type(4)));
constexpr int BM = 256, BK = 64, HALF = 128, HTB = HALF * BK * 2  , STAGE_BYTES = 8 * HTB, NXCD = 8, WGM = 8;

__host__ __device__ __forceinline__ int lds_byte(int r, int c) { const int st = (r >> 4) * 2 + (c >> 5), rr = r & 15, cc = c & 31, ob = rr * 64 + cc * 2; return st * 1024 + (ob ^ (((ob >> 9) & 1) << 5)); }
__host__ __device__ __forceinline__ void stage_rc(int b, int& R, int& C) { const int st = b / 1024, sb = b % 1024, swz = sb ^ (((sb >> 9) & 1) << 5); R = (st >> 1) * 16 + swz / 64; C = (st & 1) * 32 + (swz % 64) / 2; }
__host__ __device__ __forceinline__ int perm32(int rho) { const int n = rho >> 4, i = rho & 15; return 8 * (i >> 2) + 4 * n + (i & 3); }

struct Unit { int pm, pn, ks, koff; };
struct Gemm { const bf16_t* A; const bf16_t* Bt; int M, N, K, Klen; };

struct StaticOrder {
    int nM, nN, nwg, G, c;
    __host__ __device__ void init(int M, int N, int G_, int c_) { nM = M / BM; nN = N / BM; nwg = nM * nN; G = G_; c = c_; }
    __host__ __device__ bool next(int i, Unit& u) const {
        const long L = (long)i * G + c; if (L >= nwg) return false;
        int wgid = (int)L; { const int q = nwg / NXCD, r = nwg % NXCD, xcd = wgid % NXCD, off = wgid / NXCD; wgid = (xcd < r ? xcd * (q + 1) : r * (q + 1) + (xcd - r) * q) + off; }
        const int nig = WGM * nN, gid = wgid / nig, fm = gid * WGM, gsz = (nM - fm) < WGM ? (nM - fm) : WGM;
        u.pm = fm + ((wgid % nig) % gsz); u.pn = (wgid % nig) / gsz; u.ks = 0; u.koff = 0; return true;
    }
    __device__ __forceinline__ void a_ready(const Unit&) const {}
    __device__ __forceinline__ void done(const Unit&) const {}
};
__device__ __forceinline__ unsigned cvt_pk_bf16(float lo, float hi) { unsigned r; asm volatile("v_cvt_pk_bf16_f32 %0, %1, %2" : "=v"(r) : "v"(lo), "v"(hi)); return r; }
typedef float f32x2 __attribute__((ext_vector_type(2)));
template <class Epi, class Sched, bool STAMP = false>
__device__ __forceinline__ void gemm_phase(PG8_LAS unsigned char* lds, const Gemm g, const Sched& S, const Epi& E, unsigned long long* stamps) {
    int tid_ = threadIdx.x; asm volatile("" : "+v"(tid_));
    const int tid = tid_, wid = __builtin_amdgcn_readfirstlane(tid >> 6), lane = tid & 63, wr = wid >> 2, wc = wid & 3, fr = lane & 15, fq = lane >> 4;
    const int K = g.K, nt = g.Klen / BK;
    int ts_lo = 0, ts_hi = 0, nts = 0; const unsigned long long rt_entry = STAMP ? (unsigned long long)wall_clock64() : 0ull;
#define PG8_STAMP() do { if (STAMP && wid == 0 && nts < 64) { const unsigned long long _c = (unsigned long long)clock64(); \
        ts_lo = (lane == nts) ? (int)(unsigned)_c : ts_lo; ts_hi = (lane == nts) ? (int)(unsigned)(_c >> 32) : ts_hi; ++nts; } } while (0)
    PG8_STAMP();
    unsigned voffA[2], voffB[2];
#pragma unroll
    for (int i = 0; i < 2; ++i) { int R, C; stage_rc(tid * 16 + i * 8192, R, C); const int Rb = Epi::PERM ? ((R & ~31) + perm32(R & 31)) : R;
        voffA[i] = (unsigned)(R * K + C) * 2u; voffB[i] = (unsigned)(Rb * K + C) * 2u; }
    const size_t kstep = (size_t)(BK * 2);
    const size_t hstep = (size_t)HALF * K * 2;
    const size_t tstep = 2 * hstep;
    const unsigned ldsw = (unsigned)wid * 1024u;
    const int aoff = lds_byte(wr * 64 + fr, fq * 8), boff = lds_byte(wc * 32 + fr, fq * 8);
#define PG8_SA(b, h) (((b) * 2 + (h)) * HTB)
#define PG8_SB(b, h) ((4 + (b) * 2 + (h)) * HTB)
#define PG8_STAGE(bufoff, gbase, voff) do { _Pragma("unroll") for (int _i = 0; _i < 2; ++_i) \
        __builtin_amdgcn_global_load_lds((const unsigned*)((const char*)(gbase) + (voff)[_i]), (PG8_LAS unsigned*)(lds + (bufoff) + ldsw + _i * 8192), 16, 0, 0); } while (0)
#define PG8_LDA(dst, b, h) do { _Pragma("unroll") for (int m = 0; m < 4; ++m) _Pragma("unroll") for (int k = 0; k < 2; ++k) dst[m][k] = *(const PG8_LAS bf16x8*)(lds + PG8_SA(b, h) + aoff + m * 2048 + k * 1024); } while (0)
#define PG8_LDB(dst, b, h) do { _Pragma("unroll") for (int n = 0; n < 2; ++n) _Pragma("unroll") for (int k = 0; k < 2; ++k) dst[n][k] = *(const PG8_LAS bf16x8*)(lds + PG8_SB(b, h) + boff + n * 2048 + k * 1024); } while (0)
#define PG8_MMA(ai, bj, At, Bt) do { __builtin_amdgcn_s_setprio(1); _Pragma("unroll") for (int m = 0; m < 4; ++m) _Pragma("unroll") for (int n = 0; n < 2; ++n) _Pragma("unroll") for (int k = 0; k < 2; ++k) \
        acc[ai][bj][m][n] = __builtin_amdgcn_mfma_f32_16x16x32_bf16(Bt[n][k], At[m][k], acc[ai][bj][m][n], 0, 0, 0); __builtin_amdgcn_s_setprio(0); } while (0)
#define PG8_WAIT_V(n) asm volatile("s_waitcnt vmcnt(" #n ")" ::: "memory")
#define PG8_WAIT_L(n) asm volatile("s_waitcnt lgkmcnt(" #n ")" ::: "memory")
#define PG8_BAR __builtin_amdgcn_s_barrier()
#define PG8_SCHED __builtin_amdgcn_sched_barrier(0)
    Unit cur, nxt; int ui = 0;
    if (!S.next(0, cur)) return;
    f32x4 acc[2][2][4][2];
#pragma unroll
    for (int a = 0; a < 2; ++a)
#pragma unroll
        for (int b = 0; b < 2; ++b)
#pragma unroll
            for (int m = 0; m < 4; ++m)
#pragma unroll
                for (int n = 0; n < 2; ++n) acc[a][b][m][n] = (f32x4){0.f, 0.f, 0.f, 0.f};
    bf16x8 At[4][2], B0[2][2], B1[2][2];
    const char* cA = (const char*)g.A + (size_t)cur.pm * tstep + (size_t)cur.koff * 2; const char* cB = (const char*)g.Bt + (size_t)cur.pn * tstep + (size_t)cur.koff * 2;
    S.a_ready(cur);
    PG8_STAGE(PG8_SB(0, 0), cB, voffB); PG8_STAGE(PG8_SB(0, 1), cB + hstep, voffB); PG8_STAGE(PG8_SA(0, 0), cA, voffA); PG8_STAGE(PG8_SA(0, 1), cA + hstep, voffA);
    if (wr == 1) PG8_BAR;
    PG8_WAIT_V(2); PG8_BAR;
    PG8_STAGE(PG8_SB(1, 0), cB + kstep, voffB); PG8_STAGE(PG8_SA(1, 0), cA + kstep, voffA); PG8_STAGE(PG8_SB(1, 1), cB + hstep + kstep, voffB);
    PG8_WAIT_V(6); PG8_BAR;
    PG8_STAMP();
    for (;;) {
        const bool has_next = S.next(ui + 1, nxt);
        const char* nA = has_next ? (const char*)g.A + (size_t)nxt.pm * tstep + (size_t)nxt.koff * 2 : cA; const char* nB = has_next ? (const char*)g.Bt + (size_t)nxt.pn * tstep + (size_t)nxt.koff * 2 : cB;
        for (int t = 0; t < nt; t += 2) {
            const bool last = (t == nt - 2);
            const char* a1 = cA + (size_t)(t + 1) * kstep;
            const char* a2 = last ? nA : cA + (size_t)(t + 2) * kstep; const char* b2 = last ? nB : cB + (size_t)(t + 2) * kstep;
            const char* a3 = a2 + kstep; const char* b3 = b2 + kstep;
            if (last && has_next) S.a_ready(nxt);
            PG8_LDB(B0, 0, 0); PG8_LDB(B1, 0, 1); PG8_SCHED; PG8_LDA(At, 0, 0); PG8_STAGE(PG8_SA(1, 1), a1 + hstep, voffA);
            PG8_WAIT_V(8); PG8_WAIT_L(0); PG8_BAR; PG8_MMA(0, 0, At, B0); PG8_MMA(0, 1, At, B1); PG8_BAR; PG8_SCHED;
            PG8_LDA(At, 0, 1); PG8_STAGE(PG8_SB(0, 0), b2, voffB); PG8_STAGE(PG8_SB(0, 1), b2 + hstep, voffB); PG8_STAGE(PG8_SA(0, 0), a2, voffA);
            PG8_WAIT_V(8); PG8_WAIT_L(0); PG8_BAR; PG8_MMA(1, 0, At, B0); PG8_MMA(1, 1, At, B1); PG8_BAR; PG8_SCHED;
            PG8_LDB(B0, 1, 0); PG8_LDB(B1, 1, 1); PG8_SCHED; PG8_LDA(At, 1, 0); PG8_STAGE(PG8_SA(0, 1), a2 + hstep, voffA);
            PG8_WAIT_V(8); PG8_WAIT_L(0); PG8_BAR; PG8_MMA(0, 0, At, B0); PG8_MMA(0, 1, At, B1); PG8_BAR; PG8_SCHED;
            PG8_LDA(At, 1, 1); PG8_STAGE(PG8_SB(1, 0), b3, voffB); PG8_STAGE(PG8_SB(1, 1), b3 + hstep, voffB); PG8_STAGE(PG8_SA(1, 0), a3, voffA);
            PG8_WAIT_V(8); PG8_WAIT_L(0); PG8_BAR; PG8_MMA(1, 0, At, B0); PG8_MMA(1, 1, At, B1); PG8_BAR; PG8_SCHED;
        }
        PG8_STAMP();
        if (wr == 0) PG8_BAR;
        if constexpr (!Epi::AFTER_DRAIN) { E(acc, cur, wr, wc, fr, fq); S.done(cur); }
        PG8_STAMP();
        if (!has_next) break;
#pragma unroll
        for (int a = 0; a < 2; ++a)
#pragma unroll
            for (int b = 0; b < 2; ++b)
#pragma unroll
                for (int m = 0; m < 4; ++m)
#pragma unroll
                    for (int n = 0; n < 2; ++n) acc[a][b][m][n] = (f32x4){0.f, 0.f, 0.f, 0.f};
        cur = nxt; cA = nA; cB = nB; ++ui;
        if (wr == 1) PG8_BAR;
    }
    PG8_WAIT_V(0);
    PG8_BAR;
    if constexpr (Epi::AFTER_DRAIN) { E.fused(acc, cur, wr, wc, fr, fq, lds, wid, lane); S.done(cur); }
    PG8_STAMP();
    if (STAMP && wid == 0) { stamps[lane] = lane < nts ? (((unsigned long long)(unsigned)ts_hi << 32) | (unsigned)ts_lo) : 0ull;
        if (lane == 62) stamps[62] = rt_entry; if (lane == 63) stamps[63] = (unsigned long long)wall_clock64(); }
#undef PG8_STAMP
#undef PG8_SA
#undef PG8_SB
#undef PG8_STAGE
#undef PG8_LDA
#undef PG8_LDB
#undef PG8_MMA
#undef PG8_WAIT_V
#undef PG8_WAIT_L
#undef PG8_BAR
#undef PG8_SCHED
}
}
#define LAS __attribute__((address_space(3)))
#define XB_TMO      128
#define XB_XCNT(j)  (256  + 64 * (j))
#define XB_XSUB(j)  (1280 + 64 * (j))
#define XB_XGEN(j)  (2304 + 64 * (j))
#define XB_TOP      3328
#define XB_TOPGEN   3392
#define XCD_BAR_WORDS 3456
#define XB_SPIN_CAP (1u << 18)

__device__ __forceinline__ unsigned xb_ld(unsigned* p)              { return __hip_atomic_load(p, __ATOMIC_RELAXED, __HIP_MEMORY_SCOPE_AGENT); }
__device__ __forceinline__ unsigned xb_add(unsigned* p, unsigned v) { return __hip_atomic_fetch_add(p, v, __ATOMIC_RELAXED, __HIP_MEMORY_SCOPE_AGENT); }
__device__ __forceinline__ unsigned xb_xcc_id() { return (unsigned)__builtin_amdgcn_s_getreg((3 << 11) | 20) & 0xFu; }
#define XB_SPIN(cond, bar) do { unsigned _sp = 0; while (cond) { __builtin_amdgcn_s_sleep(1); \
    if ((++_sp & 255u) == 0u) { if (xb_ld(&(bar)[XB_TMO])) break; if (_sp > XB_SPIN_CAP) { atomicAdd(&(bar)[XB_TMO], 1u); break; } } } } while (0)

struct XcdBarrier {
    unsigned* bar; unsigned x;
    volatile LAS unsigned* st;
};

__device__ __forceinline__ XcdBarrier xcd_barrier_post(unsigned* bar, volatile LAS unsigned* st) {
    XcdBarrier b; b.bar = bar; b.x = xb_xcc_id(); b.st = st;
    if (threadIdx.x == 0) (void)xb_add(&bar[XB_XCNT(b.x)], 1u);
    return b;
}
__device__ __forceinline__ void xcd_barrier_complete(unsigned* bar, unsigned x, unsigned& nloc, unsigned& nx) {
    const unsigned G = gridDim.x * gridDim.y * gridDim.z;
    unsigned sum, cnt, mine, sp = 0u;
    for (;;) {
        sum = 0u; cnt = 0u; mine = 0u;
#pragma unroll
        for (unsigned j = 0; j < 16; ++j) { const unsigned c = xb_ld(&bar[XB_XCNT(j)]); sum += c; cnt += (c > 0u) ? 1u : 0u; mine = (j == x) ? c : mine; }
        if (sum == G) break;
        __builtin_amdgcn_s_sleep(1);
        if ((++sp & 255u) == 0u) { if (xb_ld(&bar[XB_TMO])) break; if (sp > XB_SPIN_CAP) { atomicAdd(&bar[XB_TMO], 1u); break; } }
    }
    nloc = mine > 0u ? mine : 1u; nx = cnt > 0u ? cnt : 1u;
}

__device__ __forceinline__ void xcd_barrier(const XcdBarrier& b) {
    asm volatile("s_waitcnt vmcnt(0)" ::: "memory");
    __syncthreads();
    if (threadIdx.x == 0) {
        unsigned* bar = b.bar;
        __builtin_amdgcn_s_waitcnt(0);
        unsigned nloc = b.st[0], nx = b.st[1];
        if (nloc == 0u) { xcd_barrier_complete(bar, b.x, nloc, nx); b.st[0] = nloc; b.st[1] = nx; }
        const unsigned old = xb_add(&bar[XB_XSUB(b.x)], 1u);
        const unsigned gen = old / nloc;
        if (old + 1u == (gen + 1u) * nloc) {
            __builtin_amdgcn_fence(__ATOMIC_RELEASE, "agent");
            asm volatile("s_waitcnt vmcnt(0)" ::: "memory");
            const unsigned og = xb_add(&bar[XB_TOP], 1u);
            const unsigned tg = og / nx;
            if (og + 1u == (tg + 1u) * nx) xb_add(&bar[XB_TOPGEN], 1u);
            else XB_SPIN(xb_ld(&bar[XB_TOPGEN]) == tg, bar);
            __builtin_amdgcn_fence(__ATOMIC_ACQUIRE, "agent");
            xb_add(&bar[XB_XGEN(b.x)], 1u);
            asm volatile("s_waitcnt vmcnt(0)" ::: "memory");
        } else {
            XB_SPIN(xb_ld(&bar[XB_XGEN(b.x)]) == gen, bar);
            __builtin_amdgcn_fence(__ATOMIC_ACQUIRE, "agent");
            asm volatile("s_waitcnt vmcnt(0)" ::: "memory");
        }
    }
    __syncthreads();
}


using pg8::bf16_t; using pg8::bf16x8; using pg8::f32x4; using pg8::u32x4; using pg8::Unit;
typedef float f32x16 __attribute__((ext_vector_type(16)));
typedef unsigned u32x2 __attribute__((ext_vector_type(2)));
typedef float f32x2 __attribute__((ext_vector_type(2)));

constexpr int MP = 8192, MS = 1024, MT = 9216, DM = 2048, NZ = 5120, NINP = 5376, DFF = 5632, PLE = 256;
constexpr int LDS_BYTES = 131072 + 16;
constexpr size_t OFF_BAR = 0;
constexpr size_t OFF_WIN = 16384;
constexpr size_t OFF_WOUT = OFF_WIN + (size_t)NINP * DM * 2;
constexpr size_t OFF_WFI = OFF_WOUT + (size_t)DM * DM * 2;
constexpr size_t OFF_WFO = OFF_WFI + (size_t)2 * DFF * DM * 2;
constexpr size_t OFF_WPLE = OFF_WFO + (size_t)DM * DFF * 2;
constexpr size_t OFF_WGT = OFF_WPLE + (size_t)DM * PLE * 2;
constexpr size_t OFF_A0 = OFF_WGT + (size_t)DM * DM * 2;
constexpr size_t OFF_PB = OFF_A0 + (size_t)MT * DM * 2;
constexpr size_t OFF_ALOW = OFF_PB + (size_t)MT * PLE * 2;
constexpr size_t OFF_STAT = OFF_ALOW + (size_t)MT * 16 * 4;
constexpr size_t OFF_BIG = OFF_STAT + (size_t)MT * 2 * 4;
constexpr size_t OFF_Z = OFF_BIG;
constexpr size_t OFF_ORAW = OFF_Z + (size_t)MT * NZ * 2;
constexpr size_t OFF_MRAW = OFF_ORAW + (size_t)MT * 1024 * 4;
constexpr size_t OFF_IMG = OFF_BIG + (size_t)MT * DFF * 2 + (size_t)MT * DM * 4;
constexpr size_t WS_END = OFF_IMG + (size_t)4 * 1024 * 2048 * 4;
constexpr size_t OFF_ACT = OFF_BIG;
constexpr size_t OFF_GATEZ = OFF_BIG;
constexpr size_t OFF_PZ = OFF_BIG + (size_t)MT * DFF * 2;
constexpr size_t OUT_Y = 0, OUT_SP = (size_t)MT * DM, OUT_SS = OUT_SP + (size_t)4 * 4 * 128 * 256, OUT_VS = OUT_SS + (size_t)128 * 4 * 128 * 256;

struct Params {
    const float *x_prompt, *x_sample, *state_gla, *p_prompt, *p_sample, *g_mix, *w_in, *w_a2, *b_a, *g_gla_norm, *g_gmlp_ln, *b_gmlp_ln, *w_s, *b_s,
        *g_gmlp_out, *w_out, *g_ffn, *w_ffn_in, *w_ffn_out, *w_ple, *g_ple, *g_ple_gate, *w_ple_gate, *g_final;
    float* out;
    unsigned char* ws;
};

__device__ __forceinline__ unsigned pk2(float lo, float hi) { return pg8::cvt_pk_bf16(lo, hi); }
__device__ __forceinline__ bf16_t f2bf(float f) { return (bf16_t)(pk2(f, 0.f) & 0xffffu); }
__device__ __forceinline__ float bf2f(bf16_t b) { return __uint_as_float(((unsigned)b) << 16); }
__device__ __forceinline__ float bflo(unsigned w) { return __uint_as_float(w << 16); }
__device__ __forceinline__ float bfhi(unsigned w) { return __uint_as_float(w & 0xffff0000u); }
__device__ __forceinline__ f32x4 unpack4(u32x2 w) { return (f32x4){bflo(w.x), bfhi(w.x), bflo(w.y), bfhi(w.y)}; }
template <int CTRL> __device__ __forceinline__ float dpp_f(float v) { return __int_as_float(__builtin_amdgcn_update_dpp(0, __float_as_int(v), CTRL, 0xf, 0xf, true)); }
__device__ __forceinline__ float row16_sum(float v) {
    v += dpp_f<0xB1>(v); v += dpp_f<0x4E>(v); v += dpp_f<0x141>(v); v += dpp_f<0x140>(v); return v;
}
__device__ __forceinline__ float wave_sum(float v) {
    v = row16_sum(v);
    return (__int_as_float(__builtin_amdgcn_readlane(__float_as_int(v), 0)) + __int_as_float(__builtin_amdgcn_readlane(__float_as_int(v), 16))) + (__int_as_float(__builtin_amdgcn_readlane(__float_as_int(v), 32)) + __int_as_float(__builtin_amdgcn_readlane(__float_as_int(v), 48)));
}
__device__ __forceinline__ float sigmoid_f(float x) { return __builtin_amdgcn_rcpf(1.f + __expf(-x)); }
__device__ __forceinline__ float silu_f(float x) { return x * __builtin_amdgcn_rcpf(1.f + __expf(-x)); }
__device__ __forceinline__ float gelu_f(float x) { const float u = 1.5957691216f * (x + 0.044715f * x * x * x); return x * __builtin_amdgcn_rcpf(1.f + __expf(-u)); }
__device__ __forceinline__ float logsigmoid_f(float x) { return fminf(x, 0.f) - __logf(1.f + __expf(-fabsf(x))); }
template <class T> __device__ __forceinline__ T* opaque(T* p) { return p; }
__device__ __forceinline__ const f32x4* row_mid(const float* row, int lane) { return opaque((const f32x4*)row + lane + 256); }
__device__ __forceinline__ f32x4* row_mid(float* row, int lane) { return opaque((f32x4*)row + lane + 256); }
__device__ __forceinline__ int otid() { int t = threadIdx.x; asm volatile("" : "+v"(t)); return t; }
template <class T> __device__ __forceinline__ T ldnt(const T* p) { return __builtin_nontemporal_load(p); }
template <class T> __device__ __forceinline__ void stnt(T* p, T v) { __builtin_nontemporal_store(v, p); }
__device__ __forceinline__ void lds_wait() { asm volatile("s_waitcnt lgkmcnt(0)" ::: "memory"); }

struct EpiIn {
    static constexpr bool PERM = true, AFTER_DRAIN = false;
    bf16_t* Z; float* alow;
    __device__ __forceinline__ void operator()(const f32x4 (&acc)[2][2][4][2], const Unit& u, int wr, int wc, int fr, int fq) const {
        const int row0 = u.pm * 256 + wr * 64 + fr, pn = u.pn;
        if (pn == 20) {
            if (wc == 0 && fq < 2) {
#pragma unroll
                for (int ai = 0; ai < 2; ++ai)
#pragma unroll
                    for (int m = 0; m < 4; ++m) { float* p = alow + (size_t)(row0 + ai * 128 + m * 16) * 16 + 8 * fq; *(f32x4*)p = acc[ai][0][m][0]; *(f32x4*)(p + 4) = acc[ai][0][m][1]; }
            }
            return;
        }
        const int kind = pn < 8 ? 0 : (pn < 12 ? 1 : 2); const float qs = pn < 2 ? 0.08838834764831845f : 1.f;
#pragma unroll
        for (int ai = 0; ai < 2; ++ai)
#pragma unroll
            for (int m = 0; m < 4; ++m) { bf16_t* rowp = Z + (size_t)(row0 + ai * 128 + m * 16) * NZ + pn * 256 + wc * 32 + 8 * fq;
#pragma unroll
                for (int bj = 0; bj < 2; ++bj) { f32x4 v0 = acc[ai][bj][m][0], v1 = acc[ai][bj][m][1];
                    if (kind == 0) { v0 *= qs; v1 *= qs; }
                    else if (kind == 1) {
#pragma unroll
                        for (int j = 0; j < 4; ++j) { v0[j] = silu_f(v0[j]); v1[j] = silu_f(v1[j]); } }
                    else {
#pragma unroll
                        for (int j = 0; j < 4; ++j) { v0[j] = gelu_f(v0[j]); v1[j] = gelu_f(v1[j]); } }
                    u32x4 w; w.x = pk2(v0[0], v0[1]); w.y = pk2(v0[2], v0[3]); w.z = pk2(v1[0], v1[1]); w.w = pk2(v1[2], v1[3]);
                    *(u32x4*)(rowp + bj * 128) = w; } }
    }
};
struct EpiRes {
    static constexpr bool PERM = false, AFTER_DRAIN = false;
    const float* res_p; const float* res_s; float* out;
    __device__ __forceinline__ void operator()(const f32x4 (&acc)[2][2][4][2], const Unit& u, int wr, int wc, int fr, int fq) const {
        const int row0 = u.pm * 256 + wr * 64 + fr, col0 = u.pn * 256 + wc * 32 + 4 * fq;
#pragma unroll
        for (int ai = 0; ai < 2; ++ai)
#pragma unroll
            for (int m = 0; m < 4; ++m) { const int row = row0 + ai * 128 + m * 16;
                const float* rp = (row < MP ? res_p + (size_t)row * DM : res_s + (size_t)(row - MP) * DM) + col0; float* op = out + (size_t)row * DM + col0;
#pragma unroll
                for (int bj = 0; bj < 2; ++bj)
#pragma unroll
                    for (int n = 0; n < 2; ++n) { const f32x4 r = *(const f32x4*)(rp + bj * 128 + n * 16); *(f32x4*)(op + bj * 128 + n * 16) = acc[ai][bj][m][n] + r; } }
    }
};
struct EpiSwiglu {
    static constexpr bool PERM = true, AFTER_DRAIN = false;
    bf16_t* act;
    __device__ __forceinline__ void operator()(const f32x4 (&acc)[2][2][4][2], const Unit& u, int wr, int wc, int fr, int fq) const {
        const int row0 = u.pm * 256 + wr * 64 + fr, col0 = u.pn * 128 + wc * 32 + 8 * fq;
#pragma unroll
        for (int ai = 0; ai < 2; ++ai)
#pragma unroll
            for (int m = 0; m < 4; ++m) { float a[8];
#pragma unroll
                for (int n = 0; n < 2; ++n)
#pragma unroll
                    for (int j = 0; j < 4; ++j) a[n * 4 + j] = silu_f(acc[ai][0][m][n][j]) * acc[ai][1][m][n][j];
                u32x4 w; w.x = pk2(a[0], a[1]); w.y = pk2(a[2], a[3]); w.z = pk2(a[4], a[5]); w.w = pk2(a[6], a[7]);
                *(u32x4*)(act + (size_t)(row0 + ai * 128 + m * 16) * DFF + col0) = w; }
    }
};
struct EpiBfN {
    static constexpr bool PERM = false, AFTER_DRAIN = false;
    bf16_t* out;
    __device__ __forceinline__ void operator()(const f32x4 (&acc)[2][2][4][2], const Unit& u, int wr, int wc, int fr, int fq) const {
        const int row0 = u.pm * 256 + wr * 64 + fr, col0 = u.pn * 256 + wc * 32 + 4 * fq;
#pragma unroll
        for (int ai = 0; ai < 2; ++ai)
#pragma unroll
            for (int m = 0; m < 4; ++m) { bf16_t* op = out + (size_t)(row0 + ai * 128 + m * 16) * DM + col0;
#pragma unroll
                for (int bj = 0; bj < 2; ++bj)
#pragma unroll
                    for (int n = 0; n < 2; ++n) { const f32x4 v = acc[ai][bj][m][n]; u32x2 w; w.x = pk2(v[0], v[1]); w.y = pk2(v[2], v[3]); *(u32x2*)(op + bj * 128 + n * 16) = w; } }
    }
};
struct EpiPlain {
    static constexpr bool PERM = false, AFTER_DRAIN = false;
    float* out;
    __device__ __forceinline__ void operator()(const f32x4 (&acc)[2][2][4][2], const Unit& u, int wr, int wc, int fr, int fq) const {
        const int row0 = u.pm * 256 + wr * 64 + fr, col0 = u.pn * 256 + wc * 32 + 4 * fq;
#pragma unroll
        for (int ai = 0; ai < 2; ++ai)
#pragma unroll
            for (int m = 0; m < 4; ++m) { float* op = out + (size_t)(row0 + ai * 128 + m * 16) * DM + col0;
#pragma unroll
                for (int bj = 0; bj < 2; ++bj)
#pragma unroll
                    for (int n = 0; n < 2; ++n) *(f32x4*)(op + bj * 128 + n * 16) = acc[ai][bj][m][n]; }
    }
};

template <class Epi> __device__ __forceinline__ void run_gemm(LAS unsigned char* lds, const bf16_t* A, const bf16_t* Bt, int M, int N, int K, const Epi& E) {
    pg8::Gemm g; g.A = A; g.Bt = Bt; g.M = M; g.N = N; g.K = K; g.Klen = K;
    pg8::StaticOrder S; S.init(M, N, (int)gridDim.x, (int)blockIdx.x);
    pg8::gemm_phase<Epi, pg8::StaticOrder, false>(lds, g, S, E, nullptr);
}
struct SplitOrderK {
    int nN, G, c, klen, ns, kbase, ksoff;
    __device__ __forceinline__ bool next(int i, Unit& u) const { const int L = i * G + c; if (L >= 4 * ns * nN) return false;
        const int sp = L % ns, tile = L / ns; u.ks = ksoff + sp; u.pn = tile % nN; u.pm = 32 + tile / nN; u.koff = kbase + sp * klen; return true; }
    __device__ __forceinline__ void a_ready(const Unit&) const {}
    __device__ __forceinline__ void done(const Unit&) const {}
};
struct EpiPart {
    static constexpr bool PERM = false, AFTER_DRAIN = false;
    bf16_t* part;
    __device__ __forceinline__ void operator()(const f32x4 (&acc)[2][2][4][2], const Unit& u, int wr, int wc, int fr, int fq) const {
        const int row0 = (u.pm - 32) * 256 + wr * 64 + fr, col0 = u.pn * 256 + wc * 32 + 4 * fq; bf16_t* pb = part + (size_t)u.ks * MS * DM;
#pragma unroll
        for (int ai = 0; ai < 2; ++ai)
#pragma unroll
            for (int m = 0; m < 4; ++m) { bf16_t* op = pb + (size_t)(row0 + ai * 128 + m * 16) * DM + col0;
#pragma unroll
                for (int bj = 0; bj < 2; ++bj)
#pragma unroll
                    for (int n = 0; n < 2; ++n) { const f32x4 v = acc[ai][bj][m][n]; u32x2 w; w.x = pk2(v[0], v[1]); w.y = pk2(v[2], v[3]); *(u32x2*)(op + bj * 128 + n * 16) = w; } }
    }
};
__device__ __forceinline__ void run_split(LAS unsigned char* lds, const bf16_t* A, const bf16_t* Bt, int K, bf16_t* part, int ns, int klen, int kbase, int ksoff, int c) {
    pg8::Gemm g; g.A = A; g.Bt = Bt; g.M = MT; g.N = DM; g.K = K; g.Klen = klen;
    SplitOrderK S; S.nN = DM / 256; S.G = (int)gridDim.x; S.c = c; S.klen = klen; S.ns = ns; S.kbase = kbase; S.ksoff = ksoff;
    EpiPart P; P.part = part;
    pg8::gemm_phase<EpiPart, SplitOrderK, false>(lds, g, S, P, nullptr);
}
template <class Epi> __device__ __forceinline__ void run_gemm_n2048(LAS unsigned char* lds, const bf16_t* A, const bf16_t* Bt, int K, const Epi& E, bf16_t* part) {
    run_gemm(lds, A, Bt, MP, DM, K, E);
    run_split(lds, A, Bt, K, part, 8, K / 8, 0, 0, (int)blockIdx.x);
}

__device__ __forceinline__ void transpose_item(const float* W, int N, bf16_t* WT, int K, int k0, int n0_dst, int n0_src, int nvalid, LAS float* scr, int lane) {
    const int j = lane & 31;
#pragma unroll 8
    for (int i = 0; i < 32; ++i) { const int kk = 2 * i + (lane >> 5); scr[kk * 33 + j] = (j < nvalid) ? ldnt(W + (size_t)(k0 + kk) * N + n0_src + j) : 0.f; }
    lds_wait();
    const int c = lane & 7;
#pragma unroll
    for (int q = 0; q < 4; ++q) { const int n = (lane >> 3) + 8 * q; const LAS float* s = scr + (8 * c) * 33 + n;
        u32x4 o; o.x = pk2(s[0 * 33], s[1 * 33]); o.y = pk2(s[2 * 33], s[3 * 33]); o.z = pk2(s[4 * 33], s[5 * 33]); o.w = pk2(s[6 * 33], s[7 * 33]);
        *(u32x4*)(WT + (size_t)(n0_dst + n) * K + k0 + 8 * c) = o; }
    lds_wait();
}
struct Row8 { f32x4 v[8]; };
__device__ __forceinline__ void row_load_nt(Row8& a, const float* src, int lane) { const f32x4* sm = row_mid(src, lane);
#pragma unroll
    for (int j = 0; j < 8; ++j) a.v[j] = ldnt(sm + 64 * (j - 4)); }
__device__ __forceinline__ void row_load(Row8& a, const float* src, int lane) { const f32x4* sm = row_mid(src, lane);
#pragma unroll
    for (int j = 0; j < 8; ++j) a.v[j] = sm[64 * (j - 4)]; }
__device__ __forceinline__ void rms_finish_bf16(const Row8& a, const float* gain, bf16_t* dst, int lane) {
    float s = 0.f;
#pragma unroll
    for (int j = 0; j < 8; ++j) s += (a.v[j][0] * a.v[j][0] + a.v[j][1] * a.v[j][1]) + (a.v[j][2] * a.v[j][2] + a.v[j][3] * a.v[j][3]);
    const float rinv = rsqrtf(wave_sum(s) * (1.f / DM) + 1e-6f);
    const f32x4* gm = row_mid(gain, lane); u32x2* dm = (u32x2*)dst + lane;
#pragma unroll
    for (int j = 0; j < 8; ++j) { const f32x4 g = gm[64 * (j - 4)]; u32x2 o; o.x = pk2(a.v[j][0] * rinv * g[0], a.v[j][1] * rinv * g[1]); o.y = pk2(a.v[j][2] * rinv * g[2], a.v[j][3] * rinv * g[3]);
        dm[64 * j] = o; }
}
__device__ __forceinline__ void rms_row_bf16(const float* src, const float* gain, bf16_t* dst, int lane) { Row8 a; row_load(a, src, lane); rms_finish_bf16(a, gain, dst, lane); }
namespace cv { constexpr int I_IN = (DM / 64) * (NINP / 32), I_OUT = (DM / 64) * (DM / 32), I_FI = (DM / 64) * (2 * DFF / 32), I_FO = (DFF / 64) * (DM / 32), I_PLE = (PLE / 64) * (DM / 32), I_GT = I_OUT;
    constexpr int E_IN = I_IN, E_OUT = E_IN + I_OUT, E_FI = E_OUT + I_FI, E_FO = E_FI + I_FO, E_PLE = E_FO + I_PLE, E_GT = E_PLE + I_GT; }
__device__ __forceinline__ void convert_range(const Params& p, LAS unsigned char* lds, int lo, int hi, int gw, int NGW) {
    const int tid = otid(), lane = tid & 63, wave = tid >> 6;
    LAS float* scr = (LAS float*)(lds + wave * 8448);
    bf16_t* win = (bf16_t*)(p.ws + OFF_WIN); bf16_t* wout = (bf16_t*)(p.ws + OFF_WOUT); bf16_t* wfi = (bf16_t*)(p.ws + OFF_WFI);
    bf16_t* wfo = (bf16_t*)(p.ws + OFF_WFO); bf16_t* wple = (bf16_t*)(p.ws + OFF_WPLE); bf16_t* wgt = (bf16_t*)(p.ws + OFF_WGT);
    for (int it = lo + gw; it < hi; it += NGW) {
        int r = it;
        if (r < cv::E_IN) { const int nblk = NINP / 32, kb = r / nblk, nb = r % nblk, n0d = nb * 32; int src, nv;
            if (n0d < 3072) { src = n0d; nv = 32; } else if (n0d < 5120) { src = n0d + 16; nv = 32; } else if (n0d == 5120) { src = 3072; nv = 16; } else { src = 0; nv = 0; }
            transpose_item(p.w_in, 5136, win, DM, kb * 64, n0d, src, nv, scr, lane); continue; }
        if (r < cv::E_OUT) { r -= cv::E_IN; const int nblk = DM / 32, kb = r / nblk, nb = r % nblk; transpose_item(p.w_out, DM, wout, DM, kb * 64, nb * 32, nb * 32, 32, scr, lane); continue; }
        if (r < cv::E_FI) { r -= cv::E_OUT; const int nblk = 2 * DFF / 32, kb = r / nblk, nb = r % nblk, n0d = nb * 32, jb = n0d >> 8, within = n0d & 255, up = within >> 7, j0 = jb * 128 + (within & 127);
            transpose_item(p.w_ffn_in, 2 * DFF, wfi, DM, kb * 64, n0d, up * DFF + j0, 32, scr, lane); continue; }
        if (r < cv::E_FO) { r -= cv::E_FI; const int nblk = DM / 32, kb = r / nblk, nb = r % nblk; transpose_item(p.w_ffn_out, DM, wfo, DFF, kb * 64, nb * 32, nb * 32, 32, scr, lane); continue; }
        if (r < cv::E_PLE) { r -= cv::E_FO; const int nblk = DM / 32, kb = r / nblk, nb = r % nblk; transpose_item(p.w_ple, DM, wple, PLE, kb * 64, nb * 32, nb * 32, 32, scr, lane); continue; }
        { r -= cv::E_PLE; const int nblk = DM / 32, kb = r / nblk, nb = r % nblk; transpose_item(p.w_ple_gate, DM, wgt, DM, kb * 64, nb * 32, nb * 32, 32, scr, lane); }
    }
}
__device__ __forceinline__ void phase0(const Params& p, LAS unsigned char* lds) {
    const int tid = otid(), lane = tid & 63, wave = tid >> 6;
    const int gw = blockIdx.x * 8 + wave, NGW = gridDim.x * 8;
    convert_range(p, lds, 0, cv::E_IN, gw, NGW);
    bf16_t* a0 = (bf16_t*)(p.ws + OFF_A0); bf16_t* pb = (bf16_t*)(p.ws + OFF_PB);
    for (int r = gw; r < MT; r += 2 * NGW) {
        const int r2 = r + NGW; const bool has2 = r2 < MT; const int q2 = has2 ? r2 : r;
        const float* x1 = r < MP ? p.x_prompt + (size_t)r * DM : p.x_sample + (size_t)(r - MP) * DM; const float* x2 = q2 < MP ? p.x_prompt + (size_t)q2 * DM : p.x_sample + (size_t)(q2 - MP) * DM;
        const float* p1 = r < MP ? p.p_prompt + (size_t)r * PLE : p.p_sample + (size_t)(r - MP) * PLE; const float* p2 = q2 < MP ? p.p_prompt + (size_t)q2 * PLE : p.p_sample + (size_t)(q2 - MP) * PLE;
        Row8 a, b; row_load_nt(a, x1, lane); row_load_nt(b, x2, lane);
        const f32x4 pv1 = ldnt((const f32x4*)p1 + lane), pv2 = ldnt((const f32x4*)p2 + lane);
        rms_finish_bf16(a, p.g_mix, a0 + (size_t)r * DM, lane);
        { u32x2 o; o.x = pk2(pv1[0], pv1[1]); o.y = pk2(pv1[2], pv1[3]); ((u32x2*)(pb + (size_t)r * PLE))[lane] = o; }
        if (has2) { rms_finish_bf16(b, p.g_mix, a0 + (size_t)r2 * DM, lane);
            u32x2 o; o.x = pk2(pv2[0], pv2[1]); o.y = pk2(pv2[2], pv2[3]); ((u32x2*)(pb + (size_t)r2 * PLE))[lane] = o; }
    }
}

__device__ __forceinline__ f32x16 mfma32(bf16x8 a, bf16x8 b, f32x16 c) { return __builtin_amdgcn_mfma_f32_32x32x16_bf16(a, b, c, 0, 0, 0); }
__device__ __forceinline__ void mma32(f32x16& acc, const LAS bf16_t* A, int lda, const LAS bf16_t* B, int ldb, int kk, int lane) {
    const int r = lane & 31, h = lane >> 5; const LAS bf16_t* ap = A + r * lda + 8 * h; const LAS bf16_t* bp = B + r * ldb + 8 * h;
    for (int k = 0; k < kk; k += 16) { const bf16x8 a = *(const LAS bf16x8*)(ap + k); const bf16x8 b = *(const LAS bf16x8*)(bp + k); acc = mfma32(a, b, acc); }
}
constexpr int LQ = 136, LS = 72;
constexpr int R_QE = 0, R_KLT = 17408, R_ATT = 35840, R_DEC = 45056, IMG_BYTES = 45568, R_VT = 45568, R_QM = 82432, R_KM = 99840, R_ALOW = 117248, R_GSUM = 121344, R_BMID = 123392;
constexpr int IMG_V4 = IMG_BYTES / 16;

__device__ __forceinline__ void gla_prep(const Params& p, LAS unsigned char* lds, int rb, int h, int T) {
    const int tid = otid(), lane = tid & 63, wave = tid >> 6;
    const bf16_t* Z = (const bf16_t*)(p.ws + OFF_Z); const float* alowg = (const float*)(p.ws + OFF_ALOW);
    LAS bf16_t* Qe = (LAS bf16_t*)(lds + R_QE); LAS bf16_t* Qm = (LAS bf16_t*)(lds + R_QM); LAS bf16_t* Km = (LAS bf16_t*)(lds + R_KM);
    LAS bf16_t* KlT = (LAS bf16_t*)(lds + R_KLT); LAS bf16_t* ATT = (LAS bf16_t*)(lds + R_ATT); LAS float* DEC = (LAS float*)(lds + R_DEC);
    LAS float* alowL = (LAS float*)(lds + R_ALOW); LAS float* gsum = (LAS float*)(lds + R_GSUM); LAS float* bmidL = (LAS float*)(lds + R_BMID);
    const int c = tid & 127, tg = tid >> 7;
    float wa[16];
#pragma unroll
    for (int j = 0; j < 16; ++j) wa[j] = p.w_a2[j * 512 + h * 128 + c];
    const float ba = p.b_a[h * 128 + c];
    for (int idx = tid; idx < 1024; idx += 512) { const int t = idx >> 4; alowL[idx] = (t < T) ? alowg[(size_t)(rb + t) * 16 + (idx & 15)] : 0.f; }
    float qv[16], kv[16];
#pragma unroll
    for (int i = 0; i < 16; ++i) { const int t = tg * 16 + i; const bool ok = t < T; const bf16_t* zr = Z + (size_t)(rb + t) * NZ + h * 128 + c;
        qv[i] = ok ? bf2f(zr[0]) : 0.f; kv[i] = ok ? bf2f(zr[512]) : 0.f; }
    __syncthreads();
    float b[16]; float run = 0.f;
#pragma unroll
    for (int i = 0; i < 16; ++i) { const int t = tg * 16 + i; float pre = ba;
#pragma unroll
        for (int j4 = 0; j4 < 4; ++j4) { const f32x4 a4 = *(const LAS f32x4*)(alowL + t * 16 + j4 * 4); pre += a4[0] * wa[j4 * 4] + a4[1] * wa[j4 * 4 + 1] + a4[2] * wa[j4 * 4 + 2] + a4[3] * wa[j4 * 4 + 3]; }
        const float la = (t < T) ? logsigmoid_f(pre) * 0.0625f : 0.f; run += la; b[i] = run; }
    gsum[tg * 128 + c] = run;
    __syncthreads();
    const float g0 = gsum[c], g1 = gsum[128 + c], g2 = gsum[256 + c], g3 = gsum[384 + c];
    const float pref = tg == 0 ? 0.f : (tg == 1 ? g0 : (tg == 2 ? g0 + g1 : g0 + g1 + g2));
    const float blast = ((g0 + g1) + g2) + g3;
#pragma unroll
    for (int i = 0; i < 16; ++i) b[i] += pref;
    if (tg == 2) bmidL[c] = b[0];
    if (tg == 0) DEC[c] = __expf(blast);
    __syncthreads();
    const float bm = bmidL[c];
    {
        unsigned klp[8];
#pragma unroll
        for (int i = 0; i < 16; i += 2) {
            const int t = tg * 16 + i;
            Qe[t * LQ + c] = f2bf(qv[i] * __expf(b[i])); Qe[(t + 1) * LQ + c] = f2bf(qv[i + 1] * __expf(b[i + 1]));
            Qm[t * LQ + c] = f2bf(qv[i] * __expf(b[i] - bm)); Qm[(t + 1) * LQ + c] = f2bf(qv[i + 1] * __expf(b[i + 1] - bm));
            Km[t * LQ + c] = f2bf(kv[i] * __expf(bm - b[i])); Km[(t + 1) * LQ + c] = f2bf(kv[i + 1] * __expf(bm - b[i + 1]));
            klp[i >> 1] = pk2(kv[i] * __expf(blast - b[i]), kv[i + 1] * __expf(blast - b[i + 1]));
        }
        LAS u32x4* kd = (LAS u32x4*)(KlT + c * LS + tg * 16);
        kd[0] = (u32x4){klp[0], klp[1], klp[2], klp[3]}; kd[1] = (u32x4){klp[4], klp[5], klp[6], klp[7]};
    }
    __syncthreads();
    if (wave < 3) {
        const int si = wave >> 1, ti = wave == 0 ? 0 : 1, l31 = lane & 31, hh = lane >> 5;
        f32x16 o;
#pragma unroll
        for (int i = 0; i < 16; ++i) o[i] = 0.f;
        mma32(o, Km + si * 32 * LQ, LQ, Qm + ti * 32 * LQ, LQ, 128, lane);
        const int tl = ti * 32 + l31;
#pragma unroll
        for (int g = 0; g < 4; ++g) { const int s0 = si * 32 + 8 * g + 4 * hh; float a0 = o[4 * g], a1 = o[4 * g + 1], a2 = o[4 * g + 2], a3 = o[4 * g + 3];
            a0 = (s0 <= tl) ? a0 : 0.f; a1 = (s0 + 1 <= tl) ? a1 : 0.f; a2 = (s0 + 2 <= tl) ? a2 : 0.f; a3 = (s0 + 3 <= tl) ? a3 : 0.f;
            u32x2 w; w.x = pk2(a0, a1); w.y = pk2(a2, a3); *(LAS u32x2*)(ATT + tl * LS + s0) = w; }
    }
    __syncthreads();
}
struct VRegs { u32x4 r[4]; };
__device__ __forceinline__ void v_load(const Params& p, VRegs& v, int rb, int h, int T) {
    const int tid = otid(), s = tid & 63, vg = tid >> 6; const bf16_t* Z = (const bf16_t*)(p.ws + OFF_Z);
#pragma unroll
    for (int k = 0; k < 4; ++k) v.r[k] = (s < T) ? *(const u32x4*)(Z + (size_t)(rb + s) * NZ + 1024 + h * 256 + vg * 32 + 8 * k) : (u32x4){0u, 0u, 0u, 0u};
}
__device__ __forceinline__ void v_store_t(LAS unsigned char* lds, const VRegs& v) {
    const int tid = otid(), s = tid & 63, vg = tid >> 6; LAS bf16_t* VT = (LAS bf16_t*)(lds + R_VT) + (vg * 32) * LS + s;
#pragma unroll
    for (int k = 0; k < 4; ++k) {
        VT[(8 * k + 0) * LS] = (bf16_t)(v.r[k].x & 0xffffu); VT[(8 * k + 1) * LS] = (bf16_t)(v.r[k].x >> 16);
        VT[(8 * k + 2) * LS] = (bf16_t)(v.r[k].y & 0xffffu); VT[(8 * k + 3) * LS] = (bf16_t)(v.r[k].y >> 16);
        VT[(8 * k + 4) * LS] = (bf16_t)(v.r[k].z & 0xffffu); VT[(8 * k + 5) * LS] = (bf16_t)(v.r[k].z >> 16);
        VT[(8 * k + 6) * LS] = (bf16_t)(v.r[k].w & 0xffffu); VT[(8 * k + 7) * LS] = (bf16_t)(v.r[k].w >> 16); }
}
__device__ __forceinline__ void gla_step(const Params& p, LAS unsigned char* lds, f32x16 (&S)[4], int rb, int h, int T, int vb, int vtrow) {
    const int lane = otid() & 63, l31 = lane & 31, hh = lane >> 5;
    LAS bf16_t* Qe = (LAS bf16_t*)(lds + R_QE); LAS bf16_t* KlT = (LAS bf16_t*)(lds + R_KLT); LAS bf16_t* ATT = (LAS bf16_t*)(lds + R_ATT); LAS float* DEC = (LAS float*)(lds + R_DEC);
    LAS bf16_t* VT = (LAS bf16_t*)(lds + R_VT);
    bf16_t* oraw = (bf16_t*)(p.ws + OFF_ORAW);
    f32x16 Za[2], Zb[2];
#pragma unroll
    for (int tt = 0; tt < 2; ++tt)
#pragma unroll
        for (int i = 0; i < 16; ++i) { Za[tt][i] = 0.f; Zb[tt][i] = 0.f; }
    bf16x8 sa[4][2];
#pragma unroll
    for (int cb = 0; cb < 4; ++cb)
#pragma unroll
        for (int s = 0; s < 2; ++s) { u32x4 aw; aw.x = pk2(S[cb][8 * s], S[cb][8 * s + 1]); aw.y = pk2(S[cb][8 * s + 2], S[cb][8 * s + 3]); aw.z = pk2(S[cb][8 * s + 4], S[cb][8 * s + 5]); aw.w = pk2(S[cb][8 * s + 6], S[cb][8 * s + 7]);
            sa[cb][s] = __builtin_bit_cast(bf16x8, aw); }
    bf16x8 vt[4];
    const LAS bf16_t* vp = VT + (vtrow + l31) * LS + 8 * hh;
#pragma unroll
    for (int ks = 0; ks < 4; ++ks) vt[ks] = *(const LAS bf16x8*)(vp + 16 * ks);
#pragma unroll
    for (int cb = 0; cb < 4; ++cb)
#pragma unroll
        for (int g = 0; g < 4; ++g) { const f32x4 d = *(const LAS f32x4*)(DEC + cb * 32 + 8 * g + 4 * hh);
            S[cb][4 * g] *= d[0]; S[cb][4 * g + 1] *= d[1]; S[cb][4 * g + 2] *= d[2]; S[cb][4 * g + 3] *= d[3]; }
#pragma unroll
    for (int ks = 0; ks < 4; ++ks)
#pragma unroll
        for (int cb = 0; cb < 4; ++cb) { const bf16x8 a = *(const LAS bf16x8*)(KlT + (32 * cb + l31) * LS + 16 * ks + 8 * hh); S[cb] = mfma32(a, vt[ks], S[cb]); }
#pragma unroll
    for (int cb = 0; cb < 4; ++cb)
#pragma unroll
        for (int s = 0; s < 2; ++s)
#pragma unroll
            for (int tt = 0; tt < 2; ++tt) { const LAS bf16_t* qp = Qe + (32 * tt + l31) * LQ + 32 * cb + 16 * s + 4 * hh;
                const u32x2 q0 = *(const LAS u32x2*)qp, q1 = *(const LAS u32x2*)(qp + 8); const u32x4 bw = (u32x4){q0.x, q0.y, q1.x, q1.y};
                Za[tt] = mfma32(sa[cb][s], __builtin_bit_cast(bf16x8, bw), Za[tt]); }
#pragma unroll
    for (int ks = 0; ks < 4; ++ks)
#pragma unroll
        for (int tt = 0; tt < 2; ++tt) if (ks < 2 * (tt + 1)) { const bf16x8 bq = *(const LAS bf16x8*)(ATT + (32 * tt + l31) * LS + 16 * ks + 8 * hh); Zb[tt] = mfma32(vt[ks], bq, Zb[tt]); }
#pragma unroll
    for (int tt = 0; tt < 2; ++tt) { const int t = 32 * tt + l31;
        if (t < T) { bf16_t* op = oraw + (size_t)(rb + t) * 1024 + h * 256 + 32 * vb + 4 * hh;
#pragma unroll
            for (int g = 0; g < 4; ++g) { u32x2 w; w.x = pk2(Za[tt][4 * g] + Zb[tt][4 * g], Za[tt][4 * g + 1] + Zb[tt][4 * g + 1]); w.y = pk2(Za[tt][4 * g + 2] + Zb[tt][4 * g + 2], Za[tt][4 * g + 3] + Zb[tt][4 * g + 3]); *(u32x2*)(op + 8 * g) = w; } } }
}
__device__ __forceinline__ size_t s_index(int cb, int i, int hh, int wave, int l31) { return (size_t)(cb * 32 + (i & 3) + 8 * (i >> 2) + 4 * hh) * 256 + 32 * wave + l31; }

__device__ __forceinline__ void gla_prep_item(const Params& p, LAS unsigned char* lds, int chain, int ch) {
    const int b = chain >> 2, h = chain & 3;
    gla_prep(p, lds, b * 2048 + ch * 64, h, 64);
    u32x4* img = (u32x4*)(p.ws + OFF_IMG + (size_t)(chain * 32 + ch) * IMG_BYTES);
    for (int i = otid(); i < IMG_V4; i += 512) img[i] = ((const LAS u32x4*)lds)[i];
    __syncthreads();
}
constexpr int SG_TAB = 0, SG_ALOW = 20480, SG_PART = 24576;
__device__ __forceinline__ void gla_sample_pair(const Params& p, LAS unsigned char* lds, int item) {
    const int tid = otid(), lane = tid & 63, wave = tid >> 6, q = wave & 3, grp = wave >> 2, chain = item * 2 + grp;
    const int b = chain >> 2, h = chain & 3, rb = MP + b * 8;
    LAS float* tab = (LAS float*)(lds + SG_TAB + wave * 2560); LAS float* alw = (LAS float*)(lds + SG_ALOW + wave * 512); LAS float* part = (LAS float*)(lds + SG_PART);
    const bf16_t* Z = (const bf16_t*)(p.ws + OFF_Z); const float* alowg = (const float*)(p.ws + OFF_ALOW); bf16_t* oraw = (bf16_t*)(p.ws + OFF_ORAW);
    alw[lane] = alowg[(size_t)rb * 16 + lane]; alw[lane + 64] = alowg[(size_t)rb * 16 + 64 + lane];
    float qe[8][2], kv[8][2]; f32x4 V[8];
#pragma unroll
    for (int t = 0; t < 8; ++t) { const bf16_t* zr = Z + (size_t)(rb + t) * NZ; const unsigned qw = *(const unsigned*)(zr + h * 128 + 2 * lane), kw = *(const unsigned*)(zr + 512 + h * 128 + 2 * lane);
        const u32x2 vw = *(const u32x2*)(zr + 1024 + h * 256 + 4 * lane);
        qe[t][0] = bflo(qw); qe[t][1] = bfhi(qw); kv[t][0] = bflo(kw); kv[t][1] = bfhi(kw); V[t] = (f32x4){bflo(vw.x), bfhi(vw.x), bflo(vw.y), bfhi(vw.y)}; }
    float bc[8][2];
    {   f32x2 wa[16];
#pragma unroll
        for (int j = 0; j < 16; ++j) wa[j] = *(const f32x2*)(p.w_a2 + j * 512 + h * 128 + 2 * lane);
        const f32x2 ba = *(const f32x2*)(p.b_a + h * 128 + 2 * lane);
        lds_wait();
        float run0 = 0.f, run1 = 0.f;
#pragma unroll
        for (int t = 0; t < 8; ++t) { float p0 = ba.x, p1 = ba.y;
#pragma unroll
            for (int j4 = 0; j4 < 4; ++j4) { const f32x4 a4 = *(const LAS f32x4*)(alw + t * 16 + 4 * j4);
#pragma unroll
                for (int k = 0; k < 4; ++k) { p0 += a4[k] * wa[4 * j4 + k].x; p1 += a4[k] * wa[4 * j4 + k].y; } }
            run0 += logsigmoid_f(p0) * 0.0625f; run1 += logsigmoid_f(p1) * 0.0625f; bc[t][0] = run0; bc[t][1] = run1; } }
    float ki[8][2];
#pragma unroll
    for (int t = 0; t < 8; ++t) { qe[t][0] *= __expf(bc[t][0]); qe[t][1] *= __expf(bc[t][1]); ki[t][0] = kv[t][0] * __expf(-bc[t][0]); ki[t][1] = kv[t][1] * __expf(-bc[t][1]); }
    lds_wait();
#pragma unroll
    for (int t = 0; t < 8; ++t)
#pragma unroll
        for (int s = 0; s <= t; ++s) { const float a = wave_sum(qe[t][0] * ki[s][0] + qe[t][1] * ki[s][1]); if (lane == 0) alw[t * (t + 1) / 2 + s] = a; }
    if ((lane >> 4) == q) { const float e0 = __expf(bc[7][0]), e1 = __expf(bc[7][1]); LAS float* r0 = tab + (2 * lane - 32 * q) * 20; LAS float* r1 = r0 + 20;
        *(LAS f32x4*)(r0) = (f32x4){qe[0][0], qe[1][0], qe[2][0], qe[3][0]}; *(LAS f32x4*)(r0 + 4) = (f32x4){qe[4][0], qe[5][0], qe[6][0], qe[7][0]};
        *(LAS f32x4*)(r1) = (f32x4){qe[0][1], qe[1][1], qe[2][1], qe[3][1]}; *(LAS f32x4*)(r1 + 4) = (f32x4){qe[4][1], qe[5][1], qe[6][1], qe[7][1]};
        *(LAS f32x4*)(r0 + 8) = (f32x4){ki[0][0] * e0, ki[1][0] * e0, ki[2][0] * e0, ki[3][0] * e0}; *(LAS f32x4*)(r0 + 12) = (f32x4){ki[4][0] * e0, ki[5][0] * e0, ki[6][0] * e0, ki[7][0] * e0};
        *(LAS f32x4*)(r1 + 8) = (f32x4){ki[0][1] * e1, ki[1][1] * e1, ki[2][1] * e1, ki[3][1] * e1}; *(LAS f32x4*)(r1 + 12) = (f32x4){ki[4][1] * e1, ki[5][1] * e1, ki[6][1] * e1, ki[7][1] * e1};
        r0[16] = e0; r1[16] = e1; }
    lds_wait();
    f32x4 o[8];
#pragma unroll
    for (int t = 0; t < 8; ++t) o[t] = (f32x4){0.f, 0.f, 0.f, 0.f};
    const f32x4* S0 = (const f32x4*)(p.state_gla + (size_t)chain * 32768 + (size_t)(32 * q) * 256) + lane; f32x4* So = (f32x4*)(p.out + OUT_SS + (size_t)chain * 32768 + (size_t)(32 * q) * 256) + lane;
#pragma unroll 1
    for (int cc = 0; cc < 32; cc += 16) { f32x4 s[16];
#pragma unroll
        for (int u = 0; u < 16; ++u) s[u] = ldnt(S0 + (cc + u) * 64);
#pragma unroll
        for (int u = 0; u < 16; ++u) { const LAS float* row = tab + (cc + u) * 20; const f32x4 qa = *(const LAS f32x4*)row, qb = *(const LAS f32x4*)(row + 4), ka = *(const LAS f32x4*)(row + 8), kb = *(const LAS f32x4*)(row + 12); const float d = row[16];
            o[0] += qa[0] * s[u]; o[1] += qa[1] * s[u]; o[2] += qa[2] * s[u]; o[3] += qa[3] * s[u]; o[4] += qb[0] * s[u]; o[5] += qb[1] * s[u]; o[6] += qb[2] * s[u]; o[7] += qb[3] * s[u];
            f32x4 sn = d * s[u]; sn += ka[0] * V[0]; sn += ka[1] * V[1]; sn += ka[2] * V[2]; sn += ka[3] * V[3]; sn += kb[0] * V[4]; sn += kb[1] * V[5]; sn += kb[2] * V[6]; sn += kb[3] * V[7];
            stnt(So + (cc + u) * 64, sn); } }
#pragma unroll
    for (int t = 0; t < 8; ++t) *(LAS f32x4*)(part + (wave * 8 + t) * 256 + 4 * lane) = o[t];
    __syncthreads();
#pragma unroll
    for (int tt = 0; tt < 2; ++tt) { const int t = 2 * q + tt; f32x4 acc = (f32x4){0.f, 0.f, 0.f, 0.f};
#pragma unroll
        for (int w = 0; w < 4; ++w) acc += *(const LAS f32x4*)(part + ((grp * 4 + w) * 8 + t) * 256 + 4 * lane);
#pragma unroll
        for (int s = 0; s < 8; ++s) { const float a = (s <= t) ? alw[t * (t + 1) / 2 + s] : 0.f; acc += a * V[s]; }
        { u32x2 w; w.x = pk2(acc[0], acc[1]); w.y = pk2(acc[2], acc[3]); *(u32x2*)(oraw + (size_t)(rb + t) * 1024 + h * 256 + 4 * lane) = w; } }
    __syncthreads();
}
struct VRegs2 { u32x4 r[2]; };
__device__ __forceinline__ void v_load_half(const Params& p, VRegs2& v, int rb, int h, int vhalf) {
    const int tid = otid(), s = tid & 63, vg = tid >> 6; const bf16_t* Z = (const bf16_t*)(p.ws + OFF_Z);
#pragma unroll
    for (int k = 0; k < 2; ++k) v.r[k] = *(const u32x4*)(Z + (size_t)(rb + s) * NZ + 1024 + h * 256 + vhalf * 128 + vg * 16 + 8 * k);
}
__device__ __forceinline__ void v_store_half_t(LAS unsigned char* lds, const VRegs2& v) {
    const int tid = otid(), s = tid & 63, vg = tid >> 6; LAS bf16_t* VT = (LAS bf16_t*)(lds + R_VT) + (vg * 16) * LS + s;
#pragma unroll
    for (int k = 0; k < 2; ++k) {
        VT[(8 * k + 0) * LS] = (bf16_t)(v.r[k].x & 0xffffu); VT[(8 * k + 1) * LS] = (bf16_t)(v.r[k].x >> 16);
        VT[(8 * k + 2) * LS] = (bf16_t)(v.r[k].y & 0xffffu); VT[(8 * k + 3) * LS] = (bf16_t)(v.r[k].y >> 16);
        VT[(8 * k + 4) * LS] = (bf16_t)(v.r[k].z & 0xffffu); VT[(8 * k + 5) * LS] = (bf16_t)(v.r[k].z >> 16);
        VT[(8 * k + 6) * LS] = (bf16_t)(v.r[k].w & 0xffffu); VT[(8 * k + 7) * LS] = (bf16_t)(v.r[k].w >> 16); }
}
constexpr int CH_BUF = 64000;
template <int NTHR> __device__ __forceinline__ void chain_stage(const Params& p, LAS unsigned char* buf, const u32x4* img, int rb, int h, int vhalf, int t) {
    const bf16_t* Z = (const bf16_t*)(p.ws + OFF_Z);
    constexpr int NI = (IMG_V4 + NTHR - 1) / NTHR, NV = 512 / NTHR;
    u32x4 im[NI], v0[NV], v1[NV];
#pragma unroll
    for (int k = 0; k < NI; ++k) { const int i = t + NTHR * k; im[k] = (i < IMG_V4) ? img[i] : (u32x4){0u, 0u, 0u, 0u}; }
#pragma unroll
    for (int k = 0; k < NV; ++k) { const int e = t + NTHR * k, s = e & 63, vg = e >> 6; const bf16_t* zp = Z + (size_t)(rb + s) * NZ + 1024 + h * 256 + vhalf * 128 + vg * 16; v0[k] = *(const u32x4*)zp; v1[k] = *(const u32x4*)(zp + 8); }
#pragma unroll
    for (int k = 0; k < NI; ++k) { const int i = t + NTHR * k; if (i < IMG_V4) ((LAS u32x4*)buf)[i] = im[k]; }
#pragma unroll
    for (int k = 0; k < NV; ++k) { const int e = t + NTHR * k, s = e & 63, vg = e >> 6; const u32x4 r0 = v0[k], r1 = v1[k];
        LAS bf16_t* VT = (LAS bf16_t*)(buf + R_VT) + (vg * 16) * LS + s;
        VT[0 * LS] = (bf16_t)(r0.x & 0xffffu); VT[1 * LS] = (bf16_t)(r0.x >> 16); VT[2 * LS] = (bf16_t)(r0.y & 0xffffu); VT[3 * LS] = (bf16_t)(r0.y >> 16);
        VT[4 * LS] = (bf16_t)(r0.z & 0xffffu); VT[5 * LS] = (bf16_t)(r0.z >> 16); VT[6 * LS] = (bf16_t)(r0.w & 0xffffu); VT[7 * LS] = (bf16_t)(r0.w >> 16);
        VT[8 * LS] = (bf16_t)(r1.x & 0xffffu); VT[9 * LS] = (bf16_t)(r1.x >> 16); VT[10 * LS] = (bf16_t)(r1.y & 0xffffu); VT[11 * LS] = (bf16_t)(r1.y >> 16);
        VT[12 * LS] = (bf16_t)(r1.z & 0xffffu); VT[13 * LS] = (bf16_t)(r1.z >> 16); VT[14 * LS] = (bf16_t)(r1.w & 0xffffu); VT[15 * LS] = (bf16_t)(r1.w >> 16); }
}
__device__ __forceinline__ void gla_chain_item(const Params& p, LAS unsigned char* lds, int chain, int vhalf) {
    const int tid = otid(), lane = tid & 63, wave = tid >> 6, l31 = lane & 31, hh = lane >> 5;
    const int b = chain >> 2, h = chain & 3, vb = vhalf * 4 + (wave & 3);
    f32x16 S[4];
#pragma unroll
    for (int cb = 0; cb < 4; ++cb)
#pragma unroll
        for (int i = 0; i < 16; ++i) S[cb][i] = 0.f;
    const u32x4* img = (const u32x4*)(p.ws + OFF_IMG + (size_t)(chain * 32) * IMG_BYTES);
    chain_stage<512>(p, lds, img, b * 2048, h, vhalf, tid);
    __syncthreads();
#pragma unroll 1
    for (int ch = 0; ch < 32; ++ch) {
        const int rb = b * 2048 + ch * 64;
        if (wave >= 4) { if (ch + 1 < 32) chain_stage<256>(p, lds + ((ch + 1) & 1) * CH_BUF, img + (size_t)(ch + 1) * IMG_V4, rb + 64, h, vhalf, tid - 256); }
        else gla_step(p, lds + (ch & 1) * CH_BUF, S, rb, h, 64, vb, 32 * wave);
        __syncthreads();
    }
    if (wave < 4) {
        float* Sout = p.out + OUT_SP + (size_t)chain * 32768;
#pragma unroll
        for (int cb = 0; cb < 4; ++cb)
#pragma unroll
            for (int i = 0; i < 16; ++i) Sout[s_index(cb, i, hh, vb, l31)] = S[cb][i];
    }
}

constexpr int M_W = 0, M_V = 34816, M_STAT = 69632;
__device__ __forceinline__ void gmlp_item(const Params& p, LAS unsigned char* lds, int rowbase, int T, int g, float* vs_out) {
    const int tid = otid(), lane = tid & 63, wave = tid >> 6;
    const bf16_t* Z = (const bf16_t*)(p.ws + OFF_Z); bf16_t* mraw = (bf16_t*)(p.ws + OFF_MRAW);
    LAS bf16_t* LW = (LAS bf16_t*)(lds + M_W); LAS bf16_t* LV = (LAS bf16_t*)(lds + M_V); LAS float* stat = (LAS float*)(lds + M_STAT);
    if (tid < 128) { const f32x2 st = (tid < T) ? *(const f32x2*)((const float*)(p.ws + OFF_STAT) + (size_t)(rowbase + tid) * 2) : (f32x2){0.f, 0.f}; stat[2 * tid] = st.x; stat[2 * tid + 1] = st.y; }
    for (int idx = tid; idx < 4096; idx += 512) { const int t = idx >> 5, s4 = (idx & 31) * 4; const f32x4 w = *(const f32x4*)(p.w_s + ((size_t)g * 128 + t) * 128 + s4);
        u32x2 o; o.x = pk2(s4 <= t ? w[0] : 0.f, s4 + 1 <= t ? w[1] : 0.f); o.y = pk2(s4 + 2 <= t ? w[2] : 0.f, s4 + 3 <= t ? w[3] : 0.f);
        *(LAS u32x2*)(LW + t * LQ + s4) = o; }
    __syncthreads();
    { const int s = tid & 127, dq = tid >> 7; const float mean = stat[2 * s], rstd = stat[2 * s + 1];
#pragma unroll
        for (int ps = 0; ps < 4; ++ps) { const int d8 = (dq * 4 + ps) * 8; float vn[8];
            if (s < T) { const u32x4 r = *(const u32x4*)(Z + (size_t)(rowbase + s) * NZ + 4096 + g * 128 + d8);
                const float x[8] = {bflo(r.x), bfhi(r.x), bflo(r.y), bfhi(r.y), bflo(r.z), bfhi(r.z), bflo(r.w), bfhi(r.w)};
                const f32x4 ga = *(const f32x4*)(p.g_gmlp_ln + g * 128 + d8), gb = *(const f32x4*)(p.g_gmlp_ln + g * 128 + d8 + 4);
                const f32x4 ba = *(const f32x4*)(p.b_gmlp_ln + g * 128 + d8), bb = *(const f32x4*)(p.b_gmlp_ln + g * 128 + d8 + 4);
#pragma unroll
                for (int j = 0; j < 4; ++j) { vn[j] = (x[j] - mean) * rstd * ga[j] + ba[j]; vn[4 + j] = (x[4 + j] - mean) * rstd * gb[j] + bb[j]; }
                if (vs_out) { float* vp = vs_out + (size_t)s * 1024 + g * 128 + d8; *(f32x4*)vp = (f32x4){vn[0], vn[1], vn[2], vn[3]}; *(f32x4*)(vp + 4) = (f32x4){vn[4], vn[5], vn[6], vn[7]}; }
            } else {
#pragma unroll
                for (int j = 0; j < 8; ++j) vn[j] = 0.f;
            }
#pragma unroll
            for (int j = 0; j < 8; ++j) LV[(d8 + j) * LQ + s] = f2bf(vn[j]); } }
    __syncthreads();
#pragma unroll 1
    for (int q = 0; q < 2; ++q) { const int id = wave * 2 + q, ti = id >> 2, di = id & 3;
        if (ti * 32 < T) { f32x16 acc;
#pragma unroll
            for (int i = 0; i < 16; ++i) acc[i] = 0.f;
            mma32(acc, LW + ti * 32 * LQ, LQ, LV + di * 32 * LQ, LQ, (ti + 1) * 32, lane);
            const int d = di * 32 + (lane & 31);
#pragma unroll
            for (int i = 0; i < 16; ++i) { const int t = ti * 32 + (i & 3) + 8 * (i >> 2) + 4 * (lane >> 5);
                if (t < T) { const float uval = bf2f(Z[(size_t)(rowbase + t) * NZ + 3072 + g * 128 + d]);
                    mraw[(size_t)(rowbase + t) * 1024 + g * 128 + d] = f2bf(uval * (acc[i] + p.b_s[g * 128 + t])); } } } }
    __syncthreads();
}

__device__ __forceinline__ void gmlp_sample_item(const Params& p, int b) {
    const int tid = otid(), d2 = tid * 2, g = __builtin_amdgcn_readfirstlane(tid >> 6), rb = MP + b * 8;
    const bf16_t* Z = (const bf16_t*)(p.ws + OFF_Z); bf16_t* mraw = (bf16_t*)(p.ws + OFF_MRAW); const float* st = (const float*)(p.ws + OFF_STAT) + (size_t)rb * 2;
    float* vs_out = p.out + OUT_VS + (size_t)b * 8 * 1024;
    const f32x2 ga = *(const f32x2*)(p.g_gmlp_ln + d2), be = *(const f32x2*)(p.b_gmlp_ln + d2);
    unsigned xv[8], uv[8];
#pragma unroll
    for (int s_ = 0; s_ < 8; ++s_) { xv[s_] = *(const unsigned*)(Z + (size_t)(rb + s_) * NZ + 4096 + d2); uv[s_] = *(const unsigned*)(Z + (size_t)(rb + s_) * NZ + 3072 + d2); }
    float v0[8], v1[8];
#pragma unroll
    for (int s_ = 0; s_ < 8; ++s_) { const float mean = st[2 * s_], rstd = st[2 * s_ + 1];
        v0[s_] = (bflo(xv[s_]) - mean) * rstd * ga.x + be.x; v1[s_] = (bfhi(xv[s_]) - mean) * rstd * ga.y + be.y;
        *(f32x2*)(vs_out + (size_t)s_ * 1024 + d2) = (f32x2){v0[s_], v1[s_]}; }
    const float* wg = p.w_s + (size_t)g * 128 * 128; const float* bs = p.b_s + g * 128;
#pragma unroll
    for (int t = 0; t < 8; ++t) { float m0 = bs[t], m1 = m0;
#pragma unroll
        for (int s_ = 0; s_ <= t; ++s_) { const float w = wg[t * 128 + s_]; m0 += w * v0[s_]; m1 += w * v1[s_]; }
        *(unsigned*)(mraw + (size_t)(rb + t) * 1024 + d2) = pk2(bflo(uv[t]) * m0, bfhi(uv[t]) * m1); }
}
__device__ __forceinline__ void phase2a(const Params& p, LAS unsigned char* lds) {
    {   const int tid = otid(), lane = tid & 63, gw = blockIdx.x * 8 + (tid >> 6), NGW = gridDim.x * 8;
        const bf16_t* Z = (const bf16_t*)(p.ws + OFF_Z); float* st = (float*)(p.ws + OFF_STAT);
        for (int r = gw; r < MT; r += NGW) {
            const bf16_t* zr = Z + (size_t)r * NZ + 4096; const u32x4 r0 = *(const u32x4*)(zr + lane * 8), r1 = *(const u32x4*)(zr + 512 + lane * 8);
            const float x[16] = {bflo(r0.x), bfhi(r0.x), bflo(r0.y), bfhi(r0.y), bflo(r0.z), bfhi(r0.z), bflo(r0.w), bfhi(r0.w), bflo(r1.x), bfhi(r1.x), bflo(r1.y), bfhi(r1.y), bflo(r1.z), bfhi(r1.z), bflo(r1.w), bfhi(r1.w)};
            float s = 0.f;
#pragma unroll
            for (int j = 0; j < 16; ++j) s += x[j];
            const float mean = wave_sum(s) * (1.f / 1024.f); float q = 0.f;
#pragma unroll
            for (int j = 0; j < 16; ++j) { const float d = x[j] - mean; q += d * d; }
            const float rstd = rsqrtf(wave_sum(q) * (1.f / 1024.f) + 1e-6f);
            if (lane == 0) *(f32x2*)(st + (size_t)r * 2) = (f32x2){mean, rstd};
        }
    }
    for (int j = blockIdx.x; j < 512; j += gridDim.x) gla_prep_item(p, lds, j >> 5, j & 31);
    for (int j = blockIdx.x; j < 256; j += gridDim.x) gla_sample_pair(p, lds, j);
    { const int gw = blockIdx.x * 8 + (otid() >> 6), NGW = gridDim.x * 8; convert_range(p, lds, cv::E_IN, cv::E_OUT, gw, NGW); convert_range(p, lds, cv::E_FO, cv::E_PLE, gw, NGW); }
}
__device__ __forceinline__ void phase2c(const Params& p, LAS unsigned char* lds) {
    const int nb = gridDim.x, bid = blockIdx.x;
    constexpr int NCH = 32, N_GP = 512, N_GS = 0, N_MS = 128;
    const int nlb = nb > 2 * NCH ? NCH : (nb > 1 ? nb / 2 : 0);
    if (bid < nlb || nlb == 0) { for (int j = (nlb ? bid : 0); j < NCH; j += (nlb ? nlb : 1)) gla_chain_item(p, lds, j >> 1, j & 1); }
    if (bid >= nlb) {
        const int ob = bid - nlb, onb = nb - nlb;
        for (int j = ob; j < N_GP + N_GS + N_MS; j += onb) {
            if (j < N_GP) gmlp_item(p, lds, (j >> 3) * 128, 128, j & 7, nullptr);
            else gmlp_sample_item(p, j - N_GP - N_GS);
        }
        __syncthreads();
        convert_range(p, lds, cv::E_OUT, cv::E_FI, ob * 8 + (otid() >> 6), onb * 8);
    }
}

struct Mix10 { f32x4 o[4], m[4]; u32x4 r0, r1; };
__device__ __forceinline__ void mix_load(Mix10& a, const Params& p, int r, int col) {
    const bf16_t* Z = (const bf16_t*)(p.ws + OFF_Z); const bf16_t* oraw = (const bf16_t*)(p.ws + OFF_ORAW); const bf16_t* mraw = (const bf16_t*)(p.ws + OFF_MRAW);
#pragma unroll
    for (int j = 0; j < 2; ++j) { const u32x4 ow = ldnt((const u32x4*)(oraw + (size_t)r * 1024 + col + 8 * j)), mw = ldnt((const u32x4*)(mraw + (size_t)r * 1024 + col + 8 * j));
        a.o[2 * j] = (f32x4){bflo(ow.x), bfhi(ow.x), bflo(ow.y), bfhi(ow.y)}; a.o[2 * j + 1] = (f32x4){bflo(ow.z), bfhi(ow.z), bflo(ow.w), bfhi(ow.w)};
        a.m[2 * j] = (f32x4){bflo(mw.x), bfhi(mw.x), bflo(mw.y), bfhi(mw.y)}; a.m[2 * j + 1] = (f32x4){bflo(mw.z), bfhi(mw.z), bflo(mw.w), bfhi(mw.w)}; }
    a.r0 = ldnt((const u32x4*)(Z + (size_t)r * NZ + 2048 + col)); a.r1 = ldnt((const u32x4*)(Z + (size_t)r * NZ + 2048 + col + 8));
}
__device__ __forceinline__ void mix_finish(const Mix10& a, const Params& p, int r, int col) {
    bf16_t* cat = (bf16_t*)(p.ws + OFF_A0);
    { float s = 0.f;
#pragma unroll
        for (int j = 0; j < 4; ++j) s += (a.o[j][0] * a.o[j][0] + a.o[j][1] * a.o[j][1]) + (a.o[j][2] * a.o[j][2] + a.o[j][3] * a.o[j][3]);
        s = row16_sum(s);
        const float rinv = rsqrtf(s * (1.f / 256.f) + 1e-6f);
        const float sr[16] = {bflo(a.r0.x), bfhi(a.r0.x), bflo(a.r0.y), bfhi(a.r0.y), bflo(a.r0.z), bfhi(a.r0.z), bflo(a.r0.w), bfhi(a.r0.w), bflo(a.r1.x), bfhi(a.r1.x), bflo(a.r1.y), bfhi(a.r1.y), bflo(a.r1.z), bfhi(a.r1.z), bflo(a.r1.w), bfhi(a.r1.w)};
        unsigned w[8];
#pragma unroll
        for (int j = 0; j < 4; ++j) { const f32x4 g = *(const f32x4*)(p.g_gla_norm + col + 4 * j);
            w[2 * j] = pk2(a.o[j][0] * rinv * g[0] * sr[4 * j], a.o[j][1] * rinv * g[1] * sr[4 * j + 1]); w[2 * j + 1] = pk2(a.o[j][2] * rinv * g[2] * sr[4 * j + 2], a.o[j][3] * rinv * g[3] * sr[4 * j + 3]); }
        u32x4* dp = (u32x4*)(cat + (size_t)r * DM + col); dp[0] = (u32x4){w[0], w[1], w[2], w[3]}; dp[1] = (u32x4){w[4], w[5], w[6], w[7]}; }
    { float s = 0.f;
#pragma unroll
        for (int j = 0; j < 4; ++j) s += (a.m[j][0] * a.m[j][0] + a.m[j][1] * a.m[j][1]) + (a.m[j][2] * a.m[j][2] + a.m[j][3] * a.m[j][3]);
        const float rinv = rsqrtf(wave_sum(s) * (1.f / 1024.f) + 1e-6f);
        unsigned w[8];
#pragma unroll
        for (int j = 0; j < 4; ++j) { const f32x4 g = *(const f32x4*)(p.g_gmlp_out + col + 4 * j);
            w[2 * j] = pk2(a.m[j][0] * rinv * g[0], a.m[j][1] * rinv * g[1]); w[2 * j + 1] = pk2(a.m[j][2] * rinv * g[2], a.m[j][3] * rinv * g[3]); }
        u32x4* dp = (u32x4*)(cat + (size_t)r * DM + 1024 + col); dp[0] = (u32x4){w[0], w[1], w[2], w[3]}; dp[1] = (u32x4){w[4], w[5], w[6], w[7]}; }
}
__device__ __forceinline__ void phase2b(const Params& p) {
    const int lane = otid() & 63, gw = blockIdx.x * 8 + (otid() >> 6), NGW = gridDim.x * 8, col = lane * 16;
    for (int r = gw; r < MT; r += 2 * NGW) {
        const int r2 = r + NGW; const bool has2 = r2 < MT;
        Mix10 a, b; mix_load(a, p, r, col); mix_load(b, p, has2 ? r2 : r, col);
        mix_finish(a, p, r, col);
        if (has2) mix_finish(b, p, r2, col);
    }
}
template <int NS> __device__ __forceinline__ void phase_norm(const Params& p, const float* gain, const float* base_s) {
    const int lane = otid() & 63, gw = blockIdx.x * 8 + (otid() >> 6), NGW = gridDim.x * 8; bf16_t* a0 = (bf16_t*)(p.ws + OFF_A0); const bf16_t* part = (const bf16_t*)(p.ws + OFF_IMG);
    for (int r = gw; r < MP; r += 4 * NGW) {
        const int r2 = r + NGW, r3 = r + 2 * NGW, r4 = r + 3 * NGW; const bool h2 = r2 < MP, h3 = r3 < MP, h4 = r4 < MP;
        Row8 a, b, c4, d; row_load_nt(a, p.out + OUT_Y + (size_t)r * DM, lane); row_load_nt(b, p.out + OUT_Y + (size_t)(h2 ? r2 : r) * DM, lane);
        row_load_nt(c4, p.out + OUT_Y + (size_t)(h3 ? r3 : r) * DM, lane); row_load_nt(d, p.out + OUT_Y + (size_t)(h4 ? r4 : r) * DM, lane);
        rms_finish_bf16(a, gain, a0 + (size_t)r * DM, lane);
        if (h2) rms_finish_bf16(b, gain, a0 + (size_t)r2 * DM, lane);
        if (h3) rms_finish_bf16(c4, gain, a0 + (size_t)r3 * DM, lane);
        if (h4) rms_finish_bf16(d, gain, a0 + (size_t)r4 * DM, lane);
    }
    for (int r = MP + gw; r < MT; r += NGW) {
        f32x4 v[8]; float s = 0.f; const f32x4* sm = row_mid(base_s + (size_t)(r - MP) * DM, lane); const f32x4* gm = row_mid(gain, lane);
        const u32x2* pm0 = (const u32x2*)(part + (size_t)(r - MP) * DM) + lane; f32x4* om = row_mid(p.out + OUT_Y + (size_t)r * DM, lane);
#pragma unroll
        for (int j = 0; j < 8; ++j) v[j] = sm[64 * (j - 4)];
#pragma unroll 4
        for (int k = 0; k < NS; ++k) { const u32x2* pk = pm0 + (size_t)k * (MS * DM / 4);
#pragma unroll
            for (int j = 0; j < 8; ++j) v[j] += unpack4(pk[64 * j]); }
#pragma unroll
        for (int j = 0; j < 8; ++j) { om[64 * (j - 4)] = v[j]; s += (v[j][0] * v[j][0] + v[j][1] * v[j][1]) + (v[j][2] * v[j][2] + v[j][3] * v[j][3]); }
        const float rinv = rsqrtf(wave_sum(s) * (1.f / DM) + 1e-6f);
        u32x2* dm = (u32x2*)(a0 + (size_t)r * DM) + lane;
#pragma unroll
        for (int j = 0; j < 8; ++j) { const f32x4 g = gm[64 * (j - 4)]; u32x2 o; o.x = pk2(v[j][0] * rinv * g[0], v[j][1] * rinv * g[1]); o.y = pk2(v[j][2] * rinv * g[2], v[j][3] * rinv * g[3]);
            dm[64 * j] = o; }
    }
}
#define P7_TAIL() \
        float s = 0.f; \
        _Pragma("unroll") for (int j = 0; j < 8; ++j) s += (v.v[j][0] * v.v[j][0] + v.v[j][1] * v.v[j][1]) + (v.v[j][2] * v.v[j][2] + v.v[j][3] * v.v[j][3]); \
        const float rp = rsqrtf(wave_sum(s) * (1.f / DM) + 1e-6f); float s3 = 0.f; \
        const f32x4* gpm = row_mid(p.g_ple, lane); \
        _Pragma("unroll") for (int j = 0; j < 8; ++j) { const f32x4 g = gpm[64 * (j - 4)]; \
            _Pragma("unroll") for (int k = 0; k < 4; ++k) { const float h3 = hh.v[j][k] + v.v[j][k] * rp * g[k] * sigmoid_f(z.v[j][k]); v.v[j][k] = h3; s3 += h3 * h3; } } \
        const float r3 = rsqrtf(wave_sum(s3) * (1.f / DM) + 1e-6f); \
        const f32x4* gfm = row_mid(p.g_final, lane); \
        _Pragma("unroll") for (int j = 0; j < 8; ++j) { const f32x4 g = gfm[64 * (j - 4)]; stnt(om + 64 * (j - 4), (f32x4){v.v[j][0] * r3 * g[0], v.v[j][1] * r3 * g[1], v.v[j][2] * r3 * g[2], v.v[j][3] * r3 * g[3]}); }
__device__ __forceinline__ void phase7(const Params& p) {
    const int lane = otid() & 63, gw = blockIdx.x * 8 + (otid() >> 6), NGW = gridDim.x * 8;
    const bf16_t* gz = (const bf16_t*)(p.ws + OFF_GATEZ); const bf16_t* pz = (const bf16_t*)(p.ws + OFF_PZ);
#pragma unroll 1
    for (int r = gw; r < MP; r += NGW) {
        f32x4* om = row_mid(p.out + OUT_Y + (size_t)r * DM, lane);
        const u32x2* pzr = (const u32x2*)(pz + (size_t)r * DM) + lane; const u32x2* zb = (const u32x2*)(gz + (size_t)r * DM) + lane;
        Row8 v, hh, z;
#pragma unroll
        for (int j = 0; j < 8; ++j) { const u32x2 w = ldnt(pzr + 64 * j), zw = ldnt(zb + 64 * j); v.v[j] = (f32x4){bflo(w.x), bfhi(w.x), bflo(w.y), bfhi(w.y)}; z.v[j] = (f32x4){bflo(zw.x), bfhi(zw.x), bflo(zw.y), bfhi(zw.y)}; hh.v[j] = ldnt(om + 64 * (j - 4)); }
        P7_TAIL()
    }
#pragma unroll 1
    for (int r = MP + gw; r < MT; r += NGW) {
        f32x4* om = row_mid(p.out + OUT_Y + (size_t)r * DM, lane);
        const u32x2* pzr = (const u32x2*)(pz + (size_t)r * DM) + lane; const u32x2* zm = (const u32x2*)((const bf16_t*)(p.ws + OFF_IMG) + (size_t)(r - MP) * DM) + lane;
        Row8 v, hh, z;
#pragma unroll
        for (int j = 0; j < 8; ++j) { const u32x2 w = ldnt(pzr + 64 * j); v.v[j] = unpack4(w); hh.v[j] = ldnt(om + 64 * (j - 4)); z.v[j] = (f32x4){0.f, 0.f, 0.f, 0.f}; }
#pragma unroll 4
        for (int k = 0; k < 8; ++k) { const u32x2* pk = zm + (size_t)k * (MS * DM / 4);
#pragma unroll
            for (int j = 0; j < 8; ++j) z.v[j] += unpack4(ldnt(pk + 64 * j)); }
        P7_TAIL()
    }
}
#undef P7_TAIL

__global__ void __launch_bounds__(512, 2) fwd_kernel(Params p) {
    extern __shared__ __attribute__((aligned(16))) unsigned char shm[];
    LAS unsigned char* lds = (LAS unsigned char*)shm;
    cg::grid_group grid = cg::this_grid();
    if (threadIdx.x == 0) { *(volatile LAS unsigned*)(lds + 131072) = 0u; *(volatile LAS unsigned*)(lds + 131076) = 0u; }
    __syncthreads();
    const XcdBarrier xb = xcd_barrier_post((unsigned*)(p.ws + OFF_BAR), (volatile LAS unsigned*)(lds + 131072));
    bf16_t* a0 = (bf16_t*)(p.ws + OFF_A0);
    phase0(p, lds);
    if (p.ws == nullptr) grid.sync();
    xcd_barrier(xb);
    { EpiIn E; E.Z = (bf16_t*)(p.ws + OFF_Z); E.alow = (float*)(p.ws + OFF_ALOW); run_gemm(lds, a0, (const bf16_t*)(p.ws + OFF_WIN), MT, NINP, DM, E); }
    xcd_barrier(xb);
    phase2a(p, lds);
    xcd_barrier(xb);
    phase2c(p, lds);
    xcd_barrier(xb);
    phase2b(p);
    xcd_barrier(xb);
    bf16_t* part = (bf16_t*)(p.ws + OFF_IMG);
    { EpiRes E; E.res_p = p.x_prompt; E.res_s = p.x_sample; E.out = p.out + OUT_Y; run_gemm_n2048(lds, a0, (const bf16_t*)(p.ws + OFF_WOUT), DM, E, part); }
    xcd_barrier(xb);
    phase_norm<8>(p, p.g_ffn, p.x_sample);
    xcd_barrier(xb);
    { EpiSwiglu E; E.act = (bf16_t*)(p.ws + OFF_ACT); run_gemm(lds, a0, (const bf16_t*)(p.ws + OFF_WFI), MT, 2 * DFF, DM, E); }
    {
        const int G = (int)gridDim.x, extra = ((MT / 256) * (2 * DFF / 256)) % G, cb = (int)blockIdx.x;
        if (extra == 0 || cb >= extra) { EpiBfN E; E.out = (bf16_t*)(p.ws + OFF_PZ); pg8::Gemm g; g.A = (const bf16_t*)(p.ws + OFF_PB); g.Bt = (const bf16_t*)(p.ws + OFF_WPLE); g.M = MT; g.N = DM; g.K = PLE; g.Klen = PLE;
            pg8::StaticOrder S; S.init(MT, DM, extra ? G - extra : G, extra ? cb - extra : cb); pg8::gemm_phase<EpiBfN, pg8::StaticOrder, false>(lds, g, S, E, nullptr);
            { const int ob = extra ? cb - extra : cb, onb = extra ? G - extra : G, gw = ob * 8 + (otid() >> 6); convert_range(p, lds, cv::E_FI, cv::E_FO, gw, onb * 8); convert_range(p, lds, cv::E_PLE, cv::E_GT, gw, onb * 8); } }
    }
    xcd_barrier(xb);
    { EpiRes E; E.res_p = p.out + OUT_Y; E.res_s = p.out + OUT_Y + (size_t)MP * DM; E.out = p.out + OUT_Y;
      const bf16_t* A = (const bf16_t*)(p.ws + OFF_ACT); const bf16_t* Bt = (const bf16_t*)(p.ws + OFF_WFO); const int G = (int)gridDim.x, hb = (int)((blockIdx.x + G / 2) % G);
      run_gemm(lds, A, Bt, MP, DM, DFF, E);
      run_split(lds, A, Bt, DFF, part, 4, 768, 0, 0, hb);
      run_split(lds, A, Bt, DFF, part, 4, 640, 3072, 4, (int)blockIdx.x); }
    xcd_barrier(xb);
    phase_norm<8>(p, p.g_ple_gate, p.out + OUT_Y + (size_t)MP * DM);
    xcd_barrier(xb);
    { EpiBfN E; E.out = (bf16_t*)(p.ws + OFF_GATEZ); run_gemm_n2048(lds, a0, (const bf16_t*)(p.ws + OFF_WGT), DM, E, part); }
    xcd_barrier(xb);
    phase7(p);
}

extern "C" void kernel_launch(void* const* d_in, const int* in_sizes, int n_in, void* d_out, int out_size, void* d_ws, size_t ws_size, hipStream_t stream) {
    static int grid = 0;
    if (grid == 0) {
        if (n_in != 24 || ws_size < WS_END) { fprintf(stderr, "kernel_launch: unexpected n_in %d or ws_size %zu (< %zu)\n", n_in, ws_size, (size_t)WS_END); grid = -1; return; }
        int dev = 0, cus = 0, per_cu = 0;
        if (hipGetDevice(&dev) != hipSuccess || hipDeviceGetAttribute(&cus, hipDeviceAttributeMultiprocessorCount, dev) != hipSuccess) { grid = -1; return; }
        if (hipFuncSetAttribute((const void*)fwd_kernel, hipFuncAttributeMaxDynamicSharedMemorySize, LDS_BYTES) != hipSuccess) { fprintf(stderr, "kernel_launch: hipFuncSetAttribute failed\n"); grid = -1; return; }
        if (hipOccupancyMaxActiveBlocksPerMultiprocessor(&per_cu, (const void*)fwd_kernel, 512, LDS_BYTES) != hipSuccess || per_cu < 1) { fprintf(stderr, "kernel_launch: occupancy query says %d blocks per CU\n", per_cu); grid = -1; (void)hipGetLastError(); return; }
        grid = cus;
    }
    if (grid < 0) return;
    if (hipMemsetAsync(d_ws, 0, XCD_BAR_WORDS * sizeof(unsigned), stream) != hipSuccess) { fprintf(stderr, "kernel_launch: memset failed\n"); return; }
    Params p{};
    const float** f = (const float**)&p;
    for (int i = 0; i < 24; ++i) f[i] = (const float*)d_in[i];
    p.out = (float*)d_out; p.ws = (unsigned char*)d_ws;
    void* args[] = {&p};
    hipError_t e = hipLaunchCooperativeKernel((const void*)fwd_kernel, dim3(grid), dim3(512), args, LDS_BYTES, stream);
    if (e != hipSuccess) fprintf(stderr, "cooperative launch failed: %s (grid %d)\n", hipGetErrorString(e), grid);
}
```

```cpp
#include <hip/hip_runtime.h>
#include <hip/hip_cooperative_groups.h>
#include <cstdio>
#include <cstdint>
namespace cg = cooperative_groups;
namespace pg8 {
#define PG8_LAS __attribute__((address_space(3)))
typedef unsigned short bf16_t;
typedef short bf16x8 __attribute__((ext_vector_type(8)));
typedef float f32x4 __attribute__((ext_vector_type(4)));
typedef unsigned u32x4 __attribute__((ext_vector_type(4)));
constexpr int BM = 256, BK = 64, HALF = 128, HTB = HALF * BK * 2  , STAGE_BYTES = 8 * HTB, NXCD = 8, WGM = 8;

__host__ __device__ __forceinline__ int lds_byte(int r, int c) { const int st = (r >> 4) * 2 + (c >> 5), rr = r & 15, cc = c & 31, ob = rr * 64 + cc * 2; return st * 1024 + (ob ^ (((ob >> 9) & 1) << 5)); }
__host__ __device__ __forceinline__ void stage_rc(int b, int& R, int& C) { const int st = b / 1024, sb = b % 1024, swz = sb ^ (((sb >> 9) & 1) << 5); R = (st >> 1) * 16 + swz / 64; C = (st & 1) * 32 + (swz % 64) / 2; }
__host__ __device__ __forceinline__ int perm32(int rho) { const int n = rho >> 4, i = rho & 15; return 8 * (i >> 2) + 4 * n + (i & 3); }

struct Unit { int pm, pn, ks, koff; };
struct Gemm { const bf16_t* A; const bf16_t* Bt; int M, N, K, Klen; };

struct StaticOrder {
    int nM, nN, nwg, G, c;
    __host__ __device__ void init(int M, int N, int G_, int c_) { nM = M / BM; nN = N / BM; nwg = nM * nN; G = G_; c = c_; }
    __host__ __device__ bool next(int i, Unit& u) const {
        const long L = (long)i * G + c; if (L >= nwg) return false;
        int wgid = (int)L; { const int q = nwg / NXCD, r = nwg % NXCD, xcd = wgid % NXCD, off = wgid / NXCD; wgid = (xcd < r ? xcd * (q + 1) : r * (q + 1) + (xcd - r) * q) + off; }
        const int nig = WGM * nN, gid = wgid / nig, fm = gid * WGM, gsz = (nM - fm) < WGM ? (nM - fm) : WGM;
        u.pm = fm + ((wgid % nig) % gsz); u.pn = (wgid % nig) / gsz; u.ks = 0; u.koff = 0; return true;
    }
    __device__ __forceinline__ void a_ready(const Unit&) const {}
    __device__ __forceinline__ void done(const Unit&) const {}
};
__device__ __forceinline__ unsigned cvt_pk_bf16(float lo, float hi) { unsigned r; asm volatile("v_cvt_pk_bf16_f32 %0, %1, %2" : "=v"(r) : "v"(lo), "v"(hi)); return r; }
typedef float f32x2 __attribute__((ext_vector_type(2)));
template <class Epi, class Sched, bool STAMP = false>
__device__ __forceinline__ void gemm_phase(PG8_LAS unsigned char* lds, const Gemm g, const Sched& S, const Epi& E, unsigned long long* stamps) {
    int tid_ = threadIdx.x; asm volatile("" : "+v"(tid_));
    const int tid = tid_, wid = __builtin_amdgcn_readfirstlane(tid >> 6), lane = tid & 63, wr = wid >> 2, wc = wid & 3, fr = lane & 15, fq = lane >> 4;
    const int K = g.K, nt = g.Klen / BK;
    int ts_lo = 0, ts_hi = 0, nts = 0; const unsigned long long rt_entry = STAMP ? (unsigned long long)wall_clock64() : 0ull;
#define PG8_STAMP() do { if (STAMP && wid == 0 && nts < 64) { const unsigned long long _c = (unsigned long long)clock64(); \
        ts_lo = (lane == nts) ? (int)(unsigned)_c : ts_lo; ts_hi = (lane == nts) ? (int)(unsigned)(_c >> 32) : ts_hi; ++nts; } } while (0)
    PG8_STAMP();
    unsigned voffA[2], voffB[2];
#pragma unroll
    for (int i = 0; i < 2; ++i) { int R, C; stage_rc(tid * 16 + i * 8192, R, C); const int Rb = Epi::PERM ? ((R & ~31) + perm32(R & 31)) : R;
        voffA[i] = (unsigned)(R * K + C) * 2u; voffB[i] = (unsigned)(Rb * K + C) * 2u; }
    const size_t kstep = (size_t)(BK * 2);
    const size_t hstep = (size_t)HALF * K * 2;
    const size_t tstep = 2 * hstep;
    const unsigned ldsw = (unsigned)wid * 1024u;
    const int aoff = lds_byte(wr * 64 + fr, fq * 8), boff = lds_byte(wc * 32 + fr, fq * 8);
#define PG8_SA(b, h) (((b) * 2 + (h)) * HTB)
#define PG8_SB(b, h) ((4 + (b) * 2 + (h)) * HTB)
#define PG8_STAGE(bufoff, gbase, voff) do { _Pragma("unroll") for (int _i = 0; _i < 2; ++_i) \
        __builtin_amdgcn_global_load_lds((const unsigned*)((const char*)(gbase) + (voff)[_i]), (PG8_LAS unsigned*)(lds + (bufoff) + ldsw + _i * 8192), 16, 0, 0); } while (0)
#define PG8_LDA(dst, b, h) do { _Pragma("unroll") for (int m = 0; m < 4; ++m) _Pragma("unroll") for (int k = 0; k < 2; ++k) dst[m][k] = *(const PG8_LAS bf16x8*)(lds + PG8_SA(b, h) + aoff + m * 2048 + k * 1024); } while (0)
#define PG8_LDB(dst, b, h) do { _Pragma("unroll") for (int n = 0; n < 2; ++n) _Pragma("unroll") for (int k = 0; k < 2; ++k) dst[n][k] = *(const PG8_LAS bf16x8*)(lds + PG8_SB(b, h) + boff + n * 2048 + k * 1024); } while (0)
#define PG8_MMA(ai, bj, At, Bt) do { __builtin_amdgcn_s_setprio(1); _Pragma("unroll") for (int m = 0; m < 4; ++m) _Pragma("unroll") for (int n = 0; n < 2; ++n) _Pragma("unroll") for (int k = 0; k < 2; ++k) \
        acc[ai][bj][m][n] = __builtin_amdgcn_mfma_f32_16x16x32_bf16(Bt[n][k], At[m][k], acc[ai][bj][m][n], 0, 0, 0); __builtin_amdgcn_s_setprio(0); } while (0)
#define PG8_WAIT_V(n) asm volatile("s_waitcnt vmcnt(" #n ")" ::: "memory")
#define PG8_WAIT_L(n) asm volatile("s_waitcnt lgkmcnt(" #n ")" ::: "memory")
#define PG8_BAR __builtin_amdgcn_s_barrier()
#define PG8_SCHED __builtin_amdgcn_sched_barrier(0)
    Unit cur, nxt; int ui = 0;
    if (!S.next(0, cur)) return;
    f32x4 acc[2][2][4][2];
#pragma unroll
    for (int a = 0; a < 2; ++a)
#pragma unroll
        for (int b = 0; b < 2; ++b)
#pragma unroll
            for (int m = 0; m < 4; ++m)
#pragma unroll
                for (int n = 0; n < 2; ++n) acc[a][b][m][n] = (f32x4){0.f, 0.f, 0.f, 0.f};
    bf16x8 At[4][2], B0[2][2], B1[2][2];
    const char* cA = (const char*)g.A + (size_t)cur.pm * tstep + (size_t)cur.koff * 2; const char* cB = (const char*)g.Bt + (size_t)cur.pn * tstep + (size_t)cur.koff * 2;
    S.a_ready(cur);
    PG8_STAGE(PG8_SB(0, 0), cB, voffB); PG8_STAGE(PG8_SB(0, 1), cB + hstep, voffB); PG8_STAGE(PG8_SA(0, 0), cA, voffA); PG8_STAGE(PG8_SA(0, 1), cA + hstep, voffA);
    if (wr == 1) PG8_BAR;
    PG8_WAIT_V(2); PG8_BAR;
    PG8_STAGE(PG8_SB(1, 0), cB + kstep, voffB); PG8_STAGE(PG8_SA(1, 0), cA + kstep, voffA); PG8_STAGE(PG8_SB(1, 1), cB + hstep + kstep, voffB);
    PG8_WAIT_V(6); PG8_BAR;
    PG8_STAMP();
    for (;;) {
        const bool has_next = S.next(ui + 1, nxt);
        const char* nA = has_next ? (const char*)g.A + (size_t)nxt.pm * tstep + (size_t)nxt.koff * 2 : cA; const char* nB = has_next ? (const char*)g.Bt + (size_t)nxt.pn * tstep + (size_t)nxt.koff * 2 : cB;
        for (int t = 0; t < nt; t += 2) {
            const bool last = (t == nt - 2);
            const char* a1 = cA + (size_t)(t + 1) * kstep;
            const char* a2 = last ? nA : cA + (size_t)(t + 2) * kstep; const char* b2 = last ? nB : cB + (size_t)(t + 2) * kstep;
            const char* a3 = a2 + kstep; const char* b3 = b2 + kstep;
            if (last && has_next) S.a_ready(nxt);
            PG8_LDB(B0, 0, 0); PG8_LDB(B1, 0, 1); PG8_SCHED; PG8_LDA(At, 0, 0); PG8_STAGE(PG8_SA(1, 1), a1 + hstep, voffA);
            PG8_WAIT_V(8); PG8_WAIT_L(0); PG8_BAR; PG8_MMA(0, 0, At, B0); PG8_MMA(0, 1, At, B1); PG8_BAR; PG8_SCHED;
            PG8_LDA(At, 0, 1); PG8_STAGE(PG8_SB(0, 0), b2, voffB); PG8_STAGE(PG8_SB(0, 1), b2 + hstep, voffB); PG8_STAGE(PG8_SA(0, 0), a2, voffA);
            PG8_WAIT_V(8); PG8_WAIT_L(0); PG8_BAR; PG8_MMA(1, 0, At, B0); PG8_MMA(1, 1, At, B1); PG8_BAR; PG8_SCHED;
            PG8_LDB(B0, 1, 0); PG8_LDB(B1, 1, 1); PG8_SCHED; PG8_LDA(At, 1, 0); PG8_STAGE(PG8_SA(0, 1), a2 + hstep, voffA);
            PG8_WAIT_V(8); PG8_WAIT_L(0); PG8_BAR; PG8_MMA(0, 0, At, B0); PG8_MMA(0, 1, At, B1); PG8_BAR; PG8_SCHED;
            PG8_LDA(At, 1, 1); PG8_STAGE(PG8_SB(1, 0), b3, voffB); PG8_STAGE(PG8_SB(1, 1), b3 + hstep, voffB); PG8_STAGE(PG8_SA(1, 0), a3, voffA);
            PG8_WAIT_V(8); PG8_WAIT_L(0); PG8_BAR; PG8_MMA(1, 0, At, B0); PG8_MMA(1, 1, At, B1); PG8_BAR; PG8_SCHED;
        }
        PG8_STAMP();
        if (wr == 0) PG8_BAR;
        if constexpr (!Epi::AFTER_DRAIN) { E(acc, cur, wr, wc, fr, fq); S.done(cur); }
        PG8_STAMP();
        if (!has_next) break;
#pragma unroll
        for (int a = 0; a < 2; ++a)
#pragma unroll
            for (int b = 0; b < 2; ++b)
#pragma unroll
                for (int m = 0; m < 4; ++m)
#pragma unroll
                    for (int n = 0; n < 2; ++n) acc[a][b][m][n] = (f32x4){0.f, 0.f, 0.f, 0.f};
        cur = nxt; cA = nA; cB = nB; ++ui;
        if (wr == 1) PG8_BAR;
    }
    PG8_WAIT_V(0);
    PG8_BAR;
    if constexpr (Epi::AFTER_DRAIN) { E.fused(acc, cur, wr, wc, fr, fq, lds, wid, lane); S.done(cur); }
    PG8_STAMP();
    if (STAMP && wid == 0) { stamps[lane] = lane < nts ? (((unsigned long long)(unsigned)ts_hi << 32) | (unsigned)ts_lo) : 0ull;
        if (lane == 62) stamps[62] = rt_entry; if (lane == 63) stamps[63] = (unsigned long long)wall_clock64(); }
#undef PG8_STAMP
#undef PG8_SA
#undef PG8_SB
#undef PG8_STAGE
#undef PG8_LDA
#undef PG8_LDB
#undef PG8_MMA
#undef PG8_WAIT_V
#undef PG8_WAIT_L
#undef PG8_BAR
#undef PG8_SCHED
}
}
#define LAS __attribute__((address_space(3)))
#define XB_TMO      128
#define XB_XCNT(j)  (256  + 64 * (j))
#define XB_XSUB(j)  (1280 + 64 * (j))
#define XB_XGEN(j)  (2304 + 64 * (j))
#define XB_TOP      3328
#define XB_TOPGEN   3392
#define XCD_BAR_WORDS 3456
#define XB_SPIN_CAP (1u << 18)

__device__ __forceinline__ unsigned xb_ld(unsigned* p)              { return __hip_atomic_load(p, __ATOMIC_RELAXED, __HIP_MEMORY_SCOPE_AGENT); }
__device__ __forceinline__ unsigned xb_add(unsigned* p, unsigned v) { return __hip_atomic_fetch_add(p, v, __ATOMIC_RELAXED, __HIP_MEMORY_SCOPE_AGENT); }
__device__ __forceinline__ unsigned xb_xcc_id() { return (unsigned)__builtin_amdgcn_s_getreg((3 << 11) | 20) & 0xFu; }
#define XB_SPIN(cond, bar) do { unsigned _sp = 0; while (cond) { __builtin_amdgcn_s_sleep(1); \
    if ((++_sp & 255u) == 0u) { if (xb_ld(&(bar)[XB_TMO])) break; if (_sp > XB_SPIN_CAP) { atomicAdd(&(bar)[XB_TMO], 1u); break; } } } } while (0)

struct XcdBarrier {
    unsigned* bar; unsigned x;
    volatile LAS unsigned* st;
};

__device__ __forceinline__ XcdBarrier xcd_barrier_post(unsigned* bar, volatile LAS unsigned* st) {
    XcdBarrier b; b.bar = bar; b.x = xb_xcc_id(); b.st = st;
    if (threadIdx.x == 0) (void)xb_add(&bar[XB_XCNT(b.x)], 1u);
    return b;
}
__device__ __forceinline__ void xcd_barrier_complete(unsigned* bar, unsigned x, unsigned& nloc, unsigned& nx) {
    const unsigned G = gridDim.x * gridDim.y * gridDim.z;
    unsigned sum, cnt, mine, sp = 0u;
    for (;;) {
        sum = 0u; cnt = 0u; mine = 0u;
#pragma unroll
        for (unsigned j = 0; j < 16; ++j) { const unsigned c = xb_ld(&bar[XB_XCNT(j)]); sum += c; cnt += (c > 0u) ? 1u : 0u; mine = (j == x) ? c : mine; }
        if (sum == G) break;
        __builtin_amdgcn_s_sleep(1);
        if ((++sp & 255u) == 0u) { if (xb_ld(&bar[XB_TMO])) break; if (sp > XB_SPIN_CAP) { atomicAdd(&bar[XB_TMO], 1u); break; } }
    }
    nloc = mine > 0u ? mine : 1u; nx = cnt > 0u ? cnt : 1u;
}

__device__ __forceinline__ void xcd_barrier(const XcdBarrier& b) {
    asm volatile("s_waitcnt vmcnt(0)" ::: "memory");
    __syncthreads();
    if (threadIdx.x == 0) {
        unsigned* bar = b.bar;
        __builtin_amdgcn_s_waitcnt(0);
        unsigned nloc = b.st[0], nx = b.st[1];
        if (nloc == 0u) { xcd_barrier_complete(bar, b.x, nloc, nx); b.st[0] = nloc; b.st[1] = nx; }
        const unsigned old = xb_add(&bar[XB_XSUB(b.x)], 1u);
        const unsigned gen = old / nloc;
        if (old + 1u == (gen + 1u) * nloc) {
            __builtin_amdgcn_fence(__ATOMIC_RELEASE, "agent");
            asm volatile("s_waitcnt vmcnt(0)" ::: "memory");
            const unsigned og = xb_add(&bar[XB_TOP], 1u);
            const unsigned tg = og / nx;
            if (og + 1u == (tg + 1u) * nx) xb_add(&bar[XB_TOPGEN], 1u);
            else XB_SPIN(xb_ld(&bar[XB_TOPGEN]) == tg, bar);
            __builtin_amdgcn_fence(__ATOMIC_ACQUIRE, "agent");
            xb_add(&bar[XB_XGEN(b.x)], 1u);
            asm volatile("s_waitcnt vmcnt(0)" ::: "memory");
        } else {
            XB_SPIN(xb_ld(&bar[XB_XGEN(b.x)]) == gen, bar);
            __builtin_amdgcn_fence(__ATOMIC_ACQUIRE, "agent");
            asm volatile("s_waitcnt vmcnt(0)" ::: "memory");
        }
    }
    __syncthreads();
}


using pg8::bf16_t; using pg8::bf16x8; using pg8::f32x4; using pg8::u32x4; using pg8::Unit;
typedef float f32x16 __attribute__((ext_vector_type(16)));
typedef unsigned u32x2 __attribute__((ext_vector_type(2)));
typedef float f32x2 __attribute__((ext_vector_type(2)));

constexpr int MP = 8192, MS = 1024, MT = 9216, DM = 2048, NZ = 5120, NINP = 5376, DFF = 5632, PLE = 256;
constexpr int LDS_BYTES = 131072 + 16;
constexpr size_t OFF_BAR = 0;
constexpr size_t OFF_WIN = 16384;
constexpr size_t OFF_WOUT = OFF_WIN + (size_t)NINP * DM * 2;
constexpr size_t OFF_WFI = OFF_WOUT + (size_t)DM * DM * 2;
constexpr size_t OFF_WFO = OFF_WFI + (size_t)2 * DFF * DM * 2;
constexpr size_t OFF_WPLE = OFF_WFO + (size_t)DM * DFF * 2;
constexpr size_t OFF_WGT = OFF_WPLE + (size_t)DM * PLE * 2;
constexpr size_t OFF_A0 = OFF_WGT + (size_t)DM * DM * 2;
constexpr size_t OFF_PB = OFF_A0 + (size_t)MT * DM * 2;
constexpr size_t OFF_ALOW = OFF_PB + (size_t)MT * PLE * 2;
constexpr size_t OFF_STAT = OFF_ALOW + (size_t)MT * 16 * 4;
constexpr size_t OFF_BIG = OFF_STAT + (size_t)MT * 2 * 4;
constexpr size_t OFF_Z = OFF_BIG;
constexpr size_t OFF_ORAW = OFF_Z + (size_t)MT * NZ * 2;
constexpr size_t OFF_MRAW = OFF_ORAW + (size_t)MT * 1024 * 4;
constexpr size_t OFF_IMG = OFF_BIG + (size_t)MT * DFF * 2 + (size_t)MT * DM * 4;
constexpr size_t WS_END = OFF_IMG + (size_t)4 * 1024 * 2048 * 4;
constexpr size_t OFF_ACT = OFF_BIG;
constexpr size_t OFF_GATEZ = OFF_BIG;
constexpr size_t OFF_PZ = OFF_BIG + (size_t)MT * DFF * 2;
constexpr size_t OUT_Y = 0, OUT_SP = (size_t)MT * DM, OUT_SS = OUT_SP + (size_t)4 * 4 * 128 * 256, OUT_VS = OUT_SS + (size_t)128 * 4 * 128 * 256;

struct Params {
    const float *x_prompt, *x_sample, *state_gla, *p_prompt, *p_sample, *g_mix, *w_in, *w_a2, *b_a, *g_gla_norm, *g_gmlp_ln, *b_gmlp_ln, *w_s, *b_s,
        *g_gmlp_out, *w_out, *g_ffn, *w_ffn_in, *w_ffn_out, *w_ple, *g_ple, *g_ple_gate, *w_ple_gate, *g_final;
    float* out;
    unsigned char* ws;
};

__device__ __forceinline__ unsigned pk2(float lo, float hi) { return pg8::cvt_pk_bf16(lo, hi); }
__device__ __forceinline__ bf16_t f2bf(float f) { return (bf16_t)(pk2(f, 0.f) & 0xffffu); }
__device__ __forceinline__ float bf2f(bf16_t b) { return __uint_as_float(((unsigned)b) << 16); }
__device__ __forceinline__ float bflo(unsigned w) { return __uint_as_float(w << 16); }
__device__ __forceinline__ float bfhi(unsigned w) { return __uint_as_float(w & 0xffff0000u); }
__device__ __forceinline__ f32x4 unpack4(u32x2 w) { return (f32x4){bflo(w.x), bfhi(w.x), bflo(w.y), bfhi(w.y)}; }
template <int CTRL> __device__ __forceinline__ float dpp_f(float v) { return __int_as_float(__builtin_amdgcn_update_dpp(0, __float_as_int(v), CTRL, 0xf, 0xf, true)); }
__device__ __forceinline__ float row16_sum(float v) {
    v += dpp_f<0xB1>(v); v += dpp_f<0x4E>(v); v += dpp_f<0x141>(v); v += dpp_f<0x140>(v); return v;
}
__device__ __forceinline__ float wave_sum(float v) {
    v = row16_sum(v);
    return (__int_as_float(__builtin_amdgcn_readlane(__float_as_int(v), 0)) + __int_as_float(__builtin_amdgcn_readlane(__float_as_int(v), 16))) + (__int_as_float(__builtin_amdgcn_readlane(__float_as_int(v), 32)) + __int_as_float(__builtin_amdgcn_readlane(__float_as_int(v), 48)));
}
__device__ __forceinline__ float sigmoid_f(float x) { return __builtin_amdgcn_rcpf(1.f + __expf(-x)); }
__device__ __forceinline__ float silu_f(float x) { return x * __builtin_amdgcn_rcpf(1.f + __expf(-x)); }
__device__ __forceinline__ float gelu_f(float x) { const float u = 1.5957691216f * (x + 0.044715f * x * x * x); return x * __builtin_amdgcn_rcpf(1.f + __expf(-u)); }
__device__ __forceinline__ float logsigmoid_f(float x) { return fminf(x, 0.f) - __logf(1.f + __expf(-fabsf(x))); }
template <class T> __device__ __forceinline__ T* opaque(T* p) { return p; }
__device__ __forceinline__ const f32x4* row_mid(const float* row, int lane) { return opaque((const f32x4*)row + lane + 256); }
__device__ __forceinline__ f32x4* row_mid(float* row, int lane) { return opaque((f32x4*)row + lane + 256); }
__device__ __forceinline__ int otid() { int t = threadIdx.x; asm volatile("" : "+v"(t)); return t; }
template <class T> __device__ __forceinline__ T ldnt(const T* p) { return __builtin_nontemporal_load(p); }
template <class T> __device__ __forceinline__ void stnt(T* p, T v) { __builtin_nontemporal_store(v, p); }
__device__ __forceinline__ void lds_wait() { asm volatile("s_waitcnt lgkmcnt(0)" ::: "memory"); }

struct EpiIn {
    static constexpr bool PERM = true, AFTER_DRAIN = false;
    bf16_t* Z; float* alow;
    __device__ __forceinline__ void operator()(const f32x4 (&acc)[2][2][4][2], const Unit& u, int wr, int wc, int fr, int fq) const {
        const int row0 = u.pm * 256 + wr * 64 + fr, pn = u.pn;
        if (pn == 20) {
            if (wc == 0 && fq < 2) {
#pragma unroll
                for (int ai = 0; ai < 2; ++ai)
#pragma unroll
                    for (int m = 0; m < 4; ++m) { float* p = alow + (size_t)(row0 + ai * 128 + m * 16) * 16 + 8 * fq; *(f32x4*)p = acc[ai][0][m][0]; *(f32x4*)(p + 4) = acc[ai][0][m][1]; }
            }
            return;
        }
        const int kind = pn < 8 ? 0 : (pn < 12 ? 1 : 2); const float qs = pn < 2 ? 0.08838834764831845f : 1.f;
#pragma unroll
        for (int ai = 0; ai < 2; ++ai)
#pragma unroll
            for (int m = 0; m < 4; ++m) { bf16_t* rowp = Z + (size_t)(row0 + ai * 128 + m * 16) * NZ + pn * 256 + wc * 32 + 8 * fq;
#pragma unroll
                for (int bj = 0; bj < 2; ++bj) { f32x4 v0 = acc[ai][bj][m][0], v1 = acc[ai][bj][m][1];
                    if (kind == 0) { v0 *= qs; v1 *= qs; }
                    else if (kind == 1) {
#pragma unroll
                        for (int j = 0; j < 4; ++j) { v0[j] = silu_f(v0[j]); v1[j] = silu_f(v1[j]); } }
                    else {
#pragma unroll
                        for (int j = 0; j < 4; ++j) { v0[j] = gelu_f(v0[j]); v1[j] = gelu_f(v1[j]); } }
                    u32x4 w; w.x = pk2(v0[0], v0[1]); w.y = pk2(v0[2], v0[3]); w.z = pk2(v1[0], v1[1]); w.w = pk2(v1[2], v1[3]);
                    *(u32x4*)(rowp + bj * 128) = w; } }
    }
};
struct EpiRes {
    static constexpr bool PERM = false, AFTER_DRAIN = false;
    const float* res_p; const float* res_s; float* out;
    __device__ __forceinline__ void operator()(const f32x4 (&acc)[2][2][4][2], const Unit& u, int wr, int wc, int fr, int fq) const {
        const int row0 = u.pm * 256 + wr * 64 + fr, col0 = u.pn * 256 + wc * 32 + 4 * fq;
#pragma unroll
        for (int ai = 0; ai < 2; ++ai)
#pragma unroll
            for (int m = 0; m < 4; ++m) { const int row = row0 + ai * 128 + m * 16;
                const float* rp = (row < MP ? res_p + (size_t)row * DM : res_s + (size_t)(row - MP) * DM) + col0; float* op = out + (size_t)row * DM + col0;
#pragma unroll
                for (int bj = 0; bj < 2; ++bj)
#pragma unroll
                    for (int n = 0; n < 2; ++n) { const f32x4 r = *(const f32x4*)(rp + bj * 128 + n * 16); *(f32x4*)(op + bj * 128 + n * 16) = acc[ai][bj][m][n] + r; } }
    }
};
struct EpiSwiglu {
    static constexpr bool PERM = true, AFTER_DRAIN = false;
    bf16_t* act;
    __device__ __forceinline__ void operator()(const f32x4 (&acc)[2][2][4][2], const Unit& u, int wr, int wc, int fr, int fq) const {
        const int row0 = u.pm * 256 + wr * 64 + fr, col0 = u.pn * 128 + wc * 32 + 8 * fq;
#pragma unroll
        for (int ai = 0; ai < 2; ++ai)
#pragma unroll
            for (int m = 0; m < 4; ++m) { float a[8];
#pragma unroll
                for (int n = 0; n < 2; ++n)
#pragma unroll
                    for (int j = 0; j < 4; ++j) a[n * 4 + j] = silu_f(acc[ai][0][m][n][j]) * acc[ai][1][m][n][j];
                u32x4 w; w.x = pk2(a[0], a[1]); w.y = pk2(a[2], a[3]); w.z = pk2(a[4], a[5]); w.w = pk2(a[6], a[7]);
                *(u32x4*)(act + (size_t)(row0 + ai * 128 + m * 16) * DFF + col0) = w; }
    }
};
struct EpiBfN {
    static constexpr bool PERM = false, AFTER_DRAIN = false;
    bf16_t* out;
    __device__ __forceinline__ void operator()(const f32x4 (&acc)[2][2][4][2], const Unit& u, int wr, int wc, int fr, int fq) const {
        const int row0 = u.pm * 256 + wr * 64 + fr, col0 = u.pn * 256 + wc * 32 + 4 * fq;
#pragma unroll
        for (int ai = 0; ai < 2; ++ai)
#pragma unroll
            for (int m = 0; m < 4; ++m) { bf16_t* op = out + (size_t)(row0 + ai * 128 + m * 16) * DM + col0;
#pragma unroll
                for (int bj = 0; bj < 2; ++bj)
#pragma unroll
                    for (int n = 0; n < 2; ++n) { const f32x4 v = acc[ai][bj][m][n]; u32x2 w; w.x = pk2(v[0], v[1]); w.y = pk2(v[2], v[3]); *(u32x2*)(op + bj * 128 + n * 16) = w; } }
    }
};
struct EpiPlain {
    static constexpr bool PERM = false, AFTER_DRAIN = false;
    float* out;
    __device__ __forceinline__ void operator()(const f32x4 (&acc)[2][2][4][2], const Unit& u, int wr, int wc, int fr, int fq) const {
        const int row0 = u.pm * 256 + wr * 64 + fr, col0 = u.pn * 256 + wc * 32 + 4 * fq;
#pragma unroll
        for (int ai = 0; ai < 2; ++ai)
#pragma unroll
            for (int m = 0; m < 4; ++m) { float* op = out + (size_t)(row0 + ai * 128 + m * 16) * DM + col0;
#pragma unroll
                for (int bj = 0; bj < 2; ++bj)
#pragma unroll
                    for (int n = 0; n < 2; ++n) *(f32x4*)(op + bj * 128 + n * 16) = acc[ai][bj][m][n]; }
    }
};

template <class Epi> __device__ __forceinline__ void run_gemm(LAS unsigned char* lds, const bf16_t* A, const bf16_t* Bt, int M, int N, int K, const Epi& E) {
    pg8::Gemm g; g.A = A; g.Bt = Bt; g.M = M; g.N = N; g.K = K; g.Klen = K;
    pg8::StaticOrder S; S.init(M, N, (int)gridDim.x, (int)blockIdx.x);
    pg8::gemm_phase<Epi, pg8::StaticOrder, false>(lds, g, S, E, nullptr);
}
struct SplitOrderK {
    int nN, G, c, klen, ns, kbase, ksoff;
    __device__ __forceinline__ bool next(int i, Unit& u) const { const int L = i * G + c; if (L >= 4 * ns * nN) return false;
        const int sp = L % ns, tile = L / ns; u.ks = ksoff + sp; u.pn = tile % nN; u.pm = 32 + tile / nN; u.koff = kbase + sp * klen; return true; }
    __device__ __forceinline__ void a_ready(const Unit&) const {}
    __device__ __forceinline__ void done(const Unit&) const {}
};
struct EpiPart {
    static constexpr bool PERM = false, AFTER_DRAIN = false;
    bf16_t* part;
    __device__ __forceinline__ void operator()(const f32x4 (&acc)[2][2][4][2], const Unit& u, int wr, int wc, int fr, int fq) const {
        const int row0 = (u.pm - 32) * 256 + wr * 64 + fr, col0 = u.pn * 256 + wc * 32 + 4 * fq; bf16_t* pb = part + (size_t)u.ks * MS * DM;
#pragma unroll
        for (int ai = 0; ai < 2; ++ai)
#pragma unroll
            for (int m = 0; m < 4; ++m) { bf16_t* op = pb + (size_t)(row0 + ai * 128 + m * 16) * DM + col0;
#pragma unroll
                for (int bj = 0; bj < 2; ++bj)
#pragma unroll
                    for (int n = 0; n < 2; ++n) { const f32x4 v = acc[ai][bj][m][n]; u32x2 w; w.x = pk2(v[0], v[1]); w.y = pk2(v[2], v[3]); *(u32x2*)(op + bj * 128 + n * 16) = w; } }
    }
};
__device__ __forceinline__ void run_split(LAS unsigned char* lds, const bf16_t* A, const bf16_t* Bt, int K, bf16_t* part, int ns, int klen, int kbase, int ksoff, int c) {
    pg8::Gemm g; g.A = A; g.Bt = Bt; g.M = MT; g.N = DM; g.K = K; g.Klen = klen;
    SplitOrderK S; S.nN = DM / 256; S.G = (int)gridDim.x; S.c = c; S.klen = klen; S.ns = ns; S.kbase = kbase; S.ksoff = ksoff;
    EpiPart P; P.part = part;
    pg8::gemm_phase<EpiPart, SplitOrderK, false>(lds, g, S, P, nullptr);
}
template <class Epi> __device__ __forceinline__ void run_gemm_n2048(LAS unsigned char* lds, const bf16_t* A, const bf16_t* Bt, int K, const Epi& E, bf16_t* part) {
    run_gemm(lds, A, Bt, MP, DM, K, E);
    run_split(lds, A, Bt, K, part, 8, K / 8, 0, 0, (int)blockIdx.x);
}

__device__ __forceinline__ void transpose_item(const float* W, int N, bf16_t* WT, int K, int k0, int n0_dst, int n0_src, int nvalid, LAS float* scr, int lane) {
    if (nvalid == 32) {
        const int c4 = (lane & 7) * 4, kr = lane >> 3; f32x4 v[8];
#pragma unroll
        for (int i = 0; i < 8; ++i) v[i] = ldnt((const f32x4*)(W + (size_t)(k0 + 8 * i + kr) * N + n0_src + c4));
#pragma unroll
        for (int i = 0; i < 8; ++i) { LAS float* d = scr + (8 * i + kr) * 33 + c4; d[0] = v[i][0]; d[1] = v[i][1]; d[2] = v[i][2]; d[3] = v[i][3]; }
    } else {
        const int j = lane & 31;
#pragma unroll 8
        for (int i = 0; i < 32; ++i) { const int kk = 2 * i + (lane >> 5); scr[kk * 33 + j] = (j < nvalid) ? ldnt(W + (size_t)(k0 + kk) * N + n0_src + j) : 0.f; }
    }
    lds_wait();
    const int c = lane & 7;
#pragma unroll
    for (int q = 0; q < 4; ++q) { const int n = (lane >> 3) + 8 * q; const LAS float* s = scr + (8 * c) * 33 + n;
        u32x4 o; o.x = pk2(s[0 * 33], s[1 * 33]); o.y = pk2(s[2 * 33], s[3 * 33]); o.z = pk2(s[4 * 33], s[5 * 33]); o.w = pk2(s[6 * 33], s[7 * 33]);
        *(u32x4*)(WT + (size_t)(n0_dst + n) * K + k0 + 8 * c) = o; }
    lds_wait();
}
struct Row8 { f32x4 v[8]; };
__device__ __forceinline__ void row_load_nt(Row8& a, const float* src, int lane) { const f32x4* sm = row_mid(src, lane);
#pragma unroll
    for (int j = 0; j < 8; ++j) a.v[j] = ldnt(sm + 64 * (j - 4)); }
__device__ __forceinline__ void row_load(Row8& a, const float* src, int lane) { const f32x4* sm = row_mid(src, lane);
#pragma unroll
    for (int j = 0; j < 8; ++j) a.v[j] = sm[64 * (j - 4)]; }
__device__ __forceinline__ void rms_finish_bf16(const Row8& a, const float* gain, bf16_t* dst, int lane) {
    float s = 0.f;
#pragma unroll
    for (int j = 0; j < 8; ++j) s += (a.v[j][0] * a.v[j][0] + a.v[j][1] * a.v[j][1]) + (a.v[j][2] * a.v[j][2] + a.v[j][3] * a.v[j][3]);
    const float rinv = rsqrtf(wave_sum(s) * (1.f / DM) + 1e-6f);
    const f32x4* gm = row_mid(gain, lane); u32x2* dm = (u32x2*)dst + lane;
#pragma unroll
    for (int j = 0; j < 8; ++j) { const f32x4 g = gm[64 * (j - 4)]; u32x2 o; o.x = pk2(a.v[j][0] * rinv * g[0], a.v[j][1] * rinv * g[1]); o.y = pk2(a.v[j][2] * rinv * g[2], a.v[j][3] * rinv * g[3]);
        dm[64 * j] = o; }
}
__device__ __forceinline__ void rms_row_bf16(const float* src, const float* gain, bf16_t* dst, int lane) { Row8 a; row_load(a, src, lane); rms_finish_bf16(a, gain, dst, lane); }
namespace cv { constexpr int I_IN = (DM / 64) * (NINP / 32), I_OUT = (DM / 64) * (DM / 32), I_FI = (DM / 64) * (2 * DFF / 32), I_FO = (DFF / 64) * (DM / 32), I_PLE = (PLE / 64) * (DM / 32), I_GT = I_OUT;
    constexpr int E_IN = I_IN, E_OUT = E_IN + I_OUT, E_FI = E_OUT + I_FI, E_FO = E_FI + I_FO, E_PLE = E_FO + I_PLE, E_GT = E_PLE + I_GT; }
__device__ __forceinline__ void convert_range(const Params& p, LAS unsigned char* lds, int lo, int hi, int gw, int NGW) {
    const int tid = otid(), lane = tid & 63, wave = tid >> 6;
    LAS float* scr = (LAS float*)(lds + wave * 8448);
    bf16_t* win = (bf16_t*)(p.ws + OFF_WIN); bf16_t* wout = (bf16_t*)(p.ws + OFF_WOUT); bf16_t* wfi = (bf16_t*)(p.ws + OFF_WFI);
    bf16_t* wfo = (bf16_t*)(p.ws + OFF_WFO); bf16_t* wple = (bf16_t*)(p.ws + OFF_WPLE); bf16_t* wgt = (bf16_t*)(p.ws + OFF_WGT);
    for (int it = lo + gw; it < hi; it += NGW) {
        int r = it;
        if (r < cv::E_IN) { const int nblk = NINP / 32, kb = r / nblk, nb = r % nblk, n0d = nb * 32; int src, nv;
            if (n0d < 3072) { src = n0d; nv = 32; } else if (n0d < 5120) { src = n0d + 16; nv = 32; } else if (n0d == 5120) { src = 3072; nv = 16; } else { src = 0; nv = 0; }
            transpose_item(p.w_in, 5136, win, DM, kb * 64, n0d, src, nv, scr, lane); continue; }
        if (r < cv::E_OUT) { r -= cv::E_IN; const int nblk = DM / 32, kb = r / nblk, nb = r % nblk; transpose_item(p.w_out, DM, wout, DM, kb * 64, nb * 32, nb * 32, 32, scr, lane); continue; }
        if (r < cv::E_FI) { r -= cv::E_OUT; const int nblk = 2 * DFF / 32, kb = r / nblk, nb = r % nblk, n0d = nb * 32, jb = n0d >> 8, within = n0d & 255, up = within >> 7, j0 = jb * 128 + (within & 127);
            transpose_item(p.w_ffn_in, 2 * DFF, wfi, DM, kb * 64, n0d, up * DFF + j0, 32, scr, lane); continue; }
        if (r < cv::E_FO) { r -= cv::E_FI; const int nblk = DM / 32, kb = r / nblk, nb = r % nblk; transpose_item(p.w_ffn_out, DM, wfo, DFF, kb * 64, nb * 32, nb * 32, 32, scr, lane); continue; }
        if (r < cv::E_PLE) { r -= cv::E_FO; const int nblk = DM / 32, kb = r / nblk, nb = r % nblk; transpose_item(p.w_ple, DM, wple, PLE, kb * 64, nb * 32, nb * 32, 32, scr, lane); continue; }
        { r -= cv::E_PLE; const int nblk = DM / 32, kb = r / nblk, nb = r % nblk; transpose_item(p.w_ple_gate, DM, wgt, DM, kb * 64, nb * 32, nb * 32, 32, scr, lane); }
    }
}
__device__ __forceinline__ void phase0(const Params& p, LAS unsigned char* lds) {
    const int tid = otid(), lane = tid & 63, wave = tid >> 6;
    const int gw = blockIdx.x * 8 + wave, NGW = gridDim.x * 8;
    convert_range(p, lds, 0, cv::E_IN, gw, NGW);
    bf16_t* a0 = (bf16_t*)(p.ws + OFF_A0); bf16_t* pb = (bf16_t*)(p.ws + OFF_PB);
    for (int r = gw; r < MT; r += 2 * NGW) {
        const int r2 = r + NGW; const bool has2 = r2 < MT; const int q2 = has2 ? r2 : r;
        const float* x1 = r < MP ? p.x_prompt + (size_t)r * DM : p.x_sample + (size_t)(r - MP) * DM; const float* x2 = q2 < MP ? p.x_prompt + (size_t)q2 * DM : p.x_sample + (size_t)(q2 - MP) * DM;
        const float* p1 = r < MP ? p.p_prompt + (size_t)r * PLE : p.p_sample + (size_t)(r - MP) * PLE; const float* p2 = q2 < MP ? p.p_prompt + (size_t)q2 * PLE : p.p_sample + (size_t)(q2 - MP) * PLE;
        Row8 a, b; row_load_nt(a, x1, lane); row_load_nt(b, x2, lane);
        const f32x4 pv1 = ldnt((const f32x4*)p1 + lane), pv2 = ldnt((const f32x4*)p2 + lane);
        rms_finish_bf16(a, p.g_mix, a0 + (size_t)r * DM, lane);
        { u32x2 o; o.x = pk2(pv1[0], pv1[1]); o.y = pk2(pv1[2], pv1[3]); ((u32x2*)(pb + (size_t)r * PLE))[lane] = o; }
        if (has2) { rms_finish_bf16(b, p.g_mix, a0 + (size_t)r2 * DM, lane);
            u32x2 o; o.x = pk2(pv2[0], pv2[1]); o.y = pk2(pv2[2], pv2[3]); ((u32x2*)(pb + (size_t)r2 * PLE))[lane] = o; }
    }
}

__device__ __forceinline__ f32x16 mfma32(bf16x8 a, bf16x8 b, f32x16 c) { return __builtin_amdgcn_mfma_f32_32x32x16_bf16(a, b, c, 0, 0, 0); }
__device__ __forceinline__ void mma32(f32x16& acc, const LAS bf16_t* A, int lda, const LAS bf16_t* B, int ldb, int kk, int lane) {
    const int r = lane & 31, h = lane >> 5; const LAS bf16_t* ap = A + r * lda + 8 * h; const LAS bf16_t* bp = B + r * ldb + 8 * h;
    for (int k = 0; k < kk; k += 16) { const bf16x8 a = *(const LAS bf16x8*)(ap + k); const bf16x8 b = *(const LAS bf16x8*)(bp + k); acc = mfma32(a, b, acc); }
}
constexpr int LQ = 136, LS = 72;
constexpr int R_QE = 0, R_KLT = 17408, R_ATT = 35840, R_DEC = 45056, IMG_BYTES = 45568, R_VT = 45568, R_QM = 82432, R_KM = 99840, R_ALOW = 117248, R_GSUM = 121344, R_BMID = 123392;
constexpr int IMG_V4 = IMG_BYTES / 16;

__device__ __forceinline__ void gla_prep(const Params& p, LAS unsigned char* lds, int rb, int h, int T) {
    const int tid = otid(), lane = tid & 63, wave = tid >> 6;
    const bf16_t* Z = (const bf16_t*)(p.ws + OFF_Z); const float* alowg = (const float*)(p.ws + OFF_ALOW);
    LAS bf16_t* Qe = (LAS bf16_t*)(lds + R_QE); LAS bf16_t* Qm = (LAS bf16_t*)(lds + R_QM); LAS bf16_t* Km = (LAS bf16_t*)(lds + R_KM);
    LAS bf16_t* KlT = (LAS bf16_t*)(lds + R_KLT); LAS bf16_t* ATT = (LAS bf16_t*)(lds + R_ATT); LAS float* DEC = (LAS float*)(lds + R_DEC);
    LAS float* alowL = (LAS float*)(lds + R_ALOW); LAS float* gsum = (LAS float*)(lds + R_GSUM); LAS float* bmidL = (LAS float*)(lds + R_BMID);
    const int c = tid & 127, tg = tid >> 7;
    float wa[16];
#pragma unroll
    for (int j = 0; j < 16; ++j) wa[j] = p.w_a2[j * 512 + h * 128 + c];
    const float ba = p.b_a[h * 128 + c];
    for (int idx = tid; idx < 1024; idx += 512) { const int t = idx >> 4; alowL[idx] = (t < T) ? alowg[(size_t)(rb + t) * 16 + (idx & 15)] : 0.f; }
    float qv[16], kv[16];
#pragma unroll
    for (int i = 0; i < 16; ++i) { const int t = tg * 16 + i; const bool ok = t < T; const bf16_t* zr = Z + (size_t)(rb + t) * NZ + h * 128 + c;
        qv[i] = ok ? bf2f(zr[0]) : 0.f; kv[i] = ok ? bf2f(zr[512]) : 0.f; }
    __syncthreads();
    float b[16]; float run = 0.f;
#pragma unroll
    for (int i = 0; i < 16; ++i) { const int t = tg * 16 + i; float pre = ba;
#pragma unroll
        for (int j4 = 0; j4 < 4; ++j4) { const f32x4 a4 = *(const LAS f32x4*)(alowL + t * 16 + j4 * 4); pre += a4[0] * wa[j4 * 4] + a4[1] * wa[j4 * 4 + 1] + a4[2] * wa[j4 * 4 + 2] + a4[3] * wa[j4 * 4 + 3]; }
        const float la = (t < T) ? logsigmoid_f(pre) * 0.0625f : 0.f; run += la; b[i] = run; }
    gsum[tg * 128 + c] = run;
    __syncthreads();
    const float g0 = gsum[c], g1 = gsum[128 + c], g2 = gsum[256 + c], g3 = gsum[384 + c];
    const float pref = tg == 0 ? 0.f : (tg == 1 ? g0 : (tg == 2 ? g0 + g1 : g0 + g1 + g2));
    const float blast = ((g0 + g1) + g2) + g3;
#pragma unroll
    for (int i = 0; i < 16; ++i) b[i] += pref;
    if (tg == 2) bmidL[c] = b[0];
    if (tg == 0) DEC[c] = __expf(blast);
    __syncthreads();
    const float bm = bmidL[c];
    {
        unsigned klp[8];
#pragma unroll
        for (int i = 0; i < 16; i += 2) {
            const int t = tg * 16 + i;
            Qe[t * LQ + c] = f2bf(qv[i] * __expf(b[i])); Qe[(t + 1) * LQ + c] = f2bf(qv[i + 1] * __expf(b[i + 1]));
            Qm[t * LQ + c] = f2bf(qv[i] * __expf(b[i] - bm)); Qm[(t + 1) * LQ + c] = f2bf(qv[i + 1] * __expf(b[i + 1] - bm));
            Km[t * LQ + c] = f2bf(kv[i] * __expf(bm - b[i])); Km[(t + 1) * LQ + c] = f2bf(kv[i + 1] * __expf(bm - b[i + 1]));
            klp[i >> 1] = pk2(kv[i] * __expf(blast - b[i]), kv[i + 1] * __expf(blast - b[i + 1]));
        }
        LAS u32x4* kd = (LAS u32x4*)(KlT + c * LS + tg * 16);
        kd[0] = (u32x4){klp[0], klp[1], klp[2], klp[3]}; kd[1] = (u32x4){klp[4], klp[5], klp[6], klp[7]};
    }
    __syncthreads();
    if (wave < 3) {
        const int si = wave >> 1, ti = wave == 0 ? 0 : 1, l31 = lane & 31, hh = lane >> 5;
        f32x16 o;
#pragma unroll
        for (int i = 0; i < 16; ++i) o[i] = 0.f;
        mma32(o, Km + si * 32 * LQ, LQ, Qm + ti * 32 * LQ, LQ, 128, lane);
        const int tl = ti * 32 + l31;
#pragma unroll
        for (int g = 0; g < 4; ++g) { const int s0 = si * 32 + 8 * g + 4 * hh; float a0 = o[4 * g], a1 = o[4 * g + 1], a2 = o[4 * g + 2], a3 = o[4 * g + 3];
            a0 = (s0 <= tl) ? a0 : 0.f; a1 = (s0 + 1 <= tl) ? a1 : 0.f; a2 = (s0 + 2 <= tl) ? a2 : 0.f; a3 = (s0 + 3 <= tl) ? a3 : 0.f;
            u32x2 w; w.x = pk2(a0, a1); w.y = pk2(a2, a3); *(LAS u32x2*)(ATT + tl * LS + s0) = w; }
    }
    __syncthreads();
}
struct VRegs { u32x4 r[4]; };
__device__ __forceinline__ void v_load(const Params& p, VRegs& v, int rb, int h, int T) {
    const int tid = otid(), s = tid & 63, vg = tid >> 6; const bf16_t* Z = (const bf16_t*)(p.ws + OFF_Z);
#pragma unroll
    for (int k = 0; k < 4; ++k) v.r[k] = (s < T) ? *(const u32x4*)(Z + (size_t)(rb + s) * NZ + 1024 + h * 256 + vg * 32 + 8 * k) : (u32x4){0u, 0u, 0u, 0u};
}
__device__ __forceinline__ void v_store_t(LAS unsigned char* lds, const VRegs& v) {
    const int tid = otid(), s = tid & 63, vg = tid >> 6; LAS bf16_t* VT = (LAS bf16_t*)(lds + R_VT) + (vg * 32) * LS + s;
#pragma unroll
    for (int k = 0; k < 4; ++k) {
        VT[(8 * k + 0) * LS] = (bf16_t)(v.r[k].x & 0xffffu); VT[(8 * k + 1) * LS] = (bf16_t)(v.r[k].x >> 16);
        VT[(8 * k + 2) * LS] = (bf16_t)(v.r[k].y & 0xffffu); VT[(8 * k + 3) * LS] = (bf16_t)(v.r[k].y >> 16);
        VT[(8 * k + 4) * LS] = (bf16_t)(v.r[k].z & 0xffffu); VT[(8 * k + 5) * LS] = (bf16_t)(v.r[k].z >> 16);
        VT[(8 * k + 6) * LS] = (bf16_t)(v.r[k].w & 0xffffu); VT[(8 * k + 7) * LS] = (bf16_t)(v.r[k].w >> 16); }
}
__device__ __forceinline__ void gla_step(const Params& p, LAS unsigned char* lds, f32x16 (&S)[4], int rb, int h, int T, int vb, int vtrow) {
    const int lane = otid() & 63, l31 = lane & 31, hh = lane >> 5;
    LAS bf16_t* Qe = (LAS bf16_t*)(lds + R_QE); LAS bf16_t* KlT = (LAS bf16_t*)(lds + R_KLT); LAS bf16_t* ATT = (LAS bf16_t*)(lds + R_ATT); LAS float* DEC = (LAS float*)(lds + R_DEC);
    LAS bf16_t* VT = (LAS bf16_t*)(lds + R_VT);
    bf16_t* oraw = (bf16_t*)(p.ws + OFF_ORAW);
    f32x16 Za[2], Zb[2];
#pragma unroll
    for (int tt = 0; tt < 2; ++tt)
#pragma unroll
        for (int i = 0; i < 16; ++i) { Za[tt][i] = 0.f; Zb[tt][i] = 0.f; }
    bf16x8 sa[4][2];
#pragma unroll
    for (int cb = 0; cb < 4; ++cb)
#pragma unroll
        for (int s = 0; s < 2; ++s) { u32x4 aw; aw.x = pk2(S[cb][8 * s], S[cb][8 * s + 1]); aw.y = pk2(S[cb][8 * s + 2], S[cb][8 * s + 3]); aw.z = pk2(S[cb][8 * s + 4], S[cb][8 * s + 5]); aw.w = pk2(S[cb][8 * s + 6], S[cb][8 * s + 7]);
            sa[cb][s] = __builtin_bit_cast(bf16x8, aw); }
    bf16x8 vt[4];
    const LAS bf16_t* vp = VT + (vtrow + l31) * LS + 8 * hh;
#pragma unroll
    for (int ks = 0; ks < 4; ++ks) vt[ks] = *(const LAS bf16x8*)(vp + 16 * ks);
#pragma unroll
    for (int cb = 0; cb < 4; ++cb)
#pragma unroll
        for (int g = 0; g < 4; ++g) { const f32x4 d = *(const LAS f32x4*)(DEC + cb * 32 + 8 * g + 4 * hh);
            S[cb][4 * g] *= d[0]; S[cb][4 * g + 1] *= d[1]; S[cb][4 * g + 2] *= d[2]; S[cb][4 * g + 3] *= d[3]; }
#pragma unroll
    for (int ks = 0; ks < 4; ++ks)
#pragma unroll
        for (int cb = 0; cb < 4; ++cb) { const bf16x8 a = *(const LAS bf16x8*)(KlT + (32 * cb + l31) * LS + 16 * ks + 8 * hh); S[cb] = mfma32(a, vt[ks], S[cb]); }
#pragma unroll
    for (int cb = 0; cb < 4; ++cb)
#pragma unroll
        for (int s = 0; s < 2; ++s)
#pragma unroll
            for (int tt = 0; tt < 2; ++tt) { const LAS bf16_t* qp = Qe + (32 * tt + l31) * LQ + 32 * cb + 16 * s + 4 * hh;
                const u32x2 q0 = *(const LAS u32x2*)qp, q1 = *(const LAS u32x2*)(qp + 8); const u32x4 bw = (u32x4){q0.x, q0.y, q1.x, q1.y};
                Za[tt] = mfma32(sa[cb][s], __builtin_bit_cast(bf16x8, bw), Za[tt]); }
#pragma unroll
    for (int ks = 0; ks < 4; ++ks)
#pragma unroll
        for (int tt = 0; tt < 2; ++tt) if (ks < 2 * (tt + 1)) { const bf16x8 bq = *(const LAS bf16x8*)(ATT + (32 * tt + l31) * LS + 16 * ks + 8 * hh); Zb[tt] = mfma32(vt[ks], bq, Zb[tt]); }
#pragma unroll
    for (int tt = 0; tt < 2; ++tt) { const int t = 32 * tt + l31;
        if (t < T) { bf16_t* op = oraw + (size_t)(rb + t) * 1024 + h * 256 + 32 * vb + 4 * hh;
#pragma unroll
            for (int g = 0; g < 4; ++g) { u32x2 w; w.x = pk2(Za[tt][4 * g] + Zb[tt][4 * g], Za[tt][4 * g + 1] + Zb[tt][4 * g + 1]); w.y = pk2(Za[tt][4 * g + 2] + Zb[tt][4 * g + 2], Za[tt][4 * g + 3] + Zb[tt][4 * g + 3]); *(u32x2*)(op + 8 * g) = w; } } }
}
__device__ __forceinline__ size_t s_index(int cb, int i, int hh, int wave, int l31) { return (size_t)(cb * 32 + (i & 3) + 8 * (i >> 2) + 4 * hh) * 256 + 32 * wave + l31; }

__device__ __forceinline__ void gla_prep_item(const Params& p, LAS unsigned char* lds, int chain, int ch) {
    const int b = chain >> 2, h = chain & 3;
    gla_prep(p, lds, b * 2048 + ch * 64, h, 64);
    u32x4* img = (u32x4*)(p.ws + OFF_IMG + (size_t)(chain * 32 + ch) * IMG_BYTES);
    for (int i = otid(); i < IMG_V4; i += 512) img[i] = ((const LAS u32x4*)lds)[i];
    __syncthreads();
}
constexpr int SG_TAB = 0, SG_ALOW = 20480, SG_PART = 24576;
__device__ __forceinline__ void gla_sample_pair(const Params& p, LAS unsigned char* lds, int item) {
    const int tid = otid(), lane = tid & 63, wave = tid >> 6, q = wave & 3, grp = wave >> 2, chain = item * 2 + grp;
    const int b = chain >> 2, h = chain & 3, rb = MP + b * 8;
    LAS float* tab = (LAS float*)(lds + SG_TAB + wave * 2560); LAS float* alw = (LAS float*)(lds + SG_ALOW + wave * 512); LAS float* part = (LAS float*)(lds + SG_PART);
    const bf16_t* Z = (const bf16_t*)(p.ws + OFF_Z); const float* alowg = (const float*)(p.ws + OFF_ALOW); bf16_t* oraw = (bf16_t*)(p.ws + OFF_ORAW);
    alw[lane] = alowg[(size_t)rb * 16 + lane]; alw[lane + 64] = alowg[(size_t)rb * 16 + 64 + lane];
    float qe[8][2], kv[8][2]; f32x4 V[8];
#pragma unroll
    for (int t = 0; t < 8; ++t) { const bf16_t* zr = Z + (size_t)(rb + t) * NZ; const unsigned qw = *(const unsigned*)(zr + h * 128 + 2 * lane), kw = *(const unsigned*)(zr + 512 + h * 128 + 2 * lane);
        const u32x2 vw = *(const u32x2*)(zr + 1024 + h * 256 + 4 * lane);
        qe[t][0] = bflo(qw); qe[t][1] = bfhi(qw); kv[t][0] = bflo(kw); kv[t][1] = bfhi(kw); V[t] = (f32x4){bflo(vw.x), bfhi(vw.x), bflo(vw.y), bfhi(vw.y)}; }
    float bc[8][2];
    {   f32x2 wa[16];
#pragma unroll
        for (int j = 0; j < 16; ++j) wa[j] = *(const f32x2*)(p.w_a2 + j * 512 + h * 128 + 2 * lane);
        const f32x2 ba = *(const f32x2*)(p.b_a + h * 128 + 2 * lane);
        lds_wait();
        float run0 = 0.f, run1 = 0.f;
#pragma unroll
        for (int t = 0; t < 8; ++t) { float p0 = ba.x, p1 = ba.y;
#pragma unroll
            for (int j4 = 0; j4 < 4; ++j4) { const f32x4 a4 = *(const LAS f32x4*)(alw + t * 16 + 4 * j4);
#pragma unroll
                for (int k = 0; k < 4; ++k) { p0 += a4[k] * wa[4 * j4 + k].x; p1 += a4[k] * wa[4 * j4 + k].y; } }
            run0 += logsigmoid_f(p0) * 0.0625f; run1 += logsigmoid_f(p1) * 0.0625f; bc[t][0] = run0; bc[t][1] = run1; } }
    float ki[8][2];
#pragma unroll
    for (int t = 0; t < 8; ++t) { qe[t][0] *= __expf(bc[t][0]); qe[t][1] *= __expf(bc[t][1]); ki[t][0] = kv[t][0] * __expf(-bc[t][0]); ki[t][1] = kv[t][1] * __expf(-bc[t][1]); }
    lds_wait();
#pragma unroll
    for (int t = 0; t < 8; ++t)
#pragma unroll
        for (int s = 0; s <= t; ++s) { const float a = wave_sum(qe[t][0] * ki[s][0] + qe[t][1] * ki[s][1]); if (lane == 0) alw[t * (t + 1) / 2 + s] = a; }
    if ((lane >> 4) == q) { const float e0 = __expf(bc[7][0]), e1 = __expf(bc[7][1]); LAS float* r0 = tab + (2 * lane - 32 * q) * 20; LAS float* r1 = r0 + 20;
        *(LAS f32x4*)(r0) = (f32x4){qe[0][0], qe[1][0], qe[2][0], qe[3][0]}; *(LAS f32x4*)(r0 + 4) = (f32x4){qe[4][0], qe[5][0], qe[6][0], qe[7][0]};
        *(LAS f32x4*)(r1) = (f32x4){qe[0][1], qe[1][1], qe[2][1], qe[3][1]}; *(LAS f32x4*)(r1 + 4) = (f32x4){qe[4][1], qe[5][1], qe[6][1], qe[7][1]};
        *(LAS f32x4*)(r0 + 8) = (f32x4){ki[0][0] * e0, ki[1][0] * e0, ki[2][0] * e0, ki[3][0] * e0}; *(LAS f32x4*)(r0 + 12) = (f32x4){ki[4][0] * e0, ki[5][0] * e0, ki[6][0] * e0, ki[7][0] * e0};
        *(LAS f32x4*)(r1 + 8) = (f32x4){ki[0][1] * e1, ki[1][1] * e1, ki[2][1] * e1, ki[3][1] * e1}; *(LAS f32x4*)(r1 + 12) = (f32x4){ki[4][1] * e1, ki[5][1] * e1, ki[6][1] * e1, ki[7][1] * e1};
        r0[16] = e0; r1[16] = e1; }
    lds_wait();
    f32x4 o[8];
#pragma unroll
    for (int t = 0; t < 8; ++t) o[t] = (f32x4){0.f, 0.f, 0.f, 0.f};
    const f32x4* S0 = (const f32x4*)(p.state_gla + (size_t)chain * 32768 + (size_t)(32 * q) * 256) + lane; f32x4* So = (f32x4*)(p.out + OUT_SS + (size_t)chain * 32768 + (size_t)(32 * q) * 256) + lane;
#pragma unroll 1
    for (int cc = 0; cc < 32; cc += 16) { f32x4 s[16];
#pragma unroll
        for (int u = 0; u < 16; ++u) s[u] = ldnt(S0 + (cc + u) * 64);
#pragma unroll
        for (int u = 0; u < 16; ++u) { const LAS float* row = tab + (cc + u) * 20; const f32x4 qa = *(const LAS f32x4*)row, qb = *(const LAS f32x4*)(row + 4), ka = *(const LAS f32x4*)(row + 8), kb = *(const LAS f32x4*)(row + 12); const float d = row[16];
            o[0] += qa[0] * s[u]; o[1] += qa[1] * s[u]; o[2] += qa[2] * s[u]; o[3] += qa[3] * s[u]; o[4] += qb[0] * s[u]; o[5] += qb[1] * s[u]; o[6] += qb[2] * s[u]; o[7] += qb[3] * s[u];
            f32x4 sn = d * s[u]; sn += ka[0] * V[0]; sn += ka[1] * V[1]; sn += ka[2] * V[2]; sn += ka[3] * V[3]; sn += kb[0] * V[4]; sn += kb[1] * V[5]; sn += kb[2] * V[6]; sn += kb[3] * V[7];
            stnt(So + (cc + u) * 64, sn); } }
#pragma unroll
    for (int t = 0; t < 8; ++t) *(LAS f32x4*)(part + (wave * 8 + t) * 256 + 4 * lane) = o[t];
    __syncthreads();
#pragma unroll
    for (int tt = 0; tt < 2; ++tt) { const int t = 2 * q + tt; f32x4 acc = (f32x4){0.f, 0.f, 0.f, 0.f};
#pragma unroll
        for (int w = 0; w < 4; ++w) acc += *(const LAS f32x4*)(part + ((grp * 4 + w) * 8 + t) * 256 + 4 * lane);
#pragma unroll
        for (int s = 0; s < 8; ++s) { const float a = (s <= t) ? alw[t * (t + 1) / 2 + s] : 0.f; acc += a * V[s]; }
        { u32x2 w; w.x = pk2(acc[0], acc[1]); w.y = pk2(acc[2], acc[3]); *(u32x2*)(oraw + (size_t)(rb + t) * 1024 + h * 256 + 4 * lane) = w; } }
    __syncthreads();
}
struct VRegs2 { u32x4 r[2]; };
__device__ __forceinline__ void v_load_half(const Params& p, VRegs2& v, int rb, int h, int vhalf) {
    const int tid = otid(), s = tid & 63, vg = tid >> 6; const bf16_t* Z = (const bf16_t*)(p.ws + OFF_Z);
#pragma unroll
    for (int k = 0; k < 2; ++k) v.r[k] = *(const u32x4*)(Z + (size_t)(rb + s) * NZ + 1024 + h * 256 + vhalf * 128 + vg * 16 + 8 * k);
}
__device__ __forceinline__ void v_store_half_t(LAS unsigned char* lds, const VRegs2& v) {
    const int tid = otid(), s = tid & 63, vg = tid >> 6; LAS bf16_t* VT = (LAS bf16_t*)(lds + R_VT) + (vg * 16) * LS + s;
#pragma unroll
    for (int k = 0; k < 2; ++k) {
        VT[(8 * k + 0) * LS] = (bf16_t)(v.r[k].x & 0xffffu); VT[(8 * k + 1) * LS] = (bf16_t)(v.r[k].x >> 16);
        VT[(8 * k + 2) * LS] = (bf16_t)(v.r[k].y & 0xffffu); VT[(8 * k + 3) * LS] = (bf16_t)(v.r[k].y >> 16);
        VT[(8 * k + 4) * LS] = (bf16_t)(v.r[k].z & 0xffffu); VT[(8 * k + 5) * LS] = (bf16_t)(v.r[k].z >> 16);
        VT[(8 * k + 6) * LS] = (bf16_t)(v.r[k].w & 0xffffu); VT[(8 * k + 7) * LS] = (bf16_t)(v.r[k].w >> 16); }
}
constexpr int CH_BUF = 64000;
template <int NTHR> __device__ __forceinline__ void chain_stage(const Params& p, LAS unsigned char* buf, const u32x4* img, int rb, int h, int vhalf, int t) {
    const bf16_t* Z = (const bf16_t*)(p.ws + OFF_Z);
    constexpr int NI = (IMG_V4 + NTHR - 1) / NTHR, NV = 512 / NTHR;
    u32x4 im[NI], v0[NV], v1[NV];
#pragma unroll
    for (int k = 0; k < NI; ++k) { const int i = t + NTHR * k; im[k] = (i < IMG_V4) ? img[i] : (u32x4){0u, 0u, 0u, 0u}; }
#pragma unroll
    for (int k = 0; k < NV; ++k) { const int e = t + NTHR * k, s = e & 63, vg = e >> 6; const bf16_t* zp = Z + (size_t)(rb + s) * NZ + 1024 + h * 256 + vhalf * 128 + vg * 16; v0[k] = *(const u32x4*)zp; v1[k] = *(const u32x4*)(zp + 8); }
#pragma unroll
    for (int k = 0; k < NI; ++k) { const int i = t + NTHR * k; if (i < IMG_V4) ((LAS u32x4*)buf)[i] = im[k]; }
#pragma unroll
    for (int k = 0; k < NV; ++k) { const int e = t + NTHR * k, s = e & 63, vg = e >> 6; const u32x4 r0 = v0[k], r1 = v1[k];
        LAS bf16_t* VT = (LAS bf16_t*)(buf + R_VT) + (vg * 16) * LS + s;
        VT[0 * LS] = (bf16_t)(r0.x & 0xffffu); VT[1 * LS] = (bf16_t)(r0.x >> 16); VT[2 * LS] = (bf16_t)(r0.y & 0xffffu); VT[3 * LS] = (bf16_t)(r0.y >> 16);
        VT[4 * LS] = (bf16_t)(r0.z & 0xffffu); VT[5 * LS] = (bf16_t)(r0.z >> 16); VT[6 * LS] = (bf16_t)(r0.w & 0xffffu); VT[7 * LS] = (bf16_t)(r0.w >> 16);
        VT[8 * LS] = (bf16_t)(r1.x & 0xffffu); VT[9 * LS] = (bf16_t)(r1.x >> 16); VT[10 * LS] = (bf16_t)(r1.y & 0xffffu); VT[11 * LS] = (bf16_t)(r1.y >> 16);
        VT[12 * LS] = (bf16_t)(r1.z & 0xffffu); VT[13 * LS] = (bf16_t)(r1.z >> 16); VT[14 * LS] = (bf16_t)(r1.w & 0xffffu); VT[15 * LS] = (bf16_t)(r1.w >> 16); }
}
__device__ __forceinline__ void gla_chain_item(const Params& p, LAS unsigned char* lds, int chain, int vhalf) {
    const int tid = otid(), lane = tid & 63, wave = tid >> 6, l31 = lane & 31, hh = lane >> 5;
    const int b = chain >> 2, h = chain & 3, vb = vhalf * 4 + (wave & 3);
    f32x16 S[4];
#pragma unroll
    for (int cb = 0; cb < 4; ++cb)
#pragma unroll
        for (int i = 0; i < 16; ++i) S[cb][i] = 0.f;
    const u32x4* img = (const u32x4*)(p.ws + OFF_IMG + (size_t)(chain * 32) * IMG_BYTES);
    chain_stage<512>(p, lds, img, b * 2048, h, vhalf, tid);
    __syncthreads();
#pragma unroll 1
    for (int ch = 0; ch < 32; ++ch) {
        const int rb = b * 2048 + ch * 64;
        if (wave >= 4) { if (ch + 1 < 32) chain_stage<256>(p, lds + ((ch + 1) & 1) * CH_BUF, img + (size_t)(ch + 1) * IMG_V4, rb + 64, h, vhalf, tid - 256); }
        else gla_step(p, lds + (ch & 1) * CH_BUF, S, rb, h, 64, vb, 32 * wave);
        __syncthreads();
    }
    if (wave < 4) {
        float* Sout = p.out + OUT_SP + (size_t)chain * 32768;
#pragma unroll
        for (int cb = 0; cb < 4; ++cb)
#pragma unroll
            for (int i = 0; i < 16; ++i) Sout[s_index(cb, i, hh, vb, l31)] = S[cb][i];
    }
}

constexpr int M_W = 0, M_V = 34816, M_STAT = 69632;
__device__ __forceinline__ void gmlp_item(const Params& p, LAS unsigned char* lds, int rowbase, int T, int g, float* vs_out) {
    const int tid = otid(), lane = tid & 63, wave = tid >> 6;
    const bf16_t* Z = (const bf16_t*)(p.ws + OFF_Z); bf16_t* mraw = (bf16_t*)(p.ws + OFF_MRAW);
    LAS bf16_t* LW = (LAS bf16_t*)(lds + M_W); LAS bf16_t* LV = (LAS bf16_t*)(lds + M_V); LAS float* stat = (LAS float*)(lds + M_STAT);
    if (tid < 128) { const f32x2 st = (tid < T) ? *(const f32x2*)((const float*)(p.ws + OFF_STAT) + (size_t)(rowbase + tid) * 2) : (f32x2){0.f, 0.f}; stat[2 * tid] = st.x; stat[2 * tid + 1] = st.y; }
    for (int idx = tid; idx < 4096; idx += 512) { const int t = idx >> 5, s4 = (idx & 31) * 4; const f32x4 w = *(const f32x4*)(p.w_s + ((size_t)g * 128 + t) * 128 + s4);
        u32x2 o; o.x = pk2(s4 <= t ? w[0] : 0.f, s4 + 1 <= t ? w[1] : 0.f); o.y = pk2(s4 + 2 <= t ? w[2] : 0.f, s4 + 3 <= t ? w[3] : 0.f);
        *(LAS u32x2*)(LW + t * LQ + s4) = o; }
    __syncthreads();
    { const int s = tid & 127, dq = tid >> 7; const float mean = stat[2 * s], rstd = stat[2 * s + 1];
#pragma unroll
        for (int ps = 0; ps < 4; ++ps) { const int d8 = (dq * 4 + ps) * 8; float vn[8];
            if (s < T) { const u32x4 r = *(const u32x4*)(Z + (size_t)(rowbase + s) * NZ + 4096 + g * 128 + d8);
                const float x[8] = {bflo(r.x), bfhi(r.x), bflo(r.y), bfhi(r.y), bflo(r.z), bfhi(r.z), bflo(r.w), bfhi(r.w)};
                const f32x4 ga = *(const f32x4*)(p.g_gmlp_ln + g * 128 + d8), gb = *(const f32x4*)(p.g_gmlp_ln + g * 128 + d8 + 4);
                const f32x4 ba = *(const f32x4*)(p.b_gmlp_ln + g * 128 + d8), bb = *(const f32x4*)(p.b_gmlp_ln + g * 128 + d8 + 4);
#pragma unroll
                for (int j = 0; j < 4; ++j) { vn[j] = (x[j] - mean) * rstd * ga[j] + ba[j]; vn[4 + j] = (x[4 + j] - mean) * rstd * gb[j] + bb[j]; }
                if (vs_out) { float* vp = vs_out + (size_t)s * 1024 + g * 128 + d8; *(f32x4*)vp = (f32x4){vn[0], vn[1], vn[2], vn[3]}; *(f32x4*)(vp + 4) = (f32x4){vn[4], vn[5], vn[6], vn[7]}; }
            } else {
#pragma unroll
                for (int j = 0; j < 8; ++j) vn[j] = 0.f;
            }
#pragma unroll
            for (int j = 0; j < 8; ++j) LV[(d8 + j) * LQ + s] = f2bf(vn[j]); } }
    __syncthreads();
#pragma unroll 1
    for (int q = 0; q < 2; ++q) { const int id = wave * 2 + q, ti = id >> 2, di = id & 3;
        if (ti * 32 < T) { f32x16 acc;
#pragma unroll
            for (int i = 0; i < 16; ++i) acc[i] = 0.f;
            mma32(acc, LW + ti * 32 * LQ, LQ, LV + di * 32 * LQ, LQ, (ti + 1) * 32, lane);
            const int d = di * 32 + (lane & 31);
#pragma unroll
            for (int i = 0; i < 16; ++i) { const int t = ti * 32 + (i & 3) + 8 * (i >> 2) + 4 * (lane >> 5);
                if (t < T) { const float uval = bf2f(Z[(size_t)(rowbase + t) * NZ + 3072 + g * 128 + d]);
                    mraw[(size_t)(rowbase + t) * 1024 + g * 128 + d] = f2bf(uval * (acc[i] + p.b_s[g * 128 + t])); } } } }
    __syncthreads();
}

__device__ __forceinline__ void gmlp_sample_item(const Params& p, int b) {
    const int tid = otid(), d2 = tid * 2, g = __builtin_amdgcn_readfirstlane(tid >> 6), rb = MP + b * 8;
    const bf16_t* Z = (const bf16_t*)(p.ws + OFF_Z); bf16_t* mraw = (bf16_t*)(p.ws + OFF_MRAW); const float* st = (const float*)(p.ws + OFF_STAT) + (size_t)rb * 2;
    float* vs_out = p.out + OUT_VS + (size_t)b * 8 * 1024;
    const f32x2 ga = *(const f32x2*)(p.g_gmlp_ln + d2), be = *(const f32x2*)(p.b_gmlp_ln + d2);
    unsigned xv[8], uv[8];
#pragma unroll
    for (int s_ = 0; s_ < 8; ++s_) { xv[s_] = *(const unsigned*)(Z + (size_t)(rb + s_) * NZ + 4096 + d2); uv[s_] = *(const unsigned*)(Z + (size_t)(rb + s_) * NZ + 3072 + d2); }
    float v0[8], v1[8];
#pragma unroll
    for (int s_ = 0; s_ < 8; ++s_) { const float mean = st[2 * s_], rstd = st[2 * s_ + 1];
        v0[s_] = (bflo(xv[s_]) - mean) * rstd * ga.x + be.x; v1[s_] = (bfhi(xv[s_]) - mean) * rstd * ga.y + be.y;
        *(f32x2*)(vs_out + (size_t)s_ * 1024 + d2) = (f32x2){v0[s_], v1[s_]}; }
    const float* wg = p.w_s + (size_t)g * 128 * 128; const float* bs = p.b_s + g * 128;
#pragma unroll
    for (int t = 0; t < 8; ++t) { float m0 = bs[t], m1 = m0;
#pragma unroll
        for (int s_ = 0; s_ <= t; ++s_) { const float w = wg[t * 128 + s_]; m0 += w * v0[s_]; m1 += w * v1[s_]; }
        *(unsigned*)(mraw + (size_t)(rb + t) * 1024 + d2) = pk2(bflo(uv[t]) * m0, bfhi(uv[t]) * m1); }
}
__device__ __forceinline__ void phase2a(const Params& p, LAS unsigned char* lds) {
    {   const int tid = otid(), lane = tid & 63, gw = blockIdx.x * 8 + (tid >> 6), NGW = gridDim.x * 8;
        const bf16_t* Z = (const bf16_t*)(p.ws + OFF_Z); float* st = (float*)(p.ws + OFF_STAT);
        for (int r = gw; r < MT; r += NGW) {
            const bf16_t* zr = Z + (size_t)r * NZ + 4096; const u32x4 r0 = *(const u32x4*)(zr + lane * 8), r1 = *(const u32x4*)(zr + 512 + lane * 8);
            const float x[16] = {bflo(r0.x), bfhi(r0.x), bflo(r0.y), bfhi(r0.y), bflo(r0.z), bfhi(r0.z), bflo(r0.w), bfhi(r0.w), bflo(r1.x), bfhi(r1.x), bflo(r1.y), bfhi(r1.y), bflo(r1.z), bfhi(r1.z), bflo(r1.w), bfhi(r1.w)};
            float s = 0.f;
#pragma unroll
            for (int j = 0; j < 16; ++j) s += x[j];
            const float mean = wave_sum(s) * (1.f / 1024.f); float q = 0.f;
#pragma unroll
            for (int j = 0; j < 16; ++j) { const float d = x[j] - mean; q += d * d; }
            const float rstd = rsqrtf(wave_sum(q) * (1.f / 1024.f) + 1e-6f);
            if (lane == 0) *(f32x2*)(st + (size_t)r * 2) = (f32x2){mean, rstd};
        }
    }
    for (int j = blockIdx.x; j < 512; j += gridDim.x) gla_prep_item(p, lds, j >> 5, j & 31);
    for (int j = blockIdx.x; j < 256; j += gridDim.x) gla_sample_pair(p, lds, j);
    { const int gw = blockIdx.x * 8 + (otid() >> 6), NGW = gridDim.x * 8; convert_range(p, lds, cv::E_IN, cv::E_OUT, gw, NGW); convert_range(p, lds, cv::E_FO, cv::E_PLE, gw, NGW); }
}
__device__ __forceinline__ void phase2c(const Params& p, LAS unsigned char* lds) {
    const int nb = gridDim.x, bid = blockIdx.x;
    constexpr int NCH = 32, N_GP = 512, N_GS = 0, N_MS = 128;
    const int nlb = nb > 2 * NCH ? NCH : (nb > 1 ? nb / 2 : 0);
    if (bid < nlb || nlb == 0) { for (int j = (nlb ? bid : 0); j < NCH; j += (nlb ? nlb : 1)) gla_chain_item(p, lds, j >> 1, j & 1); }
    if (bid >= nlb) {
        const int ob = bid - nlb, onb = nb - nlb;
        for (int j = ob; j < N_GP + N_GS + N_MS; j += onb) {
            if (j < N_GP) gmlp_item(p, lds, (j >> 3) * 128, 128, j & 7, nullptr);
            else gmlp_sample_item(p, j - N_GP - N_GS);
        }
        __syncthreads();
        convert_range(p, lds, cv::E_OUT, cv::E_FI, ob * 8 + (otid() >> 6), onb * 8);
    }
}

struct Mix10 { f32x4 o[4], m[4]; u32x4 r0, r1; };
__device__ __forceinline__ void mix_load(Mix10& a, const Params& p, int r, int col) {
    const bf16_t* Z = (const bf16_t*)(p.ws + OFF_Z); const bf16_t* oraw = (const bf16_t*)(p.ws + OFF_ORAW); const bf16_t* mraw = (const bf16_t*)(p.ws + OFF_MRAW);
#pragma unroll
    for (int j = 0; j < 2; ++j) { const u32x4 ow = ldnt((const u32x4*)(oraw + (size_t)r * 1024 + col + 8 * j)), mw = ldnt((const u32x4*)(mraw + (size_t)r * 1024 + col + 8 * j));
        a.o[2 * j] = (f32x4){bflo(ow.x), bfhi(ow.x), bflo(ow.y), bfhi(ow.y)}; a.o[2 * j + 1] = (f32x4){bflo(ow.z), bfhi(ow.z), bflo(ow.w), bfhi(ow.w)};
        a.m[2 * j] = (f32x4){bflo(mw.x), bfhi(mw.x), bflo(mw.y), bfhi(mw.y)}; a.m[2 * j + 1] = (f32x4){bflo(mw.z), bfhi(mw.z), bflo(mw.w), bfhi(mw.w)}; }
    a.r0 = ldnt((const u32x4*)(Z + (size_t)r * NZ + 2048 + col)); a.r1 = ldnt((const u32x4*)(Z + (size_t)r * NZ + 2048 + col + 8));
}
__device__ __forceinline__ void mix_finish(const Mix10& a, const Params& p, int r, int col) {
    bf16_t* cat = (bf16_t*)(p.ws + OFF_A0);
    { float s = 0.f;
#pragma unroll
        for (int j = 0; j < 4; ++j) s += (a.o[j][0] * a.o[j][0] + a.o[j][1] * a.o[j][1]) + (a.o[j][2] * a.o[j][2] + a.o[j][3] * a.o[j][3]);
        s = row16_sum(s);
        const float rinv = rsqrtf(s * (1.f / 256.f) + 1e-6f);
        const float sr[16] = {bflo(a.r0.x), bfhi(a.r0.x), bflo(a.r0.y), bfhi(a.r0.y), bflo(a.r0.z), bfhi(a.r0.z), bflo(a.r0.w), bfhi(a.r0.w), bflo(a.r1.x), bfhi(a.r1.x), bflo(a.r1.y), bfhi(a.r1.y), bflo(a.r1.z), bfhi(a.r1.z), bflo(a.r1.w), bfhi(a.r1.w)};
        unsigned w[8];
#pragma unroll
        for (int j = 0; j < 4; ++j) { const f32x4 g = *(const f32x4*)(p.g_gla_norm + col + 4 * j);
            w[2 * j] = pk2(a.o[j][0] * rinv * g[0] * sr[4 * j], a.o[j][1] * rinv * g[1] * sr[4 * j + 1]); w[2 * j + 1] = pk2(a.o[j][2] * rinv * g[2] * sr[4 * j + 2], a.o[j][3] * rinv * g[3] * sr[4 * j + 3]); }
        u32x4* dp = (u32x4*)(cat + (size_t)r * DM + col); dp[0] = (u32x4){w[0], w[1], w[2], w[3]}; dp[1] = (u32x4){w[4], w[5], w[6], w[7]}; }
    { float s = 0.f;
#pragma unroll
        for (int j = 0; j < 4; ++j) s += (a.m[j][0] * a.m[j][0] + a.m[j][1] * a.m[j][1]) + (a.m[j][2] * a.m[j][2] + a.m[j][3] * a.m[j][3]);
        const float rinv = rsqrtf(wave_sum(s) * (1.f / 1024.f) + 1e-6f);
        unsigned w[8];
#pragma unroll
        for (int j = 0; j < 4; ++j) { const f32x4 g = *(const f32x4*)(p.g_gmlp_out + col + 4 * j);
            w[2 * j] = pk2(a.m[j][0] * rinv * g[0], a.m[j][1] * rinv * g[1]); w[2 * j + 1] = pk2(a.m[j][2] * rinv * g[2], a.m[j][3] * rinv * g[3]); }
        u32x4* dp = (u32x4*)(cat + (size_t)r * DM + 1024 + col); dp[0] = (u32x4){w[0], w[1], w[2], w[3]}; dp[1] = (u32x4){w[4], w[5], w[6], w[7]}; }
}
__device__ __forceinline__ void phase2b(const Params& p) {
    const int lane = otid() & 63, gw = blockIdx.x * 8 + (otid() >> 6), NGW = gridDim.x * 8, col = lane * 16;
    for (int r = gw; r < MT; r += 2 * NGW) {
        const int r2 = r + NGW; const bool has2 = r2 < MT;
        Mix10 a, b; mix_load(a, p, r, col); mix_load(b, p, has2 ? r2 : r, col);
        mix_finish(a, p, r, col);
        if (has2) mix_finish(b, p, r2, col);
    }
}
template <int NS> __device__ __forceinline__ void phase_norm(const Params& p, const float* gain, const float* base_s) {
    const int lane = otid() & 63, gw = blockIdx.x * 8 + (otid() >> 6), NGW = gridDim.x * 8; bf16_t* a0 = (bf16_t*)(p.ws + OFF_A0); const bf16_t* part = (const bf16_t*)(p.ws + OFF_IMG);
    for (int r = gw; r < MP; r += 4 * NGW) {
        const int r2 = r + NGW, r3 = r + 2 * NGW, r4 = r + 3 * NGW; const bool h2 = r2 < MP, h3 = r3 < MP, h4 = r4 < MP;
        Row8 a, b, c4, d; row_load_nt(a, p.out + OUT_Y + (size_t)r * DM, lane); row_load_nt(b, p.out + OUT_Y + (size_t)(h2 ? r2 : r) * DM, lane);
        row_load_nt(c4, p.out + OUT_Y + (size_t)(h3 ? r3 : r) * DM, lane); row_load_nt(d, p.out + OUT_Y + (size_t)(h4 ? r4 : r) * DM, lane);
        rms_finish_bf16(a, gain, a0 + (size_t)r * DM, lane);
        if (h2) rms_finish_bf16(b, gain, a0 + (size_t)r2 * DM, lane);
        if (h3) rms_finish_bf16(c4, gain, a0 + (size_t)r3 * DM, lane);
        if (h4) rms_finish_bf16(d, gain, a0 + (size_t)r4 * DM, lane);
    }
    for (int r = MP + gw; r < MT; r += NGW) {
        f32x4 v[8]; float s = 0.f; const f32x4* sm = row_mid(base_s + (size_t)(r - MP) * DM, lane); const f32x4* gm = row_mid(gain, lane);
        const u32x2* pm0 = (const u32x2*)(part + (size_t)(r - MP) * DM) + lane; f32x4* om = row_mid(p.out + OUT_Y + (size_t)r * DM, lane);
#pragma unroll
        for (int j = 0; j < 8; ++j) v[j] = sm[64 * (j - 4)];
#pragma unroll 4
        for (int k = 0; k < NS; ++k) { const u32x2* pk = pm0 + (size_t)k * (MS * DM / 4);
#pragma unroll
            for (int j = 0; j < 8; ++j) v[j] += unpack4(pk[64 * j]); }
#pragma unroll
        for (int j = 0; j < 8; ++j) { om[64 * (j - 4)] = v[j]; s += (v[j][0] * v[j][0] + v[j][1] * v[j][1]) + (v[j][2] * v[j][2] + v[j][3] * v[j][3]); }
        const float rinv = rsqrtf(wave_sum(s) * (1.f / DM) + 1e-6f);
        u32x2* dm = (u32x2*)(a0 + (size_t)r * DM) + lane;
#pragma unroll
        for (int j = 0; j < 8; ++j) { const f32x4 g = gm[64 * (j - 4)]; u32x2 o; o.x = pk2(v[j][0] * rinv * g[0], v[j][1] * rinv * g[1]); o.y = pk2(v[j][2] * rinv * g[2], v[j][3] * rinv * g[3]);
            dm[64 * j] = o; }
    }
}
#define P7_TAIL() \
        float s = 0.f; \
        _Pragma("unroll") for (int j = 0; j < 8; ++j) s += (v.v[j][0] * v.v[j][0] + v.v[j][1] * v.v[j][1]) + (v.v[j][2] * v.v[j][2] + v.v[j][3] * v.v[j][3]); \
        const float rp = rsqrtf(wave_sum(s) * (1.f / DM) + 1e-6f); float s3 = 0.f; \
        const f32x4* gpm = row_mid(p.g_ple, lane); \
        _Pragma("unroll") for (int j = 0; j < 8; ++j) { const f32x4 g = gpm[64 * (j - 4)]; \
            _Pragma("unroll") for (int k = 0; k < 4; ++k) { const float h3 = hh.v[j][k] + v.v[j][k] * rp * g[k] * sigmoid_f(z.v[j][k]); v.v[j][k] = h3; s3 += h3 * h3; } } \
        const float r3 = rsqrtf(wave_sum(s3) * (1.f / DM) + 1e-6f); \
        const f32x4* gfm = row_mid(p.g_final, lane); \
        _Pragma("unroll") for (int j = 0; j < 8; ++j) { const f32x4 g = gfm[64 * (j - 4)]; stnt(om + 64 * (j - 4), (f32x4){v.v[j][0] * r3 * g[0], v.v[j][1] * r3 * g[1], v.v[j][2] * r3 * g[2], v.v[j][3] * r3 * g[3]}); }
__device__ __forceinline__ void phase7(const Params& p) {
    const int lane = otid() & 63, gw = blockIdx.x * 8 + (otid() >> 6), NGW = gridDim.x * 8;
    const bf16_t* gz = (const bf16_t*)(p.ws + OFF_GATEZ); const bf16_t* pz = (const bf16_t*)(p.ws + OFF_PZ);
#pragma unroll 1
    for (int r = gw; r < MP; r += NGW) {
        f32x4* om = row_mid(p.out + OUT_Y + (size_t)r * DM, lane);
        const u32x2* pzr = (const u32x2*)(pz + (size_t)r * DM) + lane; const u32x2* zb = (const u32x2*)(gz + (size_t)r * DM) + lane;
        Row8 v, hh, z;
#pragma unroll
        for (int j = 0; j < 8; ++j) { const u32x2 w = ldnt(pzr + 64 * j), zw = ldnt(zb + 64 * j); v.v[j] = (f32x4){bflo(w.x), bfhi(w.x), bflo(w.y), bfhi(w.y)}; z.v[j] = (f32x4){bflo(zw.x), bfhi(zw.x), bflo(zw.y), bfhi(zw.y)}; hh.v[j] = ldnt(om + 64 * (j - 4)); }
        P7_TAIL()
    }
#pragma unroll 1
    for (int r = MP + gw; r < MT; r += NGW) {
        f32x4* om = row_mid(p.out + OUT_Y + (size_t)r * DM, lane);
        const u32x2* pzr = (const u32x2*)(pz + (size_t)r * DM) + lane; const u32x2* zm = (const u32x2*)((const bf16_t*)(p.ws + OFF_IMG) + (size_t)(r - MP) * DM) + lane;
        Row8 v, hh, z;
#pragma unroll
        for (int j = 0; j < 8; ++j) { const u32x2 w = ldnt(pzr + 64 * j); v.v[j] = unpack4(w); hh.v[j] = ldnt(om + 64 * (j - 4)); z.v[j] = (f32x4){0.f, 0.f, 0.f, 0.f}; }
#pragma unroll 4
        for (int k = 0; k < 8; ++k) { const u32x2* pk = zm + (size_t)k * (MS * DM / 4);
#pragma unroll
            for (int j = 0; j < 8; ++j) z.v[j] += unpack4(ldnt(pk + 64 * j)); }
        P7_TAIL()
    }
}
#undef P7_TAIL

__global__ void __launch_bounds__(512, 2) fwd_kernel(Params p) {
    extern __shared__ __attribute__((aligned(16))) unsigned char shm[];
    LAS unsigned char* lds = (LAS unsigned char*)shm;
    cg::grid_group grid = cg::this_grid();
    if (threadIdx.x == 0) { *(volatile LAS unsigned*)(lds + 131072) = 0u; *(volatile LAS unsigned*)(lds + 131076) = 0u; }
    __syncthreads();
    const XcdBarrier xb = xcd_barrier_post((unsigned*)(p.ws + OFF_BAR), (volatile LAS unsigned*)(lds + 131072));
    bf16_t* a0 = (bf16_t*)(p.ws + OFF_A0);
    phase0(p, lds);
    if (p.ws == nullptr) grid.sync();
    xcd_barrier(xb);
    { EpiIn E; E.Z = (bf16_t*)(p.ws + OFF_Z); E.alow = (float*)(p.ws + OFF_ALOW); run_gemm(lds, a0, (const bf16_t*)(p.ws + OFF_WIN), MT, NINP, DM, E); }
    xcd_barrier(xb);
    phase2a(p, lds);
    xcd_barrier(xb);
    phase2c(p, lds);
    xcd_barrier(xb);
    phase2b(p);
    xcd_barrier(xb);
    bf16_t* part = (bf16_t*)(p.ws + OFF_IMG);
    { EpiRes E; E.res_p = p.x_prompt; E.res_s = p.x_sample; E.out = p.out + OUT_Y; run_gemm_n2048(lds, a0, (const bf16_t*)(p.ws + OFF_WOUT), DM, E, part); }
    xcd_barrier(xb);
    phase_norm<8>(p, p.g_ffn, p.x_sample);
    xcd_barrier(xb);
    { EpiSwiglu E; E.act = (bf16_t*)(p.ws + OFF_ACT); run_gemm(lds, a0, (const bf16_t*)(p.ws + OFF_WFI), MT, 2 * DFF, DM, E); }
    {
        const int G = (int)gridDim.x, extra = ((MT / 256) * (2 * DFF / 256)) % G, cb = (int)blockIdx.x;
        if (extra == 0 || cb >= extra) { EpiBfN E; E.out = (bf16_t*)(p.ws + OFF_PZ); pg8::Gemm g; g.A = (const bf16_t*)(p.ws + OFF_PB); g.Bt = (const bf16_t*)(p.ws + OFF_WPLE); g.M = MT; g.N = DM; g.K = PLE; g.Klen = PLE;
            pg8::StaticOrder S; S.init(MT, DM, extra ? G - extra : G, extra ? cb - extra : cb); pg8::gemm_phase<EpiBfN, pg8::StaticOrder, false>(lds, g, S, E, nullptr);
            { const int ob = extra ? cb - extra : cb, onb = extra ? G - extra : G, gw = ob * 8 + (otid() >> 6); convert_range(p, lds, cv::E_FI, cv::E_FO, gw, onb * 8); convert_range(p, lds, cv::E_PLE, cv::E_GT, gw, onb * 8); } }
    }
    xcd_barrier(xb);
    { EpiRes E; E.res_p = p.out + OUT_Y; E.res_s = p.out + OUT_Y + (size_t)MP * DM; E.out = p.out + OUT_Y;
      const bf16_t* A = (const bf16_t*)(p.ws + OFF_ACT); const bf16_t* Bt = (const bf16_t*)(p.ws + OFF_WFO); const int G = (int)gridDim.x, hb = (int)((blockIdx.x + G / 2) % G);
      run_gemm(lds, A, Bt, MP, DM, DFF, E);
      run_split(lds, A, Bt, DFF, part, 4, 768, 0, 0, hb);
      run_split(lds, A, Bt, DFF, part, 4, 640, 3072, 4, (int)blockIdx.x); }
    xcd_barrier(xb);
    phase_norm<8>(p, p.g_ple_gate, p.out + OUT_Y + (size_t)MP * DM);
    xcd_barrier(xb);
    { EpiBfN E; E.out = (bf16_t*)(p.ws + OFF_GATEZ); run_gemm_n2048(lds, a0, (const bf16_t*)(p.ws + OFF_WGT), DM, E, part); }
    xcd_barrier(xb);
    phase7(p);
}

extern "C" void kernel_launch(void* const* d_in, const int* in_sizes, int n_in, void* d_out, int out_size, void* d_ws, size_t ws_size, hipStream_t stream) {
    static int grid = 0;
    if (grid == 0) {
        if (n_in != 24 || ws_size < WS_END) { fprintf(stderr, "kernel_launch: unexpected n_in %d or ws_size %zu (< %zu)\n", n_in, ws_size, (size_t)WS_END); grid = -1; return; }
        int dev = 0, cus = 0, per_cu = 0;
        if (hipGetDevice(&dev) != hipSuccess || hipDeviceGetAttribute(&cus, hipDeviceAttributeMultiprocessorCount, dev) != hipSuccess) { grid = -1; return; }
        if (hipFuncSetAttribute((const void*)fwd_kernel, hipFuncAttributeMaxDynamicSharedMemorySize, LDS_BYTES) != hipSuccess) { fprintf(stderr, "kernel_launch: hipFuncSetAttribute failed\n"); grid = -1; return; }
        if (hipOccupancyMaxActiveBlocksPerMultiprocessor(&per_cu, (const void*)fwd_kernel, 512, LDS_BYTES) != hipSuccess || per_cu < 1) { fprintf(stderr, "kernel_launch: occupancy query says %d blocks per CU\n", per_cu); grid = -1; (void)hipGetLastError(); return; }
        grid = cus;
    }
    if (grid < 0) return;
    if (hipMemsetAsync(d_ws, 0, XCD_BAR_WORDS * sizeof(unsigned), stream) != hipSuccess) { fprintf(stderr, "kernel_launch: memset failed\n"); return; }
    Params p{};
    const float** f = (const float**)&p;
    for (int i = 0; i < 24; ++i) f[i] = (const float*)d_in[i];
    p.out = (float*)d_out; p.ws = (unsigned char*)d_ws;
    void* args[] = {&p};
    hipError_t e = hipLaunchCooperativeKernel((const void*)fwd_kernel, dim3(grid), dim3(512), args, LDS_BYTES, stream);
    if (e != hipSuccess) fprintf(stderr, "cooperative launch failed: %s (grid %d)\n", hipGetErrorString(e), grid);
}
```

```cpp
#include <hip/hip_runtime.h>
#include <hip/hip_cooperative_groups.h>
#include <cstdio>
#include <cstdint>
namespace cg = cooperative_groups;
namespace pg8 {
#define PG8_LAS __attribute__((address_space(3)))
typedef unsigned short bf16_t;
typedef short bf16x8 __attribute__((ext_vector_type(8)));
typedef float f32x4 __attribute__((ext_vector_type(4)));
typedef unsigned u32x4 __attribute__((ext_vector_type(4)));
constexpr int BM = 256, BK = 64, HALF = 128, HTB = HALF * BK * 2  , STAGE_BYTES = 8 * HTB, NXCD = 8, WGM = 8;

__host__ __device__ __forceinline__ int lds_byte(int r, int c) { const int st = (r >> 4) * 2 + (c >> 5), rr = r & 15, cc = c & 31, ob = rr * 64 + cc * 2; return st * 1024 + (ob ^ (((ob >> 9) & 1) << 5)); }
__host__ __device__ __forceinline__ void stage_rc(int b, int& R, int& C) { const int st = b / 1024, sb = b % 1024, swz = sb ^ (((sb >> 9) & 1) << 5); R = (st >> 1) * 16 + swz / 64; C = (st & 1) * 32 + (swz % 64) / 2; }
__host__ __device__ __forceinline__ int perm32(int rho) { const int n = rho >> 4, i = rho & 15; return 8 * (i >> 2) + 4 * n + (i & 3); }

struct Unit { int pm, pn, ks, koff; };
struct Gemm { const bf16_t* A; const bf16_t* Bt; int M, N, K, Klen; };

struct StaticOrder {
    int nM, nN, nwg, G, c;
    __host__ __device__ void init(int M, int N, int G_, int c_) { nM = M / BM; nN = N / BM; nwg = nM * nN; G = G_; c = c_; }
    __host__ __device__ bool next(int i, Unit& u) const {
        const long L = (long)i * G + c; if (L >= nwg) return false;
        int wgid = (int)L; { const int q = nwg / NXCD, r = nwg % NXCD, xcd = wgid % NXCD, off = wgid / NXCD; wgid = (xcd < r ? xcd * (q + 1) : r * (q + 1) + (xcd - r) * q) + off; }
        const int nig = WGM * nN, gid = wgid / nig, fm = gid * WGM, gsz = (nM - fm) < WGM ? (nM - fm) : WGM;
        u.pm = fm + ((wgid % nig) % gsz); u.pn = (wgid % nig) / gsz; u.ks = 0; u.koff = 0; return true;
    }
    __device__ __forceinline__ void a_ready(const Unit&) const {}
    __device__ __forceinline__ void done(const Unit&) const {}
};
__device__ __forceinline__ unsigned cvt_pk_bf16(float lo, float hi) { unsigned r; asm volatile("v_cvt_pk_bf16_f32 %0, %1, %2" : "=v"(r) : "v"(lo), "v"(hi)); return r; }
typedef float f32x2 __attribute__((ext_vector_type(2)));
template <class Epi, class Sched, bool STAMP = false>
__device__ __forceinline__ void gemm_phase(PG8_LAS unsigned char* lds, const Gemm g, const Sched& S, const Epi& E, unsigned long long* stamps) {
    int tid_ = threadIdx.x; asm volatile("" : "+v"(tid_));
    const int tid = tid_, wid = __builtin_amdgcn_readfirstlane(tid >> 6), lane = tid & 63, wr = wid >> 2, wc = wid & 3, fr = lane & 15, fq = lane >> 4;
    const int K = g.K, nt = g.Klen / BK;
    int ts_lo = 0, ts_hi = 0, nts = 0; const unsigned long long rt_entry = STAMP ? (unsigned long long)wall_clock64() : 0ull;
#define PG8_STAMP() do { if (STAMP && wid == 0 && nts < 64) { const unsigned long long _c = (unsigned long long)clock64(); \
        ts_lo = (lane == nts) ? (int)(unsigned)_c : ts_lo; ts_hi = (lane == nts) ? (int)(unsigned)(_c >> 32) : ts_hi; ++nts; } } while (0)
    PG8_STAMP();
    unsigned voffA[2], voffB[2];
#pragma unroll
    for (int i = 0; i < 2; ++i) { int R, C; stage_rc(tid * 16 + i * 8192, R, C); const int Rb = Epi::PERM ? ((R & ~31) + perm32(R & 31)) : R;
        voffA[i] = (unsigned)(R * K + C) * 2u; voffB[i] = (unsigned)(Rb * K + C) * 2u; }
    const size_t kstep = (size_t)(BK * 2);
    const size_t hstep = (size_t)HALF * K * 2;
    const size_t tstep = 2 * hstep;
    const unsigned ldsw = (unsigned)wid * 1024u;
    const int aoff = lds_byte(wr * 64 + fr, fq * 8), boff = lds_byte(wc * 32 + fr, fq * 8);
#define PG8_SA(b, h) (((b) * 2 + (h)) * HTB)
#define PG8_SB(b, h) ((4 + (b) * 2 + (h)) * HTB)
#define PG8_STAGE(bufoff, gbase, voff) do { _Pragma("unroll") for (int _i = 0; _i < 2; ++_i) \
        __builtin_amdgcn_global_load_lds((const unsigned*)((const char*)(gbase) + (voff)[_i]), (PG8_LAS unsigned*)(lds + (bufoff) + ldsw + _i * 8192), 16, 0, 0); } while (0)
#define PG8_LDA(dst, b, h) do { _Pragma("unroll") for (int m = 0; m < 4; ++m) _Pragma("unroll") for (int k = 0; k < 2; ++k) dst[m][k] = *(const PG8_LAS bf16x8*)(lds + PG8_SA(b, h) + aoff + m * 2048 + k * 1024); } while (0)
#define PG8_LDB(dst, b, h) do { _Pragma("unroll") for (int n = 0; n < 2; ++n) _Pragma("unroll") for (int k = 0; k < 2; ++k) dst[n][k] = *(const PG8_LAS bf16x8*)(lds + PG8_SB(b, h) + boff + n * 2048 + k * 1024); } while (0)
#define PG8_MMA(ai, bj, At, Bt) do { __builtin_amdgcn_s_setprio(1); _Pragma("unroll") for (int m = 0; m < 4; ++m) _Pragma("unroll") for (int n = 0; n < 2; ++n) _Pragma("unroll") for (int k = 0; k < 2; ++k) \
        acc[ai][bj][m][n] = __builtin_amdgcn_mfma_f32_16x16x32_bf16(Bt[n][k], At[m][k], acc[ai][bj][m][n], 0, 0, 0); __builtin_amdgcn_s_setprio(0); } while (0)
#define PG8_WAIT_V(n) asm volatile("s_waitcnt vmcnt(" #n ")" ::: "memory")
#define PG8_WAIT_L(n) asm volatile("s_waitcnt lgkmcnt(" #n ")" ::: "memory")
#define PG8_BAR __builtin_amdgcn_s_barrier()
#define PG8_SCHED __builtin_amdgcn_sched_barrier(0)
    Unit cur, nxt; int ui = 0;
    if (!S.next(0, cur)) return;
    f32x4 acc[2][2][4][2];
#pragma unroll
    for (int a = 0; a < 2; ++a)
#pragma unroll
        for (int b = 0; b < 2; ++b)
#pragma unroll
            for (int m = 0; m < 4; ++m)
#pragma unroll
                for (int n = 0; n < 2; ++n) acc[a][b][m][n] = (f32x4){0.f, 0.f, 0.f, 0.f};
    bf16x8 At[4][2], B0[2][2], B1[2][2];
    const char* cA = (const char*)g.A + (size_t)cur.pm * tstep + (size_t)cur.koff * 2; const char* cB = (const char*)g.Bt + (size_t)cur.pn * tstep + (size_t)cur.koff * 2;
    S.a_ready(cur);
    PG8_STAGE(PG8_SB(0, 0), cB, voffB); PG8_STAGE(PG8_SB(0, 1), cB + hstep, voffB); PG8_STAGE(PG8_SA(0, 0), cA, voffA); PG8_STAGE(PG8_SA(0, 1), cA + hstep, voffA);
    if (wr == 1) PG8_BAR;
    PG8_WAIT_V(2); PG8_BAR;
    PG8_STAGE(PG8_SB(1, 0), cB + kstep, voffB); PG8_STAGE(PG8_SA(1, 0), cA + kstep, voffA); PG8_STAGE(PG8_SB(1, 1), cB + hstep + kstep, voffB);
    PG8_WAIT_V(6); PG8_BAR;
    PG8_STAMP();
    for (;;) {
        const bool has_next = S.next(ui + 1, nxt);
        const char* nA = has_next ? (const char*)g.A + (size_t)nxt.pm * tstep + (size_t)nxt.koff * 2 : cA; const char* nB = has_next ? (const char*)g.Bt + (size_t)nxt.pn * tstep + (size_t)nxt.koff * 2 : cB;
        for (int t = 0; t < nt; t += 2) {
            const bool last = (t == nt - 2);
            const char* a1 = cA + (size_t)(t + 1) * kstep;
            const char* a2 = last ? nA : cA + (size_t)(t + 2) * kstep; const char* b2 = last ? nB : cB + (size_t)(t + 2) * kstep;
            const char* a3 = a2 + kstep; const char* b3 = b2 + kstep;
            if (last && has_next) S.a_ready(nxt);
            PG8_LDB(B0, 0, 0); PG8_LDB(B1, 0, 1); PG8_SCHED; PG8_LDA(At, 0, 0); PG8_STAGE(PG8_SA(1, 1), a1 + hstep, voffA);
            PG8_WAIT_V(8); PG8_WAIT_L(0); PG8_BAR; PG8_MMA(0, 0, At, B0); PG8_MMA(0, 1, At, B1); PG8_BAR; PG8_SCHED;
            PG8_LDA(At, 0, 1); PG8_STAGE(PG8_SB(0, 0), b2, voffB); PG8_STAGE(PG8_SB(0, 1), b2 + hstep, voffB); PG8_STAGE(PG8_SA(0, 0), a2, voffA);
            PG8_WAIT_V(8); PG8_WAIT_L(0); PG8_BAR; PG8_MMA(1, 0, At, B0); PG8_MMA(1, 1, At, B1); PG8_BAR; PG8_SCHED;
            PG8_LDB(B0, 1, 0); PG8_LDB(B1, 1, 1); PG8_SCHED; PG8_LDA(At, 1, 0); PG8_STAGE(PG8_SA(0, 1), a2 + hstep, voffA);
            PG8_WAIT_V(8); PG8_WAIT_L(0); PG8_BAR; PG8_MMA(0, 0, At, B0); PG8_MMA(0, 1, At, B1); PG8_BAR; PG8_SCHED;
            PG8_LDA(At, 1, 1); PG8_STAGE(PG8_SB(1, 0), b3, voffB); PG8_STAGE(PG8_SB(1, 1), b3 + hstep, voffB); PG8_STAGE(PG8_SA(1, 0), a3, voffA);
            PG8_WAIT_V(8); PG8_WAIT_L(0); PG8_BAR; PG8_MMA(1, 0, At, B0); PG8_MMA(1, 1, At, B1); PG8_BAR; PG8_SCHED;
        }
        PG8_STAMP();
        if (wr == 0) PG8_BAR;
        if constexpr (!Epi::AFTER_DRAIN) { E(acc, cur, wr, wc, fr, fq); S.done(cur); }
        PG8_STAMP();
        if (!has_next) break;
#pragma unroll
        for (int a = 0; a < 2; ++a)
#pragma unroll
            for (int b = 0; b < 2; ++b)
#pragma unroll
                for (int m = 0; m < 4; ++m)
#pragma unroll
                    for (int n = 0; n < 2; ++n) acc[a][b][m][n] = (f32x4){0.f, 0.f, 0.f, 0.f};
        cur = nxt; cA = nA; cB = nB; ++ui;
        if (wr == 1) PG8_BAR;
    }
    PG8_WAIT_V(0);
    PG8_BAR;
    if constexpr (Epi::AFTER_DRAIN) { E.fused(acc, cur, wr, wc, fr, fq, lds, wid, lane); S.done(cur); }
    PG8_STAMP();
    if (STAMP && wid == 0) { stamps[lane] = lane < nts ? (((unsigned long long)(unsigned)ts_hi << 32) | (unsigned)ts_lo) : 0ull;
        if (lane == 62) stamps[62] = rt_entry; if (lane == 63) stamps[63] = (unsigned long long)wall_clock64(); }
#undef PG8_STAMP
#undef PG8_SA
#undef PG8_SB
#undef PG8_STAGE
#undef PG8_LDA
#undef PG8_LDB
#undef PG8_MMA
#undef PG8_WAIT_V
#undef PG8_WAIT_L
#undef PG8_BAR
#undef PG8_SCHED
}
}
#define LAS __attribute__((address_space(3)))
#define XB_TMO      128
#define XB_XCNT(j)  (256  + 64 * (j))
#define XB_XSUB(j)  (1280 + 64 * (j))
#define XB_XGEN(j)  (2304 + 64 * (j))
#define XB_TOP      3328
#define XB_TOPGEN   3392
#define XCD_BAR_WORDS 3456
#define XB_SPIN_CAP (1u << 18)

__device__ __forceinline__ unsigned xb_ld(unsigned* p)              { return __hip_atomic_load(p, __ATOMIC_RELAXED, __HIP_MEMORY_SCOPE_AGENT); }
__device__ __forceinline__ unsigned xb_add(unsigned* p, unsigned v) { return __hip_atomic_fetch_add(p, v, __ATOMIC_RELAXED, __HIP_MEMORY_SCOPE_AGENT); }
__device__ __forceinline__ unsigned xb_xcc_id() { return (unsigned)__builtin_amdgcn_s_getreg((3 << 11) | 20) & 0xFu; }
#define XB_SPIN(cond, bar) do { unsigned _sp = 0; while (cond) { __builtin_amdgcn_s_sleep(1); \
    if ((++_sp & 255u) == 0u) { if (xb_ld(&(bar)[XB_TMO])) break; if (_sp > XB_SPIN_CAP) { atomicAdd(&(bar)[XB_TMO], 1u); break; } } } } while (0)

struct XcdBarrier {
    unsigned* bar; unsigned x;
    volatile LAS unsigned* st;
};

__device__ __forceinline__ XcdBarrier xcd_barrier_post(unsigned* bar, volatile LAS unsigned* st) {
    XcdBarrier b; b.bar = bar; b.x = xb_xcc_id(); b.st = st;
    if (threadIdx.x == 0) (void)xb_add(&bar[XB_XCNT(b.x)], 1u);
    return b;
}
__device__ __forceinline__ void xcd_barrier_complete(unsigned* bar, unsigned x, unsigned& nloc, unsigned& nx) {
    const unsigned G = gridDim.x * gridDim.y * gridDim.z;
    unsigned sum, cnt, mine, sp = 0u;
    for (;;) {
        sum = 0u; cnt = 0u; mine = 0u;
#pragma unroll
        for (unsigned j = 0; j < 16; ++j) { const unsigned c = xb_ld(&bar[XB_XCNT(j)]); sum += c; cnt += (c > 0u) ? 1u : 0u; mine = (j == x) ? c : mine; }
        if (sum == G) break;
        __builtin_amdgcn_s_sleep(1);
        if ((++sp & 255u) == 0u) { if (xb_ld(&bar[XB_TMO])) break; if (sp > XB_SPIN_CAP) { atomicAdd(&bar[XB_TMO], 1u); break; } }
    }
    nloc = mine > 0u ? mine : 1u; nx = cnt > 0u ? cnt : 1u;
}

__device__ __forceinline__ void xcd_barrier(const XcdBarrier& b) {
    asm volatile("s_waitcnt vmcnt(0)" ::: "memory");
    __syncthreads();
    if (threadIdx.x == 0) {
        unsigned* bar = b.bar;
        __builtin_amdgcn_s_waitcnt(0);
        unsigned nloc = b.st[0], nx = b.st[1];
        if (nloc == 0u) { xcd_barrier_complete(bar, b.x, nloc, nx); b.st[0] = nloc; b.st[1] = nx; }
        const unsigned old = xb_add(&bar[XB_XSUB(b.x)], 1u);
        const unsigned gen = old / nloc;
        if (old + 1u == (gen + 1u) * nloc) {
            __builtin_amdgcn_fence(__ATOMIC_RELEASE, "agent");
            asm volatile("s_waitcnt vmcnt(0)" ::: "memory");
            const unsigned og = xb_add(&bar[XB_TOP], 1u);
            const unsigned tg = og / nx;
            if (og + 1u == (tg + 1u) * nx) xb_add(&bar[XB_TOPGEN], 1u);
            else XB_SPIN(xb_ld(&bar[XB_TOPGEN]) == tg, bar);
            __builtin_amdgcn_fence(__ATOMIC_ACQUIRE, "agent");
            xb_add(&bar[XB_XGEN(b.x)], 1u);
            asm volatile("s_waitcnt vmcnt(0)" ::: "memory");
        } else {
            XB_SPIN(xb_ld(&bar[XB_XGEN(b.x)]) == gen, bar);
            __builtin_amdgcn_fence(__ATOMIC_ACQUIRE, "agent");
            asm volatile("s_waitcnt vmcnt(0)" ::: "memory");
        }
    }
    __syncthreads();
}


using pg8::bf16_t; using pg8::bf16x8; using pg8::f32x4; using pg8::u32x4; using pg8::Unit;
typedef float f32x16 __attribute__((ext_vector_type(16)));
typedef unsigned u32x2 __attribute__((ext_vector_type(2)));
typedef float f32x2 __attribute__((ext_vector_type(2)));

constexpr int MP = 8192, MS = 1024, MT = 9216, DM = 2048, NZ = 5120, NINP = 5376, DFF = 5632, PLE = 256;
constexpr int LDS_BYTES = 131072 + 16;
constexpr size_t OFF_BAR = 0;
constexpr size_t OFF_WIN = 16384;
constexpr size_t OFF_WOUT = OFF_WIN + (size_t)NINP * DM * 2;
constexpr size_t OFF_WFI = OFF_WOUT + (size_t)DM * DM * 2;
constexpr size_t OFF_WFO = OFF_WFI + (size_t)2 * DFF * DM * 2;
constexpr size_t OFF_WPLE = OFF_WFO + (size_t)DM * DFF * 2;
constexpr size_t OFF_WGT = OFF_WPLE + (size_t)DM * PLE * 2;
constexpr size_t OFF_A0 = OFF_WGT + (size_t)DM * DM * 2;
constexpr size_t OFF_PB = OFF_A0 + (size_t)MT * DM * 2;
constexpr size_t OFF_ALOW = OFF_PB + (size_t)MT * PLE * 2;
constexpr size_t OFF_STAT = OFF_ALOW + (size_t)MT * 16 * 4;
constexpr size_t OFF_BIG = OFF_STAT + (size_t)MT * 2 * 4;
constexpr size_t OFF_Z = OFF_BIG;
constexpr size_t OFF_ORAW = OFF_Z + (size_t)MT * NZ * 2;
constexpr size_t OFF_MRAW = OFF_ORAW + (size_t)MT * 1024 * 4;
constexpr size_t OFF_IMG = OFF_BIG + (size_t)MT * DFF * 2 + (size_t)MT * DM * 4;
constexpr size_t WS_END = OFF_IMG + (size_t)4 * 1024 * 2048 * 4;
constexpr size_t OFF_ACT = OFF_BIG;
constexpr size_t OFF_GATEZ = OFF_BIG;
constexpr size_t OFF_PZ = OFF_BIG + (size_t)MT * DFF * 2;
constexpr size_t OUT_Y = 0, OUT_SP = (size_t)MT * DM, OUT_SS = OUT_SP + (size_t)4 * 4 * 128 * 256, OUT_VS = OUT_SS + (size_t)128 * 4 * 128 * 256;

struct Params {
    const float *x_prompt, *x_sample, *state_gla, *p_prompt, *p_sample, *g_mix, *w_in, *w_a2, *b_a, *g_gla_norm, *g_gmlp_ln, *b_gmlp_ln, *w_s, *b_s,
        *g_gmlp_out, *w_out, *g_ffn, *w_ffn_in, *w_ffn_out, *w_ple, *g_ple, *g_ple_gate, *w_ple_gate, *g_final;
    float* out;
    unsigned char* ws;
};

__device__ __forceinline__ unsigned pk2(float lo, float hi) { return pg8::cvt_pk_bf16(lo, hi); }
__device__ __forceinline__ bf16_t f2bf(float f) { return (bf16_t)(pk2(f, 0.f) & 0xffffu); }
__device__ __forceinline__ float bf2f(bf16_t b) { return __uint_as_float(((unsigned)b) << 16); }
__device__ __forceinline__ float bflo(unsigned w) { return __uint_as_float(w << 16); }
__device__ __forceinline__ float bfhi(unsigned w) { return __uint_as_float(w & 0xffff0000u); }
__device__ __forceinline__ f32x4 unpack4(u32x2 w) { return (f32x4){bflo(w.x), bfhi(w.x), bflo(w.y), bfhi(w.y)}; }
template <int CTRL> __device__ __forceinline__ float dpp_f(float v) { return __int_as_float(__builtin_amdgcn_update_dpp(0, __float_as_int(v), CTRL, 0xf, 0xf, true)); }
__device__ __forceinline__ float row16_sum(float v) {
    v += dpp_f<0xB1>(v); v += dpp_f<0x4E>(v); v += dpp_f<0x141>(v); v += dpp_f<0x140>(v); return v;
}
__device__ __forceinline__ float wave_sum(float v) {
    v = row16_sum(v);
    return (__int_as_float(__builtin_amdgcn_readlane(__float_as_int(v), 0)) + __int_as_float(__builtin_amdgcn_readlane(__float_as_int(v), 16))) + (__int_as_float(__builtin_amdgcn_readlane(__float_as_int(v), 32)) + __int_as_float(__builtin_amdgcn_readlane(__float_as_int(v), 48)));
}
__device__ __forceinline__ float sigmoid_f(float x) { return __builtin_amdgcn_rcpf(1.f + __expf(-x)); }
__device__ __forceinline__ float silu_f(float x) { return x * __builtin_amdgcn_rcpf(1.f + __expf(-x)); }
__device__ __forceinline__ float gelu_f(float x) { const float u = 1.5957691216f * (x + 0.044715f * x * x * x); return x * __builtin_amdgcn_rcpf(1.f + __expf(-u)); }
__device__ __forceinline__ float logsigmoid_f(float x) { return fminf(x, 0.f) - __logf(1.f + __expf(-fabsf(x))); }
template <class T> __device__ __forceinline__ T* opaque(T* p) { return p; }
__device__ __forceinline__ const f32x4* row_mid(const float* row, int lane) { return opaque((const f32x4*)row + lane + 256); }
__device__ __forceinline__ f32x4* row_mid(float* row, int lane) { return opaque((f32x4*)row + lane + 256); }
__device__ __forceinline__ int otid() { int t = threadIdx.x; asm volatile("" : "+v"(t)); return t; }
template <class T> __device__ __forceinline__ T ldnt(const T* p) { return __builtin_nontemporal_load(p); }
template <class T> __device__ __forceinline__ void stnt(T* p, T v) { __builtin_nontemporal_store(v, p); }
__device__ __forceinline__ void lds_wait() { asm volatile("s_waitcnt lgkmcnt(0)" ::: "memory"); }

struct EpiIn {
    static constexpr bool PERM = true, AFTER_DRAIN = false;
    bf16_t* Z; float* alow;
    __device__ __forceinline__ void operator()(const f32x4 (&acc)[2][2][4][2], const Unit& u, int wr, int wc, int fr, int fq) const {
        const int row0 = u.pm * 256 + wr * 64 + fr, pn = u.pn;
        if (pn == 20) {
            if (wc == 0 && fq < 2) {
#pragma unroll
                for (int ai = 0; ai < 2; ++ai)
#pragma unroll
                    for (int m = 0; m < 4; ++m) { float* p = alow + (size_t)(row0 + ai * 128 + m * 16) * 16 + 8 * fq; *(f32x4*)p = acc[ai][0][m][0]; *(f32x4*)(p + 4) = acc[ai][0][m][1]; }
            }
            return;
        }
        const int kind = pn < 8 ? 0 : (pn < 12 ? 1 : 2); const float qs = pn < 2 ? 0.08838834764831845f : 1.f;
#pragma unroll
        for (int ai = 0; ai < 2; ++ai)
#pragma unroll
            for (int m = 0; m < 4; ++m) { bf16_t* rowp = Z + (size_t)(row0 + ai * 128 + m * 16) * NZ + pn * 256 + wc * 32 + 8 * fq;
#pragma unroll
                for (int bj = 0; bj < 2; ++bj) { f32x4 v0 = acc[ai][bj][m][0], v1 = acc[ai][bj][m][1];
                    if (kind == 0) { v0 *= qs; v1 *= qs; }
                    else if (kind == 1) {
#pragma unroll
                        for (int j = 0; j < 4; ++j) { v0[j] = silu_f(v0[j]); v1[j] = silu_f(v1[j]); } }
                    else {
#pragma unroll
                        for (int j = 0; j < 4; ++j) { v0[j] = gelu_f(v0[j]); v1[j] = gelu_f(v1[j]); } }
                    u32x4 w; w.x = pk2(v0[0], v0[1]); w.y = pk2(v0[2], v0[3]); w.z = pk2(v1[0], v1[1]); w.w = pk2(v1[2], v1[3]);
                    *(u32x4*)(rowp + bj * 128) = w; } }
    }
};
struct EpiRes {
    static constexpr bool PERM = false, AFTER_DRAIN = false;
    const float* res_p; const float* res_s; float* out;
    __device__ __forceinline__ void operator()(const f32x4 (&acc)[2][2][4][2], const Unit& u, int wr, int wc, int fr, int fq) const {
        const int row0 = u.pm * 256 + wr * 64 + fr, col0 = u.pn * 256 + wc * 32 + 4 * fq;
#pragma unroll
        for (int ai = 0; ai < 2; ++ai)
#pragma unroll
            for (int m = 0; m < 4; ++m) { const int row = row0 + ai * 128 + m * 16;
                const float* rp = (row < MP ? res_p + (size_t)row * DM : res_s + (size_t)(row - MP) * DM) + col0; float* op = out + (size_t)row * DM + col0;
#pragma unroll
                for (int bj = 0; bj < 2; ++bj)
#pragma unroll
                    for (int n = 0; n < 2; ++n) { const f32x4 r = *(const f32x4*)(rp + bj * 128 + n * 16); *(f32x4*)(op + bj * 128 + n * 16) = acc[ai][bj][m][n] + r; } }
    }
};
struct EpiSwiglu {
    static constexpr bool PERM = true, AFTER_DRAIN = false;
    bf16_t* act;
    __device__ __forceinline__ void operator()(const f32x4 (&acc)[2][2][4][2], const Unit& u, int wr, int wc, int fr, int fq) const {
        const int row0 = u.pm * 256 + wr * 64 + fr, col0 = u.pn * 128 + wc * 32 + 8 * fq;
#pragma unroll
        for (int ai = 0; ai < 2; ++ai)
#pragma unroll
            for (int m = 0; m < 4; ++m) { float a[8];
#pragma unroll
                for (int n = 0; n < 2; ++n)
#pragma unroll
                    for (int j = 0; j < 4; ++j) a[n * 4 + j] = silu_f(acc[ai][0][m][n][j]) * acc[ai][1][m][n][j];
                u32x4 w; w.x = pk2(a[0], a[1]); w.y = pk2(a[2], a[3]); w.z = pk2(a[4], a[5]); w.w = pk2(a[6], a[7]);
                *(u32x4*)(act + (size_t)(row0 + ai * 128 + m * 16) * DFF + col0) = w; }
    }
};
struct EpiBfN {
    static constexpr bool PERM = false, AFTER_DRAIN = false;
    bf16_t* out;
    __device__ __forceinline__ void operator()(const f32x4 (&acc)[2][2][4][2], const Unit& u, int wr, int wc, int fr, int fq) const {
        const int row0 = u.pm * 256 + wr * 64 + fr, col0 = u.pn * 256 + wc * 32 + 4 * fq;
#pragma unroll
        for (int ai = 0; ai < 2; ++ai)
#pragma unroll
            for (int m = 0; m < 4; ++m) { bf16_t* op = out + (size_t)(row0 + ai * 128 + m * 16) * DM + col0;
#pragma unroll
                for (int bj = 0; bj < 2; ++bj)
#pragma unroll
                    for (int n = 0; n < 2; ++n) { const f32x4 v = acc[ai][bj][m][n]; u32x2 w; w.x = pk2(v[0], v[1]); w.y = pk2(v[2], v[3]); *(u32x2*)(op + bj * 128 + n * 16) = w; } }
    }
};
struct EpiPlain {
    static constexpr bool PERM = false, AFTER_DRAIN = false;
    float* out;
    __device__ __forceinline__ void operator()(const f32x4 (&acc)[2][2][4][2], const Unit& u, int wr, int wc, int fr, int fq) const {
        const int row0 = u.pm * 256 + wr * 64 + fr, col0 = u.pn * 256 + wc * 32 + 4 * fq;
#pragma unroll
        for (int ai = 0; ai < 2; ++ai)
#pragma unroll
            for (int m = 0; m < 4; ++m) { float* op = out + (size_t)(row0 + ai * 128 + m * 16) * DM + col0;
#pragma unroll
                for (int bj = 0; bj < 2; ++bj)
#pragma unroll
                    for (int n = 0; n < 2; ++n) *(f32x4*)(op + bj * 128 + n * 16) = acc[ai][bj][m][n]; }
    }
};

template <class Epi> __device__ __forceinline__ void run_gemm(LAS unsigned char* lds, const bf16_t* A, const bf16_t* Bt, int M, int N, int K, const Epi& E) {
    pg8::Gemm g; g.A = A; g.Bt = Bt; g.M = M; g.N = N; g.K = K; g.Klen = K;
    pg8::StaticOrder S; S.init(M, N, (int)gridDim.x, (int)blockIdx.x);
    pg8::gemm_phase<Epi, pg8::StaticOrder, false>(lds, g, S, E, nullptr);
}
struct SplitOrderK {
    int nN, G, c, klen, ns, kbase, ksoff;
    __device__ __forceinline__ bool next(int i, Unit& u) const { const int L = i * G + c; if (L >= 4 * ns * nN) return false;
        const int sp = L % ns, tile = L / ns; u.ks = ksoff + sp; u.pn = tile % nN; u.pm = 32 + tile / nN; u.koff = kbase + sp * klen; return true; }
    __device__ __forceinline__ void a_ready(const Unit&) const {}
    __device__ __forceinline__ void done(const Unit&) const {}
};
struct EpiPart {
    static constexpr bool PERM = false, AFTER_DRAIN = false;
    bf16_t* part;
    __device__ __forceinline__ void operator()(const f32x4 (&acc)[2][2][4][2], const Unit& u, int wr, int wc, int fr, int fq) const {
        const int row0 = (u.pm - 32) * 256 + wr * 64 + fr, col0 = u.pn * 256 + wc * 32 + 4 * fq; bf16_t* pb = part + (size_t)u.ks * MS * DM;
#pragma unroll
        for (int ai = 0; ai < 2; ++ai)
#pragma unroll
            for (int m = 0; m < 4; ++m) { bf16_t* op = pb + (size_t)(row0 + ai * 128 + m * 16) * DM + col0;
#pragma unroll
                for (int bj = 0; bj < 2; ++bj)
#pragma unroll
                    for (int n = 0; n < 2; ++n) { const f32x4 v = acc[ai][bj][m][n]; u32x2 w; w.x = pk2(v[0], v[1]); w.y = pk2(v[2], v[3]); *(u32x2*)(op + bj * 128 + n * 16) = w; } }
    }
};
__device__ __forceinline__ void run_split(LAS unsigned char* lds, const bf16_t* A, const bf16_t* Bt, int K, bf16_t* part, int ns, int klen, int kbase, int ksoff, int c) {
    pg8::Gemm g; g.A = A; g.Bt = Bt; g.M = MT; g.N = DM; g.K = K; g.Klen = klen;
    SplitOrderK S; S.nN = DM / 256; S.G = (int)gridDim.x; S.c = c; S.klen = klen; S.ns = ns; S.kbase = kbase; S.ksoff = ksoff;
    EpiPart P; P.part = part;
    pg8::gemm_phase<EpiPart, SplitOrderK, false>(lds, g, S, P, nullptr);
}
template <class Epi> __device__ __forceinline__ void run_gemm_n2048(LAS unsigned char* lds, const bf16_t* A, const bf16_t* Bt, int K, const Epi& E, bf16_t* part) {
    run_gemm(lds, A, Bt, MP, DM, K, E);
    run_split(lds, A, Bt, K, part, 8, K / 8, 0, 0, (int)blockIdx.x);
}

__device__ __forceinline__ void transpose_item(const float* W, int N, bf16_t* WT, int K, int k0, int n0_dst, int n0_src, int nvalid, LAS float* scr, int lane) {
    if (nvalid == 32) {
        const int c4 = (lane & 7) * 4, kr = lane >> 3; f32x4 v[8];
#pragma unroll
        for (int i = 0; i < 8; ++i) v[i] = ldnt((const f32x4*)(W + (size_t)(k0 + 8 * i + kr) * N + n0_src + c4));
#pragma unroll
        for (int i = 0; i < 8; ++i) { LAS float* d = scr + (8 * i + kr) * 33 + c4; d[0] = v[i][0]; d[1] = v[i][1]; d[2] = v[i][2]; d[3] = v[i][3]; }
    } else {
        const int j = lane & 31;
#pragma unroll 8
        for (int i = 0; i < 32; ++i) { const int kk = 2 * i + (lane >> 5); scr[kk * 33 + j] = (j < nvalid) ? ldnt(W + (size_t)(k0 + kk) * N + n0_src + j) : 0.f; }
    }
    lds_wait();
    const int c = lane & 7;
#pragma unroll
    for (int q = 0; q < 4; ++q) { const int n = (lane >> 3) + 8 * q; const LAS float* s = scr + (8 * c) * 33 + n;
        u32x4 o; o.x = pk2(s[0 * 33], s[1 * 33]); o.y = pk2(s[2 * 33], s[3 * 33]); o.z = pk2(s[4 * 33], s[5 * 33]); o.w = pk2(s[6 * 33], s[7 * 33]);
        *(u32x4*)(WT + (size_t)(n0_dst + n) * K + k0 + 8 * c) = o; }
    lds_wait();
}
struct Row8 { f32x4 v[8]; };
__device__ __forceinline__ void row_load_nt(Row8& a, const float* src, int lane) { const f32x4* sm = row_mid(src, lane);
#pragma unroll
    for (int j = 0; j < 8; ++j) a.v[j] = ldnt(sm + 64 * (j - 4)); }
__device__ __forceinline__ void row_load(Row8& a, const float* src, int lane) { const f32x4* sm = row_mid(src, lane);
#pragma unroll
    for (int j = 0; j < 8; ++j) a.v[j] = sm[64 * (j - 4)]; }
__device__ __forceinline__ void rms_finish_bf16(const Row8& a, const float* gain, bf16_t* dst, int lane) {
    float s = 0.f;
#pragma unroll
    for (int j = 0; j < 8; ++j) s += (a.v[j][0] * a.v[j][0] + a.v[j][1] * a.v[j][1]) + (a.v[j][2] * a.v[j][2] + a.v[j][3] * a.v[j][3]);
    const float rinv = rsqrtf(wave_sum(s) * (1.f / DM) + 1e-6f);
    const f32x4* gm = row_mid(gain, lane); u32x2* dm = (u32x2*)dst + lane;
#pragma unroll
    for (int j = 0; j < 8; ++j) { const f32x4 g = gm[64 * (j - 4)]; u32x2 o; o.x = pk2(a.v[j][0] * rinv * g[0], a.v[j][1] * rinv * g[1]); o.y = pk2(a.v[j][2] * rinv * g[2], a.v[j][3] * rinv * g[3]);
        dm[64 * j] = o; }
}
__device__ __forceinline__ void rms_row_bf16(const float* src, const float* gain, bf16_t* dst, int lane) { Row8 a; row_load(a, src, lane); rms_finish_bf16(a, gain, dst, lane); }
namespace cv { constexpr int I_IN = (DM / 64) * (NINP / 32), I_OUT = (DM / 64) * (DM / 32), I_FI = (DM / 64) * (2 * DFF / 32), I_FO = (DFF / 64) * (DM / 32), I_PLE = (PLE / 64) * (DM / 32), I_GT = I_OUT;
    constexpr int E_IN = I_IN, E_OUT = E_IN + I_OUT, E_FI = E_OUT + I_FI, E_FO = E_FI + I_FO, E_PLE = E_FO + I_PLE, E_GT = E_PLE + I_GT; }
__device__ __forceinline__ void convert_range(const Params& p, LAS unsigned char* lds, int lo, int hi, int gw, int NGW) {
    const int tid = otid(), lane = tid & 63, wave = tid >> 6;
    LAS float* scr = (LAS float*)(lds + wave * 8448);
    bf16_t* win = (bf16_t*)(p.ws + OFF_WIN); bf16_t* wout = (bf16_t*)(p.ws + OFF_WOUT); bf16_t* wfi = (bf16_t*)(p.ws + OFF_WFI);
    bf16_t* wfo = (bf16_t*)(p.ws + OFF_WFO); bf16_t* wple = (bf16_t*)(p.ws + OFF_WPLE); bf16_t* wgt = (bf16_t*)(p.ws + OFF_WGT);
    for (int it = lo + gw; it < hi; it += NGW) {
        int r = it;
        if (r < cv::E_IN) { const int nblk = NINP / 32, kb = r / nblk, nb = r % nblk, n0d = nb * 32; int src, nv;
            if (n0d < 3072) { src = n0d; nv = 32; } else if (n0d < 5120) { src = n0d + 16; nv = 32; } else if (n0d == 5120) { src = 3072; nv = 16; } else { src = 0; nv = 0; }
            transpose_item(p.w_in, 5136, win, DM, kb * 64, n0d, src, nv, scr, lane); continue; }
        if (r < cv::E_OUT) { r -= cv::E_IN; const int nblk = DM / 32, kb = r / nblk, nb = r % nblk; transpose_item(p.w_out, DM, wout, DM, kb * 64, nb * 32, nb * 32, 32, scr, lane); continue; }
        if (r < cv::E_FI) { r -= cv::E_OUT; const int nblk = 2 * DFF / 32, kb = r / nblk, nb = r % nblk, n0d = nb * 32, jb = n0d >> 8, within = n0d & 255, up = within >> 7, j0 = jb * 128 + (within & 127);
            transpose_item(p.w_ffn_in, 2 * DFF, wfi, DM, kb * 64, n0d, up * DFF + j0, 32, scr, lane); continue; }
        if (r < cv::E_FO) { r -= cv::E_FI; const int nblk = DM / 32, kb = r / nblk, nb = r % nblk; transpose_item(p.w_ffn_out, DM, wfo, DFF, kb * 64, nb * 32, nb * 32, 32, scr, lane); continue; }
        if (r < cv::E_PLE) { r -= cv::E_FO; const int nblk = DM / 32, kb = r / nblk, nb = r % nblk; transpose_item(p.w_ple, DM, wple, PLE, kb * 64, nb * 32, nb * 32, 32, scr, lane); continue; }
        { r -= cv::E_PLE; const int nblk = DM / 32, kb = r / nblk, nb = r % nblk; transpose_item(p.w_ple_gate, DM, wgt, DM, kb * 64, nb * 32, nb * 32, 32, scr, lane); }
    }
}
__device__ __forceinline__ void phase0(const Params& p, LAS unsigned char* lds) {
    const int tid = otid(), lane = tid & 63, wave = tid >> 6;
    const int gw = blockIdx.x * 8 + wave, NGW = gridDim.x * 8;
    convert_range(p, lds, 0, cv::E_IN, gw, NGW);
    bf16_t* a0 = (bf16_t*)(p.ws + OFF_A0); bf16_t* pb = (bf16_t*)(p.ws + OFF_PB);
    for (int r = gw; r < MT; r += 2 * NGW) {
        const int r2 = r + NGW; const bool has2 = r2 < MT; const int q2 = has2 ? r2 : r;
        const float* x1 = r < MP ? p.x_prompt + (size_t)r * DM : p.x_sample + (size_t)(r - MP) * DM; const float* x2 = q2 < MP ? p.x_prompt + (size_t)q2 * DM : p.x_sample + (size_t)(q2 - MP) * DM;
        const float* p1 = r < MP ? p.p_prompt + (size_t)r * PLE : p.p_sample + (size_t)(r - MP) * PLE; const float* p2 = q2 < MP ? p.p_prompt + (size_t)q2 * PLE : p.p_sample + (size_t)(q2 - MP) * PLE;
        Row8 a, b; row_load_nt(a, x1, lane); row_load_nt(b, x2, lane);
        const f32x4 pv1 = ldnt((const f32x4*)p1 + lane), pv2 = ldnt((const f32x4*)p2 + lane);
        rms_finish_bf16(a, p.g_mix, a0 + (size_t)r * DM, lane);
        { u32x2 o; o.x = pk2(pv1[0], pv1[1]); o.y = pk2(pv1[2], pv1[3]); ((u32x2*)(pb + (size_t)r * PLE))[lane] = o; }
        if (has2) { rms_finish_bf16(b, p.g_mix, a0 + (size_t)r2 * DM, lane);
            u32x2 o; o.x = pk2(pv2[0], pv2[1]); o.y = pk2(pv2[2], pv2[3]); ((u32x2*)(pb + (size_t)r2 * PLE))[lane] = o; }
    }
}

__device__ __forceinline__ f32x16 mfma32(bf16x8 a, bf16x8 b, f32x16 c) { return __builtin_amdgcn_mfma_f32_32x32x16_bf16(a, b, c, 0, 0, 0); }
__device__ __forceinline__ void mma32(f32x16& acc, const LAS bf16_t* A, int lda, const LAS bf16_t* B, int ldb, int kk, int lane) {
    const int r = lane & 31, h = lane >> 5; const LAS bf16_t* ap = A + r * lda + 8 * h; const LAS bf16_t* bp = B + r * ldb + 8 * h;
    for (int k = 0; k < kk; k += 16) { const bf16x8 a = *(const LAS bf16x8*)(ap + k); const bf16x8 b = *(const LAS bf16x8*)(bp + k); acc = mfma32(a, b, acc); }
}
constexpr int LQ = 136, LS = 72;
constexpr int R_QE = 0, R_KLT = 17408, R_ATT = 35840, R_DEC = 45056, IMG_BYTES = 45568, R_VT = 45568, R_QM = 82432, R_KM = 99840, R_ALOW = 117248, R_GSUM = 121344, R_BMID = 123392;
constexpr int IMG_V4 = IMG_BYTES / 16;

__device__ __forceinline__ void gla_prep(const Params& p, LAS unsigned char* lds, int rb, int h, int T) {
    const int tid = otid(), lane = tid & 63, wave = tid >> 6;
    const bf16_t* Z = (const bf16_t*)(p.ws + OFF_Z); const float* alowg = (const float*)(p.ws + OFF_ALOW);
    LAS bf16_t* Qe = (LAS bf16_t*)(lds + R_QE); LAS bf16_t* Qm = (LAS bf16_t*)(lds + R_QM); LAS bf16_t* Km = (LAS bf16_t*)(lds + R_KM);
    LAS bf16_t* KlT = (LAS bf16_t*)(lds + R_KLT); LAS bf16_t* ATT = (LAS bf16_t*)(lds + R_ATT); LAS float* DEC = (LAS float*)(lds + R_DEC);
    LAS float* alowL = (LAS float*)(lds + R_ALOW); LAS float* gsum = (LAS float*)(lds + R_GSUM); LAS float* bmidL = (LAS float*)(lds + R_BMID);
    const int c = tid & 127, tg = tid >> 7;
    float wa[16];
#pragma unroll
    for (int j = 0; j < 16; ++j) wa[j] = p.w_a2[j * 512 + h * 128 + c];
    const float ba = p.b_a[h * 128 + c];
    for (int idx = tid; idx < 1024; idx += 512) { const int t = idx >> 4; alowL[idx] = (t < T) ? alowg[(size_t)(rb + t) * 16 + (idx & 15)] : 0.f; }
    { const int row = tid >> 3, cs = (tid & 7) * 16; const bool ok = row < T; const bf16_t* zr = Z + (size_t)(rb + row) * NZ + h * 128 + cs; const u32x4 z4 = (u32x4){0u, 0u, 0u, 0u};
        const u32x4 q0 = ok ? *(const u32x4*)zr : z4, q1 = ok ? *(const u32x4*)(zr + 8) : z4, k0 = ok ? *(const u32x4*)(zr + 512) : z4, k1 = ok ? *(const u32x4*)(zr + 520) : z4;
        *(LAS u32x4*)(Qm + row * LQ + cs) = q0; *(LAS u32x4*)(Qm + row * LQ + cs + 8) = q1; *(LAS u32x4*)(Km + row * LQ + cs) = k0; *(LAS u32x4*)(Km + row * LQ + cs + 8) = k1; }
    __syncthreads();
    float qv[16], kv[16];
#pragma unroll
    for (int i = 0; i < 16; ++i) { const int t = tg * 16 + i; qv[i] = bf2f(Qm[t * LQ + c]); kv[i] = bf2f(Km[t * LQ + c]); }
    float b[16]; float run = 0.f;
#pragma unroll
    for (int i = 0; i < 16; ++i) { const int t = tg * 16 + i; float pre = ba;
#pragma unroll
        for (int j4 = 0; j4 < 4; ++j4) { const f32x4 a4 = *(const LAS f32x4*)(alowL + t * 16 + j4 * 4); pre += a4[0] * wa[j4 * 4] + a4[1] * wa[j4 * 4 + 1] + a4[2] * wa[j4 * 4 + 2] + a4[3] * wa[j4 * 4 + 3]; }
        const float la = (t < T) ? logsigmoid_f(pre) * 0.0625f : 0.f; run += la; b[i] = run; }
    gsum[tg * 128 + c] = run;
    __syncthreads();
    const float g0 = gsum[c], g1 = gsum[128 + c], g2 = gsum[256 + c], g3 = gsum[384 + c];
    const float pref = tg == 0 ? 0.f : (tg == 1 ? g0 : (tg == 2 ? g0 + g1 : g0 + g1 + g2));
    const float blast = ((g0 + g1) + g2) + g3;
#pragma unroll
    for (int i = 0; i < 16; ++i) b[i] += pref;
    if (tg == 2) bmidL[c] = b[0];
    if (tg == 0) DEC[c] = __expf(blast);
    __syncthreads();
    const float bm = bmidL[c];
    {
        unsigned klp[8];
#pragma unroll
        for (int i = 0; i < 16; i += 2) {
            const int t = tg * 16 + i;
            Qe[t * LQ + c] = f2bf(qv[i] * __expf(b[i])); Qe[(t + 1) * LQ + c] = f2bf(qv[i + 1] * __expf(b[i + 1]));
            Qm[t * LQ + c] = f2bf(qv[i] * __expf(b[i] - bm)); Qm[(t + 1) * LQ + c] = f2bf(qv[i + 1] * __expf(b[i + 1] - bm));
            Km[t * LQ + c] = f2bf(kv[i] * __expf(bm - b[i])); Km[(t + 1) * LQ + c] = f2bf(kv[i + 1] * __expf(bm - b[i + 1]));
            klp[i >> 1] = pk2(kv[i] * __expf(blast - b[i]), kv[i + 1] * __expf(blast - b[i + 1]));
        }
        LAS u32x4* kd = (LAS u32x4*)(KlT + c * LS + tg * 16);
        kd[0] = (u32x4){klp[0], klp[1], klp[2], klp[3]}; kd[1] = (u32x4){klp[4], klp[5], klp[6], klp[7]};
    }
    __syncthreads();
    if (wave < 3) {
        const int si = wave >> 1, ti = wave == 0 ? 0 : 1, l31 = lane & 31, hh = lane >> 5;
        f32x16 o;
#pragma unroll
        for (int i = 0; i < 16; ++i) o[i] = 0.f;
        mma32(o, Km + si * 32 * LQ, LQ, Qm + ti * 32 * LQ, LQ, 128, lane);
        const int tl = ti * 32 + l31;
#pragma unroll
        for (int g = 0; g < 4; ++g) { const int s0 = si * 32 + 8 * g + 4 * hh; float a0 = o[4 * g], a1 = o[4 * g + 1], a2 = o[4 * g + 2], a3 = o[4 * g + 3];
            a0 = (s0 <= tl) ? a0 : 0.f; a1 = (s0 + 1 <= tl) ? a1 : 0.f; a2 = (s0 + 2 <= tl) ? a2 : 0.f; a3 = (s0 + 3 <= tl) ? a3 : 0.f;
            u32x2 w; w.x = pk2(a0, a1); w.y = pk2(a2, a3); *(LAS u32x2*)(ATT + tl * LS + s0) = w; }
    }
    __syncthreads();
}
struct VRegs { u32x4 r[4]; };
__device__ __forceinline__ void v_load(const Params& p, VRegs& v, int rb, int h, int T) {
    const int tid = otid(), s = tid & 63, vg = tid >> 6; const bf16_t* Z = (const bf16_t*)(p.ws + OFF_Z);
#pragma unroll
    for (int k = 0; k < 4; ++k) v.r[k] = (s < T) ? *(const u32x4*)(Z + (size_t)(rb + s) * NZ + 1024 + h * 256 + vg * 32 + 8 * k) : (u32x4){0u, 0u, 0u, 0u};
}
__device__ __forceinline__ void v_store_t(LAS unsigned char* lds, const VRegs& v) {
    const int tid = otid(), s = tid & 63, vg = tid >> 6; LAS bf16_t* VT = (LAS bf16_t*)(lds + R_VT) + (vg * 32) * LS + s;
#pragma unroll
    for (int k = 0; k < 4; ++k) {
        VT[(8 * k + 0) * LS] = (bf16_t)(v.r[k].x & 0xffffu); VT[(8 * k + 1) * LS] = (bf16_t)(v.r[k].x >> 16);
        VT[(8 * k + 2) * LS] = (bf16_t)(v.r[k].y & 0xffffu); VT[(8 * k + 3) * LS] = (bf16_t)(v.r[k].y >> 16);
        VT[(8 * k + 4) * LS] = (bf16_t)(v.r[k].z & 0xffffu); VT[(8 * k + 5) * LS] = (bf16_t)(v.r[k].z >> 16);
        VT[(8 * k + 6) * LS] = (bf16_t)(v.r[k].w & 0xffffu); VT[(8 * k + 7) * LS] = (bf16_t)(v.r[k].w >> 16); }
}
__device__ __forceinline__ void gla_step(const Params& p, LAS unsigned char* lds, f32x16 (&S)[4], int rb, int h, int T, int vb, int vtrow) {
    const int lane = otid() & 63, l31 = lane & 31, hh = lane >> 5;
    LAS bf16_t* Qe = (LAS bf16_t*)(lds + R_QE); LAS bf16_t* KlT = (LAS bf16_t*)(lds + R_KLT); LAS bf16_t* ATT = (LAS bf16_t*)(lds + R_ATT); LAS float* DEC = (LAS float*)(lds + R_DEC);
    LAS bf16_t* VT = (LAS bf16_t*)(lds + R_VT);
    bf16_t* oraw = (bf16_t*)(p.ws + OFF_ORAW);
    f32x16 Za[2], Zb[2];
#pragma unroll
    for (int tt = 0; tt < 2; ++tt)
#pragma unroll
        for (int i = 0; i < 16; ++i) { Za[tt][i] = 0.f; Zb[tt][i] = 0.f; }
    bf16x8 sa[4][2];
#pragma unroll
    for (int cb = 0; cb < 4; ++cb)
#pragma unroll
        for (int s = 0; s < 2; ++s) { u32x4 aw; aw.x = pk2(S[cb][8 * s], S[cb][8 * s + 1]); aw.y = pk2(S[cb][8 * s + 2], S[cb][8 * s + 3]); aw.z = pk2(S[cb][8 * s + 4], S[cb][8 * s + 5]); aw.w = pk2(S[cb][8 * s + 6], S[cb][8 * s + 7]);
            sa[cb][s] = __builtin_bit_cast(bf16x8, aw); }
    bf16x8 vt[4];
    const LAS bf16_t* vp = VT + (vtrow + l31) * LS + 8 * hh;
#pragma unroll
    for (int ks = 0; ks < 4; ++ks) vt[ks] = *(const LAS bf16x8*)(vp + 16 * ks);
#pragma unroll
    for (int cb = 0; cb < 4; ++cb)
#pragma unroll
        for (int g = 0; g < 4; ++g) { const f32x4 d = *(const LAS f32x4*)(DEC + cb * 32 + 8 * g + 4 * hh);
            S[cb][4 * g] *= d[0]; S[cb][4 * g + 1] *= d[1]; S[cb][4 * g + 2] *= d[2]; S[cb][4 * g + 3] *= d[3]; }
#pragma unroll
    for (int ks = 0; ks < 4; ++ks)
#pragma unroll
        for (int cb = 0; cb < 4; ++cb) { const bf16x8 a = *(const LAS bf16x8*)(KlT + (32 * cb + l31) * LS + 16 * ks + 8 * hh); S[cb] = mfma32(a, vt[ks], S[cb]); }
#pragma unroll
    for (int cb = 0; cb < 4; ++cb)
#pragma unroll
        for (int s = 0; s < 2; ++s)
#pragma unroll
            for (int tt = 0; tt < 2; ++tt) { const LAS bf16_t* qp = Qe + (32 * tt + l31) * LQ + 32 * cb + 16 * s + 4 * hh;
                const u32x2 q0 = *(const LAS u32x2*)qp, q1 = *(const LAS u32x2*)(qp + 8); const u32x4 bw = (u32x4){q0.x, q0.y, q1.x, q1.y};
                Za[tt] = mfma32(sa[cb][s], __builtin_bit_cast(bf16x8, bw), Za[tt]); }
#pragma unroll
    for (int ks = 0; ks < 4; ++ks)
#pragma unroll
        for (int tt = 0; tt < 2; ++tt) if (ks < 2 * (tt + 1)) { const bf16x8 bq = *(const LAS bf16x8*)(ATT + (32 * tt + l31) * LS + 16 * ks + 8 * hh); Zb[tt] = mfma32(vt[ks], bq, Zb[tt]); }
#pragma unroll
    for (int tt = 0; tt < 2; ++tt) { const int t = 32 * tt + l31;
        if (t < T) { bf16_t* op = oraw + (size_t)(rb + t) * 1024 + h * 256 + 32 * vb + 4 * hh;
#pragma unroll
            for (int g = 0; g < 4; ++g) { u32x2 w; w.x = pk2(Za[tt][4 * g] + Zb[tt][4 * g], Za[tt][4 * g + 1] + Zb[tt][4 * g + 1]); w.y = pk2(Za[tt][4 * g + 2] + Zb[tt][4 * g + 2], Za[tt][4 * g + 3] + Zb[tt][4 * g + 3]); *(u32x2*)(op + 8 * g) = w; } } }
}
__device__ __forceinline__ size_t s_index(int cb, int i, int hh, int wave, int l31) { return (size_t)(cb * 32 + (i & 3) + 8 * (i >> 2) + 4 * hh) * 256 + 32 * wave + l31; }

__device__ __forceinline__ void gla_prep_item(const Params& p, LAS unsigned char* lds, int chain, int ch) {
    const int b = chain >> 2, h = chain & 3;
    gla_prep(p, lds, b * 2048 + ch * 64, h, 64);
    u32x4* img = (u32x4*)(p.ws + OFF_IMG + (size_t)(chain * 32 + ch) * IMG_BYTES);
    for (int i = otid(); i < IMG_V4; i += 512) img[i] = ((const LAS u32x4*)lds)[i];
    __syncthreads();
}
constexpr int SG_TAB = 0, SG_ALOW = 20480, SG_PART = 24576;
__device__ __forceinline__ void gla_sample_pair(const Params& p, LAS unsigned char* lds, int item) {
    const int tid = otid(), lane = tid & 63, wave = tid >> 6, q = wave & 3, grp = wave >> 2, chain = item * 2 + grp;
    const int b = chain >> 2, h = chain & 3, rb = MP + b * 8;
    LAS float* tab = (LAS float*)(lds + SG_TAB + wave * 2560); LAS float* alw = (LAS float*)(lds + SG_ALOW + wave * 512); LAS float* part = (LAS float*)(lds + SG_PART);
    const bf16_t* Z = (const bf16_t*)(p.ws + OFF_Z); const float* alowg = (const float*)(p.ws + OFF_ALOW); bf16_t* oraw = (bf16_t*)(p.ws + OFF_ORAW);
    alw[lane] = alowg[(size_t)rb * 16 + lane]; alw[lane + 64] = alowg[(size_t)rb * 16 + 64 + lane];
    float qe[8][2], kv[8][2]; f32x4 V[8];
#pragma unroll
    for (int t = 0; t < 8; ++t) { const bf16_t* zr = Z + (size_t)(rb + t) * NZ; const unsigned qw = *(const unsigned*)(zr + h * 128 + 2 * lane), kw = *(const unsigned*)(zr + 512 + h * 128 + 2 * lane);
        const u32x2 vw = *(const u32x2*)(zr + 1024 + h * 256 + 4 * lane);
        qe[t][0] = bflo(qw); qe[t][1] = bfhi(qw); kv[t][0] = bflo(kw); kv[t][1] = bfhi(kw); V[t] = (f32x4){bflo(vw.x), bfhi(vw.x), bflo(vw.y), bfhi(vw.y)}; }
    float bc[8][2];
    {   f32x2 wa[16];
#pragma unroll
        for (int j = 0; j < 16; ++j) wa[j] = *(const f32x2*)(p.w_a2 + j * 512 + h * 128 + 2 * lane);
        const f32x2 ba = *(const f32x2*)(p.b_a + h * 128 + 2 * lane);
        lds_wait();
        float run0 = 0.f, run1 = 0.f;
#pragma unroll
        for (int t = 0; t < 8; ++t) { float p0 = ba.x, p1 = ba.y;
#pragma unroll
            for (int j4 = 0; j4 < 4; ++j4) { const f32x4 a4 = *(const LAS f32x4*)(alw + t * 16 + 4 * j4);
#pragma unroll
                for (int k = 0; k < 4; ++k) { p0 += a4[k] * wa[4 * j4 + k].x; p1 += a4[k] * wa[4 * j4 + k].y; } }
            run0 += logsigmoid_f(p0) * 0.0625f; run1 += logsigmoid_f(p1) * 0.0625f; bc[t][0] = run0; bc[t][1] = run1; } }
    float ki[8][2];
#pragma unroll
    for (int t = 0; t < 8; ++t) { qe[t][0] *= __expf(bc[t][0]); qe[t][1] *= __expf(bc[t][1]); ki[t][0] = kv[t][0] * __expf(-bc[t][0]); ki[t][1] = kv[t][1] * __expf(-bc[t][1]); }
    lds_wait();
#pragma unroll
    for (int t = 0; t < 8; ++t)
#pragma unroll
        for (int s = 0; s <= t; ++s) { const float a = wave_sum(qe[t][0] * ki[s][0] + qe[t][1] * ki[s][1]); if (lane == 0) alw[t * (t + 1) / 2 + s] = a; }
    if ((lane >> 4) == q) { const float e0 = __expf(bc[7][0]), e1 = __expf(bc[7][1]); LAS float* r0 = tab + (2 * lane - 32 * q) * 20; LAS float* r1 = r0 + 20;
        *(LAS f32x4*)(r0) = (f32x4){qe[0][0], qe[1][0], qe[2][0], qe[3][0]}; *(LAS f32x4*)(r0 + 4) = (f32x4){qe[4][0], qe[5][0], qe[6][0], qe[7][0]};
        *(LAS f32x4*)(r1) = (f32x4){qe[0][1], qe[1][1], qe[2][1], qe[3][1]}; *(LAS f32x4*)(r1 + 4) = (f32x4){qe[4][1], qe[5][1], qe[6][1], qe[7][1]};
        *(LAS f32x4*)(r0 + 8) = (f32x4){ki[0][0] * e0, ki[1][0] * e0, ki[2][0] * e0, ki[3][0] * e0}; *(LAS f32x4*)(r0 + 12) = (f32x4){ki[4][0] * e0, ki[5][0] * e0, ki[6][0] * e0, ki[7][0] * e0};
        *(LAS f32x4*)(r1 + 8) = (f32x4){ki[0][1] * e1, ki[1][1] * e1, ki[2][1] * e1, ki[3][1] * e1}; *(LAS f32x4*)(r1 + 12) = (f32x4){ki[4][1] * e1, ki[5][1] * e1, ki[6][1] * e1, ki[7][1] * e1};
        r0[16] = e0; r1[16] = e1; }
    lds_wait();
    f32x4 o[8];
#pragma unroll
    for (int t = 0; t < 8; ++t) o[t] = (f32x4){0.f, 0.f, 0.f, 0.f};
    const f32x4* S0 = (const f32x4*)(p.state_gla + (size_t)chain * 32768 + (size_t)(32 * q) * 256) + lane; f32x4* So = (f32x4*)(p.out + OUT_SS + (size_t)chain * 32768 + (size_t)(32 * q) * 256) + lane;
#pragma unroll 1
    for (int cc = 0; cc < 32; cc += 16) { f32x4 s[16];
#pragma unroll
        for (int u = 0; u < 16; ++u) s[u] = ldnt(S0 + (cc + u) * 64);
#pragma unroll
        for (int u = 0; u < 16; ++u) { const LAS float* row = tab + (cc + u) * 20; const f32x4 qa = *(const LAS f32x4*)row, qb = *(const LAS f32x4*)(row + 4), ka = *(const LAS f32x4*)(row + 8), kb = *(const LAS f32x4*)(row + 12); const float d = row[16];
            o[0] += qa[0] * s[u]; o[1] += qa[1] * s[u]; o[2] += qa[2] * s[u]; o[3] += qa[3] * s[u]; o[4] += qb[0] * s[u]; o[5] += qb[1] * s[u]; o[6] += qb[2] * s[u]; o[7] += qb[3] * s[u];
            f32x4 sn = d * s[u]; sn += ka[0] * V[0]; sn += ka[1] * V[1]; sn += ka[2] * V[2]; sn += ka[3] * V[3]; sn += kb[0] * V[4]; sn += kb[1] * V[5]; sn += kb[2] * V[6]; sn += kb[3] * V[7];
            stnt(So + (cc + u) * 64, sn); } }
#pragma unroll
    for (int t = 0; t < 8; ++t) *(LAS f32x4*)(part + (wave * 8 + t) * 256 + 4 * lane) = o[t];
    __syncthreads();
#pragma unroll
    for (int tt = 0; tt < 2; ++tt) { const int t = 2 * q + tt; f32x4 acc = (f32x4){0.f, 0.f, 0.f, 0.f};
#pragma unroll
        for (int w = 0; w < 4; ++w) acc += *(const LAS f32x4*)(part + ((grp * 4 + w) * 8 + t) * 256 + 4 * lane);
#pragma unroll
        for (int s = 0; s < 8; ++s) { const float a = (s <= t) ? alw[t * (t + 1) / 2 + s] : 0.f; acc += a * V[s]; }
        { u32x2 w; w.x = pk2(acc[0], acc[1]); w.y = pk2(acc[2], acc[3]); *(u32x2*)(oraw + (size_t)(rb + t) * 1024 + h * 256 + 4 * lane) = w; } }
    __syncthreads();
}
struct VRegs2 { u32x4 r[2]; };
__device__ __forceinline__ void v_load_half(const Params& p, VRegs2& v, int rb, int h, int vhalf) {
    const int tid = otid(), s = tid & 63, vg = tid >> 6; const bf16_t* Z = (const bf16_t*)(p.ws + OFF_Z);
#pragma unroll
    for (int k = 0; k < 2; ++k) v.r[k] = *(const u32x4*)(Z + (size_t)(rb + s) * NZ + 1024 + h * 256 + vhalf * 128 + vg * 16 + 8 * k);
}
__device__ __forceinline__ void v_store_half_t(LAS unsigned char* lds, const VRegs2& v) {
    const int tid = otid(), s = tid & 63, vg = tid >> 6; LAS bf16_t* VT = (LAS bf16_t*)(lds + R_VT) + (vg * 16) * LS + s;
#pragma unroll
    for (int k = 0; k < 2; ++k) {
        VT[(8 * k + 0) * LS] = (bf16_t)(v.r[k].x & 0xffffu); VT[(8 * k + 1) * LS] = (bf16_t)(v.r[k].x >> 16);
        VT[(8 * k + 2) * LS] = (bf16_t)(v.r[k].y & 0xffffu); VT[(8 * k + 3) * LS] = (bf16_t)(v.r[k].y >> 16);
        VT[(8 * k + 4) * LS] = (bf16_t)(v.r[k].z & 0xffffu); VT[(8 * k + 5) * LS] = (bf16_t)(v.r[k].z >> 16);
        VT[(8 * k + 6) * LS] = (bf16_t)(v.r[k].w & 0xffffu); VT[(8 * k + 7) * LS] = (bf16_t)(v.r[k].w >> 16); }
}
constexpr int CH_BUF = 64000;
template <int NTHR> __device__ __forceinline__ void chain_stage(const Params& p, LAS unsigned char* buf, const u32x4* img, int rb, int h, int vhalf, int t) {
    const bf16_t* Z = (const bf16_t*)(p.ws + OFF_Z);
    constexpr int NI = (IMG_V4 + NTHR - 1) / NTHR, NV = 512 / NTHR;
    u32x4 im[NI], v0[NV], v1[NV];
#pragma unroll
    for (int k = 0; k < NI; ++k) { const int i = t + NTHR * k; im[k] = (i < IMG_V4) ? img[i] : (u32x4){0u, 0u, 0u, 0u}; }
#pragma unroll
    for (int k = 0; k < NV; ++k) { const int e = t + NTHR * k, s = e & 63, vg = e >> 6; const bf16_t* zp = Z + (size_t)(rb + s) * NZ + 1024 + h * 256 + vhalf * 128 + vg * 16; v0[k] = *(const u32x4*)zp; v1[k] = *(const u32x4*)(zp + 8); }
#pragma unroll
    for (int k = 0; k < NI; ++k) { const int i = t + NTHR * k; if (i < IMG_V4) ((LAS u32x4*)buf)[i] = im[k]; }
#pragma unroll
    for (int k = 0; k < NV; ++k) { const int e = t + NTHR * k, s = e & 63, vg = e >> 6; const u32x4 r0 = v0[k], r1 = v1[k];
        LAS bf16_t* VT = (LAS bf16_t*)(buf + R_VT) + (vg * 16) * LS + s;
        VT[0 * LS] = (bf16_t)(r0.x & 0xffffu); VT[1 * LS] = (bf16_t)(r0.x >> 16); VT[2 * LS] = (bf16_t)(r0.y & 0xffffu); VT[3 * LS] = (bf16_t)(r0.y >> 16);
        VT[4 * LS] = (bf16_t)(r0.z & 0xffffu); VT[5 * LS] = (bf16_t)(r0.z >> 16); VT[6 * LS] = (bf16_t)(r0.w & 0xffffu); VT[7 * LS] = (bf16_t)(r0.w >> 16);
        VT[8 * LS] = (bf16_t)(r1.x & 0xffffu); VT[9 * LS] = (bf16_t)(r1.x >> 16); VT[10 * LS] = (bf16_t)(r1.y & 0xffffu); VT[11 * LS] = (bf16_t)(r1.y >> 16);
        VT[12 * LS] = (bf16_t)(r1.z & 0xffffu); VT[13 * LS] = (bf16_t)(r1.z >> 16); VT[14 * LS] = (bf16_t)(r1.w & 0xffffu); VT[15 * LS] = (bf16_t)(r1.w >> 16); }
}
__device__ __forceinline__ void gla_chain_item(const Params& p, LAS unsigned char* lds, int chain, int vhalf) {
    const int tid = otid(), lane = tid & 63, wave = tid >> 6, l31 = lane & 31, hh = lane >> 5;
    const int b = chain >> 2, h = chain & 3, vb = vhalf * 4 + (wave & 3);
    f32x16 S[4];
#pragma unroll
    for (int cb = 0; cb < 4; ++cb)
#pragma unroll
        for (int i = 0; i < 16; ++i) S[cb][i] = 0.f;
    const u32x4* img = (const u32x4*)(p.ws + OFF_IMG + (size_t)(chain * 32) * IMG_BYTES);
    chain_stage<512>(p, lds, img, b * 2048, h, vhalf, tid);
    __syncthreads();
#pragma unroll 1
    for (int ch = 0; ch < 32; ++ch) {
        const int rb = b * 2048 + ch * 64;
        if (wave >= 4) { if (ch + 1 < 32) chain_stage<256>(p, lds + ((ch + 1) & 1) * CH_BUF, img + (size_t)(ch + 1) * IMG_V4, rb + 64, h, vhalf, tid - 256); }
        else gla_step(p, lds + (ch & 1) * CH_BUF, S, rb, h, 64, vb, 32 * wave);
        __syncthreads();
    }
    if (wave < 4) {
        float* Sout = p.out + OUT_SP + (size_t)chain * 32768;
#pragma unroll
        for (int cb = 0; cb < 4; ++cb)
#pragma unroll
            for (int i = 0; i < 16; ++i) Sout[s_index(cb, i, hh, vb, l31)] = S[cb][i];
    }
}

constexpr int M_W = 0, M_V = 34816, M_STAT = 69632;
__device__ __forceinline__ void gmlp_item(const Params& p, LAS unsigned char* lds, int rowbase, int T, int g, float* vs_out) {
    const int tid = otid(), lane = tid & 63, wave = tid >> 6;
    const bf16_t* Z = (const bf16_t*)(p.ws + OFF_Z); bf16_t* mraw = (bf16_t*)(p.ws + OFF_MRAW);
    LAS bf16_t* LW = (LAS bf16_t*)(lds + M_W); LAS bf16_t* LV = (LAS bf16_t*)(lds + M_V); LAS float* stat = (LAS float*)(lds + M_STAT);
    if (tid < 128) { const f32x2 st = (tid < T) ? *(const f32x2*)((const float*)(p.ws + OFF_STAT) + (size_t)(rowbase + tid) * 2) : (f32x2){0.f, 0.f}; stat[2 * tid] = st.x; stat[2 * tid + 1] = st.y; }
    for (int idx = tid; idx < 4096; idx += 512) { const int t = idx >> 5, s4 = (idx & 31) * 4; const f32x4 w = *(const f32x4*)(p.w_s + ((size_t)g * 128 + t) * 128 + s4);
        u32x2 o; o.x = pk2(s4 <= t ? w[0] : 0.f, s4 + 1 <= t ? w[1] : 0.f); o.y = pk2(s4 + 2 <= t ? w[2] : 0.f, s4 + 3 <= t ? w[3] : 0.f);
        *(LAS u32x2*)(LW + t * LQ + s4) = o; }
    __syncthreads();
    { const int s = tid & 127, dq = tid >> 7; const float mean = stat[2 * s], rstd = stat[2 * s + 1];
#pragma unroll
        for (int ps = 0; ps < 4; ++ps) { const int d8 = (dq * 4 + ps) * 8; float vn[8];
            if (s < T) { const u32x4 r = *(const u32x4*)(Z + (size_t)(rowbase + s) * NZ + 4096 + g * 128 + d8);
                const float x[8] = {bflo(r.x), bfhi(r.x), bflo(r.y), bfhi(r.y), bflo(r.z), bfhi(r.z), bflo(r.w), bfhi(r.w)};
                const f32x4 ga = *(const f32x4*)(p.g_gmlp_ln + g * 128 + d8), gb = *(const f32x4*)(p.g_gmlp_ln + g * 128 + d8 + 4);
                const f32x4 ba = *(const f32x4*)(p.b_gmlp_ln + g * 128 + d8), bb = *(const f32x4*)(p.b_gmlp_ln + g * 128 + d8 + 4);
#pragma unroll
                for (int j = 0; j < 4; ++j) { vn[j] = (x[j] - mean) * rstd * ga[j] + ba[j]; vn[4 + j] = (x[4 + j] - mean) * rstd * gb[j] + bb[j]; }
                if (vs_out) { float* vp = vs_out + (size_t)s * 1024 + g * 128 + d8; *(f32x4*)vp = (f32x4){vn[0], vn[1], vn[2], vn[3]}; *(f32x4*)(vp + 4) = (f32x4){vn[4], vn[5], vn[6], vn[7]}; }
            } else {
#pragma unroll
                for (int j = 0; j < 8; ++j) vn[j] = 0.f;
            }
#pragma unroll
            for (int j = 0; j < 8; ++j) LV[(d8 + j) * LQ + s] = f2bf(vn[j]); } }
    __syncthreads();
#pragma unroll 1
    for (int q = 0; q < 2; ++q) { const int id = wave * 2 + q, ti = id >> 2, di = id & 3;
        if (ti * 32 < T) { f32x16 acc;
#pragma unroll
            for (int i = 0; i < 16; ++i) acc[i] = 0.f;
            mma32(acc, LW + ti * 32 * LQ, LQ, LV + di * 32 * LQ, LQ, (ti + 1) * 32, lane);
            const int d = di * 32 + (lane & 31);
#pragma unroll
            for (int i = 0; i < 16; ++i) { const int t = ti * 32 + (i & 3) + 8 * (i >> 2) + 4 * (lane >> 5);
                if (t < T) { const float uval = bf2f(Z[(size_t)(rowbase + t) * NZ + 3072 + g * 128 + d]);
                    mraw[(size_t)(rowbase + t) * 1024 + g * 128 + d] = f2bf(uval * (acc[i] + p.b_s[g * 128 + t])); } } } }
    __syncthreads();
}

__device__ __forceinline__ void gmlp_sample_item(const Params& p, int b) {
    const int tid = otid(), d2 = tid * 2, g = __builtin_amdgcn_readfirstlane(tid >> 6), rb = MP + b * 8;
    const bf16_t* Z = (const bf16_t*)(p.ws + OFF_Z); bf16_t* mraw = (bf16_t*)(p.ws + OFF_MRAW); const float* st = (const float*)(p.ws + OFF_STAT) + (size_t)rb * 2;
    float* vs_out = p.out + OUT_VS + (size_t)b * 8 * 1024;
    const f32x2 ga = *(const f32x2*)(p.g_gmlp_ln + d2), be = *(const f32x2*)(p.b_gmlp_ln + d2);
    unsigned xv[8], uv[8];
#pragma unroll
    for (int s_ = 0; s_ < 8; ++s_) { xv[s_] = *(const unsigned*)(Z + (size_t)(rb + s_) * NZ + 4096 + d2); uv[s_] = *(const unsigned*)(Z + (size_t)(rb + s_) * NZ + 3072 + d2); }
    float v0[8], v1[8];
#pragma unroll
    for (int s_ = 0; s_ < 8; ++s_) { const float mean = st[2 * s_], rstd = st[2 * s_ + 1];
        v0[s_] = (bflo(xv[s_]) - mean) * rstd * ga.x + be.x; v1[s_] = (bfhi(xv[s_]) - mean) * rstd * ga.y + be.y;
        *(f32x2*)(vs_out + (size_t)s_ * 1024 + d2) = (f32x2){v0[s_], v1[s_]}; }
    const float* wg = p.w_s + (size_t)g * 128 * 128; const float* bs = p.b_s + g * 128;
#pragma unroll
    for (int t = 0; t < 8; ++t) { float m0 = bs[t], m1 = m0;
#pragma unroll
        for (int s_ = 0; s_ <= t; ++s_) { const float w = wg[t * 128 + s_]; m0 += w * v0[s_]; m1 += w * v1[s_]; }
        *(unsigned*)(mraw + (size_t)(rb + t) * 1024 + d2) = pk2(bflo(uv[t]) * m0, bfhi(uv[t]) * m1); }
}
__device__ __forceinline__ void phase2a(const Params& p, LAS unsigned char* lds) {
    {   const int tid = otid(), lane = tid & 63, gw = blockIdx.x * 8 + (tid >> 6), NGW = gridDim.x * 8;
        const bf16_t* Z = (const bf16_t*)(p.ws + OFF_Z); float* st = (float*)(p.ws + OFF_STAT);
        for (int r = gw; r < MT; r += NGW) {
            const bf16_t* zr = Z + (size_t)r * NZ + 4096; const u32x4 r0 = *(const u32x4*)(zr + lane * 8), r1 = *(const u32x4*)(zr + 512 + lane * 8);
            const float x[16] = {bflo(r0.x), bfhi(r0.x), bflo(r0.y), bfhi(r0.y), bflo(r0.z), bfhi(r0.z), bflo(r0.w), bfhi(r0.w), bflo(r1.x), bfhi(r1.x), bflo(r1.y), bfhi(r1.y), bflo(r1.z), bfhi(r1.z), bflo(r1.w), bfhi(r1.w)};
            float s = 0.f;
#pragma unroll
            for (int j = 0; j < 16; ++j) s += x[j];
            const float mean = wave_sum(s) * (1.f / 1024.f); float q = 0.f;
#pragma unroll
            for (int j = 0; j < 16; ++j) { const float d = x[j] - mean; q += d * d; }
            const float rstd = rsqrtf(wave_sum(q) * (1.f / 1024.f) + 1e-6f);
            if (lane == 0) *(f32x2*)(st + (size_t)r * 2) = (f32x2){mean, rstd};
        }
    }
    for (int j = blockIdx.x; j < 512; j += gridDim.x) gla_prep_item(p, lds, j >> 5, j & 31);
    for (int j = blockIdx.x; j < 256; j += gridDim.x) gla_sample_pair(p, lds, j);
    { const int gw = blockIdx.x * 8 + (otid() >> 6), NGW = gridDim.x * 8; convert_range(p, lds, cv::E_IN, cv::E_OUT, gw, NGW); convert_range(p, lds, cv::E_FO, cv::E_PLE, gw, NGW); }
}
__device__ __forceinline__ void phase2c(const Params& p, LAS unsigned char* lds) {
    const int nb = gridDim.x, bid = blockIdx.x;
    constexpr int NCH = 32, N_GP = 512, N_GS = 0, N_MS = 128;
    const int nlb = nb > 2 * NCH ? NCH : (nb > 1 ? nb / 2 : 0);
    if (bid < nlb || nlb == 0) { for (int j = (nlb ? bid : 0); j < NCH; j += (nlb ? nlb : 1)) gla_chain_item(p, lds, j >> 1, j & 1); }
    if (bid >= nlb) {
        const int ob = bid - nlb, onb = nb - nlb;
        for (int j = ob; j < N_GP + N_GS + N_MS; j += onb) {
            if (j < N_GP) gmlp_item(p, lds, (j >> 3) * 128, 128, j & 7, nullptr);
            else gmlp_sample_item(p, j - N_GP - N_GS);
        }
        __syncthreads();
        convert_range(p, lds, cv::E_OUT, cv::E_FI, ob * 8 + (otid() >> 6), onb * 8);
    }
}

struct Mix10 { f32x4 o[4], m[4]; u32x4 r0, r1; };
__device__ __forceinline__ void mix_load(Mix10& a, const Params& p, int r, int col) {
    const bf16_t* Z = (const bf16_t*)(p.ws + OFF_Z); const bf16_t* oraw = (const bf16_t*)(p.ws + OFF_ORAW); const bf16_t* mraw = (const bf16_t*)(p.ws + OFF_MRAW);
#pragma unroll
    for (int j = 0; j < 2; ++j) { const u32x4 ow = ldnt((const u32x4*)(oraw + (size_t)r * 1024 + col + 8 * j)), mw = ldnt((const u32x4*)(mraw + (size_t)r * 1024 + col + 8 * j));
        a.o[2 * j] = (f32x4){bflo(ow.x), bfhi(ow.x), bflo(ow.y), bfhi(ow.y)}; a.o[2 * j + 1] = (f32x4){bflo(ow.z), bfhi(ow.z), bflo(ow.w), bfhi(ow.w)};
        a.m[2 * j] = (f32x4){bflo(mw.x), bfhi(mw.x), bflo(mw.y), bfhi(mw.y)}; a.m[2 * j + 1] = (f32x4){bflo(mw.z), bfhi(mw.z), bflo(mw.w), bfhi(mw.w)}; }
    a.r0 = ldnt((const u32x4*)(Z + (size_t)r * NZ + 2048 + col)); a.r1 = ldnt((const u32x4*)(Z + (size_t)r * NZ + 2048 + col + 8));
}
__device__ __forceinline__ void mix_finish(const Mix10& a, const Params& p, int r, int col) {
    bf16_t* cat = (bf16_t*)(p.ws + OFF_A0);
    { float s = 0.f;
#pragma unroll
        for (int j = 0; j < 4; ++j) s += (a.o[j][0] * a.o[j][0] + a.o[j][1] * a.o[j][1]) + (a.o[j][2] * a.o[j][2] + a.o[j][3] * a.o[j][3]);
        s = row16_sum(s);
        const float rinv = rsqrtf(s * (1.f / 256.f) + 1e-6f);
        const float sr[16] = {bflo(a.r0.x), bfhi(a.r0.x), bflo(a.r0.y), bfhi(a.r0.y), bflo(a.r0.z), bfhi(a.r0.z), bflo(a.r0.w), bfhi(a.r0.w), bflo(a.r1.x), bfhi(a.r1.x), bflo(a.r1.y), bfhi(a.r1.y), bflo(a.r1.z), bfhi(a.r1.z), bflo(a.r1.w), bfhi(a.r1.w)};
        unsigned w[8];
#pragma unroll
        for (int j = 0; j < 4; ++j) { const f32x4 g = *(const f32x4*)(p.g_gla_norm + col + 4 * j);
            w[2 * j] = pk2(a.o[j][0] * rinv * g[0] * sr[4 * j], a.o[j][1] * rinv * g[1] * sr[4 * j + 1]); w[2 * j + 1] = pk2(a.o[j][2] * rinv * g[2] * sr[4 * j + 2], a.o[j][3] * rinv * g[3] * sr[4 * j + 3]); }
        u32x4* dp = (u32x4*)(cat + (size_t)r * DM + col); dp[0] = (u32x4){w[0], w[1], w[2], w[3]}; dp[1] = (u32x4){w[4], w[5], w[6], w[7]}; }
    { float s = 0.f;
#pragma unroll
        for (int j = 0; j < 4; ++j) s += (a.m[j][0] * a.m[j][0] + a.m[j][1] * a.m[j][1]) + (a.m[j][2] * a.m[j][2] + a.m[j][3] * a.m[j][3]);
        const float rinv = rsqrtf(wave_sum(s) * (1.f / 1024.f) + 1e-6f);
        unsigned w[8];
#pragma unroll
        for (int j = 0; j < 4; ++j) { const f32x4 g = *(const f32x4*)(p.g_gmlp_out + col + 4 * j);
            w[2 * j] = pk2(a.m[j][0] * rinv * g[0], a.m[j][1] * rinv * g[1]); w[2 * j + 1] = pk2(a.m[j][2] * rinv * g[2], a.m[j][3] * rinv * g[3]); }
        u32x4* dp = (u32x4*)(cat + (size_t)r * DM + 1024 + col); dp[0] = (u32x4){w[0], w[1], w[2], w[3]}; dp[1] = (u32x4){w[4], w[5], w[6], w[7]}; }
}
__device__ __forceinline__ void phase2b(const Params& p) {
    const int lane = otid() & 63, gw = blockIdx.x * 8 + (otid() >> 6), NGW = gridDim.x * 8, col = lane * 16;
    for (int r = gw; r < MT; r += 2 * NGW) {
        const int r2 = r + NGW; const bool has2 = r2 < MT;
        Mix10 a, b; mix_load(a, p, r, col); mix_load(b, p, has2 ? r2 : r, col);
        mix_finish(a, p, r, col);
        if (has2) mix_finish(b, p, r2, col);
    }
}
template <int NS> __device__ __forceinline__ void phase_norm(const Params& p, const float* gain, const float* base_s) {
    const int lane = otid() & 63, gw = blockIdx.x * 8 + (otid() >> 6), NGW = gridDim.x * 8; bf16_t* a0 = (bf16_t*)(p.ws + OFF_A0); const bf16_t* part = (const bf16_t*)(p.ws + OFF_IMG);
    for (int r = gw; r < MP; r += 4 * NGW) {
        const int r2 = r + NGW, r3 = r + 2 * NGW, r4 = r + 3 * NGW; const bool h2 = r2 < MP, h3 = r3 < MP, h4 = r4 < MP;
        Row8 a, b, c4, d; row_load_nt(a, p.out + OUT_Y + (size_t)r * DM, lane); row_load_nt(b, p.out + OUT_Y + (size_t)(h2 ? r2 : r) * DM, lane);
        row_load_nt(c4, p.out + OUT_Y + (size_t)(h3 ? r3 : r) * DM, lane); row_load_nt(d, p.out + OUT_Y + (size_t)(h4 ? r4 : r) * DM, lane);
        rms_finish_bf16(a, gain, a0 + (size_t)r * DM, lane);
        if (h2) rms_finish_bf16(b, gain, a0 + (size_t)r2 * DM, lane);
        if (h3) rms_finish_bf16(c4, gain, a0 + (size_t)r3 * DM, lane);
        if (h4) rms_finish_bf16(d, gain, a0 + (size_t)r4 * DM, lane);
    }
    for (int r = MP + gw; r < MT; r += NGW) {
        f32x4 v[8]; float s = 0.f; const f32x4* sm = row_mid(base_s + (size_t)(r - MP) * DM, lane); const f32x4* gm = row_mid(gain, lane);
        const u32x2* pm0 = (const u32x2*)(part + (size_t)(r - MP) * DM) + lane; f32x4* om = row_mid(p.out + OUT_Y + (size_t)r * DM, lane);
#pragma unroll
        for (int j = 0; j < 8; ++j) v[j] = sm[64 * (j - 4)];
#pragma unroll 4
        for (int k = 0; k < NS; ++k) { const u32x2* pk = pm0 + (size_t)k * (MS * DM / 4);
#pragma unroll
            for (int j = 0; j < 8; ++j) v[j] += unpack4(pk[64 * j]); }
#pragma unroll
        for (int j = 0; j < 8; ++j) { om[64 * (j - 4)] = v[j]; s += (v[j][0] * v[j][0] + v[j][1] * v[j][1]) + (v[j][2] * v[j][2] + v[j][3] * v[j][3]); }
        const float rinv = rsqrtf(wave_sum(s) * (1.f / DM) + 1e-6f);
        u32x2* dm = (u32x2*)(a0 + (size_t)r * DM) + lane;
#pragma unroll
        for (int j = 0; j < 8; ++j) { const f32x4 g = gm[64 * (j - 4)]; u32x2 o; o.x = pk2(v[j][0] * rinv * g[0], v[j][1] * rinv * g[1]); o.y = pk2(v[j][2] * rinv * g[2], v[j][3] * rinv * g[3]);
            dm[64 * j] = o; }
    }
}
#define P7_TAIL() \
        float s = 0.f; \
        _Pragma("unroll") for (int j = 0; j < 8; ++j) s += (v.v[j][0] * v.v[j][0] + v.v[j][1] * v.v[j][1]) + (v.v[j][2] * v.v[j][2] + v.v[j][3] * v.v[j][3]); \
        const float rp = rsqrtf(wave_sum(s) * (1.f / DM) + 1e-6f); float s3 = 0.f; \
        const f32x4* gpm = row_mid(p.g_ple, lane); \
        _Pragma("unroll") for (int j = 0; j < 8; ++j) { const f32x4 g = gpm[64 * (j - 4)]; \
            _Pragma("unroll") for (int k = 0; k < 4; ++k) { const float h3 = hh.v[j][k] + v.v[j][k] * rp * g[k] * sigmoid_f(z.v[j][k]); v.v[j][k] = h3; s3 += h3 * h3; } } \
        const float r3 = rsqrtf(wave_sum(s3) * (1.f / DM) + 1e-6f); \
        const f32x4* gfm = row_mid(p.g_final, lane); \
        _Pragma("unroll") for (int j = 0; j < 8; ++j) { const f32x4 g = gfm[64 * (j - 4)]; stnt(om + 64 * (j - 4), (f32x4){v.v[j][0] * r3 * g[0], v.v[j][1] * r3 * g[1], v.v[j][2] * r3 * g[2], v.v[j][3] * r3 * g[3]}); }
__device__ __forceinline__ void phase7(const Params& p) {
    const int lane = otid() & 63, gw = blockIdx.x * 8 + (otid() >> 6), NGW = gridDim.x * 8;
    const bf16_t* gz = (const bf16_t*)(p.ws + OFF_GATEZ); const bf16_t* pz = (const bf16_t*)(p.ws + OFF_PZ);
#pragma unroll 1
    for (int r = gw; r < MP; r += NGW) {
        f32x4* om = row_mid(p.out + OUT_Y + (size_t)r * DM, lane);
        const u32x2* pzr = (const u32x2*)(pz + (size_t)r * DM) + lane; const u32x2* zb = (const u32x2*)(gz + (size_t)r * DM) + lane;
        Row8 v, hh, z;
#pragma unroll
        for (int j = 0; j < 8; ++j) { const u32x2 w = ldnt(pzr + 64 * j), zw = ldnt(zb + 64 * j); v.v[j] = (f32x4){bflo(w.x), bfhi(w.x), bflo(w.y), bfhi(w.y)}; z.v[j] = (f32x4){bflo(zw.x), bfhi(zw.x), bflo(zw.y), bfhi(zw.y)}; hh.v[j] = ldnt(om + 64 * (j - 4)); }
        P7_TAIL()
    }
#pragma unroll 1
    for (int r = MP + gw; r < MT; r += NGW) {
        f32x4* om = row_mid(p.out + OUT_Y + (size_t)r * DM, lane);
        const u32x2* pzr = (const u32x2*)(pz + (size_t)r * DM) + lane; const u32x2* zm = (const u32x2*)((const bf16_t*)(p.ws + OFF_IMG) + (size_t)(r - MP) * DM) + lane;
        Row8 v, hh, z;
#pragma unroll
        for (int j = 0; j < 8; ++j) { const u32x2 w = ldnt(pzr + 64 * j); v.v[j] = unpack4(w); hh.v[j] = ldnt(om + 64 * (j - 4)); z.v[j] = (f32x4){0.f, 0.f, 0.f, 0.f}; }
#pragma unroll 4
        for (int k = 0; k < 8; ++k) { const u32x2* pk = zm + (size_t)k * (MS * DM / 4);
#pragma unroll
            for (int j = 0; j < 8; ++j) z.v[j] += unpack4(ldnt(pk + 64 * j)); }
        P7_TAIL()
    }
}
#undef P7_TAIL

__global__ void __launch_bounds__(512, 2) fwd_kernel(Params p) {
    extern __shared__ __attribute__((aligned(16))) unsigned char shm[];
    LAS unsigned char* lds = (LAS unsigned char*)shm;
    cg::grid_group grid = cg::this_grid();
    if (threadIdx.x == 0) { *(volatile LAS unsigned*)(lds + 131072) = 0u; *(volatile LAS unsigned*)(lds + 131076) = 0u; }
    __syncthreads();
    const XcdBarrier xb = xcd_barrier_post((unsigned*)(p.ws + OFF_BAR), (volatile LAS unsigned*)(lds + 131072));
    bf16_t* a0 = (bf16_t*)(p.ws + OFF_A0);
    phase0(p, lds);
    if (p.ws == nullptr) grid.sync();
    xcd_barrier(xb);
    { EpiIn E; E.Z = (bf16_t*)(p.ws + OFF_Z); E.alow = (float*)(p.ws + OFF_ALOW); run_gemm(lds, a0, (const bf16_t*)(p.ws + OFF_WIN), MT, NINP, DM, E); }
    xcd_barrier(xb);
    phase2a(p, lds);
    xcd_barrier(xb);
    phase2c(p, lds);
    xcd_barrier(xb);
    phase2b(p);
    xcd_barrier(xb);
    bf16_t* part = (bf16_t*)(p.ws + OFF_IMG);
    { EpiRes E; E.res_p = p.x_prompt; E.res_s = p.x_sample; E.out = p.out + OUT_Y; run_gemm_n2048(lds, a0, (const bf16_t*)(p.ws + OFF_WOUT), DM, E, part); }
    xcd_barrier(xb);
    phase_norm<8>(p, p.g_ffn, p.x_sample);
    xcd_barrier(xb);
    { EpiSwiglu E; E.act = (bf16_t*)(p.ws + OFF_ACT); run_gemm(lds, a0, (const bf16_t*)(p.ws + OFF_WFI), MT, 2 * DFF, DM, E); }
    {
        const int G = (int)gridDim.x, extra = ((MT / 256) * (2 * DFF / 256)) % G, cb = (int)blockIdx.x;
        if (extra == 0 || cb >= extra) { EpiBfN E; E.out = (bf16_t*)(p.ws + OFF_PZ); pg8::Gemm g; g.A = (const bf16_t*)(p.ws + OFF_PB); g.Bt = (const bf16_t*)(p.ws + OFF_WPLE); g.M = MT; g.N = DM; g.K = PLE; g.Klen = PLE;
            pg8::StaticOrder S; S.init(MT, DM, extra ? G - extra : G, extra ? cb - extra : cb); pg8::gemm_phase<EpiBfN, pg8::StaticOrder, false>(lds, g, S, E, nullptr);
            { const int ob = extra ? cb - extra : cb, onb = extra ? G - extra : G, gw = ob * 8 + (otid() >> 6); convert_range(p, lds, cv::E_FI, cv::E_FO, gw, onb * 8); convert_range(p, lds, cv::E_PLE, cv::E_GT, gw, onb * 8); } }
    }
    xcd_barrier(xb);
    { EpiRes E; E.res_p = p.out + OUT_Y; E.res_s = p.out + OUT_Y + (size_t)MP * DM; E.out = p.out + OUT_Y;
      const bf16_t* A = (const bf16_t*)(p.ws + OFF_ACT); const bf16_t* Bt = (const bf16_t*)(p.ws + OFF_WFO); const int G = (int)gridDim.x, hb = (int)((blockIdx.x + G / 2) % G);
      run_gemm(lds, A, Bt, MP, DM, DFF, E);
      run_split(lds, A, Bt, DFF, part, 4, 768, 0, 0, hb);
      run_split(lds, A, Bt, DFF, part, 4, 640, 3072, 4, (int)blockIdx.x); }
    xcd_barrier(xb);
    phase_norm<8>(p, p.g_ple_gate, p.out + OUT_Y + (size_t)MP * DM);
    xcd_barrier(xb);
    { EpiBfN E; E.out = (bf16_t*)(p.ws + OFF_GATEZ); run_gemm_n2048(lds, a0, (const bf16_t*)(p.ws + OFF_WGT), DM, E, part); }
    xcd_barrier(xb);
    phase7(p);
}

extern "C" void kernel_launch(void* const* d_in, const int* in_sizes, int n_in, void* d_out, int out_size, void* d_ws, size_t ws_size, hipStream_t stream) {
    static int grid = 0;
    if (grid == 0) {
        if (n_in != 24 || ws_size < WS_END) { fprintf(stderr, "kernel_launch: unexpected n_in %d or ws_size %zu (< %zu)\n", n_in, ws_size, (size_t)WS_END); grid = -1; return; }
        int dev = 0, cus = 0, per_cu = 0;
        if (hipGetDevice(&dev) != hipSuccess || hipDeviceGetAttribute(&cus, hipDeviceAttributeMultiprocessorCount, dev) != hipSuccess) { grid = -1; return; }
        if (hipFuncSetAttribute((const void*)fwd_kernel, hipFuncAttributeMaxDynamicSharedMemorySize, LDS_BYTES) != hipSuccess) { fprintf(stderr, "kernel_launch: hipFuncSetAttribute failed\n"); grid = -1; return; }
        if (hipOccupancyMaxActiveBlocksPerMultiprocessor(&per_cu, (const void*)fwd_kernel, 512, LDS_BYTES) != hipSuccess || per_cu < 1) { fprintf(stderr, "kernel_launch: occupancy query says %d blocks per CU\n", per_cu); grid = -1; (void)hipGetLastError(); return; }
        grid = cus;
    }
    if (grid < 0) return;
    if (hipMemsetAsync(d_ws, 0, XCD_BAR_WORDS * sizeof(unsigned), stream) != hipSuccess) { fprintf(stderr, "kernel_launch: memset failed\n"); return; }
    Params p{};
    const float** f = (const float**)&p;
    for (int i = 0; i < 24; ++i) f[i] = (const float*)d_in[i];
    p.out = (float*)d_out; p.ws = (unsigned char*)d_ws;
    void* args[] = {&p};
    hipError_t e = hipLaunchCooperativeKernel((const void*)fwd_kernel, dim3(grid), dim3(512), args, LDS_BYTES, stream);
    if (e != hipSuccess) fprintf(stderr, "cooperative launch failed: %s (grid %d)\n", hipGetErrorString(e), grid);
}
```

```cpp
#include <hip/hip_runtime.h>
#include <hip/hip_cooperative_groups.h>
#include <cstdio>
#include <cstdint>
namespace cg = cooperative_groups;
namespace pg8 {
#define PG8_LAS __attribute__((address_space(3)))
typedef unsigned short bf16_t;
typedef short bf16x8 __attribute__((ext_vector_type(8)));
typedef float f32x4 __attribute__((ext_vector_type(4)));
typedef unsigned u32x4 __attribute__((ext_vector_type(4)));
constexpr int BM = 256, BK = 64, HALF = 128, HTB = HALF * BK * 2  , STAGE_BYTES = 8 * HTB, NXCD = 8, WGM = 8;

__host__ __device__ __forceinline__ int lds_byte(int r, int c) { const int st = (r >> 4) * 2 + (c >> 5), rr = r & 15, cc = c & 31, ob = rr * 64 + cc * 2; return st * 1024 + (ob ^ (((ob >> 9) & 1) << 5)); }
__host__ __device__ __forceinline__ void stage_rc(int b, int& R, int& C) { const int st = b / 1024, sb = b % 1024, swz = sb ^ (((sb >> 9) & 1) << 5); R = (st >> 1) * 16 + swz / 64; C = (st & 1) * 32 + (swz % 64) / 2; }
__host__ __device__ __forceinline__ int perm32(int rho) { const int n = rho >> 4, i = rho & 15; return 8 * (i >> 2) + 4 * n + (i & 3); }

struct Unit { int pm, pn, ks, koff; };
struct Gemm { const bf16_t* A; const bf16_t* Bt; int M, N, K, Klen; };

struct StaticOrder {
    int nM, nN, nwg, G, c;
    __host__ __device__ void init(int M, int N, int G_, int c_) { nM = M / BM; nN = N / BM; nwg = nM * nN; G = G_; c = c_; }
    __host__ __device__ bool next(int i, Unit& u) const {
        const long L = (long)i * G + c; if (L >= nwg) return false;
        int wgid = (int)L; { const int q = nwg / NXCD, r = nwg % NXCD, xcd = wgid % NXCD, off = wgid / NXCD; wgid = (xcd < r ? xcd * (q + 1) : r * (q + 1) + (xcd - r) * q) + off; }
        const int nig = WGM * nN, gid = wgid / nig, fm = gid * WGM, gsz = (nM - fm) < WGM ? (nM - fm) : WGM;
        u.pm = fm + ((wgid % nig) % gsz); u.pn = (wgid % nig) / gsz; u.ks = 0; u.koff = 0; return true;
    }
    __device__ __forceinline__ void a_ready(const Unit&) const {}
    __device__ __forceinline__ void done(const Unit&) const {}
};
__device__ __forceinline__ unsigned cvt_pk_bf16(float lo, float hi) { unsigned r; asm volatile("v_cvt_pk_bf16_f32 %0, %1, %2" : "=v"(r) : "v"(lo), "v"(hi)); return r; }
typedef float f32x2 __attribute__((ext_vector_type(2)));
template <class Epi, class Sched, bool STAMP = false>
__device__ __forceinline__ void gemm_phase(PG8_LAS unsigned char* lds, const Gemm g, const Sched& S, const Epi& E, unsigned long long* stamps) {
    int tid_ = threadIdx.x; asm volatile("" : "+v"(tid_));
    const int tid = tid_, wid = __builtin_amdgcn_readfirstlane(tid >> 6), lane = tid & 63, wr = wid >> 2, wc = wid & 3, fr = lane & 15, fq = lane >> 4;
    const int K = g.K, nt = g.Klen / BK;
    int ts_lo = 0, ts_hi = 0, nts = 0; const unsigned long long rt_entry = STAMP ? (unsigned long long)wall_clock64() : 0ull;
#define PG8_STAMP() do { if (STAMP && wid == 0 && nts < 64) { const unsigned long long _c = (unsigned long long)clock64(); \
        ts_lo = (lane == nts) ? (int)(unsigned)_c : ts_lo; ts_hi = (lane == nts) ? (int)(unsigned)(_c >> 32) : ts_hi; ++nts; } } while (0)
    PG8_STAMP();
    unsigned voffA[2], voffB[2];
#pragma unroll
    for (int i = 0; i < 2; ++i) { int R, C; stage_rc(tid * 16 + i * 8192, R, C); const int Rb = Epi::PERM ? ((R & ~31) + perm32(R & 31)) : R;
        voffA[i] = (unsigned)(R * K + C) * 2u; voffB[i] = (unsigned)(Rb * K + C) * 2u; }
    const size_t kstep = (size_t)(BK * 2);
    const size_t hstep = (size_t)HALF * K * 2;
    const size_t tstep = 2 * hstep;
    const unsigned ldsw = (unsigned)wid * 1024u;
    const int aoff = lds_byte(wr * 64 + fr, fq * 8), boff = lds_byte(wc * 32 + fr, fq * 8);
#define PG8_SA(b, h) (((b) * 2 + (h)) * HTB)
#define PG8_SB(b, h) ((4 + (b) * 2 + (h)) * HTB)
#define PG8_STAGE(bufoff, gbase, voff) do { _Pragma("unroll") for (int _i = 0; _i < 2; ++_i) \
        __builtin_amdgcn_global_load_lds((const unsigned*)((const char*)(gbase) + (voff)[_i]), (PG8_LAS unsigned*)(lds + (bufoff) + ldsw + _i * 8192), 16, 0, 0); } while (0)
#define PG8_LDA(dst, b, h) do { _Pragma("unroll") for (int m = 0; m < 4; ++m) _Pragma("unroll") for (int k = 0; k < 2; ++k) dst[m][k] = *(const PG8_LAS bf16x8*)(lds + PG8_SA(b, h) + aoff + m * 2048 + k * 1024); } while (0)
#define PG8_LDB(dst, b, h) do { _Pragma("unroll") for (int n = 0; n < 2; ++n) _Pragma("unroll") for (int k = 0; k < 2; ++k) dst[n][k] = *(const PG8_LAS bf16x8*)(lds + PG8_SB(b, h) + boff + n * 2048 + k * 1024); } while (0)
#define PG8_MMA(ai, bj, At, Bt) do { __builtin_amdgcn_s_setprio(1); _Pragma("unroll") for (int m = 0; m < 4; ++m) _Pragma("unroll") for (int n = 0; n < 2; ++n) _Pragma("unroll") for (int k = 0; k < 2; ++k) \
        acc[ai][bj][m][n] = __builtin_amdgcn_mfma_f32_16x16x32_bf16(Bt[n][k], At[m][k], acc[ai][bj][m][n], 0, 0, 0); __builtin_amdgcn_s_setprio(0); } while (0)
#define PG8_WAIT_V(n) asm volatile("s_waitcnt vmcnt(" #n ")" ::: "memory")
#define PG8_WAIT_L(n) asm volatile("s_waitcnt lgkmcnt(" #n ")" ::: "memory")
#define PG8_BAR __builtin_amdgcn_s_barrier()
#define PG8_SCHED __builtin_amdgcn_sched_barrier(0)
    Unit cur, nxt; int ui = 0;
    if (!S.next(0, cur)) return;
    f32x4 acc[2][2][4][2];
#pragma unroll
    for (int a = 0; a < 2; ++a)
#pragma unroll
        for (int b = 0; b < 2; ++b)
#pragma unroll
            for (int m = 0; m < 4; ++m)
#pragma unroll
                for (int n = 0; n < 2; ++n) acc[a][b][m][n] = (f32x4){0.f, 0.f, 0.f, 0.f};
    bf16x8 At[4][2], B0[2][2], B1[2][2];
    const char* cA = (const char*)g.A + (size_t)cur.pm * tstep + (size_t)cur.koff * 2; const char* cB = (const char*)g.Bt + (size_t)cur.pn * tstep + (size_t)cur.koff * 2;
    S.a_ready(cur);
    PG8_STAGE(PG8_SB(0, 0), cB, voffB); PG8_STAGE(PG8_SB(0, 1), cB + hstep, voffB); PG8_STAGE(PG8_SA(0, 0), cA, voffA); PG8_STAGE(PG8_SA(0, 1), cA + hstep, voffA);
    if (wr == 1) PG8_BAR;
    PG8_WAIT_V(2); PG8_BAR;
    PG8_STAGE(PG8_SB(1, 0), cB + kstep, voffB); PG8_STAGE(PG8_SA(1, 0), cA + kstep, voffA); PG8_STAGE(PG8_SB(1, 1), cB + hstep + kstep, voffB);
    PG8_WAIT_V(6); PG8_BAR;
    PG8_STAMP();
    for (;;) {
        const bool has_next = S.next(ui + 1, nxt);
        const char* nA = has_next ? (const char*)g.A + (size_t)nxt.pm * tstep + (size_t)nxt.koff * 2 : cA; const char* nB = has_next ? (const char*)g.Bt + (size_t)nxt.pn * tstep + (size_t)nxt.koff * 2 : cB;
        for (int t = 0; t < nt; t += 2) {
            const bool last = (t == nt - 2);
            const char* a1 = cA + (size_t)(t + 1) * kstep;
            const char* a2 = last ? nA : cA + (size_t)(t + 2) * kstep; const char* b2 = last ? nB : cB + (size_t)(t + 2) * kstep;
            const char* a3 = a2 + kstep; const char* b3 = b2 + kstep;
            if (last && has_next) S.a_ready(nxt);
            PG8_LDB(B0, 0, 0); PG8_LDB(B1, 0, 1); PG8_SCHED; PG8_LDA(At, 0, 0); PG8_STAGE(PG8_SA(1, 1), a1 + hstep, voffA);
            PG8_WAIT_V(8); PG8_WAIT_L(0); PG8_BAR; PG8_MMA(0, 0, At, B0); PG8_MMA(0, 1, At, B1); PG8_BAR; PG8_SCHED;
            PG8_LDA(At, 0, 1); PG8_STAGE(PG8_SB(0, 0), b2, voffB); PG8_STAGE(PG8_SB(0, 1), b2 + hstep, voffB); PG8_STAGE(PG8_SA(0, 0), a2, voffA);
            PG8_WAIT_V(8); PG8_WAIT_L(0); PG8_BAR; PG8_MMA(1, 0, At, B0); PG8_MMA(1, 1, At, B1); PG8_BAR; PG8_SCHED;
            PG8_LDB(B0, 1, 0); PG8_LDB(B1, 1, 1); PG8_SCHED; PG8_LDA(At, 1, 0); PG8_STAGE(PG8_SA(0, 1), a2 + hstep, voffA);
            PG8_WAIT_V(8); PG8_WAIT_L(0); PG8_BAR; PG8_MMA(0, 0, At, B0); PG8_MMA(0, 1, At, B1); PG8_BAR; PG8_SCHED;
            PG8_LDA(At, 1, 1); PG8_STAGE(PG8_SB(1, 0), b3, voffB); PG8_STAGE(PG8_SB(1, 1), b3 + hstep, voffB); PG8_STAGE(PG8_SA(1, 0), a3, voffA);
            PG8_WAIT_V(8); PG8_WAIT_L(0); PG8_BAR; PG8_MMA(1, 0, At, B0); PG8_MMA(1, 1, At, B1); PG8_BAR; PG8_SCHED;
        }
        PG8_STAMP();
        if (wr == 0) PG8_BAR;
        if constexpr (!Epi::AFTER_DRAIN) { E(acc, cur, wr, wc, fr, fq); S.done(cur); }
        PG8_STAMP();
        if (!has_next) break;
#pragma unroll
        for (int a = 0; a < 2; ++a)
#pragma unroll
            for (int b = 0; b < 2; ++b)
#pragma unroll
                for (int m = 0; m < 4; ++m)
#pragma unroll
                    for (int n = 0; n < 2; ++n) acc[a][b][m][n] = (f32x4){0.f, 0.f, 0.f, 0.f};
        cur = nxt; cA = nA; cB = nB; ++ui;
        if (wr == 1) PG8_BAR;
    }
    PG8_WAIT_V(0);
    PG8_BAR;
    if constexpr (Epi::AFTER_DRAIN) { E.fused(acc, cur, wr, wc, fr, fq, lds, wid, lane); S.done(cur); }
    PG8_STAMP();
    if (STAMP && wid == 0) { stamps[lane] = lane < nts ? (((unsigned long long)(unsigned)ts_hi << 32) | (unsigned)ts_lo) : 0ull;
        if (lane == 62) stamps[62] = rt_entry; if (lane == 63) stamps[63] = (unsigned long long)wall_clock64(); }
#undef PG8_STAMP
#undef PG8_SA
#undef PG8_SB
#undef PG8_STAGE
#undef PG8_LDA
#undef PG8_LDB
#undef PG8_MMA
#undef PG8_WAIT_V
#undef PG8_WAIT_L
#undef PG8_BAR
#undef PG8_SCHED
}
}
#define LAS __attribute__((address_space(3)))
#define XB_TMO      128
#define XB_XCNT(j)  (256  + 64 * (j))
#define XB_XSUB(j)  (1280 + 64 * (j))
#define XB_XGEN(j)  (2304 + 64 * (j))
#define XB_TOP      3328
#define XB_TOPGEN   3392
#define XCD_BAR_WORDS 3456
#define XB_SPIN_CAP (1u << 18)

__device__ __forceinline__ unsigned xb_ld(unsigned* p)              { return __hip_atomic_load(p, __ATOMIC_RELAXED, __HIP_MEMORY_SCOPE_AGENT); }
__device__ __forceinline__ unsigned xb_add(unsigned* p, unsigned v) { return __hip_atomic_fetch_add(p, v, __ATOMIC_RELAXED, __HIP_MEMORY_SCOPE_AGENT); }
__device__ __forceinline__ unsigned xb_xcc_id() { return (unsigned)__builtin_amdgcn_s_getreg((3 << 11) | 20) & 0xFu; }
#define XB_SPIN(cond, bar) do { unsigned _sp = 0; while (cond) { __builtin_amdgcn_s_sleep(1); \
    if ((++_sp & 255u) == 0u) { if (xb_ld(&(bar)[XB_TMO])) break; if (_sp > XB_SPIN_CAP) { atomicAdd(&(bar)[XB_TMO], 1u); break; } } } } while (0)

struct XcdBarrier {
    unsigned* bar; unsigned x;
    volatile LAS unsigned* st;
};

__device__ __forceinline__ XcdBarrier xcd_barrier_post(unsigned* bar, volatile LAS unsigned* st) {
    XcdBarrier b; b.bar = bar; b.x = xb_xcc_id(); b.st = st;
    if (threadIdx.x == 0) (void)xb_add(&bar[XB_XCNT(b.x)], 1u);
    return b;
}
__device__ __forceinline__ void xcd_barrier_complete(unsigned* bar, unsigned x, unsigned& nloc, unsigned& nx) {
    const unsigned G = gridDim.x * gridDim.y * gridDim.z;
    unsigned sum, cnt, mine, sp = 0u;
    for (;;) {
        sum = 0u; cnt = 0u; mine = 0u;
#pragma unroll
        for (unsigned j = 0; j < 16; ++j) { const unsigned c = xb_ld(&bar[XB_XCNT(j)]); sum += c; cnt += (c > 0u) ? 1u : 0u; mine = (j == x) ? c : mine; }
        if (sum == G) break;
        __builtin_amdgcn_s_sleep(1);
        if ((++sp & 255u) == 0u) { if (xb_ld(&bar[XB_TMO])) break; if (sp > XB_SPIN_CAP) { atomicAdd(&bar[XB_TMO], 1u); break; } }
    }
    nloc = mine > 0u ? mine : 1u; nx = cnt > 0u ? cnt : 1u;
}

__device__ __forceinline__ void xcd_barrier(const XcdBarrier& b) {
    asm volatile("s_waitcnt vmcnt(0)" ::: "memory");
    __syncthreads();
    if (threadIdx.x == 0) {
        unsigned* bar = b.bar;
        __builtin_amdgcn_s_waitcnt(0);
        unsigned nloc = b.st[0], nx = b.st[1];
        if (nloc == 0u) { xcd_barrier_complete(bar, b.x, nloc, nx); b.st[0] = nloc; b.st[1] = nx; }
        const unsigned old = xb_add(&bar[XB_XSUB(b.x)], 1u);
        const unsigned gen = old / nloc;
        if (old + 1u == (gen + 1u) * nloc) {
            __builtin_amdgcn_fence(__ATOMIC_RELEASE, "agent");
            asm volatile("s_waitcnt vmcnt(0)" ::: "memory");
            const unsigned og = xb_add(&bar[XB_TOP], 1u);
            const unsigned tg = og / nx;
            if (og + 1u == (tg + 1u) * nx) xb_add(&bar[XB_TOPGEN], 1u);
            else XB_SPIN(xb_ld(&bar[XB_TOPGEN]) == tg, bar);
            __builtin_amdgcn_fence(__ATOMIC_ACQUIRE, "agent");
            xb_add(&bar[XB_XGEN(b.x)], 1u);
            asm volatile("s_waitcnt vmcnt(0)" ::: "memory");
        } else {
            XB_SPIN(xb_ld(&bar[XB_XGEN(b.x)]) == gen, bar);
            __builtin_amdgcn_fence(__ATOMIC_ACQUIRE, "agent");
            asm volatile("s_waitcnt vmcnt(0)" ::: "memory");
        }
    }
    __syncthreads();
}


using pg8::bf16_t; using pg8::bf16x8; using pg8::f32x4; using pg8::u32x4; using pg8::Unit;
typedef float f32x16 __attribute__((ext_vector_type(16)));
typedef unsigned u32x2 __attribute__((ext_vector_type(2)));
typedef float f32x2 __attribute__((ext_vector_type(2)));

constexpr int MP = 8192, MS = 1024, MT = 9216, DM = 2048, NZ = 5120, NINP = 5376, DFF = 5632, PLE = 256;
constexpr int LDS_BYTES = 131072 + 16;
constexpr size_t OFF_BAR = 0;
constexpr size_t OFF_WIN = 16384;
constexpr size_t OFF_WOUT = OFF_WIN + (size_t)NINP * DM * 2;
constexpr size_t OFF_WFI = OFF_WOUT + (size_t)DM * DM * 2;
constexpr size_t OFF_WFO = OFF_WFI + (size_t)2 * DFF * DM * 2;
constexpr size_t OFF_WPLE = OFF_WFO + (size_t)DM * DFF * 2;
constexpr size_t OFF_WGT = OFF_WPLE + (size_t)DM * PLE * 2;
constexpr size_t OFF_A0 = OFF_WGT + (size_t)DM * DM * 2;
constexpr size_t OFF_PB = OFF_A0 + (size_t)MT * DM * 2;
constexpr size_t OFF_ALOW = OFF_PB + (size_t)MT * PLE * 2;
constexpr size_t OFF_STAT = OFF_ALOW + (size_t)MT * 16 * 4;
constexpr size_t OFF_BIG = OFF_STAT + (size_t)MT * 2 * 4;
constexpr size_t OFF_Z = OFF_BIG;
constexpr size_t OFF_ORAW = OFF_Z + (size_t)MT * NZ * 2;
constexpr size_t OFF_MRAW = OFF_ORAW + (size_t)MT * 1024 * 4;
constexpr size_t OFF_IMG = OFF_BIG + (size_t)MT * DFF * 2 + (size_t)MT * DM * 4;
constexpr size_t WS_END = OFF_IMG + (size_t)4 * 1024 * 2048 * 4;
constexpr size_t OFF_ACT = OFF_BIG;
constexpr size_t OFF_GATEZ = OFF_BIG;
constexpr size_t OFF_PZ = OFF_BIG + (size_t)MT * DFF * 2;
constexpr size_t OUT_Y = 0, OUT_SP = (size_t)MT * DM, OUT_SS = OUT_SP + (size_t)4 * 4 * 128 * 256, OUT_VS = OUT_SS + (size_t)128 * 4 * 128 * 256;

struct Params {
    const float *x_prompt, *x_sample, *state_gla, *p_prompt, *p_sample, *g_mix, *w_in, *w_a2, *b_a, *g_gla_norm, *g_gmlp_ln, *b_gmlp_ln, *w_s, *b_s,
        *g_gmlp_out, *w_out, *g_ffn, *w_ffn_in, *w_ffn_out, *w_ple, *g_ple, *g_ple_gate, *w_ple_gate, *g_final;
    float* out;
    unsigned char* ws;
};

__device__ __forceinline__ unsigned pk2(float lo, float hi) { return pg8::cvt_pk_bf16(lo, hi); }
__device__ __forceinline__ bf16_t f2bf(float f) { return (bf16_t)(pk2(f, 0.f) & 0xffffu); }
__device__ __forceinline__ float bf2f(bf16_t b) { return __uint_as_float(((unsigned)b) << 16); }
__device__ __forceinline__ float bflo(unsigned w) { return __uint_as_float(w << 16); }
__device__ __forceinline__ float bfhi(unsigned w) { return __uint_as_float(w & 0xffff0000u); }
__device__ __forceinline__ f32x4 unpack4(u32x2 w) { return (f32x4){bflo(w.x), bfhi(w.x), bflo(w.y), bfhi(w.y)}; }
template <int CTRL> __device__ __forceinline__ float dpp_f(float v) { return __int_as_float(__builtin_amdgcn_update_dpp(0, __float_as_int(v), CTRL, 0xf, 0xf, true)); }
__device__ __forceinline__ float row16_sum(float v) {
    v += dpp_f<0xB1>(v); v += dpp_f<0x4E>(v); v += dpp_f<0x141>(v); v += dpp_f<0x140>(v); return v;
}
__device__ __forceinline__ float wave_sum(float v) {
    v = row16_sum(v);
    return (__int_as_float(__builtin_amdgcn_readlane(__float_as_int(v), 0)) + __int_as_float(__builtin_amdgcn_readlane(__float_as_int(v), 16))) + (__int_as_float(__builtin_amdgcn_readlane(__float_as_int(v), 32)) + __int_as_float(__builtin_amdgcn_readlane(__float_as_int(v), 48)));
}
__device__ __forceinline__ float sigmoid_f(float x) { return __builtin_amdgcn_rcpf(1.f + __expf(-x)); }
__device__ __forceinline__ float silu_f(float x) { return x * __builtin_amdgcn_rcpf(1.f + __expf(-x)); }
__device__ __forceinline__ float gelu_f(float x) { const float u = 1.5957691216f * (x + 0.044715f * x * x * x); return x * __builtin_amdgcn_rcpf(1.f + __expf(-u)); }
__device__ __forceinline__ float logsigmoid_f(float x) { return fminf(x, 0.f) - __logf(1.f + __expf(-fabsf(x))); }
template <class T> __device__ __forceinline__ T* opaque(T* p) { return p; }
__device__ __forceinline__ const f32x4* row_mid(const float* row, int lane) { return opaque((const f32x4*)row + lane + 256); }
__device__ __forceinline__ f32x4* row_mid(float* row, int lane) { return opaque((f32x4*)row + lane + 256); }
__device__ __forceinline__ int otid() { int t = threadIdx.x; asm volatile("" : "+v"(t)); return t; }
template <class T> __device__ __forceinline__ T ldnt(const T* p) { return __builtin_nontemporal_load(p); }
template <class T> __device__ __forceinline__ void stnt(T* p, T v) { __builtin_nontemporal_store(v, p); }
__device__ __forceinline__ void lds_wait() { asm volatile("s_waitcnt lgkmcnt(0)" ::: "memory"); }

struct EpiIn {
    static constexpr bool PERM = true, AFTER_DRAIN = false;
    bf16_t* Z; float* alow;
    __device__ __forceinline__ void operator()(const f32x4 (&acc)[2][2][4][2], const Unit& u, int wr, int wc, int fr, int fq) const {
        const int row0 = u.pm * 256 + wr * 64 + fr, pn = u.pn;
        if (pn == 20) {
            if (wc == 0 && fq < 2) {
#pragma unroll
                for (int ai = 0; ai < 2; ++ai)
#pragma unroll
                    for (int m = 0; m < 4; ++m) { float* p = alow + (size_t)(row0 + ai * 128 + m * 16) * 16 + 8 * fq; *(f32x4*)p = acc[ai][0][m][0]; *(f32x4*)(p + 4) = acc[ai][0][m][1]; }
            }
            return;
        }
        const int kind = pn < 8 ? 0 : (pn < 12 ? 1 : 2); const float qs = pn < 2 ? 0.08838834764831845f : 1.f;
#pragma unroll
        for (int ai = 0; ai < 2; ++ai)
#pragma unroll
            for (int m = 0; m < 4; ++m) { bf16_t* rowp = Z + (size_t)(row0 + ai * 128 + m * 16) * NZ + pn * 256 + wc * 32 + 8 * fq;
#pragma unroll
                for (int bj = 0; bj < 2; ++bj) { f32x4 v0 = acc[ai][bj][m][0], v1 = acc[ai][bj][m][1];
                    if (kind == 0) { v0 *= qs; v1 *= qs; }
                    else if (kind == 1) {
#pragma unroll
                        for (int j = 0; j < 4; ++j) { v0[j] = silu_f(v0[j]); v1[j] = silu_f(v1[j]); } }
                    else {
#pragma unroll
                        for (int j = 0; j < 4; ++j) { v0[j] = gelu_f(v0[j]); v1[j] = gelu_f(v1[j]); } }
                    u32x4 w; w.x = pk2(v0[0], v0[1]); w.y = pk2(v0[2], v0[3]); w.z = pk2(v1[0], v1[1]); w.w = pk2(v1[2], v1[3]);
                    *(u32x4*)(rowp + bj * 128) = w; } }
    }
};
struct EpiRes {
    static constexpr bool PERM = false, AFTER_DRAIN = false;
    const float* res_p; const float* res_s; float* out;
    __device__ __forceinline__ void operator()(const f32x4 (&acc)[2][2][4][2], const Unit& u, int wr, int wc, int fr, int fq) const {
        const int row0 = u.pm * 256 + wr * 64 + fr, col0 = u.pn * 256 + wc * 32 + 4 * fq;
#pragma unroll
        for (int ai = 0; ai < 2; ++ai)
#pragma unroll
            for (int m = 0; m < 4; ++m) { const int row = row0 + ai * 128 + m * 16;
                const float* rp = (row < MP ? res_p + (size_t)row * DM : res_s + (size_t)(row - MP) * DM) + col0; float* op = out + (size_t)row * DM + col0;
#pragma unroll
                for (int bj = 0; bj < 2; ++bj)
#pragma unroll
                    for (int n = 0; n < 2; ++n) { const f32x4 r = *(const f32x4*)(rp + bj * 128 + n * 16); *(f32x4*)(op + bj * 128 + n * 16) = acc[ai][bj][m][n] + r; } }
    }
};
struct EpiSwiglu {
    static constexpr bool PERM = true, AFTER_DRAIN = false;
    bf16_t* act;
    __device__ __forceinline__ void operator()(const f32x4 (&acc)[2][2][4][2], const Unit& u, int wr, int wc, int fr, int fq) const {
        const int row0 = u.pm * 256 + wr * 64 + fr, col0 = u.pn * 128 + wc * 32 + 8 * fq;
#pragma unroll
        for (int ai = 0; ai < 2; ++ai)
#pragma unroll
            for (int m = 0; m < 4; ++m) { float a[8];
#pragma unroll
                for (int n = 0; n < 2; ++n)
#pragma unroll
                    for (int j = 0; j < 4; ++j) a[n * 4 + j] = silu_f(acc[ai][0][m][n][j]) * acc[ai][1][m][n][j];
                u32x4 w; w.x = pk2(a[0], a[1]); w.y = pk2(a[2], a[3]); w.z = pk2(a[4], a[5]); w.w = pk2(a[6], a[7]);
                *(u32x4*)(act + (size_t)(row0 + ai * 128 + m * 16) * DFF + col0) = w; }
    }
};
struct EpiBfN {
    static constexpr bool PERM = false, AFTER_DRAIN = false;
    bf16_t* out;
    __device__ __forceinline__ void operator()(const f32x4 (&acc)[2][2][4][2], const Unit& u, int wr, int wc, int fr, int fq) const {
        const int row0 = u.pm * 256 + wr * 64 + fr, col0 = u.pn * 256 + wc * 32 + 4 * fq;
#pragma unroll
        for (int ai = 0; ai < 2; ++ai)
#pragma unroll
            for (int m = 0; m < 4; ++m) { bf16_t* op = out + (size_t)(row0 + ai * 128 + m * 16) * DM + col0;
#pragma unroll
                for (int bj = 0; bj < 2; ++bj)
#pragma unroll
                    for (int n = 0; n < 2; ++n) { const f32x4 v = acc[ai][bj][m][n]; u32x2 w; w.x = pk2(v[0], v[1]); w.y = pk2(v[2], v[3]); *(u32x2*)(op + bj * 128 + n * 16) = w; } }
    }
};
struct EpiPlain {
    static constexpr bool PERM = false, AFTER_DRAIN = false;
    float* out;
    __device__ __forceinline__ void operator()(const f32x4 (&acc)[2][2][4][2], const Unit& u, int wr, int wc, int fr, int fq) const {
        const int row0 = u.pm * 256 + wr * 64 + fr, col0 = u.pn * 256 + wc * 32 + 4 * fq;
#pragma unroll
        for (int ai = 0; ai < 2; ++ai)
#pragma unroll
            for (int m = 0; m < 4; ++m) { float* op = out + (size_t)(row0 + ai * 128 + m * 16) * DM + col0;
#pragma unroll
                for (int bj = 0; bj < 2; ++bj)
#pragma unroll
                    for (int n = 0; n < 2; ++n) *(f32x4*)(op + bj * 128 + n * 16) = acc[ai][bj][m][n]; }
    }
};

template <class Epi> __device__ __forceinline__ void run_gemm(LAS unsigned char* lds, const bf16_t* A, const bf16_t* Bt, int M, int N, int K, const Epi& E) {
    pg8::Gemm g; g.A = A; g.Bt = Bt; g.M = M; g.N = N; g.K = K; g.Klen = K;
    pg8::StaticOrder S; S.init(M, N, (int)gridDim.x, (int)blockIdx.x);
    pg8::gemm_phase<Epi, pg8::StaticOrder, false>(lds, g, S, E, nullptr);
}
struct SplitOrderK {
    int nN, G, c, klen, ns, kbase, ksoff;
    __device__ __forceinline__ bool next(int i, Unit& u) const { const int L = i * G + c; if (L >= 4 * ns * nN) return false;
        const int sp = L % ns, tile = L / ns; u.ks = ksoff + sp; u.pn = tile % nN; u.pm = 32 + tile / nN; u.koff = kbase + sp * klen; return true; }
    __device__ __forceinline__ void a_ready(const Unit&) const {}
    __device__ __forceinline__ void done(const Unit&) const {}
};
struct EpiPart {
    static constexpr bool PERM = true, AFTER_DRAIN = false;
    bf16_t* part;
    __device__ __forceinline__ void operator()(const f32x4 (&acc)[2][2][4][2], const Unit& u, int wr, int wc, int fr, int fq) const {
        const int row0 = (u.pm - 32) * 256 + wr * 64 + fr, col0 = u.pn * 256 + wc * 32 + 8 * fq; bf16_t* pb = part + (size_t)u.ks * MS * DM;
#pragma unroll
        for (int ai = 0; ai < 2; ++ai)
#pragma unroll
            for (int m = 0; m < 4; ++m) { bf16_t* op = pb + (size_t)(row0 + ai * 128 + m * 16) * DM + col0;
#pragma unroll
                for (int bj = 0; bj < 2; ++bj) { const f32x4 v0 = acc[ai][bj][m][0], v1 = acc[ai][bj][m][1];
                    u32x4 w; w.x = pk2(v0[0], v0[1]); w.y = pk2(v0[2], v0[3]); w.z = pk2(v1[0], v1[1]); w.w = pk2(v1[2], v1[3]); *(u32x4*)(op + bj * 128) = w; } }
    }
};
__device__ __forceinline__ void run_split(LAS unsigned char* lds, const bf16_t* A, const bf16_t* Bt, int K, bf16_t* part, int ns, int klen, int kbase, int ksoff, int c) {
    pg8::Gemm g; g.A = A; g.Bt = Bt; g.M = MT; g.N = DM; g.K = K; g.Klen = klen;
    SplitOrderK S; S.nN = DM / 256; S.G = (int)gridDim.x; S.c = c; S.klen = klen; S.ns = ns; S.kbase = kbase; S.ksoff = ksoff;
    EpiPart P; P.part = part;
    pg8::gemm_phase<EpiPart, SplitOrderK, false>(lds, g, S, P, nullptr);
}
template <class Epi> __device__ __forceinline__ void run_gemm_n2048(LAS unsigned char* lds, const bf16_t* A, const bf16_t* Bt, int K, const Epi& E, bf16_t* part) {
    run_gemm(lds, A, Bt, MP, DM, K, E);
    run_split(lds, A, Bt, K, part, 8, K / 8, 0, 0, (int)blockIdx.x);
}

__device__ __forceinline__ void transpose_item(const float* W, int N, bf16_t* WT, int K, int k0, int n0_dst, int n0_src, int nvalid, LAS float* scr, int lane) {
    if (nvalid == 32) {
        const int c4 = (lane & 7) * 4, kr = lane >> 3; f32x4 v[8];
#pragma unroll
        for (int i = 0; i < 8; ++i) v[i] = ldnt((const f32x4*)(W + (size_t)(k0 + 8 * i + kr) * N + n0_src + c4));
#pragma unroll
        for (int i = 0; i < 8; ++i) { LAS float* d = scr + (8 * i + kr) * 33 + c4; d[0] = v[i][0]; d[1] = v[i][1]; d[2] = v[i][2]; d[3] = v[i][3]; }
    } else {
        const int j = lane & 31;
#pragma unroll 8
        for (int i = 0; i < 32; ++i) { const int kk = 2 * i + (lane >> 5); scr[kk * 33 + j] = (j < nvalid) ? ldnt(W + (size_t)(k0 + kk) * N + n0_src + j) : 0.f; }
    }
    lds_wait();
    const int c = lane & 7;
#pragma unroll
    for (int q = 0; q < 4; ++q) { const int n = (lane >> 3) + 8 * q; const LAS float* s = scr + (8 * c) * 33 + n;
        u32x4 o; o.x = pk2(s[0 * 33], s[1 * 33]); o.y = pk2(s[2 * 33], s[3 * 33]); o.z = pk2(s[4 * 33], s[5 * 33]); o.w = pk2(s[6 * 33], s[7 * 33]);
        *(u32x4*)(WT + (size_t)(n0_dst + n) * K + k0 + 8 * c) = o; }
    lds_wait();
}
struct Row8 { f32x4 v[8]; };
__device__ __forceinline__ void row_load_nt(Row8& a, const float* src, int lane) { const f32x4* sm = row_mid(src, lane);
#pragma unroll
    for (int j = 0; j < 8; ++j) a.v[j] = ldnt(sm + 64 * (j - 4)); }
__device__ __forceinline__ void row_load(Row8& a, const float* src, int lane) { const f32x4* sm = row_mid(src, lane);
#pragma unroll
    for (int j = 0; j < 8; ++j) a.v[j] = sm[64 * (j - 4)]; }
__device__ __forceinline__ void rms_finish_bf16(const Row8& a, const float* gain, bf16_t* dst, int lane) {
    float s = 0.f;
#pragma unroll
    for (int j = 0; j < 8; ++j) s += (a.v[j][0] * a.v[j][0] + a.v[j][1] * a.v[j][1]) + (a.v[j][2] * a.v[j][2] + a.v[j][3] * a.v[j][3]);
    const float rinv = rsqrtf(wave_sum(s) * (1.f / DM) + 1e-6f);
    const f32x4* gm = row_mid(gain, lane); u32x2* dm = (u32x2*)dst + lane;
#pragma unroll
    for (int j = 0; j < 8; ++j) { const f32x4 g = gm[64 * (j - 4)]; u32x2 o; o.x = pk2(a.v[j][0] * rinv * g[0], a.v[j][1] * rinv * g[1]); o.y = pk2(a.v[j][2] * rinv * g[2], a.v[j][3] * rinv * g[3]);
        dm[64 * j] = o; }
}
__device__ __forceinline__ void rms_row_bf16(const float* src, const float* gain, bf16_t* dst, int lane) { Row8 a; row_load(a, src, lane); rms_finish_bf16(a, gain, dst, lane); }
namespace cv { constexpr int I_IN = (DM / 64) * (NINP / 32), I_OUT = (DM / 64) * (DM / 32), I_FI = (DM / 64) * (2 * DFF / 32), I_FO = (DFF / 64) * (DM / 32), I_PLE = (PLE / 64) * (DM / 32), I_GT = I_OUT;
    constexpr int E_IN = I_IN, E_OUT = E_IN + I_OUT, E_FI = E_OUT + I_FI, E_FO = E_FI + I_FO, E_PLE = E_FO + I_PLE, E_GT = E_PLE + I_GT; }
__device__ __forceinline__ void convert_range(const Params& p, LAS unsigned char* lds, int lo, int hi, int gw, int NGW) {
    const int tid = otid(), lane = tid & 63, wave = tid >> 6;
    LAS float* scr = (LAS float*)(lds + wave * 8448);
    bf16_t* win = (bf16_t*)(p.ws + OFF_WIN); bf16_t* wout = (bf16_t*)(p.ws + OFF_WOUT); bf16_t* wfi = (bf16_t*)(p.ws + OFF_WFI);
    bf16_t* wfo = (bf16_t*)(p.ws + OFF_WFO); bf16_t* wple = (bf16_t*)(p.ws + OFF_WPLE); bf16_t* wgt = (bf16_t*)(p.ws + OFF_WGT);
    for (int it = lo + gw; it < hi; it += NGW) {
        int r = it;
        if (r < cv::E_IN) { const int nblk = NINP / 32, kb = r / nblk, nb = r % nblk, n0d = nb * 32; int src, nv;
            if (n0d < 3072) { src = n0d; nv = 32; } else if (n0d < 5120) { src = n0d + 16; nv = 32; } else if (n0d == 5120) { src = 3072; nv = 16; } else { src = 0; nv = 0; }
            transpose_item(p.w_in, 5136, win, DM, kb * 64, n0d, src, nv, scr, lane); continue; }
        if (r < cv::E_OUT) { r -= cv::E_IN; const int nblk = DM / 32, kb = r / nblk, nb = r % nblk; transpose_item(p.w_out, DM, wout, DM, kb * 64, nb * 32, nb * 32, 32, scr, lane); continue; }
        if (r < cv::E_FI) { r -= cv::E_OUT; const int nblk = 2 * DFF / 32, kb = r / nblk, nb = r % nblk, n0d = nb * 32, jb = n0d >> 8, within = n0d & 255, up = within >> 7, j0 = jb * 128 + (within & 127);
            transpose_item(p.w_ffn_in, 2 * DFF, wfi, DM, kb * 64, n0d, up * DFF + j0, 32, scr, lane); continue; }
        if (r < cv::E_FO) { r -= cv::E_FI; const int nblk = DM / 32, kb = r / nblk, nb = r % nblk; transpose_item(p.w_ffn_out, DM, wfo, DFF, kb * 64, nb * 32, nb * 32, 32, scr, lane); continue; }
        if (r < cv::E_PLE) { r -= cv::E_FO; const int nblk = DM / 32, kb = r / nblk, nb = r % nblk; transpose_item(p.w_ple, DM, wple, PLE, kb * 64, nb * 32, nb * 32, 32, scr, lane); continue; }
        { r -= cv::E_PLE; const int nblk = DM / 32, kb = r / nblk, nb = r % nblk; transpose_item(p.w_ple_gate, DM, wgt, DM, kb * 64, nb * 32, nb * 32, 32, scr, lane); }
    }
}
__device__ __forceinline__ void phase0(const Params& p, LAS unsigned char* lds) {
    const int tid = otid(), lane = tid & 63, wave = tid >> 6;
    const int gw = blockIdx.x * 8 + wave, NGW = gridDim.x * 8;
    convert_range(p, lds, 0, cv::E_IN, gw, NGW);
    bf16_t* a0 = (bf16_t*)(p.ws + OFF_A0); bf16_t* pb = (bf16_t*)(p.ws + OFF_PB);
    for (int r = gw; r < MT; r += 2 * NGW) {
        const int r2 = r + NGW; const bool has2 = r2 < MT; const int q2 = has2 ? r2 : r;
        const float* x1 = r < MP ? p.x_prompt + (size_t)r * DM : p.x_sample + (size_t)(r - MP) * DM; const float* x2 = q2 < MP ? p.x_prompt + (size_t)q2 * DM : p.x_sample + (size_t)(q2 - MP) * DM;
        const float* p1 = r < MP ? p.p_prompt + (size_t)r * PLE : p.p_sample + (size_t)(r - MP) * PLE; const float* p2 = q2 < MP ? p.p_prompt + (size_t)q2 * PLE : p.p_sample + (size_t)(q2 - MP) * PLE;
        Row8 a, b; row_load_nt(a, x1, lane); row_load_nt(b, x2, lane);
        const f32x4 pv1 = ldnt((const f32x4*)p1 + lane), pv2 = ldnt((const f32x4*)p2 + lane);
        rms_finish_bf16(a, p.g_mix, a0 + (size_t)r * DM, lane);
        { u32x2 o; o.x = pk2(pv1[0], pv1[1]); o.y = pk2(pv1[2], pv1[3]); ((u32x2*)(pb + (size_t)r * PLE))[lane] = o; }
        if (has2) { rms_finish_bf16(b, p.g_mix, a0 + (size_t)r2 * DM, lane);
            u32x2 o; o.x = pk2(pv2[0], pv2[1]); o.y = pk2(pv2[2], pv2[3]); ((u32x2*)(pb + (size_t)r2 * PLE))[lane] = o; }
    }
}

__device__ __forceinline__ f32x16 mfma32(bf16x8 a, bf16x8 b, f32x16 c) { return __builtin_amdgcn_mfma_f32_32x32x16_bf16(a, b, c, 0, 0, 0); }
__device__ __forceinline__ void mma32(f32x16& acc, const LAS bf16_t* A, int lda, const LAS bf16_t* B, int ldb, int kk, int lane) {
    const int r = lane & 31, h = lane >> 5; const LAS bf16_t* ap = A + r * lda + 8 * h; const LAS bf16_t* bp = B + r * ldb + 8 * h;
    for (int k = 0; k < kk; k += 16) { const bf16x8 a = *(const LAS bf16x8*)(ap + k); const bf16x8 b = *(const LAS bf16x8*)(bp + k); acc = mfma32(a, b, acc); }
}
constexpr int LQ = 136, LS = 72;
constexpr int R_QE = 0, R_KLT = 17408, R_ATT = 35840, R_DEC = 45056, IMG_BYTES = 45568, R_VT = 45568, R_QM = 82432, R_KM = 99840, R_ALOW = 117248, R_GSUM = 121344, R_BMID = 123392;
constexpr int IMG_V4 = IMG_BYTES / 16;

__device__ __forceinline__ void gla_prep(const Params& p, LAS unsigned char* lds, int rb, int h, int T) {
    const int tid = otid(), lane = tid & 63, wave = tid >> 6;
    const bf16_t* Z = (const bf16_t*)(p.ws + OFF_Z); const float* alowg = (const float*)(p.ws + OFF_ALOW);
    LAS bf16_t* Qe = (LAS bf16_t*)(lds + R_QE); LAS bf16_t* Qm = (LAS bf16_t*)(lds + R_QM); LAS bf16_t* Km = (LAS bf16_t*)(lds + R_KM);
    LAS bf16_t* KlT = (LAS bf16_t*)(lds + R_KLT); LAS bf16_t* ATT = (LAS bf16_t*)(lds + R_ATT); LAS float* DEC = (LAS float*)(lds + R_DEC);
    LAS float* alowL = (LAS float*)(lds + R_ALOW); LAS float* gsum = (LAS float*)(lds + R_GSUM); LAS float* bmidL = (LAS float*)(lds + R_BMID);
    const int c = tid & 127, tg = tid >> 7;
    float wa[16];
#pragma unroll
    for (int j = 0; j < 16; ++j) wa[j] = p.w_a2[j * 512 + h * 128 + c];
    const float ba = p.b_a[h * 128 + c];
    for (int idx = tid; idx < 1024; idx += 512) { const int t = idx >> 4; alowL[idx] = (t < T) ? alowg[(size_t)(rb + t) * 16 + (idx & 15)] : 0.f; }
    { const int row = tid >> 3, cs = (tid & 7) * 16; const bool ok = row < T; const bf16_t* zr = Z + (size_t)(rb + row) * NZ + h * 128 + cs; const u32x4 z4 = (u32x4){0u, 0u, 0u, 0u};
        const u32x4 q0 = ok ? *(const u32x4*)zr : z4, q1 = ok ? *(const u32x4*)(zr + 8) : z4, k0 = ok ? *(const u32x4*)(zr + 512) : z4, k1 = ok ? *(const u32x4*)(zr + 520) : z4;
        *(LAS u32x4*)(Qm + row * LQ + cs) = q0; *(LAS u32x4*)(Qm + row * LQ + cs + 8) = q1; *(LAS u32x4*)(Km + row * LQ + cs) = k0; *(LAS u32x4*)(Km + row * LQ + cs + 8) = k1; }
    __syncthreads();
    float qv[16], kv[16];
#pragma unroll
    for (int i = 0; i < 16; ++i) { const int t = tg * 16 + i; qv[i] = bf2f(Qm[t * LQ + c]); kv[i] = bf2f(Km[t * LQ + c]); }
    float b[16]; float run = 0.f;
#pragma unroll
    for (int i = 0; i < 16; ++i) { const int t = tg * 16 + i; float pre = ba;
#pragma unroll
        for (int j4 = 0; j4 < 4; ++j4) { const f32x4 a4 = *(const LAS f32x4*)(alowL + t * 16 + j4 * 4); pre += a4[0] * wa[j4 * 4] + a4[1] * wa[j4 * 4 + 1] + a4[2] * wa[j4 * 4 + 2] + a4[3] * wa[j4 * 4 + 3]; }
        const float la = (t < T) ? logsigmoid_f(pre) * 0.0625f : 0.f; run += la; b[i] = run; }
    gsum[tg * 128 + c] = run;
    __syncthreads();
    const float g0 = gsum[c], g1 = gsum[128 + c], g2 = gsum[256 + c], g3 = gsum[384 + c];
    const float pref = tg == 0 ? 0.f : (tg == 1 ? g0 : (tg == 2 ? g0 + g1 : g0 + g1 + g2));
    const float blast = ((g0 + g1) + g2) + g3;
#pragma unroll
    for (int i = 0; i < 16; ++i) b[i] += pref;
    if (tg == 2) bmidL[c] = b[0];
    if (tg == 0) DEC[c] = __expf(blast);
    __syncthreads();
    const float bm = bmidL[c];
    {
        unsigned klp[8];
#pragma unroll
        for (int i = 0; i < 16; i += 2) {
            const int t = tg * 16 + i;
            Qe[t * LQ + c] = f2bf(qv[i] * __expf(b[i])); Qe[(t + 1) * LQ + c] = f2bf(qv[i + 1] * __expf(b[i + 1]));
            Qm[t * LQ + c] = f2bf(qv[i] * __expf(b[i] - bm)); Qm[(t + 1) * LQ + c] = f2bf(qv[i + 1] * __expf(b[i + 1] - bm));
            Km[t * LQ + c] = f2bf(kv[i] * __expf(bm - b[i])); Km[(t + 1) * LQ + c] = f2bf(kv[i + 1] * __expf(bm - b[i + 1]));
            klp[i >> 1] = pk2(kv[i] * __expf(blast - b[i]), kv[i + 1] * __expf(blast - b[i + 1]));
        }
        LAS u32x4* kd = (LAS u32x4*)(KlT + c * LS + tg * 16);
        kd[0] = (u32x4){klp[0], klp[1], klp[2], klp[3]}; kd[1] = (u32x4){klp[4], klp[5], klp[6], klp[7]};
    }
    __syncthreads();
    if (wave < 3) {
        const int si = wave >> 1, ti = wave == 0 ? 0 : 1, l31 = lane & 31, hh = lane >> 5;
        f32x16 o;
#pragma unroll
        for (int i = 0; i < 16; ++i) o[i] = 0.f;
        mma32(o, Km + si * 32 * LQ, LQ, Qm + ti * 32 * LQ, LQ, 128, lane);
        const int tl = ti * 32 + l31;
#pragma unroll
        for (int g = 0; g < 4; ++g) { const int s0 = si * 32 + 8 * g + 4 * hh; float a0 = o[4 * g], a1 = o[4 * g + 1], a2 = o[4 * g + 2], a3 = o[4 * g + 3];
            a0 = (s0 <= tl) ? a0 : 0.f; a1 = (s0 + 1 <= tl) ? a1 : 0.f; a2 = (s0 + 2 <= tl) ? a2 : 0.f; a3 = (s0 + 3 <= tl) ? a3 : 0.f;
            u32x2 w; w.x = pk2(a0, a1); w.y = pk2(a2, a3); *(LAS u32x2*)(ATT + tl * LS + s0) = w; }
    }
    __syncthreads();
}
struct VRegs { u32x4 r[4]; };
__device__ __forceinline__ void v_load(const Params& p, VRegs& v, int rb, int h, int T) {
    const int tid = otid(), s = tid & 63, vg = tid >> 6; const bf16_t* Z = (const bf16_t*)(p.ws + OFF_Z);
#pragma unroll
    for (int k = 0; k < 4; ++k) v.r[k] = (s < T) ? *(const u32x4*)(Z + (size_t)(rb + s) * NZ + 1024 + h * 256 + vg * 32 + 8 * k) : (u32x4){0u, 0u, 0u, 0u};
}
__device__ __forceinline__ void v_store_t(LAS unsigned char* lds, const VRegs& v) {
    const int tid = otid(), s = tid & 63, vg = tid >> 6; LAS bf16_t* VT = (LAS bf16_t*)(lds + R_VT) + (vg * 32) * LS + s;
#pragma unroll
    for (int k = 0; k < 4; ++k) {
        VT[(8 * k + 0) * LS] = (bf16_t)(v.r[k].x & 0xffffu); VT[(8 * k + 1) * LS] = (bf16_t)(v.r[k].x >> 16);
        VT[(8 * k + 2) * LS] = (bf16_t)(v.r[k].y & 0xffffu); VT[(8 * k + 3) * LS] = (bf16_t)(v.r[k].y >> 16);
        VT[(8 * k + 4) * LS] = (bf16_t)(v.r[k].z & 0xffffu); VT[(8 * k + 5) * LS] = (bf16_t)(v.r[k].z >> 16);
        VT[(8 * k + 6) * LS] = (bf16_t)(v.r[k].w & 0xffffu); VT[(8 * k + 7) * LS] = (bf16_t)(v.r[k].w >> 16); }
}
__device__ __forceinline__ void gla_step(const Params& p, LAS unsigned char* lds, f32x16 (&S)[4], int rb, int h, int T, int vb, int vtrow) {
    const int lane = otid() & 63, l31 = lane & 31, hh = lane >> 5;
    LAS bf16_t* Qe = (LAS bf16_t*)(lds + R_QE); LAS bf16_t* KlT = (LAS bf16_t*)(lds + R_KLT); LAS bf16_t* ATT = (LAS bf16_t*)(lds + R_ATT); LAS float* DEC = (LAS float*)(lds + R_DEC);
    LAS bf16_t* VT = (LAS bf16_t*)(lds + R_VT);
    bf16_t* oraw = (bf16_t*)(p.ws + OFF_ORAW);
    f32x16 Za[2], Zb[2];
#pragma unroll
    for (int tt = 0; tt < 2; ++tt)
#pragma unroll
        for (int i = 0; i < 16; ++i) { Za[tt][i] = 0.f; Zb[tt][i] = 0.f; }
    bf16x8 sa[4][2];
#pragma unroll
    for (int cb = 0; cb < 4; ++cb)
#pragma unroll
        for (int s = 0; s < 2; ++s) { u32x4 aw; aw.x = pk2(S[cb][8 * s], S[cb][8 * s + 1]); aw.y = pk2(S[cb][8 * s + 2], S[cb][8 * s + 3]); aw.z = pk2(S[cb][8 * s + 4], S[cb][8 * s + 5]); aw.w = pk2(S[cb][8 * s + 6], S[cb][8 * s + 7]);
            sa[cb][s] = __builtin_bit_cast(bf16x8, aw); }
    bf16x8 vt[4];
    const LAS bf16_t* vp = VT + (vtrow + l31) * LS + 8 * hh;
#pragma unroll
    for (int ks = 0; ks < 4; ++ks) vt[ks] = *(const LAS bf16x8*)(vp + 16 * ks);
#pragma unroll
    for (int cb = 0; cb < 4; ++cb)
#pragma unroll
        for (int g = 0; g < 4; ++g) { const f32x4 d = *(const LAS f32x4*)(DEC + cb * 32 + 8 * g + 4 * hh);
            S[cb][4 * g] *= d[0]; S[cb][4 * g + 1] *= d[1]; S[cb][4 * g + 2] *= d[2]; S[cb][4 * g + 3] *= d[3]; }
#pragma unroll
    for (int ks = 0; ks < 4; ++ks)
#pragma unroll
        for (int cb = 0; cb < 4; ++cb) { const bf16x8 a = *(const LAS bf16x8*)(KlT + (32 * cb + l31) * LS + 16 * ks + 8 * hh); S[cb] = mfma32(a, vt[ks], S[cb]); }
#pragma unroll
    for (int cb = 0; cb < 4; ++cb)
#pragma unroll
        for (int s = 0; s < 2; ++s)
#pragma unroll
            for (int tt = 0; tt < 2; ++tt) { const LAS bf16_t* qp = Qe + (32 * tt + l31) * LQ + 32 * cb + 16 * s + 4 * hh;
                const u32x2 q0 = *(const LAS u32x2*)qp, q1 = *(const LAS u32x2*)(qp + 8); const u32x4 bw = (u32x4){q0.x, q0.y, q1.x, q1.y};
                Za[tt] = mfma32(sa[cb][s], __builtin_bit_cast(bf16x8, bw), Za[tt]); }
#pragma unroll
    for (int ks = 0; ks < 4; ++ks)
#pragma unroll
        for (int tt = 0; tt < 2; ++tt) if (ks < 2 * (tt + 1)) { const bf16x8 bq = *(const LAS bf16x8*)(ATT + (32 * tt + l31) * LS + 16 * ks + 8 * hh); Zb[tt] = mfma32(vt[ks], bq, Zb[tt]); }
#pragma unroll
    for (int tt = 0; tt < 2; ++tt) { const int t = 32 * tt + l31;
        if (t < T) { bf16_t* op = oraw + (size_t)(rb + t) * 1024 + h * 256 + 32 * vb + 4 * hh;
#pragma unroll
            for (int g = 0; g < 4; ++g) { u32x2 w; w.x = pk2(Za[tt][4 * g] + Zb[tt][4 * g], Za[tt][4 * g + 1] + Zb[tt][4 * g + 1]); w.y = pk2(Za[tt][4 * g + 2] + Zb[tt][4 * g + 2], Za[tt][4 * g + 3] + Zb[tt][4 * g + 3]); *(u32x2*)(op + 8 * g) = w; } } }
}
__device__ __forceinline__ size_t s_index(int cb, int i, int hh, int wave, int l31) { return (size_t)(cb * 32 + (i & 3) + 8 * (i >> 2) + 4 * hh) * 256 + 32 * wave + l31; }

__device__ __forceinline__ void gla_prep_item(const Params& p, LAS unsigned char* lds, int chain, int ch) {
    const int b = chain >> 2, h = chain & 3;
    gla_prep(p, lds, b * 2048 + ch * 64, h, 64);
    u32x4* img = (u32x4*)(p.ws + OFF_IMG + (size_t)(chain * 32 + ch) * IMG_BYTES);
    for (int i = otid(); i < IMG_V4; i += 512) img[i] = ((const LAS u32x4*)lds)[i];
    __syncthreads();
}
constexpr int SG_TAB = 0, SG_ALOW = 20480, SG_PART = 24576;
__device__ __forceinline__ void gla_sample_pair(const Params& p, LAS unsigned char* lds, int item) {
    const int tid = otid(), lane = tid & 63, wave = tid >> 6, q = wave & 3, grp = wave >> 2, chain = item * 2 + grp;
    const int b = chain >> 2, h = chain & 3, rb = MP + b * 8;
    LAS float* tab = (LAS float*)(lds + SG_TAB + wave * 2560); LAS float* alw = (LAS float*)(lds + SG_ALOW + wave * 512); LAS float* part = (LAS float*)(lds + SG_PART);
    const bf16_t* Z = (const bf16_t*)(p.ws + OFF_Z); const float* alowg = (const float*)(p.ws + OFF_ALOW); bf16_t* oraw = (bf16_t*)(p.ws + OFF_ORAW);
    alw[lane] = alowg[(size_t)rb * 16 + lane]; alw[lane + 64] = alowg[(size_t)rb * 16 + 64 + lane];
    float qe[8][2], kv[8][2]; f32x4 V[8];
#pragma unroll
    for (int t = 0; t < 8; ++t) { const bf16_t* zr = Z + (size_t)(rb + t) * NZ; const unsigned qw = *(const unsigned*)(zr + h * 128 + 2 * lane), kw = *(const unsigned*)(zr + 512 + h * 128 + 2 * lane);
        const u32x2 vw = *(const u32x2*)(zr + 1024 + h * 256 + 4 * lane);
        qe[t][0] = bflo(qw); qe[t][1] = bfhi(qw); kv[t][0] = bflo(kw); kv[t][1] = bfhi(kw); V[t] = (f32x4){bflo(vw.x), bfhi(vw.x), bflo(vw.y), bfhi(vw.y)}; }
    float bc[8][2];
    {   f32x2 wa[16];
#pragma unroll
        for (int j = 0; j < 16; ++j) wa[j] = *(const f32x2*)(p.w_a2 + j * 512 + h * 128 + 2 * lane);
        const f32x2 ba = *(const f32x2*)(p.b_a + h * 128 + 2 * lane);
        lds_wait();
        float run0 = 0.f, run1 = 0.f;
#pragma unroll
        for (int t = 0; t < 8; ++t) { float p0 = ba.x, p1 = ba.y;
#pragma unroll
            for (int j4 = 0; j4 < 4; ++j4) { const f32x4 a4 = *(const LAS f32x4*)(alw + t * 16 + 4 * j4);
#pragma unroll
                for (int k = 0; k < 4; ++k) { p0 += a4[k] * wa[4 * j4 + k].x; p1 += a4[k] * wa[4 * j4 + k].y; } }
            run0 += logsigmoid_f(p0) * 0.0625f; run1 += logsigmoid_f(p1) * 0.0625f; bc[t][0] = run0; bc[t][1] = run1; } }
    float ki[8][2];
#pragma unroll
    for (int t = 0; t < 8; ++t) { qe[t][0] *= __expf(bc[t][0]); qe[t][1] *= __expf(bc[t][1]); ki[t][0] = kv[t][0] * __expf(-bc[t][0]); ki[t][1] = kv[t][1] * __expf(-bc[t][1]); }
    lds_wait();
#pragma unroll
    for (int t = 0; t < 8; ++t)
#pragma unroll
        for (int s = 0; s <= t; ++s) { const float a = wave_sum(qe[t][0] * ki[s][0] + qe[t][1] * ki[s][1]); if (lane == 0) alw[t * (t + 1) / 2 + s] = a; }
    if ((lane >> 4) == q) { const float e0 = __expf(bc[7][0]), e1 = __expf(bc[7][1]); LAS float* r0 = tab + (2 * lane - 32 * q) * 20; LAS float* r1 = r0 + 20;
        *(LAS f32x4*)(r0) = (f32x4){qe[0][0], qe[1][0], qe[2][0], qe[3][0]}; *(LAS f32x4*)(r0 + 4) = (f32x4){qe[4][0], qe[5][0], qe[6][0], qe[7][0]};
        *(LAS f32x4*)(r1) = (f32x4){qe[0][1], qe[1][1], qe[2][1], qe[3][1]}; *(LAS f32x4*)(r1 + 4) = (f32x4){qe[4][1], qe[5][1], qe[6][1], qe[7][1]};
        *(LAS f32x4*)(r0 + 8) = (f32x4){ki[0][0] * e0, ki[1][0] * e0, ki[2][0] * e0, ki[3][0] * e0}; *(LAS f32x4*)(r0 + 12) = (f32x4){ki[4][0] * e0, ki[5][0] * e0, ki[6][0] * e0, ki[7][0] * e0};
        *(LAS f32x4*)(r1 + 8) = (f32x4){ki[0][1] * e1, ki[1][1] * e1, ki[2][1] * e1, ki[3][1] * e1}; *(LAS f32x4*)(r1 + 12) = (f32x4){ki[4][1] * e1, ki[5][1] * e1, ki[6][1] * e1, ki[7][1] * e1};
        r0[16] = e0; r1[16] = e1; }
    lds_wait();
    f32x4 o[8];
#pragma unroll
    for (int t = 0; t < 8; ++t) o[t] = (f32x4){0.f, 0.f, 0.f, 0.f};
    const f32x4* S0 = (const f32x4*)(p.state_gla + (size_t)chain * 32768 + (size_t)(32 * q) * 256) + lane; f32x4* So = (f32x4*)(p.out + OUT_SS + (size_t)chain * 32768 + (size_t)(32 * q) * 256) + lane;
#pragma unroll 1
    for (int cc = 0; cc < 32; cc += 16) { f32x4 s[16];
#pragma unroll
        for (int u = 0; u < 16; ++u) s[u] = ldnt(S0 + (cc + u) * 64);
#pragma unroll
        for (int u = 0; u < 16; ++u) { const LAS float* row = tab + (cc + u) * 20; const f32x4 qa = *(const LAS f32x4*)row, qb = *(const LAS f32x4*)(row + 4), ka = *(const LAS f32x4*)(row + 8), kb = *(const LAS f32x4*)(row + 12); const float d = row[16];
            o[0] += qa[0] * s[u]; o[1] += qa[1] * s[u]; o[2] += qa[2] * s[u]; o[3] += qa[3] * s[u]; o[4] += qb[0] * s[u]; o[5] += qb[1] * s[u]; o[6] += qb[2] * s[u]; o[7] += qb[3] * s[u];
            f32x4 sn = d * s[u]; sn += ka[0] * V[0]; sn += ka[1] * V[1]; sn += ka[2] * V[2]; sn += ka[3] * V[3]; sn += kb[0] * V[4]; sn += kb[1] * V[5]; sn += kb[2] * V[6]; sn += kb[3] * V[7];
            stnt(So + (cc + u) * 64, sn); } }
#pragma unroll
    for (int t = 0; t < 8; ++t) *(LAS f32x4*)(part + (wave * 8 + t) * 256 + 4 * lane) = o[t];
    __syncthreads();
#pragma unroll
    for (int tt = 0; tt < 2; ++tt) { const int t = 2 * q + tt; f32x4 acc = (f32x4){0.f, 0.f, 0.f, 0.f};
#pragma unroll
        for (int w = 0; w < 4; ++w) acc += *(const LAS f32x4*)(part + ((grp * 4 + w) * 8 + t) * 256 + 4 * lane);
#pragma unroll
        for (int s = 0; s < 8; ++s) { const float a = (s <= t) ? alw[t * (t + 1) / 2 + s] : 0.f; acc += a * V[s]; }
        { u32x2 w; w.x = pk2(acc[0], acc[1]); w.y = pk2(acc[2], acc[3]); *(u32x2*)(oraw + (size_t)(rb + t) * 1024 + h * 256 + 4 * lane) = w; } }
    __syncthreads();
}
struct VRegs2 { u32x4 r[2]; };
__device__ __forceinline__ void v_load_half(const Params& p, VRegs2& v, int rb, int h, int vhalf) {
    const int tid = otid(), s = tid & 63, vg = tid >> 6; const bf16_t* Z = (const bf16_t*)(p.ws + OFF_Z);
#pragma unroll
    for (int k = 0; k < 2; ++k) v.r[k] = *(const u32x4*)(Z + (size_t)(rb + s) * NZ + 1024 + h * 256 + vhalf * 128 + vg * 16 + 8 * k);
}
__device__ __forceinline__ void v_store_half_t(LAS unsigned char* lds, const VRegs2& v) {
    const int tid = otid(), s = tid & 63, vg = tid >> 6; LAS bf16_t* VT = (LAS bf16_t*)(lds + R_VT) + (vg * 16) * LS + s;
#pragma unroll
    for (int k = 0; k < 2; ++k) {
        VT[(8 * k + 0) * LS] = (bf16_t)(v.r[k].x & 0xffffu); VT[(8 * k + 1) * LS] = (bf16_t)(v.r[k].x >> 16);
        VT[(8 * k + 2) * LS] = (bf16_t)(v.r[k].y & 0xffffu); VT[(8 * k + 3) * LS] = (bf16_t)(v.r[k].y >> 16);
        VT[(8 * k + 4) * LS] = (bf16_t)(v.r[k].z & 0xffffu); VT[(8 * k + 5) * LS] = (bf16_t)(v.r[k].z >> 16);
        VT[(8 * k + 6) * LS] = (bf16_t)(v.r[k].w & 0xffffu); VT[(8 * k + 7) * LS] = (bf16_t)(v.r[k].w >> 16); }
}
constexpr int CH_BUF = 64000;
template <int NTHR> __device__ __forceinline__ void chain_stage(const Params& p, LAS unsigned char* buf, const u32x4* img, int rb, int h, int vhalf, int t) {
    const bf16_t* Z = (const bf16_t*)(p.ws + OFF_Z);
    constexpr int NI = (IMG_V4 + NTHR - 1) / NTHR, NV = 512 / NTHR;
    u32x4 im[NI], v0[NV], v1[NV];
#pragma unroll
    for (int k = 0; k < NI; ++k) { const int i = t + NTHR * k; im[k] = (i < IMG_V4) ? img[i] : (u32x4){0u, 0u, 0u, 0u}; }
#pragma unroll
    for (int k = 0; k < NV; ++k) { const int e = t + NTHR * k, s = e & 63, vg = e >> 6; const bf16_t* zp = Z + (size_t)(rb + s) * NZ + 1024 + h * 256 + vhalf * 128 + vg * 16; v0[k] = *(const u32x4*)zp; v1[k] = *(const u32x4*)(zp + 8); }
#pragma unroll
    for (int k = 0; k < NI; ++k) { const int i = t + NTHR * k; if (i < IMG_V4) ((LAS u32x4*)buf)[i] = im[k]; }
#pragma unroll
    for (int k = 0; k < NV; ++k) { const int e = t + NTHR * k, s = e & 63, vg = e >> 6; const u32x4 r0 = v0[k], r1 = v1[k];
        LAS bf16_t* VT = (LAS bf16_t*)(buf + R_VT) + (vg * 16) * LS + s;
        VT[0 * LS] = (bf16_t)(r0.x & 0xffffu); VT[1 * LS] = (bf16_t)(r0.x >> 16); VT[2 * LS] = (bf16_t)(r0.y & 0xffffu); VT[3 * LS] = (bf16_t)(r0.y >> 16);
        VT[4 * LS] = (bf16_t)(r0.z & 0xffffu); VT[5 * LS] = (bf16_t)(r0.z >> 16); VT[6 * LS] = (bf16_t)(r0.w & 0xffffu); VT[7 * LS] = (bf16_t)(r0.w >> 16);
        VT[8 * LS] = (bf16_t)(r1.x & 0xffffu); VT[9 * LS] = (bf16_t)(r1.x >> 16); VT[10 * LS] = (bf16_t)(r1.y & 0xffffu); VT[11 * LS] = (bf16_t)(r1.y >> 16);
        VT[12 * LS] = (bf16_t)(r1.z & 0xffffu); VT[13 * LS] = (bf16_t)(r1.z >> 16); VT[14 * LS] = (bf16_t)(r1.w & 0xffffu); VT[15 * LS] = (bf16_t)(r1.w >> 16); }
}
__device__ __forceinline__ void gla_chain_item(const Params& p, LAS unsigned char* lds, int chain, int vhalf) {
    const int tid = otid(), lane = tid & 63, wave = tid >> 6, l31 = lane & 31, hh = lane >> 5;
    const int b = chain >> 2, h = chain & 3, vb = vhalf * 4 + (wave & 3);
    f32x16 S[4];
#pragma unroll
    for (int cb = 0; cb < 4; ++cb)
#pragma unroll
        for (int i = 0; i < 16; ++i) S[cb][i] = 0.f;
    const u32x4* img = (const u32x4*)(p.ws + OFF_IMG + (size_t)(chain * 32) * IMG_BYTES);
    chain_stage<512>(p, lds, img, b * 2048, h, vhalf, tid);
    __syncthreads();
#pragma unroll 1
    for (int ch = 0; ch < 32; ++ch) {
        const int rb = b * 2048 + ch * 64;
        if (wave >= 4) { if (ch + 1 < 32) chain_stage<256>(p, lds + ((ch + 1) & 1) * CH_BUF, img + (size_t)(ch + 1) * IMG_V4, rb + 64, h, vhalf, tid - 256); }
        else gla_step(p, lds + (ch & 1) * CH_BUF, S, rb, h, 64, vb, 32 * wave);
        __syncthreads();
    }
    if (wave < 4) {
        float* Sout = p.out + OUT_SP + (size_t)chain * 32768;
#pragma unroll
        for (int cb = 0; cb < 4; ++cb)
#pragma unroll
            for (int i = 0; i < 16; ++i) Sout[s_index(cb, i, hh, vb, l31)] = S[cb][i];
    }
}

constexpr int M_W = 0, M_V = 34816, M_STAT = 69632;
__device__ __forceinline__ void gmlp_item(const Params& p, LAS unsigned char* lds, int rowbase, int T, int g, float* vs_out) {
    const int tid = otid(), lane = tid & 63, wave = tid >> 6;
    const bf16_t* Z = (const bf16_t*)(p.ws + OFF_Z); bf16_t* mraw = (bf16_t*)(p.ws + OFF_MRAW);
    LAS bf16_t* LW = (LAS bf16_t*)(lds + M_W); LAS bf16_t* LV = (LAS bf16_t*)(lds + M_V); LAS float* stat = (LAS float*)(lds + M_STAT);
    if (tid < 128) { const f32x2 st = (tid < T) ? *(const f32x2*)((const float*)(p.ws + OFF_STAT) + (size_t)(rowbase + tid) * 2) : (f32x2){0.f, 0.f}; stat[2 * tid] = st.x; stat[2 * tid + 1] = st.y; }
    for (int idx = tid; idx < 4096; idx += 512) { const int t = idx >> 5, s4 = (idx & 31) * 4; const f32x4 w = *(const f32x4*)(p.w_s + ((size_t)g * 128 + t) * 128 + s4);
        u32x2 o; o.x = pk2(s4 <= t ? w[0] : 0.f, s4 + 1 <= t ? w[1] : 0.f); o.y = pk2(s4 + 2 <= t ? w[2] : 0.f, s4 + 3 <= t ? w[3] : 0.f);
        *(LAS u32x2*)(LW + t * LQ + s4) = o; }
    __syncthreads();
    { const int s = tid & 127, dq = tid >> 7; const float mean = stat[2 * s], rstd = stat[2 * s + 1];
#pragma unroll
        for (int ps = 0; ps < 4; ++ps) { const int d8 = (dq * 4 + ps) * 8; float vn[8];
            if (s < T) { const u32x4 r = *(const u32x4*)(Z + (size_t)(rowbase + s) * NZ + 4096 + g * 128 + d8);
                const float x[8] = {bflo(r.x), bfhi(r.x), bflo(r.y), bfhi(r.y), bflo(r.z), bfhi(r.z), bflo(r.w), bfhi(r.w)};
                const f32x4 ga = *(const f32x4*)(p.g_gmlp_ln + g * 128 + d8), gb = *(const f32x4*)(p.g_gmlp_ln + g * 128 + d8 + 4);
                const f32x4 ba = *(const f32x4*)(p.b_gmlp_ln + g * 128 + d8), bb = *(const f32x4*)(p.b_gmlp_ln + g * 128 + d8 + 4);
#pragma unroll
                for (int j = 0; j < 4; ++j) { vn[j] = (x[j] - mean) * rstd * ga[j] + ba[j]; vn[4 + j] = (x[4 + j] - mean) * rstd * gb[j] + bb[j]; }
                if (vs_out) { float* vp = vs_out + (size_t)s * 1024 + g * 128 + d8; *(f32x4*)vp = (f32x4){vn[0], vn[1], vn[2], vn[3]}; *(f32x4*)(vp + 4) = (f32x4){vn[4], vn[5], vn[6], vn[7]}; }
            } else {
#pragma unroll
                for (int j = 0; j < 8; ++j) vn[j] = 0.f;
            }
#pragma unroll
            for (int j = 0; j < 8; ++j) LV[(d8 + j) * LQ + s] = f2bf(vn[j]); } }
    __syncthreads();
#pragma unroll 1
    for (int q = 0; q < 2; ++q) { const int id = wave * 2 + q, ti = id >> 2, di = id & 3;
        if (ti * 32 < T) { f32x16 acc;
#pragma unroll
            for (int i = 0; i < 16; ++i) acc[i] = 0.f;
            mma32(acc, LW + ti * 32 * LQ, LQ, LV + di * 32 * LQ, LQ, (ti + 1) * 32, lane);
            const int d = di * 32 + (lane & 31);
#pragma unroll
            for (int i = 0; i < 16; ++i) { const int t = ti * 32 + (i & 3) + 8 * (i >> 2) + 4 * (lane >> 5);
                if (t < T) { const float uval = bf2f(Z[(size_t)(rowbase + t) * NZ + 3072 + g * 128 + d]);
                    mraw[(size_t)(rowbase + t) * 1024 + g * 128 + d] = f2bf(uval * (acc[i] + p.b_s[g * 128 + t])); } } } }
    __syncthreads();
}

__device__ __forceinline__ void gmlp_sample_item(const Params& p, int b) {
    const int tid = otid(), d2 = tid * 2, g = __builtin_amdgcn_readfirstlane(tid >> 6), rb = MP + b * 8;
    const bf16_t* Z = (const bf16_t*)(p.ws + OFF_Z); bf16_t* mraw = (bf16_t*)(p.ws + OFF_MRAW); const float* st = (const float*)(p.ws + OFF_STAT) + (size_t)rb * 2;
    float* vs_out = p.out + OUT_VS + (size_t)b * 8 * 1024;
    const f32x2 ga = *(const f32x2*)(p.g_gmlp_ln + d2), be = *(const f32x2*)(p.b_gmlp_ln + d2);
    unsigned xv[8], uv[8];
#pragma unroll
    for (int s_ = 0; s_ < 8; ++s_) { xv[s_] = *(const unsigned*)(Z + (size_t)(rb + s_) * NZ + 4096 + d2); uv[s_] = *(const unsigned*)(Z + (size_t)(rb + s_) * NZ + 3072 + d2); }
    float v0[8], v1[8];
#pragma unroll
    for (int s_ = 0; s_ < 8; ++s_) { const float mean = st[2 * s_], rstd = st[2 * s_ + 1];
        v0[s_] = (bflo(xv[s_]) - mean) * rstd * ga.x + be.x; v1[s_] = (bfhi(xv[s_]) - mean) * rstd * ga.y + be.y;
        *(f32x2*)(vs_out + (size_t)s_ * 1024 + d2) = (f32x2){v0[s_], v1[s_]}; }
    const float* wg = p.w_s + (size_t)g * 128 * 128; const float* bs = p.b_s + g * 128;
#pragma unroll
    for (int t = 0; t < 8; ++t) { float m0 = bs[t], m1 = m0;
#pragma unroll
        for (int s_ = 0; s_ <= t; ++s_) { const float w = wg[t * 128 + s_]; m0 += w * v0[s_]; m1 += w * v1[s_]; }
        *(unsigned*)(mraw + (size_t)(rb + t) * 1024 + d2) = pk2(bflo(uv[t]) * m0, bfhi(uv[t]) * m1); }
}
__device__ __forceinline__ void phase2a(const Params& p, LAS unsigned char* lds) {
    {   const int tid = otid(), lane = tid & 63, gw = blockIdx.x * 8 + (tid >> 6), NGW = gridDim.x * 8;
        const bf16_t* Z = (const bf16_t*)(p.ws + OFF_Z); float* st = (float*)(p.ws + OFF_STAT);
        for (int r = gw; r < MT; r += NGW) {
            const bf16_t* zr = Z + (size_t)r * NZ + 4096; const u32x4 r0 = *(const u32x4*)(zr + lane * 8), r1 = *(const u32x4*)(zr + 512 + lane * 8);
            const float x[16] = {bflo(r0.x), bfhi(r0.x), bflo(r0.y), bfhi(r0.y), bflo(r0.z), bfhi(r0.z), bflo(r0.w), bfhi(r0.w), bflo(r1.x), bfhi(r1.x), bflo(r1.y), bfhi(r1.y), bflo(r1.z), bfhi(r1.z), bflo(r1.w), bfhi(r1.w)};
            float s = 0.f;
#pragma unroll
            for (int j = 0; j < 16; ++j) s += x[j];
            const float mean = wave_sum(s) * (1.f / 1024.f); float q = 0.f;
#pragma unroll
            for (int j = 0; j < 16; ++j) { const float d = x[j] - mean; q += d * d; }
            const float rstd = rsqrtf(wave_sum(q) * (1.f / 1024.f) + 1e-6f);
            if (lane == 0) *(f32x2*)(st + (size_t)r * 2) = (f32x2){mean, rstd};
        }
    }
    for (int j = blockIdx.x; j < 512; j += gridDim.x) gla_prep_item(p, lds, j >> 5, j & 31);
    for (int j = blockIdx.x; j < 256; j += gridDim.x) gla_sample_pair(p, lds, j);
    { const int gw = blockIdx.x * 8 + (otid() >> 6), NGW = gridDim.x * 8; convert_range(p, lds, cv::E_IN, cv::E_OUT, gw, NGW); convert_range(p, lds, cv::E_FO, cv::E_PLE, gw, NGW); }
}
__device__ __forceinline__ void phase2c(const Params& p, LAS unsigned char* lds) {
    const int nb = gridDim.x, bid = blockIdx.x;
    constexpr int NCH = 32, N_GP = 512, N_GS = 0, N_MS = 128;
    const int nlb = nb > 2 * NCH ? NCH : (nb > 1 ? nb / 2 : 0);
    if (bid < nlb || nlb == 0) { for (int j = (nlb ? bid : 0); j < NCH; j += (nlb ? nlb : 1)) gla_chain_item(p, lds, j >> 1, j & 1); }
    if (bid >= nlb) {
        const int ob = bid - nlb, onb = nb - nlb;
        for (int j = ob; j < N_GP + N_GS + N_MS; j += onb) {
            if (j < N_GP) gmlp_item(p, lds, (j >> 3) * 128, 128, j & 7, nullptr);
            else gmlp_sample_item(p, j - N_GP - N_GS);
        }
        __syncthreads();
        convert_range(p, lds, cv::E_OUT, cv::E_FI, ob * 8 + (otid() >> 6), onb * 8);
    }
}

struct Mix10 { f32x4 o[4], m[4]; u32x4 r0, r1; };
__device__ __forceinline__ void mix_load(Mix10& a, const Params& p, int r, int col) {
    const bf16_t* Z = (const bf16_t*)(p.ws + OFF_Z); const bf16_t* oraw = (const bf16_t*)(p.ws + OFF_ORAW); const bf16_t* mraw = (const bf16_t*)(p.ws + OFF_MRAW);
#pragma unroll
    for (int j = 0; j < 2; ++j) { const u32x4 ow = ldnt((const u32x4*)(oraw + (size_t)r * 1024 + col + 8 * j)), mw = ldnt((const u32x4*)(mraw + (size_t)r * 1024 + col + 8 * j));
        a.o[2 * j] = (f32x4){bflo(ow.x), bfhi(ow.x), bflo(ow.y), bfhi(ow.y)}; a.o[2 * j + 1] = (f32x4){bflo(ow.z), bfhi(ow.z), bflo(ow.w), bfhi(ow.w)};
        a.m[2 * j] = (f32x4){bflo(mw.x), bfhi(mw.x), bflo(mw.y), bfhi(mw.y)}; a.m[2 * j + 1] = (f32x4){bflo(mw.z), bfhi(mw.z), bflo(mw.w), bfhi(mw.w)}; }
    a.r0 = ldnt((const u32x4*)(Z + (size_t)r * NZ + 2048 + col)); a.r1 = ldnt((const u32x4*)(Z + (size_t)r * NZ + 2048 + col + 8));
}
__device__ __forceinline__ void mix_finish(const Mix10& a, const Params& p, int r, int col) {
    bf16_t* cat = (bf16_t*)(p.ws + OFF_A0);
    { float s = 0.f;
#pragma unroll
        for (int j = 0; j < 4; ++j) s += (a.o[j][0] * a.o[j][0] + a.o[j][1] * a.o[j][1]) + (a.o[j][2] * a.o[j][2] + a.o[j][3] * a.o[j][3]);
        s = row16_sum(s);
        const float rinv = rsqrtf(s * (1.f / 256.f) + 1e-6f);
        const float sr[16] = {bflo(a.r0.x), bfhi(a.r0.x), bflo(a.r0.y), bfhi(a.r0.y), bflo(a.r0.z), bfhi(a.r0.z), bflo(a.r0.w), bfhi(a.r0.w), bflo(a.r1.x), bfhi(a.r1.x), bflo(a.r1.y), bfhi(a.r1.y), bflo(a.r1.z), bfhi(a.r1.z), bflo(a.r1.w), bfhi(a.r1.w)};
        unsigned w[8];
#pragma unroll
        for (int j = 0; j < 4; ++j) { const f32x4 g = *(const f32x4*)(p.g_gla_norm + col + 4 * j);
            w[2 * j] = pk2(a.o[j][0] * rinv * g[0] * sr[4 * j], a.o[j][1] * rinv * g[1] * sr[4 * j + 1]); w[2 * j + 1] = pk2(a.o[j][2] * rinv * g[2] * sr[4 * j + 2], a.o[j][3] * rinv * g[3] * sr[4 * j + 3]); }
        u32x4* dp = (u32x4*)(cat + (size_t)r * DM + col); dp[0] = (u32x4){w[0], w[1], w[2], w[3]}; dp[1] = (u32x4){w[4], w[5], w[6], w[7]}; }
    { float s = 0.f;
#pragma unroll
        for (int j = 0; j < 4; ++j) s += (a.m[j][0] * a.m[j][0] + a.m[j][1] * a.m[j][1]) + (a.m[j][2] * a.m[j][2] + a.m[j][3] * a.m[j][3]);
        const float rinv = rsqrtf(wave_sum(s) * (1.f / 1024.f) + 1e-6f);
        unsigned w[8];
#pragma unroll
        for (int j = 0; j < 4; ++j) { const f32x4 g = *(const f32x4*)(p.g_gmlp_out + col + 4 * j);
            w[2 * j] = pk2(a.m[j][0] * rinv * g[0], a.m[j][1] * rinv * g[1]); w[2 * j + 1] = pk2(a.m[j][2] * rinv * g[2], a.m[j][3] * rinv * g[3]); }
        u32x4* dp = (u32x4*)(cat + (size_t)r * DM + 1024 + col); dp[0] = (u32x4){w[0], w[1], w[2], w[3]}; dp[1] = (u32x4){w[4], w[5], w[6], w[7]}; }
}
__device__ __forceinline__ void phase2b(const Params& p) {
    const int lane = otid() & 63, gw = blockIdx.x * 8 + (otid() >> 6), NGW = gridDim.x * 8, col = lane * 16;
    for (int r = gw; r < MT; r += 2 * NGW) {
        const int r2 = r + NGW; const bool has2 = r2 < MT;
        Mix10 a, b; mix_load(a, p, r, col); mix_load(b, p, has2 ? r2 : r, col);
        mix_finish(a, p, r, col);
        if (has2) mix_finish(b, p, r2, col);
    }
}
template <int NS> __device__ __forceinline__ void phase_norm(const Params& p, const float* gain, const float* base_s) {
    const int lane = otid() & 63, gw = blockIdx.x * 8 + (otid() >> 6), NGW = gridDim.x * 8; bf16_t* a0 = (bf16_t*)(p.ws + OFF_A0); const bf16_t* part = (const bf16_t*)(p.ws + OFF_IMG);
    for (int r = gw; r < MP; r += 4 * NGW) {
        const int r2 = r + NGW, r3 = r + 2 * NGW, r4 = r + 3 * NGW; const bool h2 = r2 < MP, h3 = r3 < MP, h4 = r4 < MP;
        Row8 a, b, c4, d; row_load_nt(a, p.out + OUT_Y + (size_t)r * DM, lane); row_load_nt(b, p.out + OUT_Y + (size_t)(h2 ? r2 : r) * DM, lane);
        row_load_nt(c4, p.out + OUT_Y + (size_t)(h3 ? r3 : r) * DM, lane); row_load_nt(d, p.out + OUT_Y + (size_t)(h4 ? r4 : r) * DM, lane);
        rms_finish_bf16(a, gain, a0 + (size_t)r * DM, lane);
        if (h2) rms_finish_bf16(b, gain, a0 + (size_t)r2 * DM, lane);
        if (h3) rms_finish_bf16(c4, gain, a0 + (size_t)r3 * DM, lane);
        if (h4) rms_finish_bf16(d, gain, a0 + (size_t)r4 * DM, lane);
    }
    for (int r = MP + gw; r < MT; r += NGW) {
        f32x4 v[8]; float s = 0.f; const f32x4* sm = row_mid(base_s + (size_t)(r - MP) * DM, lane); const f32x4* gm = row_mid(gain, lane);
        const u32x2* pm0 = (const u32x2*)(part + (size_t)(r - MP) * DM) + lane; f32x4* om = row_mid(p.out + OUT_Y + (size_t)r * DM, lane);
#pragma unroll
        for (int j = 0; j < 8; ++j) v[j] = sm[64 * (j - 4)];
#pragma unroll 4
        for (int k = 0; k < NS; ++k) { const u32x2* pk = pm0 + (size_t)k * (MS * DM / 4);
#pragma unroll
            for (int j = 0; j < 8; ++j) v[j] += unpack4(pk[64 * j]); }
#pragma unroll
        for (int j = 0; j < 8; ++j) { om[64 * (j - 4)] = v[j]; s += (v[j][0] * v[j][0] + v[j][1] * v[j][1]) + (v[j][2] * v[j][2] + v[j][3] * v[j][3]); }
        const float rinv = rsqrtf(wave_sum(s) * (1.f / DM) + 1e-6f);
        u32x2* dm = (u32x2*)(a0 + (size_t)r * DM) + lane;
#pragma unroll
        for (int j = 0; j < 8; ++j) { const f32x4 g = gm[64 * (j - 4)]; u32x2 o; o.x = pk2(v[j][0] * rinv * g[0], v[j][1] * rinv * g[1]); o.y = pk2(v[j][2] * rinv * g[2], v[j][3] * rinv * g[3]);
            dm[64 * j] = o; }
    }
}
#define P7_TAIL() \
        float s = 0.f; \
        _Pragma("unroll") for (int j = 0; j < 8; ++j) s += (v.v[j][0] * v.v[j][0] + v.v[j][1] * v.v[j][1]) + (v.v[j][2] * v.v[j][2] + v.v[j][3] * v.v[j][3]); \
        const float rp = rsqrtf(wave_sum(s) * (1.f / DM) + 1e-6f); float s3 = 0.f; \
        const f32x4* gpm = row_mid(p.g_ple, lane); \
        _Pragma("unroll") for (int j = 0; j < 8; ++j) { const f32x4 g = gpm[64 * (j - 4)]; \
            _Pragma("unroll") for (int k = 0; k < 4; ++k) { const float h3 = hh.v[j][k] + v.v[j][k] * rp * g[k] * sigmoid_f(z.v[j][k]); v.v[j][k] = h3; s3 += h3 * h3; } } \
        const float r3 = rsqrtf(wave_sum(s3) * (1.f / DM) + 1e-6f); \
        const f32x4* gfm = row_mid(p.g_final, lane); \
        _Pragma("unroll") for (int j = 0; j < 8; ++j) { const f32x4 g = gfm[64 * (j - 4)]; stnt(om + 64 * (j - 4), (f32x4){v.v[j][0] * r3 * g[0], v.v[j][1] * r3 * g[1], v.v[j][2] * r3 * g[2], v.v[j][3] * r3 * g[3]}); }
__device__ __forceinline__ void phase7(const Params& p) {
    const int lane = otid() & 63, gw = blockIdx.x * 8 + (otid() >> 6), NGW = gridDim.x * 8;
    const bf16_t* gz = (const bf16_t*)(p.ws + OFF_GATEZ); const bf16_t* pz = (const bf16_t*)(p.ws + OFF_PZ);
#pragma unroll 1
    for (int r = gw; r < MP; r += NGW) {
        f32x4* om = row_mid(p.out + OUT_Y + (size_t)r * DM, lane);
        const u32x2* pzr = (const u32x2*)(pz + (size_t)r * DM) + lane; const u32x2* zb = (const u32x2*)(gz + (size_t)r * DM) + lane;
        Row8 v, hh, z;
#pragma unroll
        for (int j = 0; j < 8; ++j) { const u32x2 w = ldnt(pzr + 64 * j), zw = ldnt(zb + 64 * j); v.v[j] = (f32x4){bflo(w.x), bfhi(w.x), bflo(w.y), bfhi(w.y)}; z.v[j] = (f32x4){bflo(zw.x), bfhi(zw.x), bflo(zw.y), bfhi(zw.y)}; hh.v[j] = ldnt(om + 64 * (j - 4)); }
        P7_TAIL()
    }
#pragma unroll 1
    for (int r = MP + gw; r < MT; r += NGW) {
        f32x4* om = row_mid(p.out + OUT_Y + (size_t)r * DM, lane);
        const u32x2* pzr = (const u32x2*)(pz + (size_t)r * DM) + lane; const u32x2* zm = (const u32x2*)((const bf16_t*)(p.ws + OFF_IMG) + (size_t)(r - MP) * DM) + lane;
        Row8 v, hh, z;
#pragma unroll
        for (int j = 0; j < 8; ++j) { const u32x2 w = ldnt(pzr + 64 * j); v.v[j] = unpack4(w); hh.v[j] = ldnt(om + 64 * (j - 4)); z.v[j] = (f32x4){0.f, 0.f, 0.f, 0.f}; }
#pragma unroll 4
        for (int k = 0; k < 8; ++k) { const u32x2* pk = zm + (size_t)k * (MS * DM / 4);
#pragma unroll
            for (int j = 0; j < 8; ++j) z.v[j] += unpack4(ldnt(pk + 64 * j)); }
        P7_TAIL()
    }
}
#undef P7_TAIL

__global__ void __launch_bounds__(512, 2) fwd_kernel(Params p) {
    extern __shared__ __attribute__((aligned(16))) unsigned char shm[];
    LAS unsigned char* lds = (LAS unsigned char*)shm;
    cg::grid_group grid = cg::this_grid();
    if (threadIdx.x == 0) { *(volatile LAS unsigned*)(lds + 131072) = 0u; *(volatile LAS unsigned*)(lds + 131076) = 0u; }
    __syncthreads();
    const XcdBarrier xb = xcd_barrier_post((unsigned*)(p.ws + OFF_BAR), (volatile LAS unsigned*)(lds + 131072));
    bf16_t* a0 = (bf16_t*)(p.ws + OFF_A0);
    phase0(p, lds);
    if (p.ws == nullptr) grid.sync();
    xcd_barrier(xb);
    { EpiIn E; E.Z = (bf16_t*)(p.ws + OFF_Z); E.alow = (float*)(p.ws + OFF_ALOW); run_gemm(lds, a0, (const bf16_t*)(p.ws + OFF_WIN), MT, NINP, DM, E); }
    xcd_barrier(xb);
    phase2a(p, lds);
    xcd_barrier(xb);
    phase2c(p, lds);
    xcd_barrier(xb);
    phase2b(p);
    xcd_barrier(xb);
    bf16_t* part = (bf16_t*)(p.ws + OFF_IMG);
    { EpiRes E; E.res_p = p.x_prompt; E.res_s = p.x_sample; E.out = p.out + OUT_Y; run_gemm_n2048(lds, a0, (const bf16_t*)(p.ws + OFF_WOUT), DM, E, part); }
    xcd_barrier(xb);
    phase_norm<8>(p, p.g_ffn, p.x_sample);
    xcd_barrier(xb);
    { EpiSwiglu E; E.act = (bf16_t*)(p.ws + OFF_ACT); run_gemm(lds, a0, (const bf16_t*)(p.ws + OFF_WFI), MT, 2 * DFF, DM, E); }
    {
        const int G = (int)gridDim.x, extra = ((MT / 256) * (2 * DFF / 256)) % G, cb = (int)blockIdx.x;
        if (extra == 0 || cb >= extra) { EpiBfN E; E.out = (bf16_t*)(p.ws + OFF_PZ); pg8::Gemm g; g.A = (const bf16_t*)(p.ws + OFF_PB); g.Bt = (const bf16_t*)(p.ws + OFF_WPLE); g.M = MT; g.N = DM; g.K = PLE; g.Klen = PLE;
            pg8::StaticOrder S; S.init(MT, DM, extra ? G - extra : G, extra ? cb - extra : cb); pg8::gemm_phase<EpiBfN, pg8::StaticOrder, false>(lds, g, S, E, nullptr);
            { const int ob = extra ? cb - extra : cb, onb = extra ? G - extra : G, gw = ob * 8 + (otid() >> 6); convert_range(p, lds, cv::E_FI, cv::E_FO, gw, onb * 8); convert_range(p, lds, cv::E_PLE, cv::E_GT, gw, onb * 8); } }
    }
    xcd_barrier(xb);
    { EpiRes E; E.res_p = p.out + OUT_Y; E.res_s = p.out + OUT_Y + (size_t)MP * DM; E.out = p.out + OUT_Y;
      const bf16_t* A = (const bf16_t*)(p.ws + OFF_ACT); const bf16_t* Bt = (const bf16_t*)(p.ws + OFF_WFO); const int G = (int)gridDim.x, hb = (int)((blockIdx.x + G / 2) % G);
      run_gemm(lds, A, Bt, MP, DM, DFF, E);
      run_split(lds, A, Bt, DFF, part, 4, 768, 0, 0, hb);
      run_split(lds, A, Bt, DFF, part, 4, 640, 3072, 4, (int)blockIdx.x); }
    xcd_barrier(xb);
    phase_norm<8>(p, p.g_ple_gate, p.out + OUT_Y + (size_t)MP * DM);
    xcd_barrier(xb);
    { EpiBfN E; E.out = (bf16_t*)(p.ws + OFF_GATEZ); run_gemm_n2048(lds, a0, (const bf16_t*)(p.ws + OFF_WGT), DM, E, part); }
    xcd_barrier(xb);
    phase7(p);
}

extern "C" void kernel_launch(void* const* d_in, const int* in_sizes, int n_in, void* d_out, int out_size, void* d_ws, size_t ws_size, hipStream_t stream) {
    static int grid = 0;
    if (grid == 0) {
        if (n_in != 24 || ws_size < WS_END) { fprintf(stderr, "kernel_launch: unexpected n_in %d or ws_size %zu (< %zu)\n", n_in, ws_size, (size_t)WS_END); grid = -1; return; }
        int dev = 0, cus = 0, per_cu = 0;
        if (hipGetDevice(&dev) != hipSuccess || hipDeviceGetAttribute(&cus, hipDeviceAttributeMultiprocessorCount, dev) != hipSuccess) { grid = -1; return; }
        if (hipFuncSetAttribute((const void*)fwd_kernel, hipFuncAttributeMaxDynamicSharedMemorySize, LDS_BYTES) != hipSuccess) { fprintf(stderr, "kernel_launch: hipFuncSetAttribute failed\n"); grid = -1; return; }
        if (hipOccupancyMaxActiveBlocksPerMultiprocessor(&per_cu, (const void*)fwd_kernel, 512, LDS_BYTES) != hipSuccess || per_cu < 1) { fprintf(stderr, "kernel_launch: occupancy query says %d blocks per CU\n", per_cu); grid = -1; (void)hipGetLastError(); return; }
        grid = cus;
    }
    if (grid < 0) return;
    if (hipMemsetAsync(d_ws, 0, XCD_BAR_WORDS * sizeof(unsigned), stream) != hipSuccess) { fprintf(stderr, "kernel_launch: memset failed\n"); return; }
    Params p{};
    const float** f = (const float**)&p;
    for (int i = 0; i < 24; ++i) f[i] = (const float*)d_in[i];
    p.out = (float*)d_out; p.ws = (unsigned char*)d_ws;
    void* args[] = {&p};
    hipError_t e = hipLaunchCooperativeKernel((const void*)fwd_kernel, dim3(grid), dim3(512), args, LDS_BYTES, stream);
    if (e != hipSuccess) fprintf(stderr, "cooperative launch failed: %s (grid %d)\n", hipGetErrorString(e), grid);
}
```

```cpp
#include <hip/hip_runtime.h>
#include <hip/hip_cooperative_groups.h>
#include <cstdio>
#include <cstdint>
namespace cg = cooperative_groups;
namespace pg8 {
#define PG8_LAS __attribute__((address_space(3)))
typedef unsigned short bf16_t;
typedef short bf16x8 __attribute__((ext_vector_type(8)));
typedef float f32x4 __attribute__((ext_vector_type(4)));
typedef unsigned u32x4 __attribute__((ext_vector_type(4)));
constexpr int BM = 256, BK = 64, HALF = 128, HTB = HALF * BK * 2  , STAGE_BYTES = 8 * HTB, NXCD = 8, WGM = 8;

__host__ __device__ __forceinline__ int lds_byte(int r, int c) { const int st = (r >> 4) * 2 + (c >> 5), rr = r & 15, cc = c & 31, ob = rr * 64 + cc * 2; return st * 1024 + (ob ^ (((ob >> 9) & 1) << 5)); }
__host__ __device__ __forceinline__ void stage_rc(int b, int& R, int& C) { const int st = b / 1024, sb = b % 1024, swz = sb ^ (((sb >> 9) & 1) << 5); R = (st >> 1) * 16 + swz / 64; C = (st & 1) * 32 + (swz % 64) / 2; }
__host__ __device__ __forceinline__ int perm32(int rho) { const int n = rho >> 4, i = rho & 15; return 8 * (i >> 2) + 4 * n + (i & 3); }

struct Unit { int pm, pn, ks, koff; };
struct Gemm { const bf16_t* A; const bf16_t* Bt; int M, N, K, Klen; };

struct StaticOrder {
    int nM, nN, nwg, G, c;
    __host__ __device__ void init(int M, int N, int G_, int c_) { nM = M / BM; nN = N / BM; nwg = nM * nN; G = G_; c = c_; }
    __host__ __device__ bool next(int i, Unit& u) const {
        const long L = (long)i * G + c; if (L >= nwg) return false;
        int wgid = (int)L; { const int q = nwg / NXCD, r = nwg % NXCD, xcd = wgid % NXCD, off = wgid / NXCD; wgid = (xcd < r ? xcd * (q + 1) : r * (q + 1) + (xcd - r) * q) + off; }
        const int nig = WGM * nN, gid = wgid / nig, fm = gid * WGM, gsz = (nM - fm) < WGM ? (nM - fm) : WGM;
        u.pm = fm + ((wgid % nig) % gsz); u.pn = (wgid % nig) / gsz; u.ks = 0; u.koff = 0; return true;
    }
    __device__ __forceinline__ void a_ready(const Unit&) const {}
    __device__ __forceinline__ void done(const Unit&) const {}
};
__device__ __forceinline__ unsigned cvt_pk_bf16(float lo, float hi) { unsigned r; asm volatile("v_cvt_pk_bf16_f32 %0, %1, %2" : "=v"(r) : "v"(lo), "v"(hi)); return r; }
typedef float f32x2 __attribute__((ext_vector_type(2)));
template <class Epi, class Sched, bool STAMP = false>
__device__ __forceinline__ void gemm_phase(PG8_LAS unsigned char* lds, const Gemm g, const Sched& S, const Epi& E, unsigned long long* stamps) {
    int tid_ = threadIdx.x; asm volatile("" : "+v"(tid_));
    const int tid = tid_, wid = __builtin_amdgcn_readfirstlane(tid >> 6), lane = tid & 63, wr = wid >> 2, wc = wid & 3, fr = lane & 15, fq = lane >> 4;
    const int K = g.K, nt = g.Klen / BK;
    int ts_lo = 0, ts_hi = 0, nts = 0; const unsigned long long rt_entry = STAMP ? (unsigned long long)wall_clock64() : 0ull;
#define PG8_STAMP() do { if (STAMP && wid == 0 && nts < 64) { const unsigned long long _c = (unsigned long long)clock64(); \
        ts_lo = (lane == nts) ? (int)(unsigned)_c : ts_lo; ts_hi = (lane == nts) ? (int)(unsigned)(_c >> 32) : ts_hi; ++nts; } } while (0)
    PG8_STAMP();
    unsigned voffA[2], voffB[2];
#pragma unroll
    for (int i = 0; i < 2; ++i) { int R, C; stage_rc(tid * 16 + i * 8192, R, C); const int Rb = Epi::PERM ? ((R & ~31) + perm32(R & 31)) : R;
        voffA[i] = (unsigned)(R * K + C) * 2u; voffB[i] = (unsigned)(Rb * K + C) * 2u; }
    const size_t kstep = (size_t)(BK * 2);
    const size_t hstep = (size_t)HALF * K * 2;
    const size_t tstep = 2 * hstep;
    const unsigned ldsw = (unsigned)wid * 1024u;
    const int aoff = lds_byte(wr * 64 + fr, fq * 8), boff = lds_byte(wc * 32 + fr, fq * 8);
#define PG8_SA(b, h) (((b) * 2 + (h)) * HTB)
#define PG8_SB(b, h) ((4 + (b) * 2 + (h)) * HTB)
#define PG8_STAGE(bufoff, gbase, voff) do { _Pragma("unroll") for (int _i = 0; _i < 2; ++_i) \
        __builtin_amdgcn_global_load_lds((const unsigned*)((const char*)(gbase) + (voff)[_i]), (PG8_LAS unsigned*)(lds + (bufoff) + ldsw + _i * 8192), 16, 0, 0); } while (0)
#define PG8_LDA(dst, b, h) do { _Pragma("unroll") for (int m = 0; m < 4; ++m) _Pragma("unroll") for (int k = 0; k < 2; ++k) dst[m][k] = *(const PG8_LAS bf16x8*)(lds + PG8_SA(b, h) + aoff + m * 2048 + k * 1024); } while (0)
#define PG8_LDB(dst, b, h) do { _Pragma("unroll") for (int n = 0; n < 2; ++n) _Pragma("unroll") for (int k = 0; k < 2; ++k) dst[n][k] = *(const PG8_LAS bf16x8*)(lds + PG8_SB(b, h) + boff + n * 2048 + k * 1024); } while (0)
#define PG8_MMA(ai, bj, At, Bt) do { __builtin_amdgcn_s_setprio(1); _Pragma("unroll") for (int m = 0; m < 4; ++m) _Pragma("unroll") for (int n = 0; n < 2; ++n) _Pragma("unroll") for (int k = 0; k < 2; ++k) \
        acc[ai][bj][m][n] = __builtin_amdgcn_mfma_f32_16x16x32_bf16(Bt[n][k], At[m][k], acc[ai][bj][m][n], 0, 0, 0); __builtin_amdgcn_s_setprio(0); } while (0)
#define PG8_WAIT_V(n) asm volatile("s_waitcnt vmcnt(" #n ")" ::: "memory")
#define PG8_WAIT_L(n) asm volatile("s_waitcnt lgkmcnt(" #n ")" ::: "memory")
#define PG8_BAR __builtin_amdgcn_s_barrier()
#define PG8_SCHED __builtin_amdgcn_sched_barrier(0)
    Unit cur, nxt; int ui = 0;
    if (!S.next(0, cur)) return;
    f32x4 acc[2][2][4][2];
#pragma unroll
    for (int a = 0; a < 2; ++a)
#pragma unroll
        for (int b = 0; b < 2; ++b)
#pragma unroll
            for (int m = 0; m < 4; ++m)
#pragma unroll
                for (int n = 0; n < 2; ++n) acc[a][b][m][n] = (f32x4){0.f, 0.f, 0.f, 0.f};
    bf16x8 At[4][2], B0[2][2], B1[2][2];
    const char* cA = (const char*)g.A + (size_t)cur.pm * tstep + (size_t)cur.koff * 2; const char* cB = (const char*)g.Bt + (size_t)cur.pn * tstep + (size_t)cur.koff * 2;
    S.a_ready(cur);
    PG8_STAGE(PG8_SB(0, 0), cB, voffB); PG8_STAGE(PG8_SB(0, 1), cB + hstep, voffB); PG8_STAGE(PG8_SA(0, 0), cA, voffA); PG8_STAGE(PG8_SA(0, 1), cA + hstep, voffA);
    if (wr == 1) PG8_BAR;
    PG8_WAIT_V(2); PG8_BAR;
    PG8_STAGE(PG8_SB(1, 0), cB + kstep, voffB); PG8_STAGE(PG8_SA(1, 0), cA + kstep, voffA); PG8_STAGE(PG8_SB(1, 1), cB + hstep + kstep, voffB);
    PG8_WAIT_V(6); PG8_BAR;
    PG8_STAMP();
    for (;;) {
        const bool has_next = S.next(ui + 1, nxt);
        const char* nA = has_next ? (const char*)g.A + (size_t)nxt.pm * tstep + (size_t)nxt.koff * 2 : cA; const char* nB = has_next ? (const char*)g.Bt + (size_t)nxt.pn * tstep + (size_t)nxt.koff * 2 : cB;
        for (int t = 0; t < nt; t += 2) {
            const bool last = (t == nt - 2);
            const char* a1 = cA + (size_t)(t + 1) * kstep;
            const char* a2 = last ? nA : cA + (size_t)(t + 2) * kstep; const char* b2 = last ? nB : cB + (size_t)(t + 2) * kstep;
            const char* a3 = a2 + kstep; const char* b3 = b2 + kstep;
            if (last && has_next) S.a_ready(nxt);
            PG8_LDB(B0, 0, 0); PG8_LDB(B1, 0, 1); PG8_SCHED; PG8_LDA(At, 0, 0); PG8_STAGE(PG8_SA(1, 1), a1 + hstep, voffA);
            PG8_WAIT_V(8); PG8_WAIT_L(0); PG8_BAR; PG8_MMA(0, 0, At, B0); PG8_MMA(0, 1, At, B1); PG8_BAR; PG8_SCHED;
            PG8_LDA(At, 0, 1); PG8_STAGE(PG8_SB(0, 0), b2, voffB); PG8_STAGE(PG8_SB(0, 1), b2 + hstep, voffB); PG8_STAGE(PG8_SA(0, 0), a2, voffA);
            PG8_WAIT_V(8); PG8_WAIT_L(0); PG8_BAR; PG8_MMA(1, 0, At, B0); PG8_MMA(1, 1, At, B1); PG8_BAR; PG8_SCHED;
            PG8_LDB(B0, 1, 0); PG8_LDB(B1, 1, 1); PG8_SCHED; PG8_LDA(At, 1, 0); PG8_STAGE(PG8_SA(0, 1), a2 + hstep, voffA);
            PG8_WAIT_V(8); PG8_WAIT_L(0); PG8_BAR; PG8_MMA(0, 0, At, B0); PG8_MMA(0, 1, At, B1); PG8_BAR; PG8_SCHED;
            PG8_LDA(At, 1, 1); PG8_STAGE(PG8_SB(1, 0), b3, voffB); PG8_STAGE(PG8_SB(1, 1), b3 + hstep, voffB); PG8_STAGE(PG8_SA(1, 0), a3, voffA);
            PG8_WAIT_V(8); PG8_WAIT_L(0); PG8_BAR; PG8_MMA(1, 0, At, B0); PG8_MMA(1, 1, At, B1); PG8_BAR; PG8_SCHED;
        }
        PG8_STAMP();
        if (wr == 0) PG8_BAR;
        if constexpr (!Epi::AFTER_DRAIN) { E(acc, cur, wr, wc, fr, fq); S.done(cur); }
        PG8_STAMP();
        if (!has_next) break;
#pragma unroll
        for (int a = 0; a < 2; ++a)
#pragma unroll
            for (int b = 0; b < 2; ++b)
#pragma unroll
                for (int m = 0; m < 4; ++m)
#pragma unroll
                    for (int n = 0; n < 2; ++n) acc[a][b][m][n] = (f32x4){0.f, 0.f, 0.f, 0.f};
        cur = nxt; cA = nA; cB = nB; ++ui;
        if (wr == 1) PG8_BAR;
    }
    PG8_WAIT_V(0);
    PG8_BAR;
    if constexpr (Epi::AFTER_DRAIN) { E.fused(acc, cur, wr, wc, fr, fq, lds, wid, lane); S.done(cur); }
    PG8_STAMP();
    if (STAMP && wid == 0) { stamps[lane] = lane < nts ? (((unsigned long long)(unsigned)ts_hi << 32) | (unsigned)ts_lo) : 0ull;
        if (lane == 62) stamps[62] = rt_entry; if (lane == 63) stamps[63] = (unsigned long long)wall_clock64(); }
#undef PG8_STAMP
#undef PG8_SA
#undef PG8_SB
#undef PG8_STAGE
#undef PG8_LDA
#undef PG8_LDB
#undef PG8_MMA
#undef PG8_WAIT_V
#undef PG8_WAIT_L
#undef PG8_BAR
#undef PG8_SCHED
}
}
#define LAS __attribute__((address_space(3)))
#define XB_TMO      128
#define XB_XCNT(j)  (256  + 64 * (j))
#define XB_XSUB(j)  (1280 + 64 * (j))
#define XB_XGEN(j)  (2304 + 64 * (j))
#define XB_TOP      3328
#define XB_TOPGEN   3392
#define XCD_BAR_WORDS 3456
#define XB_SPIN_CAP (1u << 18)

__device__ __forceinline__ unsigned xb_ld(unsigned* p)              { return __hip_atomic_load(p, __ATOMIC_RELAXED, __HIP_MEMORY_SCOPE_AGENT); }
__device__ __forceinline__ unsigned xb_add(unsigned* p, unsigned v) { return __hip_atomic_fetch_add(p, v, __ATOMIC_RELAXED, __HIP_MEMORY_SCOPE_AGENT); }
__device__ __forceinline__ unsigned xb_xcc_id() { return (unsigned)__builtin_amdgcn_s_getreg((3 << 11) | 20) & 0xFu; }
#define XB_SPIN(cond, bar) do { unsigned _sp = 0; while (cond) { __builtin_amdgcn_s_sleep(1); \
    if ((++_sp & 255u) == 0u) { if (xb_ld(&(bar)[XB_TMO])) break; if (_sp > XB_SPIN_CAP) { atomicAdd(&(bar)[XB_TMO], 1u); break; } } } } while (0)

struct XcdBarrier {
    unsigned* bar; unsigned x;
    volatile LAS unsigned* st;
};

__device__ __forceinline__ XcdBarrier xcd_barrier_post(unsigned* bar, volatile LAS unsigned* st) {
    XcdBarrier b; b.bar = bar; b.x = xb_xcc_id(); b.st = st;
    if (threadIdx.x == 0) (void)xb_add(&bar[XB_XCNT(b.x)], 1u);
    return b;
}
__device__ __forceinline__ void xcd_barrier_complete(unsigned* bar, unsigned x, unsigned& nloc, unsigned& nx) {
    const unsigned G = gridDim.x * gridDim.y * gridDim.z;
    unsigned sum, cnt, mine, sp = 0u;
    for (;;) {
        sum = 0u; cnt = 0u; mine = 0u;
#pragma unroll
        for (unsigned j = 0; j < 16; ++j) { const unsigned c = xb_ld(&bar[XB_XCNT(j)]); sum += c; cnt += (c > 0u) ? 1u : 0u; mine = (j == x) ? c : mine; }
        if (sum == G) break;
        __builtin_amdgcn_s_sleep(1);
        if ((++sp & 255u) == 0u) { if (xb_ld(&bar[XB_TMO])) break; if (sp > XB_SPIN_CAP) { atomicAdd(&bar[XB_TMO], 1u); break; } }
    }
    nloc = mine > 0u ? mine : 1u; nx = cnt > 0u ? cnt : 1u;
}

__device__ __forceinline__ void xcd_barrier(const XcdBarrier& b) {
    asm volatile("s_waitcnt vmcnt(0)" ::: "memory");
    __syncthreads();
    if (threadIdx.x == 0) {
        unsigned* bar = b.bar;
        __builtin_amdgcn_s_waitcnt(0);
        unsigned nloc = b.st[0], nx = b.st[1];
        if (nloc == 0u) { xcd_barrier_complete(bar, b.x, nloc, nx); b.st[0] = nloc; b.st[1] = nx; }
        const unsigned old = xb_add(&bar[XB_XSUB(b.x)], 1u);
        const unsigned gen = old / nloc;
        if (old + 1u == (gen + 1u) * nloc) {
            __builtin_amdgcn_fence(__ATOMIC_RELEASE, "agent");
            asm volatile("s_waitcnt vmcnt(0)" ::: "memory");
            const unsigned og = xb_add(&bar[XB_TOP], 1u);
            const unsigned tg = og / nx;
            if (og + 1u == (tg + 1u) * nx) xb_add(&bar[XB_TOPGEN], 1u);
            else XB_SPIN(xb_ld(&bar[XB_TOPGEN]) == tg, bar);
            __builtin_amdgcn_fence(__ATOMIC_ACQUIRE, "agent");
            xb_add(&bar[XB_XGEN(b.x)], 1u);
            asm volatile("s_waitcnt vmcnt(0)" ::: "memory");
        } else {
            XB_SPIN(xb_ld(&bar[XB_XGEN(b.x)]) == gen, bar);
            __builtin_amdgcn_fence(__ATOMIC_ACQUIRE, "agent");
            asm volatile("s_waitcnt vmcnt(0)" ::: "memory");
        }
    }
    __syncthreads();
}


using pg8::bf16_t; using pg8::bf16x8; using pg8::f32x4; using pg8::u32x4; using pg8::Unit;
typedef float f32x16 __attribute__((ext_vector_type(16)));
typedef unsigned u32x2 __attribute__((ext_vector_type(2)));
typedef float f32x2 __attribute__((ext_vector_type(2)));

constexpr int MP = 8192, MS = 1024, MT = 9216, DM = 2048, NZ = 5120, NINP = 5376, DFF = 5632, PLE = 256;
constexpr int LDS_BYTES = 131072 + 16;
constexpr size_t OFF_BAR = 0;
constexpr size_t OFF_WIN = 16384;
constexpr size_t OFF_WOUT = OFF_WIN + (size_t)NINP * DM * 2;
constexpr size_t OFF_WFI = OFF_WOUT + (size_t)DM * DM * 2;
constexpr size_t OFF_WFO = OFF_WFI + (size_t)2 * DFF * DM * 2;
constexpr size_t OFF_WPLE = OFF_WFO + (size_t)DM * DFF * 2;
constexpr size_t OFF_WGT = OFF_WPLE + (size_t)DM * PLE * 2;
constexpr size_t OFF_A0 = OFF_WGT + (size_t)DM * DM * 2;
constexpr size_t OFF_PB = OFF_A0 + (size_t)MT * DM * 2;
constexpr size_t OFF_ALOW = OFF_PB + (size_t)MT * PLE * 2;
constexpr size_t OFF_STAT = OFF_ALOW + (size_t)MT * 16 * 4;
constexpr size_t OFF_BIG = OFF_STAT + (size_t)MT * 2 * 4;
constexpr size_t OFF_Z = OFF_BIG;
constexpr size_t OFF_ORAW = OFF_Z + (size_t)MT * NZ * 2;
constexpr size_t OFF_MRAW = OFF_ORAW + (size_t)MT * 1024 * 4;
constexpr size_t OFF_IMG = OFF_BIG + (size_t)MT * DFF * 2 + (size_t)MT * DM * 4;
constexpr size_t WS_END = OFF_IMG + (size_t)4 * 1024 * 2048 * 4;
constexpr size_t OFF_ACT = OFF_BIG;
constexpr size_t OFF_GATEZ = OFF_BIG;
constexpr size_t OFF_PZ = OFF_BIG + (size_t)MT * DFF * 2;
constexpr size_t OUT_Y = 0, OUT_SP = (size_t)MT * DM, OUT_SS = OUT_SP + (size_t)4 * 4 * 128 * 256, OUT_VS = OUT_SS + (size_t)128 * 4 * 128 * 256;

struct Params {
    const float *x_prompt, *x_sample, *state_gla, *p_prompt, *p_sample, *g_mix, *w_in, *w_a2, *b_a, *g_gla_norm, *g_gmlp_ln, *b_gmlp_ln, *w_s, *b_s,
        *g_gmlp_out, *w_out, *g_ffn, *w_ffn_in, *w_ffn_out, *w_ple, *g_ple, *g_ple_gate, *w_ple_gate, *g_final;
    float* out;
    unsigned char* ws;
};

__device__ __forceinline__ unsigned pk2(float lo, float hi) { return pg8::cvt_pk_bf16(lo, hi); }
__device__ __forceinline__ bf16_t f2bf(float f) { return (bf16_t)(pk2(f, 0.f) & 0xffffu); }
__device__ __forceinline__ float bf2f(bf16_t b) { return __uint_as_float(((unsigned)b) << 16); }
__device__ __forceinline__ float bflo(unsigned w) { return __uint_as_float(w << 16); }
__device__ __forceinline__ float bfhi(unsigned w) { return __uint_as_float(w & 0xffff0000u); }
__device__ __forceinline__ f32x4 unpack4(u32x2 w) { return (f32x4){bflo(w.x), bfhi(w.x), bflo(w.y), bfhi(w.y)}; }
template <int CTRL> __device__ __forceinline__ float dpp_f(float v) { return __int_as_float(__builtin_amdgcn_update_dpp(0, __float_as_int(v), CTRL, 0xf, 0xf, true)); }
__device__ __forceinline__ float row16_sum(float v) {
    v += dpp_f<0xB1>(v); v += dpp_f<0x4E>(v); v += dpp_f<0x141>(v); v += dpp_f<0x140>(v); return v;
}
__device__ __forceinline__ float wave_sum(float v) {
    v = row16_sum(v);
    return (__int_as_float(__builtin_amdgcn_readlane(__float_as_int(v), 0)) + __int_as_float(__builtin_amdgcn_readlane(__float_as_int(v), 16))) + (__int_as_float(__builtin_amdgcn_readlane(__float_as_int(v), 32)) + __int_as_float(__builtin_amdgcn_readlane(__float_as_int(v), 48)));
}
__device__ __forceinline__ float sigmoid_f(float x) { return __builtin_amdgcn_rcpf(1.f + __expf(-x)); }
__device__ __forceinline__ float silu_f(float x) { return x * __builtin_amdgcn_rcpf(1.f + __expf(-x)); }
__device__ __forceinline__ float gelu_f(float x) { const float u = 1.5957691216f * (x + 0.044715f * x * x * x); return x * __builtin_amdgcn_rcpf(1.f + __expf(-u)); }
__device__ __forceinline__ float logsigmoid_f(float x) { return fminf(x, 0.f) - __logf(1.f + __expf(-fabsf(x))); }
template <class T> __device__ __forceinline__ T* opaque(T* p) { return p; }
__device__ __forceinline__ const f32x4* row_mid(const float* row, int lane) { return opaque((const f32x4*)row + lane + 256); }
__device__ __forceinline__ f32x4* row_mid(float* row, int lane) { return opaque((f32x4*)row + lane + 256); }
__device__ __forceinline__ int otid() { int t = threadIdx.x; asm volatile("" : "+v"(t)); return t; }
template <class T> __device__ __forceinline__ T ldnt(const T* p) { return __builtin_nontemporal_load(p); }
template <class T> __device__ __forceinline__ void stnt(T* p, T v) { __builtin_nontemporal_store(v, p); }
__device__ __forceinline__ void lds_wait() { asm volatile("s_waitcnt lgkmcnt(0)" ::: "memory"); }

struct EpiIn {
    static constexpr bool PERM = true, AFTER_DRAIN = false;
    bf16_t* Z; float* alow;
    __device__ __forceinline__ void operator()(const f32x4 (&acc)[2][2][4][2], const Unit& u, int wr, int wc, int fr, int fq) const {
        const int row0 = u.pm * 256 + wr * 64 + fr, pn = u.pn;
        if (pn == 20) {
            if (wc == 0 && fq < 2) {
#pragma unroll
                for (int ai = 0; ai < 2; ++ai)
#pragma unroll
                    for (int m = 0; m < 4; ++m) { float* p = alow + (size_t)(row0 + ai * 128 + m * 16) * 16 + 8 * fq; *(f32x4*)p = acc[ai][0][m][0]; *(f32x4*)(p + 4) = acc[ai][0][m][1]; }
            }
            return;
        }
        const int kind = pn < 8 ? 0 : (pn < 12 ? 1 : 2); const float qs = pn < 2 ? 0.08838834764831845f : 1.f;
#pragma unroll
        for (int ai = 0; ai < 2; ++ai)
#pragma unroll
            for (int m = 0; m < 4; ++m) { bf16_t* rowp = Z + (size_t)(row0 + ai * 128 + m * 16) * NZ + pn * 256 + wc * 32 + 8 * fq;
#pragma unroll
                for (int bj = 0; bj < 2; ++bj) { f32x4 v0 = acc[ai][bj][m][0], v1 = acc[ai][bj][m][1];
                    if (kind == 0) { v0 *= qs; v1 *= qs; }
                    else if (kind == 1) {
#pragma unroll
                        for (int j = 0; j < 4; ++j) { v0[j] = silu_f(v0[j]); v1[j] = silu_f(v1[j]); } }
                    else {
#pragma unroll
                        for (int j = 0; j < 4; ++j) { v0[j] = gelu_f(v0[j]); v1[j] = gelu_f(v1[j]); } }
                    u32x4 w; w.x = pk2(v0[0], v0[1]); w.y = pk2(v0[2], v0[3]); w.z = pk2(v1[0], v1[1]); w.w = pk2(v1[2], v1[3]);
                    *(u32x4*)(rowp + bj * 128) = w; } }
    }
};
struct EpiRes {
    static constexpr bool PERM = false, AFTER_DRAIN = false;
    const float* res_p; const float* res_s; float* out;
    __device__ __forceinline__ void operator()(const f32x4 (&acc)[2][2][4][2], const Unit& u, int wr, int wc, int fr, int fq) const {
        const int row0 = u.pm * 256 + wr * 64 + fr, col0 = u.pn * 256 + wc * 32 + 4 * fq;
#pragma unroll
        for (int ai = 0; ai < 2; ++ai)
#pragma unroll
            for (int m = 0; m < 4; ++m) { const int row = row0 + ai * 128 + m * 16;
                const float* rp = (row < MP ? res_p + (size_t)row * DM : res_s + (size_t)(row - MP) * DM) + col0; float* op = out + (size_t)row * DM + col0;
#pragma unroll
                for (int bj = 0; bj < 2; ++bj)
#pragma unroll
                    for (int n = 0; n < 2; ++n) { const f32x4 r = *(const f32x4*)(rp + bj * 128 + n * 16); *(f32x4*)(op + bj * 128 + n * 16) = acc[ai][bj][m][n] + r; } }
    }
};
struct EpiSwiglu {
    static constexpr bool PERM = true, AFTER_DRAIN = false;
    bf16_t* act;
    __device__ __forceinline__ void operator()(const f32x4 (&acc)[2][2][4][2], const Unit& u, int wr, int wc, int fr, int fq) const {
        const int row0 = u.pm * 256 + wr * 64 + fr, col0 = u.pn * 128 + wc * 32 + 8 * fq;
#pragma unroll
        for (int ai = 0; ai < 2; ++ai)
#pragma unroll
            for (int m = 0; m < 4; ++m) { float a[8];
#pragma unroll
                for (int n = 0; n < 2; ++n)
#pragma unroll
                    for (int j = 0; j < 4; ++j) a[n * 4 + j] = silu_f(acc[ai][0][m][n][j]) * acc[ai][1][m][n][j];
                u32x4 w; w.x = pk2(a[0], a[1]); w.y = pk2(a[2], a[3]); w.z = pk2(a[4], a[5]); w.w = pk2(a[6], a[7]);
                *(u32x4*)(act + (size_t)(row0 + ai * 128 + m * 16) * DFF + col0) = w; }
    }
};
struct EpiBfN {
    static constexpr bool PERM = true, AFTER_DRAIN = false;
    bf16_t* out;
    __device__ __forceinline__ void operator()(const f32x4 (&acc)[2][2][4][2], const Unit& u, int wr, int wc, int fr, int fq) const {
        const int row0 = u.pm * 256 + wr * 64 + fr, col0 = u.pn * 256 + wc * 32 + 8 * fq;
#pragma unroll
        for (int ai = 0; ai < 2; ++ai)
#pragma unroll
            for (int m = 0; m < 4; ++m) { bf16_t* op = out + (size_t)(row0 + ai * 128 + m * 16) * DM + col0;
#pragma unroll
                for (int bj = 0; bj < 2; ++bj) { const f32x4 v0 = acc[ai][bj][m][0], v1 = acc[ai][bj][m][1];
                    u32x4 w; w.x = pk2(v0[0], v0[1]); w.y = pk2(v0[2], v0[3]); w.z = pk2(v1[0], v1[1]); w.w = pk2(v1[2], v1[3]); *(u32x4*)(op + bj * 128) = w; } }
    }
};
struct EpiPlain {
    static constexpr bool PERM = false, AFTER_DRAIN = false;
    float* out;
    __device__ __forceinline__ void operator()(const f32x4 (&acc)[2][2][4][2], const Unit& u, int wr, int wc, int fr, int fq) const {
        const int row0 = u.pm * 256 + wr * 64 + fr, col0 = u.pn * 256 + wc * 32 + 4 * fq;
#pragma unroll
        for (int ai = 0; ai < 2; ++ai)
#pragma unroll
            for (int m = 0; m < 4; ++m) { float* op = out + (size_t)(row0 + ai * 128 + m * 16) * DM + col0;
#pragma unroll
                for (int bj = 0; bj < 2; ++bj)
#pragma unroll
                    for (int n = 0; n < 2; ++n) *(f32x4*)(op + bj * 128 + n * 16) = acc[ai][bj][m][n]; }
    }
};

template <class Epi> __device__ __forceinline__ void run_gemm(LAS unsigned char* lds, const bf16_t* A, const bf16_t* Bt, int M, int N, int K, const Epi& E) {
    pg8::Gemm g; g.A = A; g.Bt = Bt; g.M = M; g.N = N; g.K = K; g.Klen = K;
    pg8::StaticOrder S; S.init(M, N, (int)gridDim.x, (int)blockIdx.x);
    pg8::gemm_phase<Epi, pg8::StaticOrder, false>(lds, g, S, E, nullptr);
}
struct SplitOrderK {
    int nN, G, c, klen, ns, kbase, ksoff;
    __device__ __forceinline__ bool next(int i, Unit& u) const { const int L = i * G + c; if (L >= 4 * ns * nN) return false;
        const int sp = L % ns, tile = L / ns; u.ks = ksoff + sp; u.pn = tile % nN; u.pm = 32 + tile / nN; u.koff = kbase + sp * klen; return true; }
    __device__ __forceinline__ void a_ready(const Unit&) const {}
    __device__ __forceinline__ void done(const Unit&) const {}
};
struct EpiPart {
    static constexpr bool PERM = true, AFTER_DRAIN = false;
    bf16_t* part;
    __device__ __forceinline__ void operator()(const f32x4 (&acc)[2][2][4][2], const Unit& u, int wr, int wc, int fr, int fq) const {
        const int row0 = (u.pm - 32) * 256 + wr * 64 + fr, col0 = u.pn * 256 + wc * 32 + 8 * fq; bf16_t* pb = part + (size_t)u.ks * MS * DM;
#pragma unroll
        for (int ai = 0; ai < 2; ++ai)
#pragma unroll
            for (int m = 0; m < 4; ++m) { bf16_t* op = pb + (size_t)(row0 + ai * 128 + m * 16) * DM + col0;
#pragma unroll
                for (int bj = 0; bj < 2; ++bj) { const f32x4 v0 = acc[ai][bj][m][0], v1 = acc[ai][bj][m][1];
                    u32x4 w; w.x = pk2(v0[0], v0[1]); w.y = pk2(v0[2], v0[3]); w.z = pk2(v1[0], v1[1]); w.w = pk2(v1[2], v1[3]); *(u32x4*)(op + bj * 128) = w; } }
    }
};
__device__ __forceinline__ void run_split(LAS unsigned char* lds, const bf16_t* A, const bf16_t* Bt, int K, bf16_t* part, int ns, int klen, int kbase, int ksoff, int c) {
    pg8::Gemm g; g.A = A; g.Bt = Bt; g.M = MT; g.N = DM; g.K = K; g.Klen = klen;
    SplitOrderK S; S.nN = DM / 256; S.G = (int)gridDim.x; S.c = c; S.klen = klen; S.ns = ns; S.kbase = kbase; S.ksoff = ksoff;
    EpiPart P; P.part = part;
    pg8::gemm_phase<EpiPart, SplitOrderK, false>(lds, g, S, P, nullptr);
}
template <class Epi> __device__ __forceinline__ void run_gemm_n2048(LAS unsigned char* lds, const bf16_t* A, const bf16_t* Bt, int K, const Epi& E, bf16_t* part) {
    run_gemm(lds, A, Bt, MP, DM, K, E);
    run_split(lds, A, Bt, K, part, 8, K / 8, 0, 0, (int)blockIdx.x);
}

__device__ __forceinline__ void transpose_item(const float* W, int N, bf16_t* WT, int K, int k0, int n0_dst, int n0_src, int nvalid, LAS float* scr, int lane) {
    if (nvalid == 32) {
        const int c4 = (lane & 7) * 4, kr = lane >> 3; f32x4 v[8];
#pragma unroll
        for (int i = 0; i < 8; ++i) v[i] = ldnt((const f32x4*)(W + (size_t)(k0 + 8 * i + kr) * N + n0_src + c4));
#pragma unroll
        for (int i = 0; i < 8; ++i) { LAS float* d = scr + (8 * i + kr) * 33 + c4; d[0] = v[i][0]; d[1] = v[i][1]; d[2] = v[i][2]; d[3] = v[i][3]; }
    } else {
        const int j = lane & 31;
#pragma unroll 8
        for (int i = 0; i < 32; ++i) { const int kk = 2 * i + (lane >> 5); scr[kk * 33 + j] = (j < nvalid) ? ldnt(W + (size_t)(k0 + kk) * N + n0_src + j) : 0.f; }
    }
    lds_wait();
    const int c = lane & 7;
#pragma unroll
    for (int q = 0; q < 4; ++q) { const int n = (lane >> 3) + 8 * q; const LAS float* s = scr + (8 * c) * 33 + n;
        u32x4 o; o.x = pk2(s[0 * 33], s[1 * 33]); o.y = pk2(s[2 * 33], s[3 * 33]); o.z = pk2(s[4 * 33], s[5 * 33]); o.w = pk2(s[6 * 33], s[7 * 33]);
        *(u32x4*)(WT + (size_t)(n0_dst + n) * K + k0 + 8 * c) = o; }
    lds_wait();
}
struct Row8 { f32x4 v[8]; };
__device__ __forceinline__ void row_load_nt(Row8& a, const float* src, int lane) { const f32x4* sm = row_mid(src, lane);
#pragma unroll
    for (int j = 0; j < 8; ++j) a.v[j] = ldnt(sm + 64 * (j - 4)); }
__device__ __forceinline__ void row_load(Row8& a, const float* src, int lane) { const f32x4* sm = row_mid(src, lane);
#pragma unroll
    for (int j = 0; j < 8; ++j) a.v[j] = sm[64 * (j - 4)]; }
__device__ __forceinline__ void rms_finish_bf16(const Row8& a, const float* gain, bf16_t* dst, int lane) {
    float s = 0.f;
#pragma unroll
    for (int j = 0; j < 8; ++j) s += (a.v[j][0] * a.v[j][0] + a.v[j][1] * a.v[j][1]) + (a.v[j][2] * a.v[j][2] + a.v[j][3] * a.v[j][3]);
    const float rinv = rsqrtf(wave_sum(s) * (1.f / DM) + 1e-6f);
    const f32x4* gm = row_mid(gain, lane); u32x2* dm = (u32x2*)dst + lane;
#pragma unroll
    for (int j = 0; j < 8; ++j) { const f32x4 g = gm[64 * (j - 4)]; u32x2 o; o.x = pk2(a.v[j][0] * rinv * g[0], a.v[j][1] * rinv * g[1]); o.y = pk2(a.v[j][2] * rinv * g[2], a.v[j][3] * rinv * g[3]);
        dm[64 * j] = o; }
}
__device__ __forceinline__ void rms_row_bf16(const float* src, const float* gain, bf16_t* dst, int lane) { Row8 a; row_load(a, src, lane); rms_finish_bf16(a, gain, dst, lane); }
namespace cv { constexpr int I_IN = (DM / 64) * (NINP / 32), I_OUT = (DM / 64) * (DM / 32), I_FI = (DM / 64) * (2 * DFF / 32), I_FO = (DFF / 64) * (DM / 32), I_PLE = (PLE / 64) * (DM / 32), I_GT = I_OUT;
    constexpr int E_IN = I_IN, E_OUT = E_IN + I_OUT, E_FI = E_OUT + I_FI, E_FO = E_FI + I_FO, E_PLE = E_FO + I_PLE, E_GT = E_PLE + I_GT; }
__device__ __forceinline__ void convert_range(const Params& p, LAS unsigned char* lds, int lo, int hi, int gw, int NGW) {
    const int tid = otid(), lane = tid & 63, wave = tid >> 6;
    LAS float* scr = (LAS float*)(lds + wave * 8448);
    bf16_t* win = (bf16_t*)(p.ws + OFF_WIN); bf16_t* wout = (bf16_t*)(p.ws + OFF_WOUT); bf16_t* wfi = (bf16_t*)(p.ws + OFF_WFI);
    bf16_t* wfo = (bf16_t*)(p.ws + OFF_WFO); bf16_t* wple = (bf16_t*)(p.ws + OFF_WPLE); bf16_t* wgt = (bf16_t*)(p.ws + OFF_WGT);
    for (int it = lo + gw; it < hi; it += NGW) {
        int r = it;
        if (r < cv::E_IN) { const int nblk = NINP / 32, kb = r / nblk, nb = r % nblk, n0d = nb * 32; int src, nv;
            if (n0d < 3072) { src = n0d; nv = 32; } else if (n0d < 5120) { src = n0d + 16; nv = 32; } else if (n0d == 5120) { src = 3072; nv = 16; } else { src = 0; nv = 0; }
            transpose_item(p.w_in, 5136, win, DM, kb * 64, n0d, src, nv, scr, lane); continue; }
        if (r < cv::E_OUT) { r -= cv::E_IN; const int nblk = DM / 32, kb = r / nblk, nb = r % nblk; transpose_item(p.w_out, DM, wout, DM, kb * 64, nb * 32, nb * 32, 32, scr, lane); continue; }
        if (r < cv::E_FI) { r -= cv::E_OUT; const int nblk = 2 * DFF / 32, kb = r / nblk, nb = r % nblk, n0d = nb * 32, jb = n0d >> 8, within = n0d & 255, up = within >> 7, j0 = jb * 128 + (within & 127);
            transpose_item(p.w_ffn_in, 2 * DFF, wfi, DM, kb * 64, n0d, up * DFF + j0, 32, scr, lane); continue; }
        if (r < cv::E_FO) { r -= cv::E_FI; const int nblk = DM / 32, kb = r / nblk, nb = r % nblk; transpose_item(p.w_ffn_out, DM, wfo, DFF, kb * 64, nb * 32, nb * 32, 32, scr, lane); continue; }
        if (r < cv::E_PLE) { r -= cv::E_FO; const int nblk = DM / 32, kb = r / nblk, nb = r % nblk; transpose_item(p.w_ple, DM, wple, PLE, kb * 64, nb * 32, nb * 32, 32, scr, lane); continue; }
        { r -= cv::E_PLE; const int nblk = DM / 32, kb = r / nblk, nb = r % nblk; transpose_item(p.w_ple_gate, DM, wgt, DM, kb * 64, nb * 32, nb * 32, 32, scr, lane); }
    }
}
__device__ __forceinline__ void phase0(const Params& p, LAS unsigned char* lds) {
    const int tid = otid(), lane = tid & 63, wave = tid >> 6;
    const int gw = blockIdx.x * 8 + wave, NGW = gridDim.x * 8;
    convert_range(p, lds, 0, cv::E_IN, gw, NGW);
    bf16_t* a0 = (bf16_t*)(p.ws + OFF_A0); bf16_t* pb = (bf16_t*)(p.ws + OFF_PB);
    for (int r = gw; r < MT; r += 2 * NGW) {
        const int r2 = r + NGW; const bool has2 = r2 < MT; const int q2 = has2 ? r2 : r;
        const float* x1 = r < MP ? p.x_prompt + (size_t)r * DM : p.x_sample + (size_t)(r - MP) * DM; const float* x2 = q2 < MP ? p.x_prompt + (size_t)q2 * DM : p.x_sample + (size_t)(q2 - MP) * DM;
        const float* p1 = r < MP ? p.p_prompt + (size_t)r * PLE : p.p_sample + (size_t)(r - MP) * PLE; const float* p2 = q2 < MP ? p.p_prompt + (size_t)q2 * PLE : p.p_sample + (size_t)(q2 - MP) * PLE;
        Row8 a, b; row_load_nt(a, x1, lane); row_load_nt(b, x2, lane);
        const f32x4 pv1 = ldnt((const f32x4*)p1 + lane), pv2 = ldnt((const f32x4*)p2 + lane);
        rms_finish_bf16(a, p.g_mix, a0 + (size_t)r * DM, lane);
        { u32x2 o; o.x = pk2(pv1[0], pv1[1]); o.y = pk2(pv1[2], pv1[3]); ((u32x2*)(pb + (size_t)r * PLE))[lane] = o; }
        if (has2) { rms_finish_bf16(b, p.g_mix, a0 + (size_t)r2 * DM, lane);
            u32x2 o; o.x = pk2(pv2[0], pv2[1]); o.y = pk2(pv2[2], pv2[3]); ((u32x2*)(pb + (size_t)r2 * PLE))[lane] = o; }
    }
}

__device__ __forceinline__ f32x16 mfma32(bf16x8 a, bf16x8 b, f32x16 c) { return __builtin_amdgcn_mfma_f32_32x32x16_bf16(a, b, c, 0, 0, 0); }
__device__ __forceinline__ void mma32(f32x16& acc, const LAS bf16_t* A, int lda, const LAS bf16_t* B, int ldb, int kk, int lane) {
    const int r = lane & 31, h = lane >> 5; const LAS bf16_t* ap = A + r * lda + 8 * h; const LAS bf16_t* bp = B + r * ldb + 8 * h;
    for (int k = 0; k < kk; k += 16) { const bf16x8 a = *(const LAS bf16x8*)(ap + k); const bf16x8 b = *(const LAS bf16x8*)(bp + k); acc = mfma32(a, b, acc); }
}
constexpr int LQ = 136, LS = 72;
constexpr int R_QE = 0, R_KLT = 17408, R_ATT = 35840, R_DEC = 45056, IMG_BYTES = 45568, R_VT = 45568, R_QM = 82432, R_KM = 99840, R_ALOW = 117248, R_GSUM = 121344, R_BMID = 123392;
constexpr int IMG_V4 = IMG_BYTES / 16;

__device__ __forceinline__ void gla_prep(const Params& p, LAS unsigned char* lds, int rb, int h, int T) {
    const int tid = otid(), lane = tid & 63, wave = tid >> 6;
    const bf16_t* Z = (const bf16_t*)(p.ws + OFF_Z); const float* alowg = (const float*)(p.ws + OFF_ALOW);
    LAS bf16_t* Qe = (LAS bf16_t*)(lds + R_QE); LAS bf16_t* Qm = (LAS bf16_t*)(lds + R_QM); LAS bf16_t* Km = (LAS bf16_t*)(lds + R_KM);
    LAS bf16_t* KlT = (LAS bf16_t*)(lds + R_KLT); LAS bf16_t* ATT = (LAS bf16_t*)(lds + R_ATT); LAS float* DEC = (LAS float*)(lds + R_DEC);
    LAS float* alowL = (LAS float*)(lds + R_ALOW); LAS float* gsum = (LAS float*)(lds + R_GSUM); LAS float* bmidL = (LAS float*)(lds + R_BMID);
    const int c = tid & 127, tg = tid >> 7;
    float wa[16];
#pragma unroll
    for (int j = 0; j < 16; ++j) wa[j] = p.w_a2[j * 512 + h * 128 + c];
    const float ba = p.b_a[h * 128 + c];
    for (int idx = tid; idx < 1024; idx += 512) { const int t = idx >> 4; alowL[idx] = (t < T) ? alowg[(size_t)(rb + t) * 16 + (idx & 15)] : 0.f; }
    { const int row = tid >> 3, cs = (tid & 7) * 16; const bool ok = row < T; const bf16_t* zr = Z + (size_t)(rb + row) * NZ + h * 128 + cs; const u32x4 z4 = (u32x4){0u, 0u, 0u, 0u};
        const u32x4 q0 = ok ? *(const u32x4*)zr : z4, q1 = ok ? *(const u32x4*)(zr + 8) : z4, k0 = ok ? *(const u32x4*)(zr + 512) : z4, k1 = ok ? *(const u32x4*)(zr + 520) : z4;
        *(LAS u32x4*)(Qm + row * LQ + cs) = q0; *(LAS u32x4*)(Qm + row * LQ + cs + 8) = q1; *(LAS u32x4*)(Km + row * LQ + cs) = k0; *(LAS u32x4*)(Km + row * LQ + cs + 8) = k1; }
    __syncthreads();
    float qv[16], kv[16];
#pragma unroll
    for (int i = 0; i < 16; ++i) { const int t = tg * 16 + i; qv[i] = bf2f(Qm[t * LQ + c]); kv[i] = bf2f(Km[t * LQ + c]); }
    float b[16]; float run = 0.f;
#pragma unroll
    for (int i = 0; i < 16; ++i) { const int t = tg * 16 + i; float pre = ba;
#pragma unroll
        for (int j4 = 0; j4 < 4; ++j4) { const f32x4 a4 = *(const LAS f32x4*)(alowL + t * 16 + j4 * 4); pre += a4[0] * wa[j4 * 4] + a4[1] * wa[j4 * 4 + 1] + a4[2] * wa[j4 * 4 + 2] + a4[3] * wa[j4 * 4 + 3]; }
        const float la = (t < T) ? logsigmoid_f(pre) * 0.0625f : 0.f; run += la; b[i] = run; }
    gsum[tg * 128 + c] = run;
    __syncthreads();
    const float g0 = gsum[c], g1 = gsum[128 + c], g2 = gsum[256 + c], g3 = gsum[384 + c];
    const float pref = tg == 0 ? 0.f : (tg == 1 ? g0 : (tg == 2 ? g0 + g1 : g0 + g1 + g2));
    const float blast = ((g0 + g1) + g2) + g3;
#pragma unroll
    for (int i = 0; i < 16; ++i) b[i] += pref;
    if (tg == 2) bmidL[c] = b[0];
    if (tg == 0) DEC[c] = __expf(blast);
    __syncthreads();
    const float bm = bmidL[c];
    {
        unsigned klp[8];
#pragma unroll
        for (int i = 0; i < 16; i += 2) {
            const int t = tg * 16 + i;
            Qe[t * LQ + c] = f2bf(qv[i] * __expf(b[i])); Qe[(t + 1) * LQ + c] = f2bf(qv[i + 1] * __expf(b[i + 1]));
            Qm[t * LQ + c] = f2bf(qv[i] * __expf(b[i] - bm)); Qm[(t + 1) * LQ + c] = f2bf(qv[i + 1] * __expf(b[i + 1] - bm));
            Km[t * LQ + c] = f2bf(kv[i] * __expf(bm - b[i])); Km[(t + 1) * LQ + c] = f2bf(kv[i + 1] * __expf(bm - b[i + 1]));
            klp[i >> 1] = pk2(kv[i] * __expf(blast - b[i]), kv[i + 1] * __expf(blast - b[i + 1]));
        }
        LAS u32x4* kd = (LAS u32x4*)(KlT + c * LS + tg * 16);
        kd[0] = (u32x4){klp[0], klp[1], klp[2], klp[3]}; kd[1] = (u32x4){klp[4], klp[5], klp[6], klp[7]};
    }
    __syncthreads();
    if (wave < 3) {
        const int si = wave >> 1, ti = wave == 0 ? 0 : 1, l31 = lane & 31, hh = lane >> 5;
        f32x16 o;
#pragma unroll
        for (int i = 0; i < 16; ++i) o[i] = 0.f;
        mma32(o, Km + si * 32 * LQ, LQ, Qm + ti * 32 * LQ, LQ, 128, lane);
        const int tl = ti * 32 + l31;
#pragma unroll
        for (int g = 0; g < 4; ++g) { const int s0 = si * 32 + 8 * g + 4 * hh; float a0 = o[4 * g], a1 = o[4 * g + 1], a2 = o[4 * g + 2], a3 = o[4 * g + 3];
            a0 = (s0 <= tl) ? a0 : 0.f; a1 = (s0 + 1 <= tl) ? a1 : 0.f; a2 = (s0 + 2 <= tl) ? a2 : 0.f; a3 = (s0 + 3 <= tl) ? a3 : 0.f;
            u32x2 w; w.x = pk2(a0, a1); w.y = pk2(a2, a3); *(LAS u32x2*)(ATT + tl * LS + s0) = w; }
    }
    __syncthreads();
}
struct VRegs { u32x4 r[4]; };
__device__ __forceinline__ void v_load(const Params& p, VRegs& v, int rb, int h, int T) {
    const int tid = otid(), s = tid & 63, vg = tid >> 6; const bf16_t* Z = (const bf16_t*)(p.ws + OFF_Z);
#pragma unroll
    for (int k = 0; k < 4; ++k) v.r[k] = (s < T) ? *(const u32x4*)(Z + (size_t)(rb + s) * NZ + 1024 + h * 256 + vg * 32 + 8 * k) : (u32x4){0u, 0u, 0u, 0u};
}
__device__ __forceinline__ void v_store_t(LAS unsigned char* lds, const VRegs& v) {
    const int tid = otid(), s = tid & 63, vg = tid >> 6; LAS bf16_t* VT = (LAS bf16_t*)(lds + R_VT) + (vg * 32) * LS + s;
#pragma unroll
    for (int k = 0; k < 4; ++k) {
        VT[(8 * k + 0) * LS] = (bf16_t)(v.r[k].x & 0xffffu); VT[(8 * k + 1) * LS] = (bf16_t)(v.r[k].x >> 16);
        VT[(8 * k + 2) * LS] = (bf16_t)(v.r[k].y & 0xffffu); VT[(8 * k + 3) * LS] = (bf16_t)(v.r[k].y >> 16);
        VT[(8 * k + 4) * LS] = (bf16_t)(v.r[k].z & 0xffffu); VT[(8 * k + 5) * LS] = (bf16_t)(v.r[k].z >> 16);
        VT[(8 * k + 6) * LS] = (bf16_t)(v.r[k].w & 0xffffu); VT[(8 * k + 7) * LS] = (bf16_t)(v.r[k].w >> 16); }
}
__device__ __forceinline__ void gla_step(const Params& p, LAS unsigned char* lds, f32x16 (&S)[4], int rb, int h, int T, int vb, int vtrow) {
    const int lane = otid() & 63, l31 = lane & 31, hh = lane >> 5;
    LAS bf16_t* Qe = (LAS bf16_t*)(lds + R_QE); LAS bf16_t* KlT = (LAS bf16_t*)(lds + R_KLT); LAS bf16_t* ATT = (LAS bf16_t*)(lds + R_ATT); LAS float* DEC = (LAS float*)(lds + R_DEC);
    LAS bf16_t* VT = (LAS bf16_t*)(lds + R_VT);
    bf16_t* oraw = (bf16_t*)(p.ws + OFF_ORAW);
    f32x16 Za[2], Zb[2];
#pragma unroll
    for (int tt = 0; tt < 2; ++tt)
#pragma unroll
        for (int i = 0; i < 16; ++i) { Za[tt][i] = 0.f; Zb[tt][i] = 0.f; }
    bf16x8 sa[4][2];
#pragma unroll
    for (int cb = 0; cb < 4; ++cb)
#pragma unroll
        for (int s = 0; s < 2; ++s) { u32x4 aw; aw.x = pk2(S[cb][8 * s], S[cb][8 * s + 1]); aw.y = pk2(S[cb][8 * s + 2], S[cb][8 * s + 3]); aw.z = pk2(S[cb][8 * s + 4], S[cb][8 * s + 5]); aw.w = pk2(S[cb][8 * s + 6], S[cb][8 * s + 7]);
            sa[cb][s] = __builtin_bit_cast(bf16x8, aw); }
    bf16x8 vt[4];
    const LAS bf16_t* vp = VT + (vtrow + l31) * LS + 8 * hh;
#pragma unroll
    for (int ks = 0; ks < 4; ++ks) vt[ks] = *(const LAS bf16x8*)(vp + 16 * ks);
#pragma unroll
    for (int cb = 0; cb < 4; ++cb)
#pragma unroll
        for (int g = 0; g < 4; ++g) { const f32x4 d = *(const LAS f32x4*)(DEC + cb * 32 + 8 * g + 4 * hh);
            S[cb][4 * g] *= d[0]; S[cb][4 * g + 1] *= d[1]; S[cb][4 * g + 2] *= d[2]; S[cb][4 * g + 3] *= d[3]; }
#pragma unroll
    for (int ks = 0; ks < 4; ++ks)
#pragma unroll
        for (int cb = 0; cb < 4; ++cb) { const bf16x8 a = *(const LAS bf16x8*)(KlT + (32 * cb + l31) * LS + 16 * ks + 8 * hh); S[cb] = mfma32(a, vt[ks], S[cb]); }
#pragma unroll
    for (int cb = 0; cb < 4; ++cb)
#pragma unroll
        for (int s = 0; s < 2; ++s)
#pragma unroll
            for (int tt = 0; tt < 2; ++tt) { const LAS bf16_t* qp = Qe + (32 * tt + l31) * LQ + 32 * cb + 16 * s + 4 * hh;
                const u32x2 q0 = *(const LAS u32x2*)qp, q1 = *(const LAS u32x2*)(qp + 8); const u32x4 bw = (u32x4){q0.x, q0.y, q1.x, q1.y};
                Za[tt] = mfma32(sa[cb][s], __builtin_bit_cast(bf16x8, bw), Za[tt]); }
#pragma unroll
    for (int ks = 0; ks < 4; ++ks)
#pragma unroll
        for (int tt = 0; tt < 2; ++tt) if (ks < 2 * (tt + 1)) { const bf16x8 bq = *(const LAS bf16x8*)(ATT + (32 * tt + l31) * LS + 16 * ks + 8 * hh); Zb[tt] = mfma32(vt[ks], bq, Zb[tt]); }
#pragma unroll
    for (int tt = 0; tt < 2; ++tt) { const int t = 32 * tt + l31;
        if (t < T) { bf16_t* op = oraw + (size_t)(rb + t) * 1024 + h * 256 + 32 * vb + 4 * hh;
#pragma unroll
            for (int g = 0; g < 4; ++g) { u32x2 w; w.x = pk2(Za[tt][4 * g] + Zb[tt][4 * g], Za[tt][4 * g + 1] + Zb[tt][4 * g + 1]); w.y = pk2(Za[tt][4 * g + 2] + Zb[tt][4 * g + 2], Za[tt][4 * g + 3] + Zb[tt][4 * g + 3]); *(u32x2*)(op + 8 * g) = w; } } }
}
__device__ __forceinline__ size_t s_index(int cb, int i, int hh, int wave, int l31) { return (size_t)(cb * 32 + (i & 3) + 8 * (i >> 2) + 4 * hh) * 256 + 32 * wave + l31; }

__device__ __forceinline__ void gla_prep_item(const Params& p, LAS unsigned char* lds, int chain, int ch) {
    const int b = chain >> 2, h = chain & 3;
    gla_prep(p, lds, b * 2048 + ch * 64, h, 64);
    u32x4* img = (u32x4*)(p.ws + OFF_IMG + (size_t)(chain * 32 + ch) * IMG_BYTES);
    for (int i = otid(); i < IMG_V4; i += 512) img[i] = ((const LAS u32x4*)lds)[i];
    __syncthreads();
}
constexpr int SG_TAB = 0, SG_ALOW = 20480, SG_PART = 24576;
__device__ __forceinline__ void gla_sample_pair(const Params& p, LAS unsigned char* lds, int item) {
    const int tid = otid(), lane = tid & 63, wave = tid >> 6, q = wave & 3, grp = wave >> 2, chain = item * 2 + grp;
    const int b = chain >> 2, h = chain & 3, rb = MP + b * 8;
    LAS float* tab = (LAS float*)(lds + SG_TAB + wave * 2560); LAS float* alw = (LAS float*)(lds + SG_ALOW + wave * 512); LAS float* part = (LAS float*)(lds + SG_PART);
    const bf16_t* Z = (const bf16_t*)(p.ws + OFF_Z); const float* alowg = (const float*)(p.ws + OFF_ALOW); bf16_t* oraw = (bf16_t*)(p.ws + OFF_ORAW);
    alw[lane] = alowg[(size_t)rb * 16 + lane]; alw[lane + 64] = alowg[(size_t)rb * 16 + 64 + lane];
    float qe[8][2], kv[8][2]; f32x4 V[8];
#pragma unroll
    for (int t = 0; t < 8; ++t) { const bf16_t* zr = Z + (size_t)(rb + t) * NZ; const unsigned qw = *(const unsigned*)(zr + h * 128 + 2 * lane), kw = *(const unsigned*)(zr + 512 + h * 128 + 2 * lane);
        const u32x2 vw = *(const u32x2*)(zr + 1024 + h * 256 + 4 * lane);
        qe[t][0] = bflo(qw); qe[t][1] = bfhi(qw); kv[t][0] = bflo(kw); kv[t][1] = bfhi(kw); V[t] = (f32x4){bflo(vw.x), bfhi(vw.x), bflo(vw.y), bfhi(vw.y)}; }
    float bc[8][2];
    {   f32x2 wa[16];
#pragma unroll
        for (int j = 0; j < 16; ++j) wa[j] = *(const f32x2*)(p.w_a2 + j * 512 + h * 128 + 2 * lane);
        const f32x2 ba = *(const f32x2*)(p.b_a + h * 128 + 2 * lane);
        lds_wait();
        float run0 = 0.f, run1 = 0.f;
#pragma unroll
        for (int t = 0; t < 8; ++t) { float p0 = ba.x, p1 = ba.y;
#pragma unroll
            for (int j4 = 0; j4 < 4; ++j4) { const f32x4 a4 = *(const LAS f32x4*)(alw + t * 16 + 4 * j4);
#pragma unroll
                for (int k = 0; k < 4; ++k) { p0 += a4[k] * wa[4 * j4 + k].x; p1 += a4[k] * wa[4 * j4 + k].y; } }
            run0 += logsigmoid_f(p0) * 0.0625f; run1 += logsigmoid_f(p1) * 0.0625f; bc[t][0] = run0; bc[t][1] = run1; } }
    float ki[8][2];
#pragma unroll
    for (int t = 0; t < 8; ++t) { qe[t][0] *= __expf(bc[t][0]); qe[t][1] *= __expf(bc[t][1]); ki[t][0] = kv[t][0] * __expf(-bc[t][0]); ki[t][1] = kv[t][1] * __expf(-bc[t][1]); }
    lds_wait();
#pragma unroll
    for (int t = 0; t < 8; ++t)
#pragma unroll
        for (int s = 0; s <= t; ++s) { const float a = wave_sum(qe[t][0] * ki[s][0] + qe[t][1] * ki[s][1]); if (lane == 0) alw[t * (t + 1) / 2 + s] = a; }
    if ((lane >> 4) == q) { const float e0 = __expf(bc[7][0]), e1 = __expf(bc[7][1]); LAS float* r0 = tab + (2 * lane - 32 * q) * 20; LAS float* r1 = r0 + 20;
        *(LAS f32x4*)(r0) = (f32x4){qe[0][0], qe[1][0], qe[2][0], qe[3][0]}; *(LAS f32x4*)(r0 + 4) = (f32x4){qe[4][0], qe[5][0], qe[6][0], qe[7][0]};
        *(LAS f32x4*)(r1) = (f32x4){qe[0][1], qe[1][1], qe[2][1], qe[3][1]}; *(LAS f32x4*)(r1 + 4) = (f32x4){qe[4][1], qe[5][1], qe[6][1], qe[7][1]};
        *(LAS f32x4*)(r0 + 8) = (f32x4){ki[0][0] * e0, ki[1][0] * e0, ki[2][0] * e0, ki[3][0] * e0}; *(LAS f32x4*)(r0 + 12) = (f32x4){ki[4][0] * e0, ki[5][0] * e0, ki[6][0] * e0, ki[7][0] * e0};
        *(LAS f32x4*)(r1 + 8) = (f32x4){ki[0][1] * e1, ki[1][1] * e1, ki[2][1] * e1, ki[3][1] * e1}; *(LAS f32x4*)(r1 + 12) = (f32x4){ki[4][1] * e1, ki[5][1] * e1, ki[6][1] * e1, ki[7][1] * e1};
        r0[16] = e0; r1[16] = e1; }
    lds_wait();
    f32x4 o[8];
#pragma unroll
    for (int t = 0; t < 8; ++t) o[t] = (f32x4){0.f, 0.f, 0.f, 0.f};
    const f32x4* S0 = (const f32x4*)(p.state_gla + (size_t)chain * 32768 + (size_t)(32 * q) * 256) + lane; f32x4* So = (f32x4*)(p.out + OUT_SS + (size_t)chain * 32768 + (size_t)(32 * q) * 256) + lane;
#pragma unroll 1
    for (int cc = 0; cc < 32; cc += 16) { f32x4 s[16];
#pragma unroll
        for (int u = 0; u < 16; ++u) s[u] = ldnt(S0 + (cc + u) * 64);
#pragma unroll
        for (int u = 0; u < 16; ++u) { const LAS float* row = tab + (cc + u) * 20; const f32x4 qa = *(const LAS f32x4*)row, qb = *(const LAS f32x4*)(row + 4), ka = *(const LAS f32x4*)(row + 8), kb = *(const LAS f32x4*)(row + 12); const float d = row[16];
            o[0] += qa[0] * s[u]; o[1] += qa[1] * s[u]; o[2] += qa[2] * s[u]; o[3] += qa[3] * s[u]; o[4] += qb[0] * s[u]; o[5] += qb[1] * s[u]; o[6] += qb[2] * s[u]; o[7] += qb[3] * s[u];
            f32x4 sn = d * s[u]; sn += ka[0] * V[0]; sn += ka[1] * V[1]; sn += ka[2] * V[2]; sn += ka[3] * V[3]; sn += kb[0] * V[4]; sn += kb[1] * V[5]; sn += kb[2] * V[6]; sn += kb[3] * V[7];
            stnt(So + (cc + u) * 64, sn); } }
#pragma unroll
    for (int t = 0; t < 8; ++t) *(LAS f32x4*)(part + (wave * 8 + t) * 256 + 4 * lane) = o[t];
    __syncthreads();
#pragma unroll
    for (int tt = 0; tt < 2; ++tt) { const int t = 2 * q + tt; f32x4 acc = (f32x4){0.f, 0.f, 0.f, 0.f};
#pragma unroll
        for (int w = 0; w < 4; ++w) acc += *(const LAS f32x4*)(part + ((grp * 4 + w) * 8 + t) * 256 + 4 * lane);
#pragma unroll
        for (int s = 0; s < 8; ++s) { const float a = (s <= t) ? alw[t * (t + 1) / 2 + s] : 0.f; acc += a * V[s]; }
        { u32x2 w; w.x = pk2(acc[0], acc[1]); w.y = pk2(acc[2], acc[3]); *(u32x2*)(oraw + (size_t)(rb + t) * 1024 + h * 256 + 4 * lane) = w; } }
    __syncthreads();
}
struct VRegs2 { u32x4 r[2]; };
__device__ __forceinline__ void v_load_half(const Params& p, VRegs2& v, int rb, int h, int vhalf) {
    const int tid = otid(), s = tid & 63, vg = tid >> 6; const bf16_t* Z = (const bf16_t*)(p.ws + OFF_Z);
#pragma unroll
    for (int k = 0; k < 2; ++k) v.r[k] = *(const u32x4*)(Z + (size_t)(rb + s) * NZ + 1024 + h * 256 + vhalf * 128 + vg * 16 + 8 * k);
}
__device__ __forceinline__ void v_store_half_t(LAS unsigned char* lds, const VRegs2& v) {
    const int tid = otid(), s = tid & 63, vg = tid >> 6; LAS bf16_t* VT = (LAS bf16_t*)(lds + R_VT) + (vg * 16) * LS + s;
#pragma unroll
    for (int k = 0; k < 2; ++k) {
        VT[(8 * k + 0) * LS] = (bf16_t)(v.r[k].x & 0xffffu); VT[(8 * k + 1) * LS] = (bf16_t)(v.r[k].x >> 16);
        VT[(8 * k + 2) * LS] = (bf16_t)(v.r[k].y & 0xffffu); VT[(8 * k + 3) * LS] = (bf16_t)(v.r[k].y >> 16);
        VT[(8 * k + 4) * LS] = (bf16_t)(v.r[k].z & 0xffffu); VT[(8 * k + 5) * LS] = (bf16_t)(v.r[k].z >> 16);
        VT[(8 * k + 6) * LS] = (bf16_t)(v.r[k].w & 0xffffu); VT[(8 * k + 7) * LS] = (bf16_t)(v.r[k].w >> 16); }
}
constexpr int CH_BUF = 64000;
template <int NTHR> __device__ __forceinline__ void chain_stage(const Params& p, LAS unsigned char* buf, const u32x4* img, int rb, int h, int vhalf, int t) {
    const bf16_t* Z = (const bf16_t*)(p.ws + OFF_Z);
    constexpr int NI = (IMG_V4 + NTHR - 1) / NTHR, NV = 512 / NTHR;
    u32x4 im[NI], v0[NV], v1[NV];
#pragma unroll
    for (int k = 0; k < NI; ++k) { const int i = t + NTHR * k; im[k] = (i < IMG_V4) ? img[i] : (u32x4){0u, 0u, 0u, 0u}; }
#pragma unroll
    for (int k = 0; k < NV; ++k) { const int e = t + NTHR * k, s = e & 63, vg = e >> 6; const bf16_t* zp = Z + (size_t)(rb + s) * NZ + 1024 + h * 256 + vhalf * 128 + vg * 16; v0[k] = *(const u32x4*)zp; v1[k] = *(const u32x4*)(zp + 8); }
#pragma unroll
    for (int k = 0; k < NI; ++k) { const int i = t + NTHR * k; if (i < IMG_V4) ((LAS u32x4*)buf)[i] = im[k]; }
#pragma unroll
    for (int k = 0; k < NV; ++k) { const int e = t + NTHR * k, s = e & 63, vg = e >> 6; const u32x4 r0 = v0[k], r1 = v1[k];
        LAS bf16_t* VT = (LAS bf16_t*)(buf + R_VT) + (vg * 16) * LS + s;
        VT[0 * LS] = (bf16_t)(r0.x & 0xffffu); VT[1 * LS] = (bf16_t)(r0.x >> 16); VT[2 * LS] = (bf16_t)(r0.y & 0xffffu); VT[3 * LS] = (bf16_t)(r0.y >> 16);
        VT[4 * LS] = (bf16_t)(r0.z & 0xffffu); VT[5 * LS] = (bf16_t)(r0.z >> 16); VT[6 * LS] = (bf16_t)(r0.w & 0xffffu); VT[7 * LS] = (bf16_t)(r0.w >> 16);
        VT[8 * LS] = (bf16_t)(r1.x & 0xffffu); VT[9 * LS] = (bf16_t)(r1.x >> 16); VT[10 * LS] = (bf16_t)(r1.y & 0xffffu); VT[11 * LS] = (bf16_t)(r1.y >> 16);
        VT[12 * LS] = (bf16_t)(r1.z & 0xffffu); VT[13 * LS] = (bf16_t)(r1.z >> 16); VT[14 * LS] = (bf16_t)(r1.w & 0xffffu); VT[15 * LS] = (bf16_t)(r1.w >> 16); }
}
__device__ __forceinline__ void gla_chain_item(const Params& p, LAS unsigned char* lds, int chain, int vhalf) {
    const int tid = otid(), lane = tid & 63, wave = tid >> 6, l31 = lane & 31, hh = lane >> 5;
    const int b = chain >> 2, h = chain & 3, vb = vhalf * 4 + (wave & 3);
    f32x16 S[4];
#pragma unroll
    for (int cb = 0; cb < 4; ++cb)
#pragma unroll
        for (int i = 0; i < 16; ++i) S[cb][i] = 0.f;
    const u32x4* img = (const u32x4*)(p.ws + OFF_IMG + (size_t)(chain * 32) * IMG_BYTES);
    chain_stage<512>(p, lds, img, b * 2048, h, vhalf, tid);
    __syncthreads();
#pragma unroll 1
    for (int ch = 0; ch < 32; ++ch) {
        const int rb = b * 2048 + ch * 64;
        if (wave >= 4) { if (ch + 1 < 32) chain_stage<256>(p, lds + ((ch + 1) & 1) * CH_BUF, img + (size_t)(ch + 1) * IMG_V4, rb + 64, h, vhalf, tid - 256); }
        else gla_step(p, lds + (ch & 1) * CH_BUF, S, rb, h, 64, vb, 32 * wave);
        __syncthreads();
    }
    if (wave < 4) {
        float* Sout = p.out + OUT_SP + (size_t)chain * 32768;
#pragma unroll
        for (int cb = 0; cb < 4; ++cb)
#pragma unroll
            for (int i = 0; i < 16; ++i) Sout[s_index(cb, i, hh, vb, l31)] = S[cb][i];
    }
}

constexpr int M_W = 0, M_V = 34816, M_STAT = 69632;
__device__ __forceinline__ void gmlp_item(const Params& p, LAS unsigned char* lds, int rowbase, int T, int g, float* vs_out) {
    const int tid = otid(), lane = tid & 63, wave = tid >> 6;
    const bf16_t* Z = (const bf16_t*)(p.ws + OFF_Z); bf16_t* mraw = (bf16_t*)(p.ws + OFF_MRAW);
    LAS bf16_t* LW = (LAS bf16_t*)(lds + M_W); LAS bf16_t* LV = (LAS bf16_t*)(lds + M_V); LAS float* stat = (LAS float*)(lds + M_STAT);
    if (tid < 128) { const f32x2 st = (tid < T) ? *(const f32x2*)((const float*)(p.ws + OFF_STAT) + (size_t)(rowbase + tid) * 2) : (f32x2){0.f, 0.f}; stat[2 * tid] = st.x; stat[2 * tid + 1] = st.y; }
    for (int idx = tid; idx < 4096; idx += 512) { const int t = idx >> 5, s4 = (idx & 31) * 4; const f32x4 w = *(const f32x4*)(p.w_s + ((size_t)g * 128 + t) * 128 + s4);
        u32x2 o; o.x = pk2(s4 <= t ? w[0] : 0.f, s4 + 1 <= t ? w[1] : 0.f); o.y = pk2(s4 + 2 <= t ? w[2] : 0.f, s4 + 3 <= t ? w[3] : 0.f);
        *(LAS u32x2*)(LW + t * LQ + s4) = o; }
    __syncthreads();
    { const int s = tid & 127, dq = tid >> 7; const float mean = stat[2 * s], rstd = stat[2 * s + 1];
#pragma unroll
        for (int ps = 0; ps < 4; ++ps) { const int d8 = (dq * 4 + ps) * 8; float vn[8];
            if (s < T) { const u32x4 r = *(const u32x4*)(Z + (size_t)(rowbase + s) * NZ + 4096 + g * 128 + d8);
                const float x[8] = {bflo(r.x), bfhi(r.x), bflo(r.y), bfhi(r.y), bflo(r.z), bfhi(r.z), bflo(r.w), bfhi(r.w)};
                const f32x4 ga = *(const f32x4*)(p.g_gmlp_ln + g * 128 + d8), gb = *(const f32x4*)(p.g_gmlp_ln + g * 128 + d8 + 4);
                const f32x4 ba = *(const f32x4*)(p.b_gmlp_ln + g * 128 + d8), bb = *(const f32x4*)(p.b_gmlp_ln + g * 128 + d8 + 4);
#pragma unroll
                for (int j = 0; j < 4; ++j) { vn[j] = (x[j] - mean) * rstd * ga[j] + ba[j]; vn[4 + j] = (x[4 + j] - mean) * rstd * gb[j] + bb[j]; }
                if (vs_out) { float* vp = vs_out + (size_t)s * 1024 + g * 128 + d8; *(f32x4*)vp = (f32x4){vn[0], vn[1], vn[2], vn[3]}; *(f32x4*)(vp + 4) = (f32x4){vn[4], vn[5], vn[6], vn[7]}; }
            } else {
#pragma unroll
                for (int j = 0; j < 8; ++j) vn[j] = 0.f;
            }
#pragma unroll
            for (int j = 0; j < 8; ++j) LV[(d8 + j) * LQ + s] = f2bf(vn[j]); } }
    __syncthreads();
#pragma unroll 1
    for (int q = 0; q < 2; ++q) { const int id = wave * 2 + q, ti = id >> 2, di = id & 3;
        if (ti * 32 < T) { f32x16 acc;
#pragma unroll
            for (int i = 0; i < 16; ++i) acc[i] = 0.f;
            mma32(acc, LW + ti * 32 * LQ, LQ, LV + di * 32 * LQ, LQ, (ti + 1) * 32, lane);
            const int d = di * 32 + (lane & 31);
#pragma unroll
            for (int i = 0; i < 16; ++i) { const int t = ti * 32 + (i & 3) + 8 * (i >> 2) + 4 * (lane >> 5);
                if (t < T) { const float uval = bf2f(Z[(size_t)(rowbase + t) * NZ + 3072 + g * 128 + d]);
                    mraw[(size_t)(rowbase + t) * 1024 + g * 128 + d] = f2bf(uval * (acc[i] + p.b_s[g * 128 + t])); } } } }
    __syncthreads();
}

__device__ __forceinline__ void gmlp_sample_item(const Params& p, int b) {
    const int tid = otid(), d2 = tid * 2, g = __builtin_amdgcn_readfirstlane(tid >> 6), rb = MP + b * 8;
    const bf16_t* Z = (const bf16_t*)(p.ws + OFF_Z); bf16_t* mraw = (bf16_t*)(p.ws + OFF_MRAW); const float* st = (const float*)(p.ws + OFF_STAT) + (size_t)rb * 2;
    float* vs_out = p.out + OUT_VS + (size_t)b * 8 * 1024;
    const f32x2 ga = *(const f32x2*)(p.g_gmlp_ln + d2), be = *(const f32x2*)(p.b_gmlp_ln + d2);
    unsigned xv[8], uv[8];
#pragma unroll
    for (int s_ = 0; s_ < 8; ++s_) { xv[s_] = *(const unsigned*)(Z + (size_t)(rb + s_) * NZ + 4096 + d2); uv[s_] = *(const unsigned*)(Z + (size_t)(rb + s_) * NZ + 3072 + d2); }
    float v0[8], v1[8];
#pragma unroll
    for (int s_ = 0; s_ < 8; ++s_) { const float mean = st[2 * s_], rstd = st[2 * s_ + 1];
        v0[s_] = (bflo(xv[s_]) - mean) * rstd * ga.x + be.x; v1[s_] = (bfhi(xv[s_]) - mean) * rstd * ga.y + be.y;
        *(f32x2*)(vs_out + (size_t)s_ * 1024 + d2) = (f32x2){v0[s_], v1[s_]}; }
    const float* wg = p.w_s + (size_t)g * 128 * 128; const float* bs = p.b_s + g * 128;
#pragma unroll
    for (int t = 0; t < 8; ++t) { float m0 = bs[t], m1 = m0;
#pragma unroll
        for (int s_ = 0; s_ <= t; ++s_) { const float w = wg[t * 128 + s_]; m0 += w * v0[s_]; m1 += w * v1[s_]; }
        *(unsigned*)(mraw + (size_t)(rb + t) * 1024 + d2) = pk2(bflo(uv[t]) * m0, bfhi(uv[t]) * m1); }
}
__device__ __forceinline__ void phase2a(const Params& p, LAS unsigned char* lds) {
    {   const int tid = otid(), lane = tid & 63, gw = blockIdx.x * 8 + (tid >> 6), NGW = gridDim.x * 8;
        const bf16_t* Z = (const bf16_t*)(p.ws + OFF_Z); float* st = (float*)(p.ws + OFF_STAT);
        for (int r = gw; r < MT; r += NGW) {
            const bf16_t* zr = Z + (size_t)r * NZ + 4096; const u32x4 r0 = *(const u32x4*)(zr + lane * 8), r1 = *(const u32x4*)(zr + 512 + lane * 8);
            const float x[16] = {bflo(r0.x), bfhi(r0.x), bflo(r0.y), bfhi(r0.y), bflo(r0.z), bfhi(r0.z), bflo(r0.w), bfhi(r0.w), bflo(r1.x), bfhi(r1.x), bflo(r1.y), bfhi(r1.y), bflo(r1.z), bfhi(r1.z), bflo(r1.w), bfhi(r1.w)};
            float s = 0.f;
#pragma unroll
            for (int j = 0; j < 16; ++j) s += x[j];
            const float mean = wave_sum(s) * (1.f / 1024.f); float q = 0.f;
#pragma unroll
            for (int j = 0; j < 16; ++j) { const float d = x[j] - mean; q += d * d; }
            const float rstd = rsqrtf(wave_sum(q) * (1.f / 1024.f) + 1e-6f);
            if (lane == 0) *(f32x2*)(st + (size_t)r * 2) = (f32x2){mean, rstd};
        }
    }
    for (int j = blockIdx.x; j < 512; j += gridDim.x) gla_prep_item(p, lds, j >> 5, j & 31);
    for (int j = blockIdx.x; j < 256; j += gridDim.x) gla_sample_pair(p, lds, j);
    { const int gw = blockIdx.x * 8 + (otid() >> 6), NGW = gridDim.x * 8; convert_range(p, lds, cv::E_IN, cv::E_OUT, gw, NGW); convert_range(p, lds, cv::E_FO, cv::E_PLE, gw, NGW); }
}
__device__ __forceinline__ void phase2c(const Params& p, LAS unsigned char* lds) {
    const int nb = gridDim.x, bid = blockIdx.x;
    constexpr int NCH = 32, N_GP = 512, N_GS = 0, N_MS = 128;
    const int nlb = nb > 2 * NCH ? NCH : (nb > 1 ? nb / 2 : 0);
    if (bid < nlb || nlb == 0) { for (int j = (nlb ? bid : 0); j < NCH; j += (nlb ? nlb : 1)) gla_chain_item(p, lds, j >> 1, j & 1); }
    if (bid >= nlb) {
        const int ob = bid - nlb, onb = nb - nlb;
        for (int j = ob; j < N_GP + N_GS + N_MS; j += onb) {
            if (j < N_GP) gmlp_item(p, lds, (j >> 3) * 128, 128, j & 7, nullptr);
            else gmlp_sample_item(p, j - N_GP - N_GS);
        }
        __syncthreads();
        convert_range(p, lds, cv::E_OUT, cv::E_FI, ob * 8 + (otid() >> 6), onb * 8);
    }
}

struct Mix10 { f32x4 o[4], m[4]; u32x4 r0, r1; };
__device__ __forceinline__ void mix_load(Mix10& a, const Params& p, int r, int col) {
    const bf16_t* Z = (const bf16_t*)(p.ws + OFF_Z); const bf16_t* oraw = (const bf16_t*)(p.ws + OFF_ORAW); const bf16_t* mraw = (const bf16_t*)(p.ws + OFF_MRAW);
#pragma unroll
    for (int j = 0; j < 2; ++j) { const u32x4 ow = ldnt((const u32x4*)(oraw + (size_t)r * 1024 + col + 8 * j)), mw = ldnt((const u32x4*)(mraw + (size_t)r * 1024 + col + 8 * j));
        a.o[2 * j] = (f32x4){bflo(ow.x), bfhi(ow.x), bflo(ow.y), bfhi(ow.y)}; a.o[2 * j + 1] = (f32x4){bflo(ow.z), bfhi(ow.z), bflo(ow.w), bfhi(ow.w)};
        a.m[2 * j] = (f32x4){bflo(mw.x), bfhi(mw.x), bflo(mw.y), bfhi(mw.y)}; a.m[2 * j + 1] = (f32x4){bflo(mw.z), bfhi(mw.z), bflo(mw.w), bfhi(mw.w)}; }
    a.r0 = ldnt((const u32x4*)(Z + (size_t)r * NZ + 2048 + col)); a.r1 = ldnt((const u32x4*)(Z + (size_t)r * NZ + 2048 + col + 8));
}
__device__ __forceinline__ void mix_finish(const Mix10& a, const Params& p, int r, int col) {
    bf16_t* cat = (bf16_t*)(p.ws + OFF_A0);
    { float s = 0.f;
#pragma unroll
        for (int j = 0; j < 4; ++j) s += (a.o[j][0] * a.o[j][0] + a.o[j][1] * a.o[j][1]) + (a.o[j][2] * a.o[j][2] + a.o[j][3] * a.o[j][3]);
        s = row16_sum(s);
        const float rinv = rsqrtf(s * (1.f / 256.f) + 1e-6f);
        const float sr[16] = {bflo(a.r0.x), bfhi(a.r0.x), bflo(a.r0.y), bfhi(a.r0.y), bflo(a.r0.z), bfhi(a.r0.z), bflo(a.r0.w), bfhi(a.r0.w), bflo(a.r1.x), bfhi(a.r1.x), bflo(a.r1.y), bfhi(a.r1.y), bflo(a.r1.z), bfhi(a.r1.z), bflo(a.r1.w), bfhi(a.r1.w)};
        unsigned w[8];
#pragma unroll
        for (int j = 0; j < 4; ++j) { const f32x4 g = *(const f32x4*)(p.g_gla_norm + col + 4 * j);
            w[2 * j] = pk2(a.o[j][0] * rinv * g[0] * sr[4 * j], a.o[j][1] * rinv * g[1] * sr[4 * j + 1]); w[2 * j + 1] = pk2(a.o[j][2] * rinv * g[2] * sr[4 * j + 2], a.o[j][3] * rinv * g[3] * sr[4 * j + 3]); }
        u32x4* dp = (u32x4*)(cat + (size_t)r * DM + col); dp[0] = (u32x4){w[0], w[1], w[2], w[3]}; dp[1] = (u32x4){w[4], w[5], w[6], w[7]}; }
    { float s = 0.f;
#pragma unroll
        for (int j = 0; j < 4; ++j) s += (a.m[j][0] * a.m[j][0] + a.m[j][1] * a.m[j][1]) + (a.m[j][2] * a.m[j][2] + a.m[j][3] * a.m[j][3]);
        const float rinv = rsqrtf(wave_sum(s) * (1.f / 1024.f) + 1e-6f);
        unsigned w[8];
#pragma unroll
        for (int j = 0; j < 4; ++j) { const f32x4 g = *(const f32x4*)(p.g_gmlp_out + col + 4 * j);
            w[2 * j] = pk2(a.m[j][0] * rinv * g[0], a.m[j][1] * rinv * g[1]); w[2 * j + 1] = pk2(a.m[j][2] * rinv * g[2], a.m[j][3] * rinv * g[3]); }
        u32x4* dp = (u32x4*)(cat + (size_t)r * DM + 1024 + col); dp[0] = (u32x4){w[0], w[1], w[2], w[3]}; dp[1] = (u32x4){w[4], w[5], w[6], w[7]}; }
}
__device__ __forceinline__ void phase2b(const Params& p) {
    const int lane = otid() & 63, gw = blockIdx.x * 8 + (otid() >> 6), NGW = gridDim.x * 8, col = lane * 16;
    for (int r = gw; r < MT; r += 2 * NGW) {
        const int r2 = r + NGW; const bool has2 = r2 < MT;
        Mix10 a, b; mix_load(a, p, r, col); mix_load(b, p, has2 ? r2 : r, col);
        mix_finish(a, p, r, col);
        if (has2) mix_finish(b, p, r2, col);
    }
}
template <int NS> __device__ __forceinline__ void phase_norm(const Params& p, const float* gain, const float* base_s) {
    const int lane = otid() & 63, gw = blockIdx.x * 8 + (otid() >> 6), NGW = gridDim.x * 8; bf16_t* a0 = (bf16_t*)(p.ws + OFF_A0); const bf16_t* part = (const bf16_t*)(p.ws + OFF_IMG);
    for (int r = gw; r < MP; r += 4 * NGW) {
        const int r2 = r + NGW, r3 = r + 2 * NGW, r4 = r + 3 * NGW; const bool h2 = r2 < MP, h3 = r3 < MP, h4 = r4 < MP;
        Row8 a, b, c4, d; row_load_nt(a, p.out + OUT_Y + (size_t)r * DM, lane); row_load_nt(b, p.out + OUT_Y + (size_t)(h2 ? r2 : r) * DM, lane);
        row_load_nt(c4, p.out + OUT_Y + (size_t)(h3 ? r3 : r) * DM, lane); row_load_nt(d, p.out + OUT_Y + (size_t)(h4 ? r4 : r) * DM, lane);
        rms_finish_bf16(a, gain, a0 + (size_t)r * DM, lane);
        if (h2) rms_finish_bf16(b, gain, a0 + (size_t)r2 * DM, lane);
        if (h3) rms_finish_bf16(c4, gain, a0 + (size_t)r3 * DM, lane);
        if (h4) rms_finish_bf16(d, gain, a0 + (size_t)r4 * DM, lane);
    }
    for (int r = MP + gw; r < MT; r += NGW) {
        f32x4 v[8]; float s = 0.f; const f32x4* sm = row_mid(base_s + (size_t)(r - MP) * DM, lane); const f32x4* gm = row_mid(gain, lane);
        const u32x2* pm0 = (const u32x2*)(part + (size_t)(r - MP) * DM) + lane; f32x4* om = row_mid(p.out + OUT_Y + (size_t)r * DM, lane);
#pragma unroll
        for (int j = 0; j < 8; ++j) v[j] = sm[64 * (j - 4)];
#pragma unroll 4
        for (int k = 0; k < NS; ++k) { const u32x2* pk = pm0 + (size_t)k * (MS * DM / 4);
#pragma unroll
            for (int j = 0; j < 8; ++j) v[j] += unpack4(pk[64 * j]); }
#pragma unroll
        for (int j = 0; j < 8; ++j) { om[64 * (j - 4)] = v[j]; s += (v[j][0] * v[j][0] + v[j][1] * v[j][1]) + (v[j][2] * v[j][2] + v[j][3] * v[j][3]); }
        const float rinv = rsqrtf(wave_sum(s) * (1.f / DM) + 1e-6f);
        u32x2* dm = (u32x2*)(a0 + (size_t)r * DM) + lane;
#pragma unroll
        for (int j = 0; j < 8; ++j) { const f32x4 g = gm[64 * (j - 4)]; u32x2 o; o.x = pk2(v[j][0] * rinv * g[0], v[j][1] * rinv * g[1]); o.y = pk2(v[j][2] * rinv * g[2], v[j][3] * rinv * g[3]);
            dm[64 * j] = o; }
    }
}
#define P7_TAIL() \
        float s = 0.f; \
        _Pragma("unroll") for (int j = 0; j < 8; ++j) s += (v.v[j][0] * v.v[j][0] + v.v[j][1] * v.v[j][1]) + (v.v[j][2] * v.v[j][2] + v.v[j][3] * v.v[j][3]); \
        const float rp = rsqrtf(wave_sum(s) * (1.f / DM) + 1e-6f); float s3 = 0.f; \
        const f32x4* gpm = row_mid(p.g_ple, lane); \
        _Pragma("unroll") for (int j = 0; j < 8; ++j) { const f32x4 g = gpm[64 * (j - 4)]; \
            _Pragma("unroll") for (int k = 0; k < 4; ++k) { const float h3 = hh.v[j][k] + v.v[j][k] * rp * g[k] * sigmoid_f(z.v[j][k]); v.v[j][k] = h3; s3 += h3 * h3; } } \
        const float r3 = rsqrtf(wave_sum(s3) * (1.f / DM) + 1e-6f); \
        const f32x4* gfm = row_mid(p.g_final, lane); \
        _Pragma("unroll") for (int j = 0; j < 8; ++j) { const f32x4 g = gfm[64 * (j - 4)]; stnt(om + 64 * (j - 4), (f32x4){v.v[j][0] * r3 * g[0], v.v[j][1] * r3 * g[1], v.v[j][2] * r3 * g[2], v.v[j][3] * r3 * g[3]}); }
__device__ __forceinline__ void phase7(const Params& p) {
    const int lane = otid() & 63, gw = blockIdx.x * 8 + (otid() >> 6), NGW = gridDim.x * 8;
    const bf16_t* gz = (const bf16_t*)(p.ws + OFF_GATEZ); const bf16_t* pz = (const bf16_t*)(p.ws + OFF_PZ);
#pragma unroll 1
    for (int r = gw; r < MP; r += NGW) {
        f32x4* om = row_mid(p.out + OUT_Y + (size_t)r * DM, lane);
        const u32x2* pzr = (const u32x2*)(pz + (size_t)r * DM) + lane; const u32x2* zb = (const u32x2*)(gz + (size_t)r * DM) + lane;
        Row8 v, hh, z;
#pragma unroll
        for (int j = 0; j < 8; ++j) { const u32x2 w = ldnt(pzr + 64 * j), zw = ldnt(zb + 64 * j); v.v[j] = (f32x4){bflo(w.x), bfhi(w.x), bflo(w.y), bfhi(w.y)}; z.v[j] = (f32x4){bflo(zw.x), bfhi(zw.x), bflo(zw.y), bfhi(zw.y)}; hh.v[j] = ldnt(om + 64 * (j - 4)); }
        P7_TAIL()
    }
#pragma unroll 1
    for (int r = MP + gw; r < MT; r += NGW) {
        f32x4* om = row_mid(p.out + OUT_Y + (size_t)r * DM, lane);
        const u32x2* pzr = (const u32x2*)(pz + (size_t)r * DM) + lane; const u32x2* zm = (const u32x2*)((const bf16_t*)(p.ws + OFF_IMG) + (size_t)(r - MP) * DM) + lane;
        Row8 v, hh, z;
#pragma unroll
        for (int j = 0; j < 8; ++j) { const u32x2 w = ldnt(pzr + 64 * j); v.v[j] = unpack4(w); hh.v[j] = ldnt(om + 64 * (j - 4)); z.v[j] = (f32x4){0.f, 0.f, 0.f, 0.f}; }
#pragma unroll 4
        for (int k = 0; k < 8; ++k) { const u32x2* pk = zm + (size_t)k * (MS * DM / 4);
#pragma unroll
            for (int j = 0; j < 8; ++j) z.v[j] += unpack4(ldnt(pk + 64 * j)); }
        P7_TAIL()
    }
}
#undef P7_TAIL

__global__ void __launch_bounds__(512, 2) fwd_kernel(Params p) {
    extern __shared__ __attribute__((aligned(16))) unsigned char shm[];
    LAS unsigned char* lds = (LAS unsigned char*)shm;
    cg::grid_group grid = cg::this_grid();
    if (threadIdx.x == 0) { *(volatile LAS unsigned*)(lds + 131072) = 0u; *(volatile LAS unsigned*)(lds + 131076) = 0u; }
    __syncthreads();
    const XcdBarrier xb = xcd_barrier_post((unsigned*)(p.ws + OFF_BAR), (volatile LAS unsigned*)(lds + 131072));
    bf16_t* a0 = (bf16_t*)(p.ws + OFF_A0);
    phase0(p, lds);
    if (p.ws == nullptr) grid.sync();
    xcd_barrier(xb);
    { EpiIn E; E.Z = (bf16_t*)(p.ws + OFF_Z); E.alow = (float*)(p.ws + OFF_ALOW); run_gemm(lds, a0, (const bf16_t*)(p.ws + OFF_WIN), MT, NINP, DM, E); }
    xcd_barrier(xb);
    phase2a(p, lds);
    xcd_barrier(xb);
    phase2c(p, lds);
    xcd_barrier(xb);
    phase2b(p);
    xcd_barrier(xb);
    bf16_t* part = (bf16_t*)(p.ws + OFF_IMG);
    { EpiRes E; E.res_p = p.x_prompt; E.res_s = p.x_sample; E.out = p.out + OUT_Y; run_gemm_n2048(lds, a0, (const bf16_t*)(p.ws + OFF_WOUT), DM, E, part); }
    xcd_barrier(xb);
    phase_norm<8>(p, p.g_ffn, p.x_sample);
    xcd_barrier(xb);
    { EpiSwiglu E; E.act = (bf16_t*)(p.ws + OFF_ACT); run_gemm(lds, a0, (const bf16_t*)(p.ws + OFF_WFI), MT, 2 * DFF, DM, E); }
    {
        const int G = (int)gridDim.x, extra = ((MT / 256) * (2 * DFF / 256)) % G, cb = (int)blockIdx.x;
        if (extra == 0 || cb >= extra) { EpiBfN E; E.out = (bf16_t*)(p.ws + OFF_PZ); pg8::Gemm g; g.A = (const bf16_t*)(p.ws + OFF_PB); g.Bt = (const bf16_t*)(p.ws + OFF_WPLE); g.M = MT; g.N = DM; g.K = PLE; g.Klen = PLE;
            pg8::StaticOrder S; S.init(MT, DM, extra ? G - extra : G, extra ? cb - extra : cb); pg8::gemm_phase<EpiBfN, pg8::StaticOrder, false>(lds, g, S, E, nullptr);
            { const int ob = extra ? cb - extra : cb, onb = extra ? G - extra : G, gw = ob * 8 + (otid() >> 6); convert_range(p, lds, cv::E_FI, cv::E_FO, gw, onb * 8); convert_range(p, lds, cv::E_PLE, cv::E_GT, gw, onb * 8); } }
    }
    xcd_barrier(xb);
    { EpiRes E; E.res_p = p.out + OUT_Y; E.res_s = p.out + OUT_Y + (size_t)MP * DM; E.out = p.out + OUT_Y;
      const bf16_t* A = (const bf16_t*)(p.ws + OFF_ACT); const bf16_t* Bt = (const bf16_t*)(p.ws + OFF_WFO); const int G = (int)gridDim.x, hb = (int)((blockIdx.x + G / 2) % G);
      run_gemm(lds, A, Bt, MP, DM, DFF, E);
      run_split(lds, A, Bt, DFF, part, 4, 768, 0, 0, hb);
      run_split(lds, A, Bt, DFF, part, 4, 640, 3072, 4, (int)blockIdx.x); }
    xcd_barrier(xb);
    phase_norm<8>(p, p.g_ple_gate, p.out + OUT_Y + (size_t)MP * DM);
    xcd_barrier(xb);
    { EpiBfN E; E.out = (bf16_t*)(p.ws + OFF_GATEZ); run_gemm_n2048(lds, a0, (const bf16_t*)(p.ws + OFF_WGT), DM, E, part); }
    xcd_barrier(xb);
    phase7(p);
}

extern "C" void kernel_launch(void* const* d_in, const int* in_sizes, int n_in, void* d_out, int out_size, void* d_ws, size_t ws_size, hipStream_t stream) {
    static int grid = 0;
    if (grid == 0) {
        if (n_in != 24 || ws_size < WS_END) { fprintf(stderr, "kernel_launch: unexpected n_in %d or ws_size %zu (< %zu)\n", n_in, ws_size, (size_t)WS_END); grid = -1; return; }
        int dev = 0, cus = 0, per_cu = 0;
        if (hipGetDevice(&dev) != hipSuccess || hipDeviceGetAttribute(&cus, hipDeviceAttributeMultiprocessorCount, dev) != hipSuccess) { grid = -1; return; }
        if (hipFuncSetAttribute((const void*)fwd_kernel, hipFuncAttributeMaxDynamicSharedMemorySize, LDS_BYTES) != hipSuccess) { fprintf(stderr, "kernel_launch: hipFuncSetAttribute failed\n"); grid = -1; return; }
        if (hipOccupancyMaxActiveBlocksPerMultiprocessor(&per_cu, (const void*)fwd_kernel, 512, LDS_BYTES) != hipSuccess || per_cu < 1) { fprintf(stderr, "kernel_launch: occupancy query says %d blocks per CU\n", per_cu); grid = -1; (void)hipGetLastError(); return; }
        grid = cus;
    }
    if (grid < 0) return;
    if (hipMemsetAsync(d_ws, 0, XCD_BAR_WORDS * sizeof(unsigned), stream) != hipSuccess) { fprintf(stderr, "kernel_launch: memset failed\n"); return; }
    Params p{};
    const float** f = (const float**)&p;
    for (int i = 0; i < 24; ++i) f[i] = (const float*)d_in[i];
    p.out = (float*)d_out; p.ws = (unsigned char*)d_ws;
    void* args[] = {&p};
    hipError_t e = hipLaunchCooperativeKernel((const void*)fwd_kernel, dim3(grid), dim3(512), args, LDS_BYTES, stream);
    if (e != hipSuccess) fprintf(stderr, "cooperative launch failed: %s (grid %d)\n", hipGetErrorString(e), grid);
}
```

```cpp
#include <hip/hip_runtime.h>
#include <hip/hip_cooperative_groups.h>
#include <cstdio>
#include <cstdint>
namespace cg = cooperative_groups;
namespace pg8 {
#define PG8_LAS __attribute__((address_space(3)))
typedef unsigned short bf16_t;
typedef short bf16x8 __attribute__((ext_vector_type(8)));
typedef float f32x4 __attribute__((ext_vector_type(4)));
typedef unsigned u32x4 __attribute__((ext_vector_type(4)));
constexpr int BM = 256, BK = 64, HALF = 128, HTB = HALF * BK * 2  , STAGE_BYTES = 8 * HTB, NXCD = 8, WGM = 8;

__host__ __device__ __forceinline__ int lds_byte(int r, int c) { const int st = (r >> 4) * 2 + (c >> 5), rr = r & 15, cc = c & 31, ob = rr * 64 + cc * 2; return st * 1024 + (ob ^ (((ob >> 9) & 1) << 5)); }
__host__ __device__ __forceinline__ void stage_rc(int b, int& R, int& C) { const int st = b / 1024, sb = b % 1024, swz = sb ^ (((sb >> 9) & 1) << 5); R = (st >> 1) * 16 + swz / 64; C = (st & 1) * 32 + (swz % 64) / 2; }
__host__ __device__ __forceinline__ int perm32(int rho) { const int n = rho >> 4, i = rho & 15; return 8 * (i >> 2) + 4 * n + (i & 3); }

struct Unit { int pm, pn, ks, koff; };
struct Gemm { const bf16_t* A; const bf16_t* Bt; int M, N, K, Klen; };

struct StaticOrder {
    int nM, nN, nwg, G, c;
    __host__ __device__ void init(int M, int N, int G_, int c_) { nM = M / BM; nN = N / BM; nwg = nM * nN; G = G_; c = c_; }
    __host__ __device__ bool next(int i, Unit& u) const {
        const long L = (long)i * G + c; if (L >= nwg) return false;
        int wgid = (int)L; { const int q = nwg / NXCD, r = nwg % NXCD, xcd = wgid % NXCD, off = wgid / NXCD; wgid = (xcd < r ? xcd * (q + 1) : r * (q + 1) + (xcd - r) * q) + off; }
        const int nig = WGM * nN, gid = wgid / nig, fm = gid * WGM, gsz = (nM - fm) < WGM ? (nM - fm) : WGM;
        u.pm = fm + ((wgid % nig) % gsz); u.pn = (wgid % nig) / gsz; u.ks = 0; u.koff = 0; return true;
    }
    __device__ __forceinline__ void a_ready(const Unit&) const {}
    __device__ __forceinline__ void done(const Unit&) const {}
};
__device__ __forceinline__ unsigned cvt_pk_bf16(float lo, float hi) { unsigned r; asm volatile("v_cvt_pk_bf16_f32 %0, %1, %2" : "=v"(r) : "v"(lo), "v"(hi)); return r; }
typedef float f32x2 __attribute__((ext_vector_type(2)));
template <class Epi, class Sched, bool STAMP = false>
__device__ __forceinline__ void gemm_phase(PG8_LAS unsigned char* lds, const Gemm g, const Sched& S, const Epi& E, unsigned long long* stamps) {
    int tid_ = threadIdx.x; asm volatile("" : "+v"(tid_));
    const int tid = tid_, wid = __builtin_amdgcn_readfirstlane(tid >> 6), lane = tid & 63, wr = wid >> 2, wc = wid & 3, fr = lane & 15, fq = lane >> 4;
    const int K = g.K, nt = g.Klen / BK;
    int ts_lo = 0, ts_hi = 0, nts = 0; const unsigned long long rt_entry = STAMP ? (unsigned long long)wall_clock64() : 0ull;
#define PG8_STAMP() do { if (STAMP && wid == 0 && nts < 64) { const unsigned long long _c = (unsigned long long)clock64(); \
        ts_lo = (lane == nts) ? (int)(unsigned)_c : ts_lo; ts_hi = (lane == nts) ? (int)(unsigned)(_c >> 32) : ts_hi; ++nts; } } while (0)
    PG8_STAMP();
    unsigned voffA[2], voffB[2];
#pragma unroll
    for (int i = 0; i < 2; ++i) { int R, C; stage_rc(tid * 16 + i * 8192, R, C); const int Rb = Epi::PERM ? ((R & ~31) + perm32(R & 31)) : R;
        voffA[i] = (unsigned)(R * K + C) * 2u; voffB[i] = (unsigned)(Rb * K + C) * 2u; }
    const size_t kstep = (size_t)(BK * 2);
    const size_t hstep = (size_t)HALF * K * 2;
    const size_t tstep = 2 * hstep;
    const unsigned ldsw = (unsigned)wid * 1024u;
    const int aoff = lds_byte(wr * 64 + fr, fq * 8), boff = lds_byte(wc * 32 + fr, fq * 8);
#define PG8_SA(b, h) (((b) * 2 + (h)) * HTB)
#define PG8_SB(b, h) ((4 + (b) * 2 + (h)) * HTB)
#define PG8_STAGE(bufoff, gbase, voff) do { _Pragma("unroll") for (int _i = 0; _i < 2; ++_i) \
        __builtin_amdgcn_global_load_lds((const unsigned*)((const char*)(gbase) + (voff)[_i]), (PG8_LAS unsigned*)(lds + (bufoff) + ldsw + _i * 8192), 16, 0, 0); } while (0)
#define PG8_LDA(dst, b, h) do { _Pragma("unroll") for (int m = 0; m < 4; ++m) _Pragma("unroll") for (int k = 0; k < 2; ++k) dst[m][k] = *(const PG8_LAS bf16x8*)(lds + PG8_SA(b, h) + aoff + m * 2048 + k * 1024); } while (0)
#define PG8_LDB(dst, b, h) do { _Pragma("unroll") for (int n = 0; n < 2; ++n) _Pragma("unroll") for (int k = 0; k < 2; ++k) dst[n][k] = *(const PG8_LAS bf16x8*)(lds + PG8_SB(b, h) + boff + n * 2048 + k * 1024); } while (0)
#define PG8_MMA(ai, bj, At, Bt) do { __builtin_amdgcn_s_setprio(1); _Pragma("unroll") for (int m = 0; m < 4; ++m) _Pragma("unroll") for (int n = 0; n < 2; ++n) _Pragma("unroll") for (int k = 0; k < 2; ++k) \
        acc[ai][bj][m][n] = __builtin_amdgcn_mfma_f32_16x16x32_bf16(Bt[n][k], At[m][k], acc[ai][bj][m][n], 0, 0, 0); __builtin_amdgcn_s_setprio(0); } while (0)
#define PG8_WAIT_V(n) asm volatile("s_waitcnt vmcnt(" #n ")" ::: "memory")
#define PG8_WAIT_L(n) asm volatile("s_waitcnt lgkmcnt(" #n ")" ::: "memory")
#define PG8_BAR __builtin_amdgcn_s_barrier()
#define PG8_SCHED __builtin_amdgcn_sched_barrier(0)
    Unit cur, nxt; int ui = 0;
    if (!S.next(0, cur)) return;
    f32x4 acc[2][2][4][2];
#pragma unroll
    for (int a = 0; a < 2; ++a)
#pragma unroll
        for (int b = 0; b < 2; ++b)
#pragma unroll
            for (int m = 0; m < 4; ++m)
#pragma unroll
                for (int n = 0; n < 2; ++n) acc[a][b][m][n] = (f32x4){0.f, 0.f, 0.f, 0.f};
    bf16x8 At[4][2], B0[2][2], B1[2][2];
    const char* cA = (const char*)g.A + (size_t)cur.pm * tstep + (size_t)cur.koff * 2; const char* cB = (const char*)g.Bt + (size_t)cur.pn * tstep + (size_t)cur.koff * 2;
    S.a_ready(cur);
    PG8_STAGE(PG8_SB(0, 0), cB, voffB); PG8_STAGE(PG8_SB(0, 1), cB + hstep, voffB); PG8_STAGE(PG8_SA(0, 0), cA, voffA); PG8_STAGE(PG8_SA(0, 1), cA + hstep, voffA);
    if (wr == 1) PG8_BAR;
    PG8_WAIT_V(2); PG8_BAR;
    PG8_STAGE(PG8_SB(1, 0), cB + kstep, voffB); PG8_STAGE(PG8_SA(1, 0), cA + kstep, voffA); PG8_STAGE(PG8_SB(1, 1), cB + hstep + kstep, voffB);
    PG8_WAIT_V(6); PG8_BAR;
    PG8_STAMP();
    for (;;) {
        const bool has_next = S.next(ui + 1, nxt);
        const char* nA = has_next ? (const char*)g.A + (size_t)nxt.pm * tstep + (size_t)nxt.koff * 2 : cA; const char* nB = has_next ? (const char*)g.Bt + (size_t)nxt.pn * tstep + (size_t)nxt.koff * 2 : cB;
        for (int t = 0; t < nt; t += 2) {
            const bool last = (t == nt - 2);
            const char* a1 = cA + (size_t)(t + 1) * kstep;
            const char* a2 = last ? nA : cA + (size_t)(t + 2) * kstep; const char* b2 = last ? nB : cB + (size_t)(t + 2) * kstep;
            const char* a3 = a2 + kstep; const char* b3 = b2 + kstep;
            if (last && has_next) S.a_ready(nxt);
            PG8_LDB(B0, 0, 0); PG8_LDB(B1, 0, 1); PG8_SCHED; PG8_LDA(At, 0, 0); PG8_STAGE(PG8_SA(1, 1), a1 + hstep, voffA);
            PG8_WAIT_V(8); PG8_WAIT_L(0); PG8_BAR; PG8_MMA(0, 0, At, B0); PG8_MMA(0, 1, At, B1); PG8_BAR; PG8_SCHED;
            PG8_LDA(At, 0, 1); PG8_STAGE(PG8_SB(0, 0), b2, voffB); PG8_STAGE(PG8_SB(0, 1), b2 + hstep, voffB); PG8_STAGE(PG8_SA(0, 0), a2, voffA);
            PG8_WAIT_V(8); PG8_WAIT_L(0); PG8_BAR; PG8_MMA(1, 0, At, B0); PG8_MMA(1, 1, At, B1); PG8_BAR; PG8_SCHED;
            PG8_LDB(B0, 1, 0); PG8_LDB(B1, 1, 1); PG8_SCHED; PG8_LDA(At, 1, 0); PG8_STAGE(PG8_SA(0, 1), a2 + hstep, voffA);
            PG8_WAIT_V(8); PG8_WAIT_L(0); PG8_BAR; PG8_MMA(0, 0, At, B0); PG8_MMA(0, 1, At, B1); PG8_BAR; PG8_SCHED;
            PG8_LDA(At, 1, 1); PG8_STAGE(PG8_SB(1, 0), b3, voffB); PG8_STAGE(PG8_SB(1, 1), b3 + hstep, voffB); PG8_STAGE(PG8_SA(1, 0), a3, voffA);
            PG8_WAIT_V(8); PG8_WAIT_L(0); PG8_BAR; PG8_MMA(1, 0, At, B0); PG8_MMA(1, 1, At, B1); PG8_BAR; PG8_SCHED;
        }
        PG8_STAMP();
        if (wr == 0) PG8_BAR;
        if constexpr (!Epi::AFTER_DRAIN) { E(acc, cur, wr, wc, fr, fq); S.done(cur); }
        PG8_STAMP();
        if (!has_next) break;
#pragma unroll
        for (int a = 0; a < 2; ++a)
#pragma unroll
            for (int b = 0; b < 2; ++b)
#pragma unroll
                for (int m = 0; m < 4; ++m)
#pragma unroll
                    for (int n = 0; n < 2; ++n) acc[a][b][m][n] = (f32x4){0.f, 0.f, 0.f, 0.f};
        cur = nxt; cA = nA; cB = nB; ++ui;
        if (wr == 1) PG8_BAR;
    }
    PG8_WAIT_V(0);
    PG8_BAR;
    if constexpr (Epi::AFTER_DRAIN) { E.fused(acc, cur, wr, wc, fr, fq, lds, wid, lane); S.done(cur); }
    PG8_STAMP();
    if (STAMP && wid == 0) { stamps[lane] = lane < nts ? (((unsigned long long)(unsigned)ts_hi << 32) | (unsigned)ts_lo) : 0ull;
        if (lane == 62) stamps[62] = rt_entry; if (lane == 63) stamps[63] = (unsigned long long)wall_clock64(); }
#undef PG8_STAMP
#undef PG8_SA
#undef PG8_SB
#undef PG8_STAGE
#undef PG8_LDA
#undef PG8_LDB
#undef PG8_MMA
#undef PG8_WAIT_V
#undef PG8_WAIT_L
#undef PG8_BAR
#undef PG8_SCHED
}
}
#define LAS __attribute__((address_space(3)))
#define XB_TMO      128
#define XB_XCNT(j)  (256  + 64 * (j))
#define XB_XSUB(j)  (1280 + 64 * (j))
#define XB_XGEN(j)  (2304 + 64 * (j))
#define XB_TOP      3328
#define XB_TOPGEN   3392
#define XCD_BAR_WORDS 3456
#define XB_SPIN_CAP (1u << 18)

__device__ __forceinline__ unsigned xb_ld(unsigned* p)              { return __hip_atomic_load(p, __ATOMIC_RELAXED, __HIP_MEMORY_SCOPE_AGENT); }
__device__ __forceinline__ unsigned xb_add(unsigned* p, unsigned v) { return __hip_atomic_fetch_add(p, v, __ATOMIC_RELAXED, __HIP_MEMORY_SCOPE_AGENT); }
__device__ __forceinline__ unsigned xb_xcc_id() { return (unsigned)__builtin_amdgcn_s_getreg((3 << 11) | 20) & 0xFu; }
#define XB_SPIN(cond, bar) do { unsigned _sp = 0; while (cond) { __builtin_amdgcn_s_sleep(1); \
    if ((++_sp & 255u) == 0u) { if (xb_ld(&(bar)[XB_TMO])) break; if (_sp > XB_SPIN_CAP) { atomicAdd(&(bar)[XB_TMO], 1u); break; } } } } while (0)

struct XcdBarrier {
    unsigned* bar; unsigned x;
    volatile LAS unsigned* st;
};

__device__ __forceinline__ XcdBarrier xcd_barrier_post(unsigned* bar, volatile LAS unsigned* st) {
    XcdBarrier b; b.bar = bar; b.x = xb_xcc_id(); b.st = st;
    if (threadIdx.x == 0) (void)xb_add(&bar[XB_XCNT(b.x)], 1u);
    return b;
}
__device__ __forceinline__ void xcd_barrier_complete(unsigned* bar, unsigned x, unsigned& nloc, unsigned& nx) {
    const unsigned G = gridDim.x * gridDim.y * gridDim.z;
    unsigned sum, cnt, mine, sp = 0u;
    for (;;) {
        sum = 0u; cnt = 0u; mine = 0u;
#pragma unroll
        for (unsigned j = 0; j < 16; ++j) { const unsigned c = xb_ld(&bar[XB_XCNT(j)]); sum += c; cnt += (c > 0u) ? 1u : 0u; mine = (j == x) ? c : mine; }
        if (sum == G) break;
        __builtin_amdgcn_s_sleep(1);
        if ((++sp & 255u) == 0u) { if (xb_ld(&bar[XB_TMO])) break; if (sp > XB_SPIN_CAP) { atomicAdd(&bar[XB_TMO], 1u); break; } }
    }
    nloc = mine > 0u ? mine : 1u; nx = cnt > 0u ? cnt : 1u;
}

__device__ __forceinline__ void xcd_barrier(const XcdBarrier& b) {
    asm volatile("s_waitcnt vmcnt(0)" ::: "memory");
    __syncthreads();
    if (threadIdx.x == 0) {
        unsigned* bar = b.bar;
        __builtin_amdgcn_s_waitcnt(0);
        unsigned nloc = b.st[0], nx = b.st[1];
        if (nloc == 0u) { xcd_barrier_complete(bar, b.x, nloc, nx); b.st[0] = nloc; b.st[1] = nx; }
        const unsigned old = xb_add(&bar[XB_XSUB(b.x)], 1u);
        const unsigned gen = old / nloc;
        if (old + 1u == (gen + 1u) * nloc) {
            __builtin_amdgcn_fence(__ATOMIC_RELEASE, "agent");
            asm volatile("s_waitcnt vmcnt(0)" ::: "memory");
            const unsigned og = xb_add(&bar[XB_TOP], 1u);
            const unsigned tg = og / nx;
            if (og + 1u == (tg + 1u) * nx) xb_add(&bar[XB_TOPGEN], 1u);
            else XB_SPIN(xb_ld(&bar[XB_TOPGEN]) == tg, bar);
            __builtin_amdgcn_fence(__ATOMIC_ACQUIRE, "agent");
            xb_add(&bar[XB_XGEN(b.x)], 1u);
            asm volatile("s_waitcnt vmcnt(0)" ::: "memory");
        } else {
            XB_SPIN(xb_ld(&bar[XB_XGEN(b.x)]) == gen, bar);
            __builtin_amdgcn_fence(__ATOMIC_ACQUIRE, "agent");
            asm volatile("s_waitcnt vmcnt(0)" ::: "memory");
        }
    }
    __syncthreads();
}


using pg8::bf16_t; using pg8::bf16x8; using pg8::f32x4; using pg8::u32x4; using pg8::Unit;
typedef float f32x16 __attribute__((ext_vector_type(16)));
typedef unsigned u32x2 __attribute__((ext_vector_type(2)));
typedef float f32x2 __attribute__((ext_vector_type(2)));

constexpr int MP = 8192, MS = 1024, MT = 9216, DM = 2048, NZ = 5120, NINP = 5376, DFF = 5632, PLE = 256;
constexpr int LDS_BYTES = 131072 + 16;
constexpr size_t OFF_BAR = 0;
constexpr size_t OFF_WIN = 16384;
constexpr size_t OFF_WOUT = OFF_WIN + (size_t)NINP * DM * 2;
constexpr size_t OFF_WFI = OFF_WOUT + (size_t)DM * DM * 2;
constexpr size_t OFF_WFO = OFF_WFI + (size_t)2 * DFF * DM * 2;
constexpr size_t OFF_WPLE = OFF_WFO + (size_t)DM * DFF * 2;
constexpr size_t OFF_WGT = OFF_WPLE + (size_t)DM * PLE * 2;
constexpr size_t OFF_A0 = OFF_WGT + (size_t)DM * DM * 2;
constexpr size_t OFF_PB = OFF_A0 + (size_t)MT * DM * 2;
constexpr size_t OFF_ALOW = OFF_PB + (size_t)MT * PLE * 2;
constexpr size_t OFF_STAT = OFF_ALOW + (size_t)MT * 16 * 4;
constexpr size_t OFF_BIG = OFF_STAT + (size_t)MT * 2 * 4;
constexpr size_t OFF_Z = OFF_BIG;
constexpr size_t OFF_ORAW = OFF_Z + (size_t)MT * NZ * 2;
constexpr size_t OFF_MRAW = OFF_ORAW + (size_t)MT * 1024 * 4;
constexpr size_t OFF_IMG = OFF_BIG + (size_t)MT * DFF * 2 + (size_t)MT * DM * 4;
constexpr size_t WS_END = OFF_IMG + (size_t)4 * 1024 * 2048 * 4;
constexpr size_t OFF_ACT = OFF_BIG;
constexpr size_t OFF_GATEZ = OFF_BIG;
constexpr size_t OFF_PZ = OFF_BIG + (size_t)MT * DFF * 2;
constexpr size_t OUT_Y = 0, OUT_SP = (size_t)MT * DM, OUT_SS = OUT_SP + (size_t)4 * 4 * 128 * 256, OUT_VS = OUT_SS + (size_t)128 * 4 * 128 * 256;

struct Params {
    const float *x_prompt, *x_sample, *state_gla, *p_prompt, *p_sample, *g_mix, *w_in, *w_a2, *b_a, *g_gla_norm, *g_gmlp_ln, *b_gmlp_ln, *w_s, *b_s,
        *g_gmlp_out, *w_out, *g_ffn, *w_ffn_in, *w_ffn_out, *w_ple, *g_ple, *g_ple_gate, *w_ple_gate, *g_final;
    float* out;
    unsigned char* ws;
};

__device__ __forceinline__ unsigned pk2(float lo, float hi) { return pg8::cvt_pk_bf16(lo, hi); }
__device__ __forceinline__ bf16_t f2bf(float f) { return (bf16_t)(pk2(f, 0.f) & 0xffffu); }
__device__ __forceinline__ float bf2f(bf16_t b) { return __uint_as_float(((unsigned)b) << 16); }
__device__ __forceinline__ float bflo(unsigned w) { return __uint_as_float(w << 16); }
__device__ __forceinline__ float bfhi(unsigned w) { return __uint_as_float(w & 0xffff0000u); }
__device__ __forceinline__ f32x4 unpack4(u32x2 w) { return (f32x4){bflo(w.x), bfhi(w.x), bflo(w.y), bfhi(w.y)}; }
template <int CTRL> __device__ __forceinline__ float dpp_f(float v) { return __int_as_float(__builtin_amdgcn_update_dpp(0, __float_as_int(v), CTRL, 0xf, 0xf, true)); }
__device__ __forceinline__ float row16_sum(float v) {
    v += dpp_f<0xB1>(v); v += dpp_f<0x4E>(v); v += dpp_f<0x141>(v); v += dpp_f<0x140>(v); return v;
}
__device__ __forceinline__ float wave_sum(float v) {
    v = row16_sum(v);
    return (__int_as_float(__builtin_amdgcn_readlane(__float_as_int(v), 0)) + __int_as_float(__builtin_amdgcn_readlane(__float_as_int(v), 16))) + (__int_as_float(__builtin_amdgcn_readlane(__float_as_int(v), 32)) + __int_as_float(__builtin_amdgcn_readlane(__float_as_int(v), 48)));
}
__device__ __forceinline__ float sigmoid_f(float x) { return __builtin_amdgcn_rcpf(1.f + __expf(-x)); }
__device__ __forceinline__ float silu_f(float x) { return x * __builtin_amdgcn_rcpf(1.f + __expf(-x)); }
__device__ __forceinline__ float gelu_f(float x) { const float u = 1.5957691216f * (x + 0.044715f * x * x * x); return x * __builtin_amdgcn_rcpf(1.f + __expf(-u)); }
__device__ __forceinline__ float logsigmoid_f(float x) { return fminf(x, 0.f) - __logf(1.f + __expf(-fabsf(x))); }
template <class T> __device__ __forceinline__ T* opaque(T* p) { return p; }
__device__ __forceinline__ const f32x4* row_mid(const float* row, int lane) { return opaque((const f32x4*)row + lane + 256); }
__device__ __forceinline__ f32x4* row_mid(float* row, int lane) { return opaque((f32x4*)row + lane + 256); }
__device__ __forceinline__ int otid() { int t = threadIdx.x; asm volatile("" : "+v"(t)); return t; }
template <class T> __device__ __forceinline__ T ldnt(const T* p) { return __builtin_nontemporal_load(p); }
template <class T> __device__ __forceinline__ void stnt(T* p, T v) { __builtin_nontemporal_store(v, p); }
__device__ __forceinline__ void lds_wait() { asm volatile("s_waitcnt lgkmcnt(0)" ::: "memory"); }

struct EpiIn {
    static constexpr bool PERM = true, AFTER_DRAIN = false;
    bf16_t* Z; float* alow;
    __device__ __forceinline__ void operator()(const f32x4 (&acc)[2][2][4][2], const Unit& u, int wr, int wc, int fr, int fq) const {
        const int row0 = u.pm * 256 + wr * 64 + fr, pn = u.pn;
        if (pn == 20) {
            if (wc == 0 && fq < 2) {
#pragma unroll
                for (int ai = 0; ai < 2; ++ai)
#pragma unroll
                    for (int m = 0; m < 4; ++m) { float* p = alow + (size_t)(row0 + ai * 128 + m * 16) * 16 + 8 * fq; *(f32x4*)p = acc[ai][0][m][0]; *(f32x4*)(p + 4) = acc[ai][0][m][1]; }
            }
            return;
        }
        const int kind = pn < 8 ? 0 : (pn < 12 ? 1 : 2); const float qs = pn < 2 ? 0.08838834764831845f : 1.f;
#pragma unroll
        for (int ai = 0; ai < 2; ++ai)
#pragma unroll
            for (int m = 0; m < 4; ++m) { bf16_t* rowp = Z + (size_t)(row0 + ai * 128 + m * 16) * NZ + pn * 256 + wc * 32 + 8 * fq;
#pragma unroll
                for (int bj = 0; bj < 2; ++bj) { f32x4 v0 = acc[ai][bj][m][0], v1 = acc[ai][bj][m][1];
                    if (kind == 0) { v0 *= qs; v1 *= qs; }
                    else if (kind == 1) {
#pragma unroll
                        for (int j = 0; j < 4; ++j) { v0[j] = silu_f(v0[j]); v1[j] = silu_f(v1[j]); } }
                    else {
#pragma unroll
                        for (int j = 0; j < 4; ++j) { v0[j] = gelu_f(v0[j]); v1[j] = gelu_f(v1[j]); } }
                    u32x4 w; w.x = pk2(v0[0], v0[1]); w.y = pk2(v0[2], v0[3]); w.z = pk2(v1[0], v1[1]); w.w = pk2(v1[2], v1[3]);
                    *(u32x4*)(rowp + bj * 128) = w; } }
    }
};
struct EpiRes {
    static constexpr bool PERM = false, AFTER_DRAIN = false;
    const float* res_p; const float* res_s; float* out;
    __device__ __forceinline__ void operator()(const f32x4 (&acc)[2][2][4][2], const Unit& u, int wr, int wc, int fr, int fq) const {
        const int row0 = u.pm * 256 + wr * 64 + fr, col0 = u.pn * 256 + wc * 32 + 4 * fq;
#pragma unroll
        for (int ai = 0; ai < 2; ++ai)
#pragma unroll
            for (int m = 0; m < 4; ++m) { const int row = row0 + ai * 128 + m * 16;
                const float* rp = (row < MP ? res_p + (size_t)row * DM : res_s + (size_t)(row - MP) * DM) + col0; float* op = out + (size_t)row * DM + col0;
#pragma unroll
                for (int bj = 0; bj < 2; ++bj)
#pragma unroll
                    for (int n = 0; n < 2; ++n) { const f32x4 r = *(const f32x4*)(rp + bj * 128 + n * 16); *(f32x4*)(op + bj * 128 + n * 16) = acc[ai][bj][m][n] + r; } }
    }
};
struct EpiSwiglu {
    static constexpr bool PERM = true, AFTER_DRAIN = false;
    bf16_t* act;
    __device__ __forceinline__ void operator()(const f32x4 (&acc)[2][2][4][2], const Unit& u, int wr, int wc, int fr, int fq) const {
        const int row0 = u.pm * 256 + wr * 64 + fr, col0 = u.pn * 128 + wc * 32 + 8 * fq;
#pragma unroll
        for (int ai = 0; ai < 2; ++ai)
#pragma unroll
            for (int m = 0; m < 4; ++m) { float a[8];
#pragma unroll
                for (int n = 0; n < 2; ++n)
#pragma unroll
                    for (int j = 0; j < 4; ++j) a[n * 4 + j] = silu_f(acc[ai][0][m][n][j]) * acc[ai][1][m][n][j];
                u32x4 w; w.x = pk2(a[0], a[1]); w.y = pk2(a[2], a[3]); w.z = pk2(a[4], a[5]); w.w = pk2(a[6], a[7]);
                *(u32x4*)(act + (size_t)(row0 + ai * 128 + m * 16) * DFF + col0) = w; }
    }
};
struct EpiBfN {
    static constexpr bool PERM = true, AFTER_DRAIN = false;
    bf16_t* out;
    __device__ __forceinline__ void operator()(const f32x4 (&acc)[2][2][4][2], const Unit& u, int wr, int wc, int fr, int fq) const {
        const int row0 = u.pm * 256 + wr * 64 + fr, col0 = u.pn * 256 + wc * 32 + 8 * fq;
#pragma unroll
        for (int ai = 0; ai < 2; ++ai)
#pragma unroll
            for (int m = 0; m < 4; ++m) { bf16_t* op = out + (size_t)(row0 + ai * 128 + m * 16) * DM + col0;
#pragma unroll
                for (int bj = 0; bj < 2; ++bj) { const f32x4 v0 = acc[ai][bj][m][0], v1 = acc[ai][bj][m][1];
                    u32x4 w; w.x = pk2(v0[0], v0[1]); w.y = pk2(v0[2], v0[3]); w.z = pk2(v1[0], v1[1]); w.w = pk2(v1[2], v1[3]); *(u32x4*)(op + bj * 128) = w; } }
    }
};
struct EpiPlain {
    static constexpr bool PERM = false, AFTER_DRAIN = false;
    float* out;
    __device__ __forceinline__ void operator()(const f32x4 (&acc)[2][2][4][2], const Unit& u, int wr, int wc, int fr, int fq) const {
        const int row0 = u.pm * 256 + wr * 64 + fr, col0 = u.pn * 256 + wc * 32 + 4 * fq;
#pragma unroll
        for (int ai = 0; ai < 2; ++ai)
#pragma unroll
            for (int m = 0; m < 4; ++m) { float* op = out + (size_t)(row0 + ai * 128 + m * 16) * DM + col0;
#pragma unroll
                for (int bj = 0; bj < 2; ++bj)
#pragma unroll
                    for (int n = 0; n < 2; ++n) *(f32x4*)(op + bj * 128 + n * 16) = acc[ai][bj][m][n]; }
    }
};

template <class Epi> __device__ __forceinline__ void run_gemm(LAS unsigned char* lds, const bf16_t* A, const bf16_t* Bt, int M, int N, int K, const Epi& E) {
    pg8::Gemm g; g.A = A; g.Bt = Bt; g.M = M; g.N = N; g.K = K; g.Klen = K;
    pg8::StaticOrder S; S.init(M, N, (int)gridDim.x, (int)blockIdx.x);
    pg8::gemm_phase<Epi, pg8::StaticOrder, false>(lds, g, S, E, nullptr);
}
struct SplitOrderK {
    int nN, G, c, klen, ns, kbase, ksoff;
    __device__ __forceinline__ bool next(int i, Unit& u) const { const int L = i * G + c; if (L >= 4 * ns * nN) return false;
        const int sp = L % ns, tile = L / ns; u.ks = ksoff + sp; u.pn = tile % nN; u.pm = 32 + tile / nN; u.koff = kbase + sp * klen; return true; }
    __device__ __forceinline__ void a_ready(const Unit&) const {}
    __device__ __forceinline__ void done(const Unit&) const {}
};
struct EpiPart {
    static constexpr bool PERM = true, AFTER_DRAIN = false;
    bf16_t* part;
    __device__ __forceinline__ void operator()(const f32x4 (&acc)[2][2][4][2], const Unit& u, int wr, int wc, int fr, int fq) const {
        const int row0 = (u.pm - 32) * 256 + wr * 64 + fr, col0 = u.pn * 256 + wc * 32 + 8 * fq; bf16_t* pb = part + (size_t)u.ks * MS * DM;
#pragma unroll
        for (int ai = 0; ai < 2; ++ai)
#pragma unroll
            for (int m = 0; m < 4; ++m) { bf16_t* op = pb + (size_t)(row0 + ai * 128 + m * 16) * DM + col0;
#pragma unroll
                for (int bj = 0; bj < 2; ++bj) { const f32x4 v0 = acc[ai][bj][m][0], v1 = acc[ai][bj][m][1];
                    u32x4 w; w.x = pk2(v0[0], v0[1]); w.y = pk2(v0[2], v0[3]); w.z = pk2(v1[0], v1[1]); w.w = pk2(v1[2], v1[3]); *(u32x4*)(op + bj * 128) = w; } }
    }
};
__device__ __forceinline__ void run_split(LAS unsigned char* lds, const bf16_t* A, const bf16_t* Bt, int K, bf16_t* part, int ns, int klen, int kbase, int ksoff, int c) {
    pg8::Gemm g; g.A = A; g.Bt = Bt; g.M = MT; g.N = DM; g.K = K; g.Klen = klen;
    SplitOrderK S; S.nN = DM / 256; S.G = (int)gridDim.x; S.c = c; S.klen = klen; S.ns = ns; S.kbase = kbase; S.ksoff = ksoff;
    EpiPart P; P.part = part;
    pg8::gemm_phase<EpiPart, SplitOrderK, false>(lds, g, S, P, nullptr);
}
template <class Epi> __device__ __forceinline__ void run_gemm_n2048(LAS unsigned char* lds, const bf16_t* A, const bf16_t* Bt, int K, const Epi& E, bf16_t* part) {
    run_gemm(lds, A, Bt, MP, DM, K, E);
    run_split(lds, A, Bt, K, part, 8, K / 8, 0, 0, (int)blockIdx.x);
}

__device__ __forceinline__ void transpose_item(const float* W, int N, bf16_t* WT, int K, int k0, int n0_dst, int n0_src, int nvalid, LAS float* scr, int lane) {
    if (nvalid == 32) {
        const int c4 = (lane & 7) * 4, kr = lane >> 3; f32x4 v[8];
#pragma unroll
        for (int i = 0; i < 8; ++i) v[i] = ldnt((const f32x4*)(W + (size_t)(k0 + 8 * i + kr) * N + n0_src + c4));
#pragma unroll
        for (int i = 0; i < 8; ++i) { LAS float* d = scr + (8 * i + kr) * 33 + c4; d[0] = v[i][0]; d[1] = v[i][1]; d[2] = v[i][2]; d[3] = v[i][3]; }
    } else {
        const int j = lane & 31;
#pragma unroll 8
        for (int i = 0; i < 32; ++i) { const int kk = 2 * i + (lane >> 5); scr[kk * 33 + j] = (j < nvalid) ? ldnt(W + (size_t)(k0 + kk) * N + n0_src + j) : 0.f; }
    }
    lds_wait();
    const int c = lane & 7;
#pragma unroll
    for (int q = 0; q < 4; ++q) { const int n = (lane >> 3) + 8 * q; const LAS float* s = scr + (8 * c) * 33 + n;
        u32x4 o; o.x = pk2(s[0 * 33], s[1 * 33]); o.y = pk2(s[2 * 33], s[3 * 33]); o.z = pk2(s[4 * 33], s[5 * 33]); o.w = pk2(s[6 * 33], s[7 * 33]);
        *(u32x4*)(WT + (size_t)(n0_dst + n) * K + k0 + 8 * c) = o; }
    lds_wait();
}
struct Row8 { f32x4 v[8]; };
__device__ __forceinline__ void row_load_nt(Row8& a, const float* src, int lane) { const f32x4* sm = row_mid(src, lane);
#pragma unroll
    for (int j = 0; j < 8; ++j) a.v[j] = ldnt(sm + 64 * (j - 4)); }
__device__ __forceinline__ void row_load(Row8& a, const float* src, int lane) { const f32x4* sm = row_mid(src, lane);
#pragma unroll
    for (int j = 0; j < 8; ++j) a.v[j] = sm[64 * (j - 4)]; }
__device__ __forceinline__ void rms_finish_bf16(const Row8& a, const float* gain, bf16_t* dst, int lane) {
    float s = 0.f;
#pragma unroll
    for (int j = 0; j < 8; ++j) s += (a.v[j][0] * a.v[j][0] + a.v[j][1] * a.v[j][1]) + (a.v[j][2] * a.v[j][2] + a.v[j][3] * a.v[j][3]);
    const float rinv = rsqrtf(wave_sum(s) * (1.f / DM) + 1e-6f);
    const f32x4* gm = row_mid(gain, lane); u32x2* dm = (u32x2*)dst + lane;
#pragma unroll
    for (int j = 0; j < 8; ++j) { const f32x4 g = gm[64 * (j - 4)]; u32x2 o; o.x = pk2(a.v[j][0] * rinv * g[0], a.v[j][1] * rinv * g[1]); o.y = pk2(a.v[j][2] * rinv * g[2], a.v[j][3] * rinv * g[3]);
        dm[64 * j] = o; }
}
__device__ __forceinline__ void rms_row_bf16(const float* src, const float* gain, bf16_t* dst, int lane) { Row8 a; row_load(a, src, lane); rms_finish_bf16(a, gain, dst, lane); }
namespace cv { constexpr int I_IN = (DM / 64) * (NINP / 32), I_OUT = (DM / 64) * (DM / 32), I_FI = (DM / 64) * (2 * DFF / 32), I_FO = (DFF / 64) * (DM / 32), I_PLE = (PLE / 64) * (DM / 32), I_GT = I_OUT;
    constexpr int E_IN = I_IN, E_OUT = E_IN + I_OUT, E_FI = E_OUT + I_FI, E_FO = E_FI + I_FO, E_PLE = E_FO + I_PLE, E_GT = E_PLE + I_GT; }
__device__ __forceinline__ void convert_range(const Params& p, LAS unsigned char* lds, int lo, int hi, int gw, int NGW) {
    const int tid = otid(), lane = tid & 63, wave = tid >> 6;
    LAS float* scr = (LAS float*)(lds + wave * 8448);
    bf16_t* win = (bf16_t*)(p.ws + OFF_WIN); bf16_t* wout = (bf16_t*)(p.ws + OFF_WOUT); bf16_t* wfi = (bf16_t*)(p.ws + OFF_WFI);
    bf16_t* wfo = (bf16_t*)(p.ws + OFF_WFO); bf16_t* wple = (bf16_t*)(p.ws + OFF_WPLE); bf16_t* wgt = (bf16_t*)(p.ws + OFF_WGT);
    for (int it = lo + gw; it < hi; it += NGW) {
        int r = it;
        if (r < cv::E_IN) { const int nblk = NINP / 32, kb = r / nblk, nb = r % nblk, n0d = nb * 32; int src, nv;
            if (n0d < 3072) { src = n0d; nv = 32; } else if (n0d < 5120) { src = n0d + 16; nv = 32; } else if (n0d == 5120) { src = 3072; nv = 16; } else { src = 0; nv = 0; }
            transpose_item(p.w_in, 5136, win, DM, kb * 64, n0d, src, nv, scr, lane); continue; }
        if (r < cv::E_OUT) { r -= cv::E_IN; const int nblk = DM / 32, kb = r / nblk, nb = r % nblk; transpose_item(p.w_out, DM, wout, DM, kb * 64, nb * 32, nb * 32, 32, scr, lane); continue; }
        if (r < cv::E_FI) { r -= cv::E_OUT; const int nblk = 2 * DFF / 32, kb = r / nblk, nb = r % nblk, n0d = nb * 32, jb = n0d >> 8, within = n0d & 255, up = within >> 7, j0 = jb * 128 + (within & 127);
            transpose_item(p.w_ffn_in, 2 * DFF, wfi, DM, kb * 64, n0d, up * DFF + j0, 32, scr, lane); continue; }
        if (r < cv::E_FO) { r -= cv::E_FI; const int nblk = DM / 32, kb = r / nblk, nb = r % nblk; transpose_item(p.w_ffn_out, DM, wfo, DFF, kb * 64, nb * 32, nb * 32, 32, scr, lane); continue; }
        if (r < cv::E_PLE) { r -= cv::E_FO; const int nblk = DM / 32, kb = r / nblk, nb = r % nblk; transpose_item(p.w_ple, DM, wple, PLE, kb * 64, nb * 32, nb * 32, 32, scr, lane); continue; }
        { r -= cv::E_PLE; const int nblk = DM / 32, kb = r / nblk, nb = r % nblk; transpose_item(p.w_ple_gate, DM, wgt, DM, kb * 64, nb * 32, nb * 32, 32, scr, lane); }
    }
}
__device__ __forceinline__ void phase0(const Params& p, LAS unsigned char* lds) {
    const int tid = otid(), lane = tid & 63, wave = tid >> 6;
    const int gw = blockIdx.x * 8 + wave, NGW = gridDim.x * 8;
    convert_range(p, lds, 0, cv::E_IN, gw, NGW);
    bf16_t* a0 = (bf16_t*)(p.ws + OFF_A0); bf16_t* pb = (bf16_t*)(p.ws + OFF_PB);
    for (int r = gw; r < MT; r += 2 * NGW) {
        const int r2 = r + NGW; const bool has2 = r2 < MT; const int q2 = has2 ? r2 : r;
        const float* x1 = r < MP ? p.x_prompt + (size_t)r * DM : p.x_sample + (size_t)(r - MP) * DM; const float* x2 = q2 < MP ? p.x_prompt + (size_t)q2 * DM : p.x_sample + (size_t)(q2 - MP) * DM;
        const float* p1 = r < MP ? p.p_prompt + (size_t)r * PLE : p.p_sample + (size_t)(r - MP) * PLE; const float* p2 = q2 < MP ? p.p_prompt + (size_t)q2 * PLE : p.p_sample + (size_t)(q2 - MP) * PLE;
        Row8 a, b; row_load_nt(a, x1, lane); row_load_nt(b, x2, lane);
        const f32x4 pv1 = ldnt((const f32x4*)p1 + lane), pv2 = ldnt((const f32x4*)p2 + lane);
        rms_finish_bf16(a, p.g_mix, a0 + (size_t)r * DM, lane);
        { u32x2 o; o.x = pk2(pv1[0], pv1[1]); o.y = pk2(pv1[2], pv1[3]); ((u32x2*)(pb + (size_t)r * PLE))[lane] = o; }
        if (has2) { rms_finish_bf16(b, p.g_mix, a0 + (size_t)r2 * DM, lane);
            u32x2 o; o.x = pk2(pv2[0], pv2[1]); o.y = pk2(pv2[2], pv2[3]); ((u32x2*)(pb + (size_t)r2 * PLE))[lane] = o; }
    }
}

__device__ __forceinline__ f32x16 mfma32(bf16x8 a, bf16x8 b, f32x16 c) { return __builtin_amdgcn_mfma_f32_32x32x16_bf16(a, b, c, 0, 0, 0); }
__device__ __forceinline__ void mma32(f32x16& acc, const LAS bf16_t* A, int lda, const LAS bf16_t* B, int ldb, int kk, int lane) {
    const int r = lane & 31, h = lane >> 5; const LAS bf16_t* ap = A + r * lda + 8 * h; const LAS bf16_t* bp = B + r * ldb + 8 * h;
    for (int k = 0; k < kk; k += 16) { const bf16x8 a = *(const LAS bf16x8*)(ap + k); const bf16x8 b = *(const LAS bf16x8*)(bp + k); acc = mfma32(a, b, acc); }
}
constexpr int LQ = 136, LS = 72;
constexpr int R_QE = 0, R_KLT = 17408, R_ATT = 35840, R_DEC = 45056, IMG_BYTES = 45568, R_VT = 45568, R_QM = 82432, R_KM = 99840, R_ALOW = 117248, R_GSUM = 121344, R_BMID = 123392;
constexpr int IMG_V4 = IMG_BYTES / 16;

__device__ __forceinline__ void gla_prep(const Params& p, LAS unsigned char* lds, int rb, int h, int T) {
    const int tid = otid(), lane = tid & 63, wave = tid >> 6;
    const bf16_t* Z = (const bf16_t*)(p.ws + OFF_Z); const float* alowg = (const float*)(p.ws + OFF_ALOW);
    LAS bf16_t* Qe = (LAS bf16_t*)(lds + R_QE); LAS bf16_t* Qm = (LAS bf16_t*)(lds + R_QM); LAS bf16_t* Km = (LAS bf16_t*)(lds + R_KM);
    LAS bf16_t* KlT = (LAS bf16_t*)(lds + R_KLT); LAS bf16_t* ATT = (LAS bf16_t*)(lds + R_ATT); LAS float* DEC = (LAS float*)(lds + R_DEC);
    LAS float* alowL = (LAS float*)(lds + R_ALOW); LAS float* gsum = (LAS float*)(lds + R_GSUM); LAS float* bmidL = (LAS float*)(lds + R_BMID);
    const int c = tid & 127, tg = tid >> 7;
    float wa[16];
#pragma unroll
    for (int j = 0; j < 16; ++j) wa[j] = p.w_a2[j * 512 + h * 128 + c];
    const float ba = p.b_a[h * 128 + c];
    for (int idx = tid; idx < 1024; idx += 512) { const int t = idx >> 4; alowL[idx] = (t < T) ? alowg[(size_t)(rb + t) * 16 + (idx & 15)] : 0.f; }
    { const int row = tid >> 3, cs = (tid & 7) * 16; const bool ok = row < T; const bf16_t* zr = Z + (size_t)(rb + row) * NZ + h * 128 + cs; const u32x4 z4 = (u32x4){0u, 0u, 0u, 0u};
        const u32x4 q0 = ok ? *(const u32x4*)zr : z4, q1 = ok ? *(const u32x4*)(zr + 8) : z4, k0 = ok ? *(const u32x4*)(zr + 512) : z4, k1 = ok ? *(const u32x4*)(zr + 520) : z4;
        *(LAS u32x4*)(Qm + row * LQ + cs) = q0; *(LAS u32x4*)(Qm + row * LQ + cs + 8) = q1; *(LAS u32x4*)(Km + row * LQ + cs) = k0; *(LAS u32x4*)(Km + row * LQ + cs + 8) = k1; }
    __syncthreads();
    float qv[16], kv[16];
#pragma unroll
    for (int i = 0; i < 16; ++i) { const int t = tg * 16 + i; qv[i] = bf2f(Qm[t * LQ + c]); kv[i] = bf2f(Km[t * LQ + c]); }
    float b[16]; float run = 0.f;
#pragma unroll
    for (int i = 0; i < 16; ++i) { const int t = tg * 16 + i; float pre = ba;
#pragma unroll
        for (int j4 = 0; j4 < 4; ++j4) { const f32x4 a4 = *(const LAS f32x4*)(alowL + t * 16 + j4 * 4); pre += a4[0] * wa[j4 * 4] + a4[1] * wa[j4 * 4 + 1] + a4[2] * wa[j4 * 4 + 2] + a4[3] * wa[j4 * 4 + 3]; }
        const float la = (t < T) ? logsigmoid_f(pre) * 0.0625f : 0.f; run += la; b[i] = run; }
    gsum[tg * 128 + c] = run;
    __syncthreads();
    const float g0 = gsum[c], g1 = gsum[128 + c], g2 = gsum[256 + c], g3 = gsum[384 + c];
    const float pref = tg == 0 ? 0.f : (tg == 1 ? g0 : (tg == 2 ? g0 + g1 : g0 + g1 + g2));
    const float blast = ((g0 + g1) + g2) + g3;
#pragma unroll
    for (int i = 0; i < 16; ++i) b[i] += pref;
    if (tg == 2) bmidL[c] = b[0];
    if (tg == 0) DEC[c] = __expf(blast);
    __syncthreads();
    const float bm = bmidL[c];
    {
        unsigned klp[8];
#pragma unroll
        for (int i = 0; i < 16; i += 2) {
            const int t = tg * 16 + i;
            Qe[t * LQ + c] = f2bf(qv[i] * __expf(b[i])); Qe[(t + 1) * LQ + c] = f2bf(qv[i + 1] * __expf(b[i + 1]));
            Qm[t * LQ + c] = f2bf(qv[i] * __expf(b[i] - bm)); Qm[(t + 1) * LQ + c] = f2bf(qv[i + 1] * __expf(b[i + 1] - bm));
            Km[t * LQ + c] = f2bf(kv[i] * __expf(bm - b[i])); Km[(t + 1) * LQ + c] = f2bf(kv[i + 1] * __expf(bm - b[i + 1]));
            klp[i >> 1] = pk2(kv[i] * __expf(blast - b[i]), kv[i + 1] * __expf(blast - b[i + 1]));
        }
        LAS u32x4* kd = (LAS u32x4*)(KlT + c * LS + tg * 16);
        kd[0] = (u32x4){klp[0], klp[1], klp[2], klp[3]}; kd[1] = (u32x4){klp[4], klp[5], klp[6], klp[7]};
    }
    __syncthreads();
    if (wave < 3) {
        const int si = wave >> 1, ti = wave == 0 ? 0 : 1, l31 = lane & 31, hh = lane >> 5;
        f32x16 o;
#pragma unroll
        for (int i = 0; i < 16; ++i) o[i] = 0.f;
        mma32(o, Km + si * 32 * LQ, LQ, Qm + ti * 32 * LQ, LQ, 128, lane);
        const int tl = ti * 32 + l31;
#pragma unroll
        for (int g = 0; g < 4; ++g) { const int s0 = si * 32 + 8 * g + 4 * hh; float a0 = o[4 * g], a1 = o[4 * g + 1], a2 = o[4 * g + 2], a3 = o[4 * g + 3];
            a0 = (s0 <= tl) ? a0 : 0.f; a1 = (s0 + 1 <= tl) ? a1 : 0.f; a2 = (s0 + 2 <= tl) ? a2 : 0.f; a3 = (s0 + 3 <= tl) ? a3 : 0.f;
            u32x2 w; w.x = pk2(a0, a1); w.y = pk2(a2, a3); *(LAS u32x2*)(ATT + tl * LS + s0) = w; }
    }
    __syncthreads();
}
struct VRegs { u32x4 r[4]; };
__device__ __forceinline__ void v_load(const Params& p, VRegs& v, int rb, int h, int T) {
    const int tid = otid(), s = tid & 63, vg = tid >> 6; const bf16_t* Z = (const bf16_t*)(p.ws + OFF_Z);
#pragma unroll
    for (int k = 0; k < 4; ++k) v.r[k] = (s < T) ? *(const u32x4*)(Z + (size_t)(rb + s) * NZ + 1024 + h * 256 + vg * 32 + 8 * k) : (u32x4){0u, 0u, 0u, 0u};
}
__device__ __forceinline__ void v_store_t(LAS unsigned char* lds, const VRegs& v) {
    const int tid = otid(), s = tid & 63, vg = tid >> 6; LAS bf16_t* VT = (LAS bf16_t*)(lds + R_VT) + (vg * 32) * LS + s;
#pragma unroll
    for (int k = 0; k < 4; ++k) {
        VT[(8 * k + 0) * LS] = (bf16_t)(v.r[k].x & 0xffffu); VT[(8 * k + 1) * LS] = (bf16_t)(v.r[k].x >> 16);
        VT[(8 * k + 2) * LS] = (bf16_t)(v.r[k].y & 0xffffu); VT[(8 * k + 3) * LS] = (bf16_t)(v.r[k].y >> 16);
        VT[(8 * k + 4) * LS] = (bf16_t)(v.r[k].z & 0xffffu); VT[(8 * k + 5) * LS] = (bf16_t)(v.r[k].z >> 16);
        VT[(8 * k + 6) * LS] = (bf16_t)(v.r[k].w & 0xffffu); VT[(8 * k + 7) * LS] = (bf16_t)(v.r[k].w >> 16); }
}
__device__ __forceinline__ void gla_step(const Params& p, LAS unsigned char* lds, f32x16 (&S)[4], int rb, int h, int T, int vb, int vtrow) {
    const int lane = otid() & 63, l31 = lane & 31, hh = lane >> 5;
    LAS bf16_t* Qe = (LAS bf16_t*)(lds + R_QE); LAS bf16_t* KlT = (LAS bf16_t*)(lds + R_KLT); LAS bf16_t* ATT = (LAS bf16_t*)(lds + R_ATT); LAS float* DEC = (LAS float*)(lds + R_DEC);
    LAS bf16_t* VT = (LAS bf16_t*)(lds + R_VT);
    bf16_t* oraw = (bf16_t*)(p.ws + OFF_ORAW);
    f32x16 Za[2], Zb[2];
#pragma unroll
    for (int tt = 0; tt < 2; ++tt)
#pragma unroll
        for (int i = 0; i < 16; ++i) { Za[tt][i] = 0.f; Zb[tt][i] = 0.f; }
    bf16x8 sa[4][2];
#pragma unroll
    for (int cb = 0; cb < 4; ++cb)
#pragma unroll
        for (int s = 0; s < 2; ++s) { u32x4 aw; aw.x = pk2(S[cb][8 * s], S[cb][8 * s + 1]); aw.y = pk2(S[cb][8 * s + 2], S[cb][8 * s + 3]); aw.z = pk2(S[cb][8 * s + 4], S[cb][8 * s + 5]); aw.w = pk2(S[cb][8 * s + 6], S[cb][8 * s + 7]);
            sa[cb][s] = __builtin_bit_cast(bf16x8, aw); }
    bf16x8 vt[4];
    const LAS bf16_t* vp = VT + (vtrow + l31) * LS + 8 * hh;
#pragma unroll
    for (int ks = 0; ks < 4; ++ks) vt[ks] = *(const LAS bf16x8*)(vp + 16 * ks);
#pragma unroll
    for (int cb = 0; cb < 4; ++cb)
#pragma unroll
        for (int g = 0; g < 4; ++g) { const f32x4 d = *(const LAS f32x4*)(DEC + cb * 32 + 8 * g + 4 * hh);
            S[cb][4 * g] *= d[0]; S[cb][4 * g + 1] *= d[1]; S[cb][4 * g + 2] *= d[2]; S[cb][4 * g + 3] *= d[3]; }
#pragma unroll
    for (int ks = 0; ks < 4; ++ks)
#pragma unroll
        for (int cb = 0; cb < 4; ++cb) { const bf16x8 a = *(const LAS bf16x8*)(KlT + (32 * cb + l31) * LS + 16 * ks + 8 * hh); S[cb] = mfma32(a, vt[ks], S[cb]); }
#pragma unroll
    for (int cb = 0; cb < 4; ++cb)
#pragma unroll
        for (int s = 0; s < 2; ++s)
#pragma unroll
            for (int tt = 0; tt < 2; ++tt) { const LAS bf16_t* qp = Qe + (32 * tt + l31) * LQ + 32 * cb + 16 * s + 4 * hh;
                const u32x2 q0 = *(const LAS u32x2*)qp, q1 = *(const LAS u32x2*)(qp + 8); const u32x4 bw = (u32x4){q0.x, q0.y, q1.x, q1.y};
                Za[tt] = mfma32(sa[cb][s], __builtin_bit_cast(bf16x8, bw), Za[tt]); }
#pragma unroll
    for (int ks = 0; ks < 4; ++ks)
#pragma unroll
        for (int tt = 0; tt < 2; ++tt) if (ks < 2 * (tt + 1)) { const bf16x8 bq = *(const LAS bf16x8*)(ATT + (32 * tt + l31) * LS + 16 * ks + 8 * hh); Zb[tt] = mfma32(vt[ks], bq, Zb[tt]); }
#pragma unroll
    for (int tt = 0; tt < 2; ++tt) { const int t = 32 * tt + l31;
        if (t < T) { bf16_t* op = oraw + (size_t)(rb + t) * 1024 + h * 256 + 32 * vb + 4 * hh;
#pragma unroll
            for (int g = 0; g < 4; ++g) { u32x2 w; w.x = pk2(Za[tt][4 * g] + Zb[tt][4 * g], Za[tt][4 * g + 1] + Zb[tt][4 * g + 1]); w.y = pk2(Za[tt][4 * g + 2] + Zb[tt][4 * g + 2], Za[tt][4 * g + 3] + Zb[tt][4 * g + 3]); *(u32x2*)(op + 8 * g) = w; } } }
}
__device__ __forceinline__ size_t s_index(int cb, int i, int hh, int wave, int l31) { return (size_t)(cb * 32 + (i & 3) + 8 * (i >> 2) + 4 * hh) * 256 + 32 * wave + l31; }

__device__ __forceinline__ void gla_prep_item(const Params& p, LAS unsigned char* lds, int chain, int ch) {
    const int b = chain >> 2, h = chain & 3;
    gla_prep(p, lds, b * 2048 + ch * 64, h, 64);
    u32x4* img = (u32x4*)(p.ws + OFF_IMG + (size_t)(chain * 32 + ch) * IMG_BYTES);
    for (int i = otid(); i < IMG_V4; i += 512) img[i] = ((const LAS u32x4*)lds)[i];
    __syncthreads();
}
constexpr int SG_TAB = 0, SG_ALOW = 20480, SG_PART = 24576;
__device__ __forceinline__ void gla_sample_pair(const Params& p, LAS unsigned char* lds, int item) {
    const int tid = otid(), lane = tid & 63, wave = tid >> 6, q = wave & 3, grp = wave >> 2, chain = item * 2 + grp;
    const int b = chain >> 2, h = chain & 3, rb = MP + b * 8;
    LAS float* tab = (LAS float*)(lds + SG_TAB + wave * 2560); LAS float* alw = (LAS float*)(lds + SG_ALOW + wave * 512); LAS float* part = (LAS float*)(lds + SG_PART);
    const bf16_t* Z = (const bf16_t*)(p.ws + OFF_Z); const float* alowg = (const float*)(p.ws + OFF_ALOW); bf16_t* oraw = (bf16_t*)(p.ws + OFF_ORAW);
    alw[lane] = alowg[(size_t)rb * 16 + lane]; alw[lane + 64] = alowg[(size_t)rb * 16 + 64 + lane];
    float qe[8][2], kv[8][2]; f32x4 V[8];
#pragma unroll
    for (int t = 0; t < 8; ++t) { const bf16_t* zr = Z + (size_t)(rb + t) * NZ; const unsigned qw = *(const unsigned*)(zr + h * 128 + 2 * lane), kw = *(const unsigned*)(zr + 512 + h * 128 + 2 * lane);
        const u32x2 vw = *(const u32x2*)(zr + 1024 + h * 256 + 4 * lane);
        qe[t][0] = bflo(qw); qe[t][1] = bfhi(qw); kv[t][0] = bflo(kw); kv[t][1] = bfhi(kw); V[t] = (f32x4){bflo(vw.x), bfhi(vw.x), bflo(vw.y), bfhi(vw.y)}; }
    float bc[8][2];
    {   f32x2 wa[16];
#pragma unroll
        for (int j = 0; j < 16; ++j) wa[j] = *(const f32x2*)(p.w_a2 + j * 512 + h * 128 + 2 * lane);
        const f32x2 ba = *(const f32x2*)(p.b_a + h * 128 + 2 * lane);
        lds_wait();
        float run0 = 0.f, run1 = 0.f;
#pragma unroll
        for (int t = 0; t < 8; ++t) { float p0 = ba.x, p1 = ba.y;
#pragma unroll
            for (int j4 = 0; j4 < 4; ++j4) { const f32x4 a4 = *(const LAS f32x4*)(alw + t * 16 + 4 * j4);
#pragma unroll
                for (int k = 0; k < 4; ++k) { p0 += a4[k] * wa[4 * j4 + k].x; p1 += a4[k] * wa[4 * j4 + k].y; } }
            run0 += logsigmoid_f(p0) * 0.0625f; run1 += logsigmoid_f(p1) * 0.0625f; bc[t][0] = run0; bc[t][1] = run1; } }
    float ki[8][2];
#pragma unroll
    for (int t = 0; t < 8; ++t) { qe[t][0] *= __expf(bc[t][0]); qe[t][1] *= __expf(bc[t][1]); ki[t][0] = kv[t][0] * __expf(-bc[t][0]); ki[t][1] = kv[t][1] * __expf(-bc[t][1]); }
    lds_wait();
#pragma unroll
    for (int t = 0; t < 8; ++t)
#pragma unroll
        for (int s = 0; s <= t; ++s) { const float a = wave_sum(qe[t][0] * ki[s][0] + qe[t][1] * ki[s][1]); if (lane == 0) alw[t * (t + 1) / 2 + s] = a; }
    if ((lane >> 4) == q) { const float e0 = __expf(bc[7][0]), e1 = __expf(bc[7][1]); LAS float* r0 = tab + (2 * lane - 32 * q) * 20; LAS float* r1 = r0 + 20;
        *(LAS f32x4*)(r0) = (f32x4){qe[0][0], qe[1][0], qe[2][0], qe[3][0]}; *(LAS f32x4*)(r0 + 4) = (f32x4){qe[4][0], qe[5][0], qe[6][0], qe[7][0]};
        *(LAS f32x4*)(r1) = (f32x4){qe[0][1], qe[1][1], qe[2][1], qe[3][1]}; *(LAS f32x4*)(r1 + 4) = (f32x4){qe[4][1], qe[5][1], qe[6][1], qe[7][1]};
        *(LAS f32x4*)(r0 + 8) = (f32x4){ki[0][0] * e0, ki[1][0] * e0, ki[2][0] * e0, ki[3][0] * e0}; *(LAS f32x4*)(r0 + 12) = (f32x4){ki[4][0] * e0, ki[5][0] * e0, ki[6][0] * e0, ki[7][0] * e0};
        *(LAS f32x4*)(r1 + 8) = (f32x4){ki[0][1] * e1, ki[1][1] * e1, ki[2][1] * e1, ki[3][1] * e1}; *(LAS f32x4*)(r1 + 12) = (f32x4){ki[4][1] * e1, ki[5][1] * e1, ki[6][1] * e1, ki[7][1] * e1};
        r0[16] = e0; r1[16] = e1; }
    lds_wait();
    f32x4 o[8];
#pragma unroll
    for (int t = 0; t < 8; ++t) o[t] = (f32x4){0.f, 0.f, 0.f, 0.f};
    const f32x4* S0 = (const f32x4*)(p.state_gla + (size_t)chain * 32768 + (size_t)(32 * q) * 256) + lane; f32x4* So = (f32x4*)(p.out + OUT_SS + (size_t)chain * 32768 + (size_t)(32 * q) * 256) + lane;
#pragma unroll 1
    for (int cc = 0; cc < 32; cc += 16) { f32x4 s[16];
#pragma unroll
        for (int u = 0; u < 16; ++u) s[u] = ldnt(S0 + (cc + u) * 64);
#pragma unroll
        for (int u = 0; u < 16; ++u) { const LAS float* row = tab + (cc + u) * 20; const f32x4 qa = *(const LAS f32x4*)row, qb = *(const LAS f32x4*)(row + 4), ka = *(const LAS f32x4*)(row + 8), kb = *(const LAS f32x4*)(row + 12); const float d = row[16];
            o[0] += qa[0] * s[u]; o[1] += qa[1] * s[u]; o[2] += qa[2] * s[u]; o[3] += qa[3] * s[u]; o[4] += qb[0] * s[u]; o[5] += qb[1] * s[u]; o[6] += qb[2] * s[u]; o[7] += qb[3] * s[u];
            f32x4 sn = d * s[u]; sn += ka[0] * V[0]; sn += ka[1] * V[1]; sn += ka[2] * V[2]; sn += ka[3] * V[3]; sn += kb[0] * V[4]; sn += kb[1] * V[5]; sn += kb[2] * V[6]; sn += kb[3] * V[7];
            stnt(So + (cc + u) * 64, sn); } }
#pragma unroll
    for (int t = 0; t < 8; ++t) *(LAS f32x4*)(part + (wave * 8 + t) * 256 + 4 * lane) = o[t];
    __syncthreads();
#pragma unroll
    for (int tt = 0; tt < 2; ++tt) { const int t = 2 * q + tt; f32x4 acc = (f32x4){0.f, 0.f, 0.f, 0.f};
#pragma unroll
        for (int w = 0; w < 4; ++w) acc += *(const LAS f32x4*)(part + ((grp * 4 + w) * 8 + t) * 256 + 4 * lane);
#pragma unroll
        for (int s = 0; s < 8; ++s) { const float a = (s <= t) ? alw[t * (t + 1) / 2 + s] : 0.f; acc += a * V[s]; }
        { u32x2 w; w.x = pk2(acc[0], acc[1]); w.y = pk2(acc[2], acc[3]); *(u32x2*)(oraw + (size_t)(rb + t) * 1024 + h * 256 + 4 * lane) = w; } }
    __syncthreads();
}
struct VRegs2 { u32x4 r[2]; };
__device__ __forceinline__ void v_load_half(const Params& p, VRegs2& v, int rb, int h, int vhalf) {
    const int tid = otid(), s = tid & 63, vg = tid >> 6; const bf16_t* Z = (const bf16_t*)(p.ws + OFF_Z);
#pragma unroll
    for (int k = 0; k < 2; ++k) v.r[k] = *(const u32x4*)(Z + (size_t)(rb + s) * NZ + 1024 + h * 256 + vhalf * 128 + vg * 16 + 8 * k);
}
__device__ __forceinline__ void v_store_half_t(LAS unsigned char* lds, const VRegs2& v) {
    const int tid = otid(), s = tid & 63, vg = tid >> 6; LAS bf16_t* VT = (LAS bf16_t*)(lds + R_VT) + (vg * 16) * LS + s;
#pragma unroll
    for (int k = 0; k < 2; ++k) {
        VT[(8 * k + 0) * LS] = (bf16_t)(v.r[k].x & 0xffffu); VT[(8 * k + 1) * LS] = (bf16_t)(v.r[k].x >> 16);
        VT[(8 * k + 2) * LS] = (bf16_t)(v.r[k].y & 0xffffu); VT[(8 * k + 3) * LS] = (bf16_t)(v.r[k].y >> 16);
        VT[(8 * k + 4) * LS] = (bf16_t)(v.r[k].z & 0xffffu); VT[(8 * k + 5) * LS] = (bf16_t)(v.r[k].z >> 16);
        VT[(8 * k + 6) * LS] = (bf16_t)(v.r[k].w & 0xffffu); VT[(8 * k + 7) * LS] = (bf16_t)(v.r[k].w >> 16); }
}
constexpr int CH_BUF = 64000;
template <int NTHR> __device__ __forceinline__ void chain_stage(const Params& p, LAS unsigned char* buf, const u32x4* img, int rb, int h, int vhalf, int t) {
    const bf16_t* Z = (const bf16_t*)(p.ws + OFF_Z);
    constexpr int NI = (IMG_V4 + NTHR - 1) / NTHR, NV = 512 / NTHR;
    u32x4 im[NI], v0[NV], v1[NV];
#pragma unroll
    for (int k = 0; k < NI; ++k) { const int i = t + NTHR * k; im[k] = (i < IMG_V4) ? img[i] : (u32x4){0u, 0u, 0u, 0u}; }
#pragma unroll
    for (int k = 0; k < NV; ++k) { const int e = t + NTHR * k, s = e & 63, vg = e >> 6; const bf16_t* zp = Z + (size_t)(rb + s) * NZ + 1024 + h * 256 + vhalf * 128 + vg * 16; v0[k] = *(const u32x4*)zp; v1[k] = *(const u32x4*)(zp + 8); }
#pragma unroll
    for (int k = 0; k < NI; ++k) { const int i = t + NTHR * k; if (i < IMG_V4) ((LAS u32x4*)buf)[i] = im[k]; }
#pragma unroll
    for (int k = 0; k < NV; ++k) { const int e = t + NTHR * k, s = e & 63, vg = e >> 6; const u32x4 r0 = v0[k], r1 = v1[k];
        LAS bf16_t* VT = (LAS bf16_t*)(buf + R_VT) + (vg * 16) * LS + s;
        VT[0 * LS] = (bf16_t)(r0.x & 0xffffu); VT[1 * LS] = (bf16_t)(r0.x >> 16); VT[2 * LS] = (bf16_t)(r0.y & 0xffffu); VT[3 * LS] = (bf16_t)(r0.y >> 16);
        VT[4 * LS] = (bf16_t)(r0.z & 0xffffu); VT[5 * LS] = (bf16_t)(r0.z >> 16); VT[6 * LS] = (bf16_t)(r0.w & 0xffffu); VT[7 * LS] = (bf16_t)(r0.w >> 16);
        VT[8 * LS] = (bf16_t)(r1.x & 0xffffu); VT[9 * LS] = (bf16_t)(r1.x >> 16); VT[10 * LS] = (bf16_t)(r1.y & 0xffffu); VT[11 * LS] = (bf16_t)(r1.y >> 16);
        VT[12 * LS] = (bf16_t)(r1.z & 0xffffu); VT[13 * LS] = (bf16_t)(r1.z >> 16); VT[14 * LS] = (bf16_t)(r1.w & 0xffffu); VT[15 * LS] = (bf16_t)(r1.w >> 16); }
}
__device__ __forceinline__ void gla_chain_item(const Params& p, LAS unsigned char* lds, int chain, int vhalf) {
    const int tid = otid(), lane = tid & 63, wave = tid >> 6, l31 = lane & 31, hh = lane >> 5;
    const int b = chain >> 2, h = chain & 3, vb = vhalf * 4 + (wave & 3);
    f32x16 S[4];
#pragma unroll
    for (int cb = 0; cb < 4; ++cb)
#pragma unroll
        for (int i = 0; i < 16; ++i) S[cb][i] = 0.f;
    const u32x4* img = (const u32x4*)(p.ws + OFF_IMG + (size_t)(chain * 32) * IMG_BYTES);
    chain_stage<512>(p, lds, img, b * 2048, h, vhalf, tid);
    __syncthreads();
#pragma unroll 1
    for (int ch = 0; ch < 32; ++ch) {
        const int rb = b * 2048 + ch * 64;
        if (wave >= 4) { if (ch + 1 < 32) chain_stage<256>(p, lds + ((ch + 1) & 1) * CH_BUF, img + (size_t)(ch + 1) * IMG_V4, rb + 64, h, vhalf, tid - 256); }
        else gla_step(p, lds + (ch & 1) * CH_BUF, S, rb, h, 64, vb, 32 * wave);
        __syncthreads();
    }
    if (wave < 4) {
        float* Sout = p.out + OUT_SP + (size_t)chain * 32768;
#pragma unroll
        for (int cb = 0; cb < 4; ++cb)
#pragma unroll
            for (int i = 0; i < 16; ++i) Sout[s_index(cb, i, hh, vb, l31)] = S[cb][i];
    }
}

constexpr int M_W = 0, M_V = 34816, M_STAT = 69632;
__device__ __forceinline__ void gmlp_item(const Params& p, LAS unsigned char* lds, int rowbase, int T, int g, float* vs_out) {
    const int tid = otid(), lane = tid & 63, wave = tid >> 6;
    const bf16_t* Z = (const bf16_t*)(p.ws + OFF_Z); bf16_t* mraw = (bf16_t*)(p.ws + OFF_MRAW);
    LAS bf16_t* LW = (LAS bf16_t*)(lds + M_W); LAS bf16_t* LV = (LAS bf16_t*)(lds + M_V); LAS float* stat = (LAS float*)(lds + M_STAT);
    if (tid < 128) { const f32x2 st = (tid < T) ? *(const f32x2*)((const float*)(p.ws + OFF_STAT) + (size_t)(rowbase + tid) * 2) : (f32x2){0.f, 0.f}; stat[2 * tid] = st.x; stat[2 * tid + 1] = st.y; }
    for (int idx = tid; idx < 4096; idx += 512) { const int t = idx >> 5, s4 = (idx & 31) * 4; const f32x4 w = *(const f32x4*)(p.w_s + ((size_t)g * 128 + t) * 128 + s4);
        u32x2 o; o.x = pk2(s4 <= t ? w[0] : 0.f, s4 + 1 <= t ? w[1] : 0.f); o.y = pk2(s4 + 2 <= t ? w[2] : 0.f, s4 + 3 <= t ? w[3] : 0.f);
        *(LAS u32x2*)(LW + t * LQ + s4) = o; }
    __syncthreads();
    { const int s = tid & 127, dq = tid >> 7; const float mean = stat[2 * s], rstd = stat[2 * s + 1];
#pragma unroll
        for (int ps = 0; ps < 4; ++ps) { const int d8 = (dq * 4 + ps) * 8; float vn[8];
            if (s < T) { const u32x4 r = *(const u32x4*)(Z + (size_t)(rowbase + s) * NZ + 4096 + g * 128 + d8);
                const float x[8] = {bflo(r.x), bfhi(r.x), bflo(r.y), bfhi(r.y), bflo(r.z), bfhi(r.z), bflo(r.w), bfhi(r.w)};
                const f32x4 ga = *(const f32x4*)(p.g_gmlp_ln + g * 128 + d8), gb = *(const f32x4*)(p.g_gmlp_ln + g * 128 + d8 + 4);
                const f32x4 ba = *(const f32x4*)(p.b_gmlp_ln + g * 128 + d8), bb = *(const f32x4*)(p.b_gmlp_ln + g * 128 + d8 + 4);
#pragma unroll
                for (int j = 0; j < 4; ++j) { vn[j] = (x[j] - mean) * rstd * ga[j] + ba[j]; vn[4 + j] = (x[4 + j] - mean) * rstd * gb[j] + bb[j]; }
                if (vs_out) { float* vp = vs_out + (size_t)s * 1024 + g * 128 + d8; *(f32x4*)vp = (f32x4){vn[0], vn[1], vn[2], vn[3]}; *(f32x4*)(vp + 4) = (f32x4){vn[4], vn[5], vn[6], vn[7]}; }
            } else {
#pragma unroll
                for (int j = 0; j < 8; ++j) vn[j] = 0.f;
            }
#pragma unroll
            for (int j = 0; j < 8; ++j) LV[(d8 + j) * LQ + s] = f2bf(vn[j]); } }
    __syncthreads();
#pragma unroll 1
    for (int q = 0; q < 2; ++q) { const int id = wave * 2 + q, ti = id >> 2, di = id & 3;
        if (ti * 32 < T) { f32x16 acc;
#pragma unroll
            for (int i = 0; i < 16; ++i) acc[i] = 0.f;
            mma32(acc, LW + ti * 32 * LQ, LQ, LV + di * 32 * LQ, LQ, (ti + 1) * 32, lane);
            const int d = di * 32 + (lane & 31);
#pragma unroll
            for (int i = 0; i < 16; ++i) { const int t = ti * 32 + (i & 3) + 8 * (i >> 2) + 4 * (lane >> 5);
                if (t < T) { const float uval = bf2f(Z[(size_t)(rowbase + t) * NZ + 3072 + g * 128 + d]);
                    mraw[(size_t)(rowbase + t) * 1024 + g * 128 + d] = f2bf(uval * (acc[i] + p.b_s[g * 128 + t])); } } } }
    __syncthreads();
}

__device__ __forceinline__ void gmlp_sample_item(const Params& p, int b) {
    const int tid = otid(), d2 = tid * 2, g = __builtin_amdgcn_readfirstlane(tid >> 6), rb = MP + b * 8;
    const bf16_t* Z = (const bf16_t*)(p.ws + OFF_Z); bf16_t* mraw = (bf16_t*)(p.ws + OFF_MRAW); const float* st = (const float*)(p.ws + OFF_STAT) + (size_t)rb * 2;
    float* vs_out = p.out + OUT_VS + (size_t)b * 8 * 1024;
    const f32x2 ga = *(const f32x2*)(p.g_gmlp_ln + d2), be = *(const f32x2*)(p.b_gmlp_ln + d2);
    unsigned xv[8], uv[8];
#pragma unroll
    for (int s_ = 0; s_ < 8; ++s_) { xv[s_] = *(const unsigned*)(Z + (size_t)(rb + s_) * NZ + 4096 + d2); uv[s_] = *(const unsigned*)(Z + (size_t)(rb + s_) * NZ + 3072 + d2); }
    float v0[8], v1[8];
#pragma unroll
    for (int s_ = 0; s_ < 8; ++s_) { const float mean = st[2 * s_], rstd = st[2 * s_ + 1];
        v0[s_] = (bflo(xv[s_]) - mean) * rstd * ga.x + be.x; v1[s_] = (bfhi(xv[s_]) - mean) * rstd * ga.y + be.y;
        *(f32x2*)(vs_out + (size_t)s_ * 1024 + d2) = (f32x2){v0[s_], v1[s_]}; }
    const float* wg = p.w_s + (size_t)g * 128 * 128; const float* bs = p.b_s + g * 128;
#pragma unroll
    for (int t = 0; t < 8; ++t) { float m0 = bs[t], m1 = m0;
#pragma unroll
        for (int s_ = 0; s_ <= t; ++s_) { const float w = wg[t * 128 + s_]; m0 += w * v0[s_]; m1 += w * v1[s_]; }
        *(unsigned*)(mraw + (size_t)(rb + t) * 1024 + d2) = pk2(bflo(uv[t]) * m0, bfhi(uv[t]) * m1); }
}
__device__ __forceinline__ void phase2a(const Params& p, LAS unsigned char* lds) {
    {   const int tid = otid(), lane = tid & 63, gw = blockIdx.x * 8 + (tid >> 6), NGW = gridDim.x * 8;
        const bf16_t* Z = (const bf16_t*)(p.ws + OFF_Z); float* st = (float*)(p.ws + OFF_STAT);
        for (int r = gw; r < MT; r += NGW) {
            const bf16_t* zr = Z + (size_t)r * NZ + 4096; const u32x4 r0 = *(const u32x4*)(zr + lane * 8), r1 = *(const u32x4*)(zr + 512 + lane * 8);
            const float x[16] = {bflo(r0.x), bfhi(r0.x), bflo(r0.y), bfhi(r0.y), bflo(r0.z), bfhi(r0.z), bflo(r0.w), bfhi(r0.w), bflo(r1.x), bfhi(r1.x), bflo(r1.y), bfhi(r1.y), bflo(r1.z), bfhi(r1.z), bflo(r1.w), bfhi(r1.w)};
            float s = 0.f;
#pragma unroll
            for (int j = 0; j < 16; ++j) s += x[j];
            const float mean = wave_sum(s) * (1.f / 1024.f); float q = 0.f;
#pragma unroll
            for (int j = 0; j < 16; ++j) { const float d = x[j] - mean; q += d * d; }
            const float rstd = rsqrtf(wave_sum(q) * (1.f / 1024.f) + 1e-6f);
            if (lane == 0) *(f32x2*)(st + (size_t)r * 2) = (f32x2){mean, rstd};
        }
    }
    for (int j = blockIdx.x; j < 512; j += gridDim.x) gla_prep_item(p, lds, j >> 5, j & 31);
    for (int j = blockIdx.x; j < 256; j += gridDim.x) gla_sample_pair(p, lds, j);
    { const int gw = blockIdx.x * 8 + (otid() >> 6), NGW = gridDim.x * 8; convert_range(p, lds, cv::E_IN, cv::E_OUT, gw, NGW); convert_range(p, lds, cv::E_FO, cv::E_PLE, gw, NGW); }
}
__device__ __forceinline__ void phase2c(const Params& p, LAS unsigned char* lds) {
    const int nb = gridDim.x, bid = blockIdx.x;
    constexpr int NCH = 32, N_GP = 512, N_GS = 0, N_MS = 128;
    const int nlb = nb > 2 * NCH ? NCH : (nb > 1 ? nb / 2 : 0);
    if (bid < nlb || nlb == 0) { for (int j = (nlb ? bid : 0); j < NCH; j += (nlb ? nlb : 1)) gla_chain_item(p, lds, j >> 1, j & 1); }
    if (bid >= nlb) {
        const int ob = bid - nlb, onb = nb - nlb;
        for (int j = ob; j < N_GP + N_GS + N_MS; j += onb) {
            if (j < N_GP) gmlp_item(p, lds, (j >> 3) * 128, 128, j & 7, nullptr);
            else gmlp_sample_item(p, j - N_GP - N_GS);
        }
        __syncthreads();
        convert_range(p, lds, cv::E_OUT, cv::E_FI, ob * 8 + (otid() >> 6), onb * 8);
    }
}

struct Mix10 { f32x4 o[4], m[4]; u32x4 r0, r1; };
__device__ __forceinline__ void mix_load(Mix10& a, const Params& p, int r, int col) {
    const bf16_t* Z = (const bf16_t*)(p.ws + OFF_Z); const bf16_t* oraw = (const bf16_t*)(p.ws + OFF_ORAW); const bf16_t* mraw = (const bf16_t*)(p.ws + OFF_MRAW);
#pragma unroll
    for (int j = 0; j < 2; ++j) { const u32x4 ow = ldnt((const u32x4*)(oraw + (size_t)r * 1024 + col + 8 * j)), mw = ldnt((const u32x4*)(mraw + (size_t)r * 1024 + col + 8 * j));
        a.o[2 * j] = (f32x4){bflo(ow.x), bfhi(ow.x), bflo(ow.y), bfhi(ow.y)}; a.o[2 * j + 1] = (f32x4){bflo(ow.z), bfhi(ow.z), bflo(ow.w), bfhi(ow.w)};
        a.m[2 * j] = (f32x4){bflo(mw.x), bfhi(mw.x), bflo(mw.y), bfhi(mw.y)}; a.m[2 * j + 1] = (f32x4){bflo(mw.z), bfhi(mw.z), bflo(mw.w), bfhi(mw.w)}; }
    a.r0 = ldnt((const u32x4*)(Z + (size_t)r * NZ + 2048 + col)); a.r1 = ldnt((const u32x4*)(Z + (size_t)r * NZ + 2048 + col + 8));
}
__device__ __forceinline__ void mix_finish(const Mix10& a, const Params& p, int r, int col) {
    bf16_t* cat = (bf16_t*)(p.ws + OFF_A0);
    { float s = 0.f;
#pragma unroll
        for (int j = 0; j < 4; ++j) s += (a.o[j][0] * a.o[j][0] + a.o[j][1] * a.o[j][1]) + (a.o[j][2] * a.o[j][2] + a.o[j][3] * a.o[j][3]);
        s = row16_sum(s);
        const float rinv = rsqrtf(s * (1.f / 256.f) + 1e-6f);
        const float sr[16] = {bflo(a.r0.x), bfhi(a.r0.x), bflo(a.r0.y), bfhi(a.r0.y), bflo(a.r0.z), bfhi(a.r0.z), bflo(a.r0.w), bfhi(a.r0.w), bflo(a.r1.x), bfhi(a.r1.x), bflo(a.r1.y), bfhi(a.r1.y), bflo(a.r1.z), bfhi(a.r1.z), bflo(a.r1.w), bfhi(a.r1.w)};
        unsigned w[8];
#pragma unroll
        for (int j = 0; j < 4; ++j) { const f32x4 g = *(const f32x4*)(p.g_gla_norm + col + 4 * j);
            w[2 * j] = pk2(a.o[j][0] * rinv * g[0] * sr[4 * j], a.o[j][1] * rinv * g[1] * sr[4 * j + 1]); w[2 * j + 1] = pk2(a.o[j][2] * rinv * g[2] * sr[4 * j + 2], a.o[j][3] * rinv * g[3] * sr[4 * j + 3]); }
        u32x4* dp = (u32x4*)(cat + (size_t)r * DM + col); dp[0] = (u32x4){w[0], w[1], w[2], w[3]}; dp[1] = (u32x4){w[4], w[5], w[6], w[7]}; }
    { float s = 0.f;
#pragma unroll
        for (int j = 0; j < 4; ++j) s += (a.m[j][0] * a.m[j][0] + a.m[j][1] * a.m[j][1]) + (a.m[j][2] * a.m[j][2] + a.m[j][3] * a.m[j][3]);
        const float rinv = rsqrtf(wave_sum(s) * (1.f / 1024.f) + 1e-6f);
        unsigned w[8];
#pragma unroll
        for (int j = 0; j < 4; ++j) { const f32x4 g = *(const f32x4*)(p.g_gmlp_out + col + 4 * j);
            w[2 * j] = pk2(a.m[j][0] * rinv * g[0], a.m[j][1] * rinv * g[1]); w[2 * j + 1] = pk2(a.m[j][2] * rinv * g[2], a.m[j][3] * rinv * g[3]); }
        u32x4* dp = (u32x4*)(cat + (size_t)r * DM + 1024 + col); dp[0] = (u32x4){w[0], w[1], w[2], w[3]}; dp[1] = (u32x4){w[4], w[5], w[6], w[7]}; }
}
__device__ __forceinline__ void phase2b(const Params& p) {
    const int lane = otid() & 63, gw = blockIdx.x * 8 + (otid() >> 6), NGW = gridDim.x * 8, col = lane * 16;
    for (int r = gw; r < MT; r += 2 * NGW) {
        const int r2 = r + NGW; const bool has2 = r2 < MT;
        Mix10 a, b; mix_load(a, p, r, col); mix_load(b, p, has2 ? r2 : r, col);
        mix_finish(a, p, r, col);
        if (has2) mix_finish(b, p, r2, col);
    }
}
template <int NS> __device__ __forceinline__ void phase_norm(const Params& p, const float* gain, const float* base_s) {
    const int lane = otid() & 63, gw = blockIdx.x * 8 + (otid() >> 6), NGW = gridDim.x * 8; bf16_t* a0 = (bf16_t*)(p.ws + OFF_A0); const bf16_t* part = (const bf16_t*)(p.ws + OFF_IMG);
    for (int r = gw; r < MP; r += 4 * NGW) {
        const bool bal = NGW == 2048, low = gw < 1024;
        const int r2 = r + NGW, r3 = r + 2 * NGW, r4 = (bal && !low) ? r + 3 * NGW : r + 3 * NGW; const bool h2 = r2 < MP, h3 = r3 < MP, h4 = r4 < MP && !(bal && low);
        Row8 a, b, c4, d; row_load_nt(a, p.out + OUT_Y + (size_t)r * DM, lane); row_load_nt(b, p.out + OUT_Y + (size_t)(h2 ? r2 : r) * DM, lane);
        row_load_nt(c4, p.out + OUT_Y + (size_t)(h3 ? r3 : r) * DM, lane); row_load_nt(d, p.out + OUT_Y + (size_t)(h4 ? r4 : r) * DM, lane);
        rms_finish_bf16(a, gain, a0 + (size_t)r * DM, lane);
        if (h2) rms_finish_bf16(b, gain, a0 + (size_t)r2 * DM, lane);
        if (h3) rms_finish_bf16(c4, gain, a0 + (size_t)r3 * DM, lane);
        if (h4) rms_finish_bf16(d, gain, a0 + (size_t)r4 * DM, lane);
        if (bal && !low) { const int rx = (gw - 1024) + 3 * NGW; rms_row_bf16(p.out + OUT_Y + (size_t)rx * DM, gain, a0 + (size_t)rx * DM, lane); }
    }
    for (int r = MP + gw; r < MT; r += NGW) {
        f32x4 v[8]; float s = 0.f; const f32x4* sm = row_mid(base_s + (size_t)(r - MP) * DM, lane); const f32x4* gm = row_mid(gain, lane);
        const u32x2* pm0 = (const u32x2*)(part + (size_t)(r - MP) * DM) + lane; f32x4* om = row_mid(p.out + OUT_Y + (size_t)r * DM, lane);
#pragma unroll
        for (int j = 0; j < 8; ++j) v[j] = sm[64 * (j - 4)];
#pragma unroll 4
        for (int k = 0; k < NS; ++k) { const u32x2* pk = pm0 + (size_t)k * (MS * DM / 4);
#pragma unroll
            for (int j = 0; j < 8; ++j) v[j] += unpack4(pk[64 * j]); }
#pragma unroll
        for (int j = 0; j < 8; ++j) { om[64 * (j - 4)] = v[j]; s += (v[j][0] * v[j][0] + v[j][1] * v[j][1]) + (v[j][2] * v[j][2] + v[j][3] * v[j][3]); }
        const float rinv = rsqrtf(wave_sum(s) * (1.f / DM) + 1e-6f);
        u32x2* dm = (u32x2*)(a0 + (size_t)r * DM) + lane;
#pragma unroll
        for (int j = 0; j < 8; ++j) { const f32x4 g = gm[64 * (j - 4)]; u32x2 o; o.x = pk2(v[j][0] * rinv * g[0], v[j][1] * rinv * g[1]); o.y = pk2(v[j][2] * rinv * g[2], v[j][3] * rinv * g[3]);
            dm[64 * j] = o; }
    }
}
#define P7_TAIL() \
        float s = 0.f; \
        _Pragma("unroll") for (int j = 0; j < 8; ++j) s += (v.v[j][0] * v.v[j][0] + v.v[j][1] * v.v[j][1]) + (v.v[j][2] * v.v[j][2] + v.v[j][3] * v.v[j][3]); \
        const float rp = rsqrtf(wave_sum(s) * (1.f / DM) + 1e-6f); float s3 = 0.f; \
        const f32x4* gpm = row_mid(p.g_ple, lane); \
        _Pragma("unroll") for (int j = 0; j < 8; ++j) { const f32x4 g = gpm[64 * (j - 4)]; \
            _Pragma("unroll") for (int k = 0; k < 4; ++k) { const float h3 = hh.v[j][k] + v.v[j][k] * rp * g[k] * sigmoid_f(z.v[j][k]); v.v[j][k] = h3; s3 += h3 * h3; } } \
        const float r3 = rsqrtf(wave_sum(s3) * (1.f / DM) + 1e-6f); \
        const f32x4* gfm = row_mid(p.g_final, lane); \
        _Pragma("unroll") for (int j = 0; j < 8; ++j) { const f32x4 g = gfm[64 * (j - 4)]; stnt(om + 64 * (j - 4), (f32x4){v.v[j][0] * r3 * g[0], v.v[j][1] * r3 * g[1], v.v[j][2] * r3 * g[2], v.v[j][3] * r3 * g[3]}); }
__device__ __forceinline__ void phase7(const Params& p) {
    const int lane = otid() & 63, gw = blockIdx.x * 8 + (otid() >> 6), NGW = gridDim.x * 8;
    const bf16_t* gz = (const bf16_t*)(p.ws + OFF_GATEZ); const bf16_t* pz = (const bf16_t*)(p.ws + OFF_PZ);
    const bool bal7 = NGW == 2048, low7 = gw < 1024; const int nk7 = bal7 ? (low7 ? 3 : 5) : (MP - gw + NGW - 1) / NGW;
#pragma unroll 1
    for (int k7 = 0; k7 < nk7; ++k7) { const int r = (k7 < 4) ? gw + k7 * NGW : (gw - 1024) + 3 * NGW;
        f32x4* om = row_mid(p.out + OUT_Y + (size_t)r * DM, lane);
        const u32x2* pzr = (const u32x2*)(pz + (size_t)r * DM) + lane; const u32x2* zb = (const u32x2*)(gz + (size_t)r * DM) + lane;
        Row8 v, hh, z;
#pragma unroll
        for (int j = 0; j < 8; ++j) { const u32x2 w = ldnt(pzr + 64 * j), zw = ldnt(zb + 64 * j); v.v[j] = (f32x4){bflo(w.x), bfhi(w.x), bflo(w.y), bfhi(w.y)}; z.v[j] = (f32x4){bflo(zw.x), bfhi(zw.x), bflo(zw.y), bfhi(zw.y)}; hh.v[j] = ldnt(om + 64 * (j - 4)); }
        P7_TAIL()
    }
#pragma unroll 1
    for (int r = MP + gw; r < MT; r += NGW) {
        f32x4* om = row_mid(p.out + OUT_Y + (size_t)r * DM, lane);
        const u32x2* pzr = (const u32x2*)(pz + (size_t)r * DM) + lane; const u32x2* zm = (const u32x2*)((const bf16_t*)(p.ws + OFF_IMG) + (size_t)(r - MP) * DM) + lane;
        Row8 v, hh, z;
#pragma unroll
        for (int j = 0; j < 8; ++j) { const u32x2 w = ldnt(pzr + 64 * j); v.v[j] = unpack4(w); hh.v[j] = ldnt(om + 64 * (j - 4)); z.v[j] = (f32x4){0.f, 0.f, 0.f, 0.f}; }
#pragma unroll 4
        for (int k = 0; k < 8; ++k) { const u32x2* pk = zm + (size_t)k * (MS * DM / 4);
#pragma unroll
            for (int j = 0; j < 8; ++j) z.v[j] += unpack4(ldnt(pk + 64 * j)); }
        P7_TAIL()
    }
}
#undef P7_TAIL

__global__ void __launch_bounds__(512, 2) fwd_kernel(Params p) {
    extern __shared__ __attribute__((aligned(16))) unsigned char shm[];
    LAS unsigned char* lds = (LAS unsigned char*)shm;
    cg::grid_group grid = cg::this_grid();
    if (threadIdx.x == 0) { *(volatile LAS unsigned*)(lds + 131072) = 0u; *(volatile LAS unsigned*)(lds + 131076) = 0u; }
    __syncthreads();
    const XcdBarrier xb = xcd_barrier_post((unsigned*)(p.ws + OFF_BAR), (volatile LAS unsigned*)(lds + 131072));
    bf16_t* a0 = (bf16_t*)(p.ws + OFF_A0);
    phase0(p, lds);
    if (p.ws == nullptr) grid.sync();
    xcd_barrier(xb);
    { EpiIn E; E.Z = (bf16_t*)(p.ws + OFF_Z); E.alow = (float*)(p.ws + OFF_ALOW); run_gemm(lds, a0, (const bf16_t*)(p.ws + OFF_WIN), MT, NINP, DM, E); }
    xcd_barrier(xb);
    phase2a(p, lds);
    xcd_barrier(xb);
    phase2c(p, lds);
    xcd_barrier(xb);
    phase2b(p);
    xcd_barrier(xb);
    bf16_t* part = (bf16_t*)(p.ws + OFF_IMG);
    { EpiRes E; E.res_p = p.x_prompt; E.res_s = p.x_sample; E.out = p.out + OUT_Y; run_gemm_n2048(lds, a0, (const bf16_t*)(p.ws + OFF_WOUT), DM, E, part); }
    xcd_barrier(xb);
    phase_norm<8>(p, p.g_ffn, p.x_sample);
    xcd_barrier(xb);
    { EpiSwiglu E; E.act = (bf16_t*)(p.ws + OFF_ACT); run_gemm(lds, a0, (const bf16_t*)(p.ws + OFF_WFI), MT, 2 * DFF, DM, E); }
    {
        const int G = (int)gridDim.x, extra = ((MT / 256) * (2 * DFF / 256)) % G, cb = (int)blockIdx.x;
        if (extra == 0 || cb >= extra) { EpiBfN E; E.out = (bf16_t*)(p.ws + OFF_PZ); pg8::Gemm g; g.A = (const bf16_t*)(p.ws + OFF_PB); g.Bt = (const bf16_t*)(p.ws + OFF_WPLE); g.M = MT; g.N = DM; g.K = PLE; g.Klen = PLE;
            pg8::StaticOrder S; S.init(MT, DM, extra ? G - extra : G, extra ? cb - extra : cb); pg8::gemm_phase<EpiBfN, pg8::StaticOrder, false>(lds, g, S, E, nullptr);
            { const int ob = extra ? cb - extra : cb, onb = extra ? G - extra : G, gw = ob * 8 + (otid() >> 6); convert_range(p, lds, cv::E_FI, cv::E_FO, gw, onb * 8); convert_range(p, lds, cv::E_PLE, cv::E_GT, gw, onb * 8); } }
    }
    xcd_barrier(xb);
    { EpiRes E; E.res_p = p.out + OUT_Y; E.res_s = p.out + OUT_Y + (size_t)MP * DM; E.out = p.out + OUT_Y;
      const bf16_t* A = (const bf16_t*)(p.ws + OFF_ACT); const bf16_t* Bt = (const bf16_t*)(p.ws + OFF_WFO); const int G = (int)gridDim.x, hb = (int)((blockIdx.x + G / 2) % G);
      run_gemm(lds, A, Bt, MP, DM, DFF, E);
      run_split(lds, A, Bt, DFF, part, 4, 768, 0, 0, hb);
      run_split(lds, A, Bt, DFF, part, 4, 640, 3072, 4, (int)blockIdx.x); }
    xcd_barrier(xb);
    phase_norm<8>(p, p.g_ple_gate, p.out + OUT_Y + (size_t)MP * DM);
    xcd_barrier(xb);
    { EpiBfN E; E.out = (bf16_t*)(p.ws + OFF_GATEZ); run_gemm_n2048(lds, a0, (const bf16_t*)(p.ws + OFF_WGT), DM, E, part); }
    xcd_barrier(xb);
    phase7(p);
}

extern "C" void kernel_launch(void* const* d_in, const int* in_sizes, int n_in, void* d_out, int out_size, void* d_ws, size_t ws_size, hipStream_t stream) {
    static int grid = 0;
    if (grid == 0) {
        if (n_in != 24 || ws_size < WS_END) { fprintf(stderr, "kernel_launch: unexpected n_in %d or ws_size %zu (< %zu)\n", n_in, ws_size, (size_t)WS_END); grid = -1; return; }
        int dev = 0, cus = 0, per_cu = 0;
        if (hipGetDevice(&dev) != hipSuccess || hipDeviceGetAttribute(&cus, hipDeviceAttributeMultiprocessorCount, dev) != hipSuccess) { grid = -1; return; }
        if (hipFuncSetAttribute((const void*)fwd_kernel, hipFuncAttributeMaxDynamicSharedMemorySize, LDS_BYTES) != hipSuccess) { fprintf(stderr, "kernel_launch: hipFuncSetAttribute failed\n"); grid = -1; return; }
        if (hipOccupancyMaxActiveBlocksPerMultiprocessor(&per_cu, (const void*)fwd_kernel, 512, LDS_BYTES) != hipSuccess || per_cu < 1) { fprintf(stderr, "kernel_launch: occupancy query says %d blocks per CU\n", per_cu); grid = -1; (void)hipGetLastError(); return; }
        grid = cus;
    }
    if (grid < 0) return;
    if (hipMemsetAsync(d_ws, 0, XCD_BAR_WORDS * sizeof(unsigned), stream) != hipSuccess) { fprintf(stderr, "kernel_launch: memset failed\n"); return; }
    Params p{};
    const float** f = (const float**)&p;
    for (int i = 0; i < 24; ++i) f[i] = (const float*)d_in[i];
    p.out = (float*)d_out; p.ws = (unsigned char*)d_ws;
    void* args[] = {&p};
    hipError_t e = hipLaunchCooperativeKernel((const void*)fwd_kernel, dim3(grid), dim3(512), args, LDS_BYTES, stream);
    if (e != hipSuccess) fprintf(stderr, "cooperative launch failed: %s (grid %d)\n", hipGetErrorString(e), grid);
}
```

```cpp
#include <hip/hip_runtime.h>
#include <hip/hip_cooperative_groups.h>
#include <cstdio>
#include <cstdint>
namespace cg = cooperative_groups;
namespace pg8 {
#define PG8_LAS __attribute__((address_space(3)))
typedef unsigned short bf16_t;
typedef short bf16x8 __attribute__((ext_vector_type(8)));
typedef float f32x4 __attribute__((ext_vector_type(4)));
typedef unsigned u32x4 __attribute__((ext_vector_type(4)));
constexpr int BM = 256, BK = 64, HALF = 128, HTB = HALF * BK * 2  , STAGE_BYTES = 8 * HTB, NXCD = 8, WGM = 8;

__host__ __device__ __forceinline__ int lds_byte(int r, int c) { const int st = (r >> 4) * 2 + (c >> 5), rr = r & 15, cc = c & 31, ob = rr * 64 + cc * 2; return st * 1024 + (ob ^ (((ob >> 9) & 1) << 5)); }
__host__ __device__ __forceinline__ void stage_rc(int b, int& R, int& C) { const int st = b / 1024, sb = b % 1024, swz = sb ^ (((sb >> 9) & 1) << 5); R = (st >> 1) * 16 + swz / 64; C = (st & 1) * 32 + (swz % 64) / 2; }
__host__ __device__ __forceinline__ int perm32(int rho) { const int n = rho >> 4, i = rho & 15; return 8 * (i >> 2) + 4 * n + (i & 3); }

struct Unit { int pm, pn, ks, koff; };
struct Gemm { const bf16_t* A; const bf16_t* Bt; int M, N, K, Klen; };

struct StaticOrder {
    int nM, nN, nwg, G, c;
    __host__ __device__ void init(int M, int N, int G_, int c_) { nM = M / BM; nN = N / BM; nwg = nM * nN; G = G_; c = c_; }
    __host__ __device__ bool next(int i, Unit& u) const {
        const long L = (long)i * G + c; if (L >= nwg) return false;
        int wgid = (int)L; { const int q = nwg / NXCD, r = nwg % NXCD, xcd = wgid % NXCD, off = wgid / NXCD; wgid = (xcd < r ? xcd * (q + 1) : r * (q + 1) + (xcd - r) * q) + off; }
        const int nig = WGM * nN, gid = wgid / nig, fm = gid * WGM, gsz = (nM - fm) < WGM ? (nM - fm) : WGM;
        u.pm = fm + ((wgid % nig) % gsz); u.pn = (wgid % nig) / gsz; u.ks = 0; u.koff = 0; return true;
    }
    __device__ __forceinline__ void a_ready(const Unit&) const {}
    __device__ __forceinline__ void done(const Unit&) const {}
};
__device__ __forceinline__ unsigned cvt_pk_bf16(float lo, float hi) { unsigned r; asm volatile("v_cvt_pk_bf16_f32 %0, %1, %2" : "=v"(r) : "v"(lo), "v"(hi)); return r; }
typedef float f32x2 __attribute__((ext_vector_type(2)));
template <class Epi, class Sched, bool STAMP = false>
__device__ __forceinline__ void gemm_phase(PG8_LAS unsigned char* lds, const Gemm g, const Sched& S, const Epi& E, unsigned long long* stamps) {
    int tid_ = threadIdx.x; asm volatile("" : "+v"(tid_));
    const int tid = tid_, wid = __builtin_amdgcn_readfirstlane(tid >> 6), lane = tid & 63, wr = wid >> 2, wc = wid & 3, fr = lane & 15, fq = lane >> 4;
    const int K = g.K, nt = g.Klen / BK;
    int ts_lo = 0, ts_hi = 0, nts = 0; const unsigned long long rt_entry = STAMP ? (unsigned long long)wall_clock64() : 0ull;
#define PG8_STAMP() do { if (STAMP && wid == 0 && nts < 64) { const unsigned long long _c = (unsigned long long)clock64(); \
        ts_lo = (lane == nts) ? (int)(unsigned)_c : ts_lo; ts_hi = (lane == nts) ? (int)(unsigned)(_c >> 32) : ts_hi; ++nts; } } while (0)
    PG8_STAMP();
    unsigned voffA[2], voffB[2];
#pragma unroll
    for (int i = 0; i < 2; ++i) { int R, C; stage_rc(tid * 16 + i * 8192, R, C); const int Rb = Epi::PERM ? ((R & ~31) + perm32(R & 31)) : R;
        voffA[i] = (unsigned)(R * K + C) * 2u; voffB[i] = (unsigned)(Rb * K + C) * 2u; }
    const size_t kstep = (size_t)(BK * 2);
    const size_t hstep = (size_t)HALF * K * 2;
    const size_t tstep = 2 * hstep;
    const unsigned ldsw = (unsigned)wid * 1024u;
    const int aoff = lds_byte(wr * 64 + fr, fq * 8), boff = lds_byte(wc * 32 + fr, fq * 8);
#define PG8_SA(b, h) (((b) * 2 + (h)) * HTB)
#define PG8_SB(b, h) ((4 + (b) * 2 + (h)) * HTB)
#define PG8_STAGE(bufoff, gbase, voff) do { _Pragma("unroll") for (int _i = 0; _i < 2; ++_i) \
        __builtin_amdgcn_global_load_lds((const unsigned*)((const char*)(gbase) + (voff)[_i]), (PG8_LAS unsigned*)(lds + (bufoff) + ldsw + _i * 8192), 16, 0, 0); } while (0)
#define PG8_LDA(dst, b, h) do { _Pragma("unroll") for (int m = 0; m < 4; ++m) _Pragma("unroll") for (int k = 0; k < 2; ++k) dst[m][k] = *(const PG8_LAS bf16x8*)(lds + PG8_SA(b, h) + aoff + m * 2048 + k * 1024); } while (0)
#define PG8_LDB(dst, b, h) do { _Pragma("unroll") for (int n = 0; n < 2; ++n) _Pragma("unroll") for (int k = 0; k < 2; ++k) dst[n][k] = *(const PG8_LAS bf16x8*)(lds + PG8_SB(b, h) + boff + n * 2048 + k * 1024); } while (0)
#define PG8_MMA(ai, bj, At, Bt) do { __builtin_amdgcn_s_setprio(1); _Pragma("unroll") for (int m = 0; m < 4; ++m) _Pragma("unroll") for (int n = 0; n < 2; ++n) _Pragma("unroll") for (int k = 0; k < 2; ++k) \
        acc[ai][bj][m][n] = __builtin_amdgcn_mfma_f32_16x16x32_bf16(Bt[n][k], At[m][k], acc[ai][bj][m][n], 0, 0, 0); __builtin_amdgcn_s_setprio(0); } while (0)
#define PG8_WAIT_V(n) asm volatile("s_waitcnt vmcnt(" #n ")" ::: "memory")
#define PG8_WAIT_L(n) asm volatile("s_waitcnt lgkmcnt(" #n ")" ::: "memory")
#define PG8_BAR __builtin_amdgcn_s_barrier()
#define PG8_SCHED __builtin_amdgcn_sched_barrier(0)
    Unit cur, nxt; int ui = 0;
    if (!S.next(0, cur)) return;
    f32x4 acc[2][2][4][2];
#pragma unroll
    for (int a = 0; a < 2; ++a)
#pragma unroll
        for (int b = 0; b < 2; ++b)
#pragma unroll
            for (int m = 0; m < 4; ++m)
#pragma unroll
                for (int n = 0; n < 2; ++n) acc[a][b][m][n] = (f32x4){0.f, 0.f, 0.f, 0.f};
    bf16x8 At[4][2], B0[2][2], B1[2][2];
    const char* cA = (const char*)g.A + (size_t)cur.pm * tstep + (size_t)cur.koff * 2; const char* cB = (const char*)g.Bt + (size_t)cur.pn * tstep + (size_t)cur.koff * 2;
    S.a_ready(cur);
    PG8_STAGE(PG8_SB(0, 0), cB, voffB); PG8_STAGE(PG8_SB(0, 1), cB + hstep, voffB); PG8_STAGE(PG8_SA(0, 0), cA, voffA); PG8_STAGE(PG8_SA(0, 1), cA + hstep, voffA);
    if (wr == 1) PG8_BAR;
    PG8_WAIT_V(2); PG8_BAR;
    PG8_STAGE(PG8_SB(1, 0), cB + kstep, voffB); PG8_STAGE(PG8_SA(1, 0), cA + kstep, voffA); PG8_STAGE(PG8_SB(1, 1), cB + hstep + kstep, voffB);
    PG8_WAIT_V(6); PG8_BAR;
    PG8_STAMP();
    for (;;) {
        const bool has_next = S.next(ui + 1, nxt);
        const char* nA = has_next ? (const char*)g.A + (size_t)nxt.pm * tstep + (size_t)nxt.koff * 2 : cA; const char* nB = has_next ? (const char*)g.Bt + (size_t)nxt.pn * tstep + (size_t)nxt.koff * 2 : cB;
        for (int t = 0; t < nt; t += 2) {
            const bool last = (t == nt - 2);
            const char* a1 = cA + (size_t)(t + 1) * kstep;
            const char* a2 = last ? nA : cA + (size_t)(t + 2) * kstep; const char* b2 = last ? nB : cB + (size_t)(t + 2) * kstep;
            const char* a3 = a2 + kstep; const char* b3 = b2 + kstep;
            if (last && has_next) S.a_ready(nxt);
            PG8_LDB(B0, 0, 0); PG8_LDB(B1, 0, 1); PG8_SCHED; PG8_LDA(At, 0, 0); PG8_STAGE(PG8_SA(1, 1), a1 + hstep, voffA);
            PG8_WAIT_V(8); PG8_WAIT_L(0); PG8_BAR; PG8_MMA(0, 0, At, B0); PG8_MMA(0, 1, At, B1); PG8_BAR; PG8_SCHED;
            PG8_LDA(At, 0, 1); PG8_STAGE(PG8_SB(0, 0), b2, voffB); PG8_STAGE(PG8_SB(0, 1), b2 + hstep, voffB); PG8_STAGE(PG8_SA(0, 0), a2, voffA);
            PG8_WAIT_V(8); PG8_WAIT_L(0); PG8_BAR; PG8_MMA(1, 0, At, B0); PG8_MMA(1, 1, At, B1); PG8_BAR; PG8_SCHED;
            PG8_LDB(B0, 1, 0); PG8_LDB(B1, 1, 1); PG8_SCHED; PG8_LDA(At, 1, 0); PG8_STAGE(PG8_SA(0, 1), a2 + hstep, voffA);
            PG8_WAIT_V(8); PG8_WAIT_L(0); PG8_BAR; PG8_MMA(0, 0, At, B0); PG8_MMA(0, 1, At, B1); PG8_BAR; PG8_SCHED;
            PG8_LDA(At, 1, 1); PG8_STAGE(PG8_SB(1, 0), b3, voffB); PG8_STAGE(PG8_SB(1, 1), b3 + hstep, voffB); PG8_STAGE(PG8_SA(1, 0), a3, voffA);
            PG8_WAIT_V(8); PG8_WAIT_L(0); PG8_BAR; PG8_MMA(1, 0, At, B0); PG8_MMA(1, 1, At, B1); PG8_BAR; PG8_SCHED;
        }
        PG8_STAMP();
        if (wr == 0) PG8_BAR;
        if constexpr (!Epi::AFTER_DRAIN) { E(acc, cur, wr, wc, fr, fq); S.done(cur); }
        PG8_STAMP();
        if (!has_next) break;
#pragma unroll
        for (int a = 0; a < 2; ++a)
#pragma unroll
            for (int b = 0; b < 2; ++b)
#pragma unroll
                for (int m = 0; m < 4; ++m)
#pragma unroll
                    for (int n = 0; n < 2; ++n) acc[a][b][m][n] = (f32x4){0.f, 0.f, 0.f, 0.f};
        cur = nxt; cA = nA; cB = nB; ++ui;
        if (wr == 1) PG8_BAR;
    }
    PG8_WAIT_V(0);
    PG8_BAR;
    if constexpr (Epi::AFTER_DRAIN) { E.fused(acc, cur, wr, wc, fr, fq, lds, wid, lane); S.done(cur); }
    PG8_STAMP();
    if (STAMP && wid == 0) { stamps[lane] = lane < nts ? (((unsigned long long)(unsigned)ts_hi << 32) | (unsigned)ts_lo) : 0ull;
        if (lane == 62) stamps[62] = rt_entry; if (lane == 63) stamps[63] = (unsigned long long)wall_clock64(); }
#undef PG8_STAMP
#undef PG8_SA
#undef PG8_SB
#undef PG8_STAGE
#undef PG8_LDA
#undef PG8_LDB
#undef PG8_MMA
#undef PG8_WAIT_V
#undef PG8_WAIT_L
#undef PG8_BAR
#undef PG8_SCHED
}
}
#define LAS __attribute__((address_space(3)))
#define XB_TMO      128
#define XB_XCNT(j)  (256  + 64 * (j))
#define XB_XSUB(j)  (1280 + 64 * (j))
#define XB_XGEN(j)  (2304 + 64 * (j))
#define XB_TOP      3328
#define XB_TOPGEN   3392
#define XCD_BAR_WORDS 3456
#define XB_SPIN_CAP (1u << 18)

__device__ __forceinline__ unsigned xb_ld(unsigned* p)              { return __hip_atomic_load(p, __ATOMIC_RELAXED, __HIP_MEMORY_SCOPE_AGENT); }
__device__ __forceinline__ unsigned xb_add(unsigned* p, unsigned v) { return __hip_atomic_fetch_add(p, v, __ATOMIC_RELAXED, __HIP_MEMORY_SCOPE_AGENT); }
__device__ __forceinline__ unsigned xb_xcc_id() { return (unsigned)__builtin_amdgcn_s_getreg((3 << 11) | 20) & 0xFu; }
#define XB_SPIN(cond, bar) do { unsigned _sp = 0; while (cond) { __builtin_amdgcn_s_sleep(1); \
    if ((++_sp & 255u) == 0u) { if (xb_ld(&(bar)[XB_TMO])) break; if (_sp > XB_SPIN_CAP) { atomicAdd(&(bar)[XB_TMO], 1u); break; } } } } while (0)

struct XcdBarrier {
    unsigned* bar; unsigned x;
    volatile LAS unsigned* st;
};

__device__ __forceinline__ XcdBarrier xcd_barrier_post(unsigned* bar, volatile LAS unsigned* st) {
    XcdBarrier b; b.bar = bar; b.x = xb_xcc_id(); b.st = st;
    if (threadIdx.x == 0) (void)xb_add(&bar[XB_XCNT(b.x)], 1u);
    return b;
}
__device__ __forceinline__ void xcd_barrier_complete(unsigned* bar, unsigned x, unsigned& nloc, unsigned& nx) {
    const unsigned G = gridDim.x * gridDim.y * gridDim.z;
    unsigned sum, cnt, mine, sp = 0u;
    for (;;) {
        sum = 0u; cnt = 0u; mine = 0u;
#pragma unroll
        for (unsigned j = 0; j < 16; ++j) { const unsigned c = xb_ld(&bar[XB_XCNT(j)]); sum += c; cnt += (c > 0u) ? 1u : 0u; mine = (j == x) ? c : mine; }
        if (sum == G) break;
        __builtin_amdgcn_s_sleep(1);
        if ((++sp & 255u) == 0u) { if (xb_ld(&bar[XB_TMO])) break; if (sp > XB_SPIN_CAP) { atomicAdd(&bar[XB_TMO], 1u); break; } }
    }
    nloc = mine > 0u ? mine : 1u; nx = cnt > 0u ? cnt : 1u;
}

__device__ __forceinline__ void xcd_barrier(const XcdBarrier& b) {
    asm volatile("s_waitcnt vmcnt(0)" ::: "memory");
    __syncthreads();
    if (threadIdx.x == 0) {
        unsigned* bar = b.bar;
        __builtin_amdgcn_s_waitcnt(0);
        unsigned nloc = b.st[0], nx = b.st[1];
        if (nloc == 0u) { xcd_barrier_complete(bar, b.x, nloc, nx); b.st[0] = nloc; b.st[1] = nx; }
        const unsigned old = xb_add(&bar[XB_XSUB(b.x)], 1u);
        const unsigned gen = old / nloc;
        if (old + 1u == (gen + 1u) * nloc) {
            __builtin_amdgcn_fence(__ATOMIC_RELEASE, "agent");
            asm volatile("s_waitcnt vmcnt(0)" ::: "memory");
            const unsigned og = xb_add(&bar[XB_TOP], 1u);
            const unsigned tg = og / nx;
            if (og + 1u == (tg + 1u) * nx) xb_add(&bar[XB_TOPGEN], 1u);
            else XB_SPIN(xb_ld(&bar[XB_TOPGEN]) == tg, bar);
            __builtin_amdgcn_fence(__ATOMIC_ACQUIRE, "agent");
            xb_add(&bar[XB_XGEN(b.x)], 1u);
            asm volatile("s_waitcnt vmcnt(0)" ::: "memory");
        } else {
            XB_SPIN(xb_ld(&bar[XB_XGEN(b.x)]) == gen, bar);
            __builtin_amdgcn_fence(__ATOMIC_ACQUIRE, "agent");
            asm volatile("s_waitcnt vmcnt(0)" ::: "memory");
        }
    }
    __syncthreads();
}


using pg8::bf16_t; using pg8::bf16x8; using pg8::f32x4; using pg8::u32x4; using pg8::Unit;
typedef float f32x16 __attribute__((ext_vector_type(16)));
typedef unsigned u32x2 __attribute__((ext_vector_type(2)));
typedef float f32x2 __attribute__((ext_vector_type(2)));

constexpr int MP = 8192, MS = 1024, MT = 9216, DM = 2048, NZ = 5120, NINP = 5376, DFF = 5632, PLE = 256;
constexpr int LDS_BYTES = 131072 + 16;
constexpr size_t OFF_BAR = 0;
constexpr size_t OFF_WIN = 16384;
constexpr size_t OFF_WOUT = OFF_WIN + (size_t)NINP * DM * 2;
constexpr size_t OFF_WFI = OFF_WOUT + (size_t)DM * DM * 2;
constexpr size_t OFF_WFO = OFF_WFI + (size_t)2 * DFF * DM * 2;
constexpr size_t OFF_WPLE = OFF_WFO + (size_t)DM * DFF * 2;
constexpr size_t OFF_WGT = OFF_WPLE + (size_t)DM * PLE * 2;
constexpr size_t OFF_A0 = OFF_WGT + (size_t)DM * DM * 2;
constexpr size_t OFF_PB = OFF_A0 + (size_t)MT * DM * 2;
constexpr size_t OFF_ALOW = OFF_PB + (size_t)MT * PLE * 2;
constexpr size_t OFF_STAT = OFF_ALOW + (size_t)MT * 16 * 4;
constexpr size_t OFF_BIG = OFF_STAT + (size_t)MT * 2 * 4;
constexpr size_t OFF_Z = OFF_BIG;
constexpr size_t OFF_ORAW = OFF_Z + (size_t)MT * NZ * 2;
constexpr size_t OFF_MRAW = OFF_ORAW + (size_t)MT * 1024 * 4;
constexpr size_t OFF_IMG = OFF_BIG + (size_t)MT * DFF * 2 + (size_t)MT * DM * 4;
constexpr size_t WS_END = OFF_IMG + (size_t)4 * 1024 * 2048 * 4;
constexpr size_t OFF_ACT = OFF_BIG;
constexpr size_t OFF_GATEZ = OFF_BIG;
constexpr size_t OFF_PZ = OFF_BIG + (size_t)MT * DFF * 2;
constexpr size_t OUT_Y = 0, OUT_SP = (size_t)MT * DM, OUT_SS = OUT_SP + (size_t)4 * 4 * 128 * 256, OUT_VS = OUT_SS + (size_t)128 * 4 * 128 * 256;

struct Params {
    const float *x_prompt, *x_sample, *state_gla, *p_prompt, *p_sample, *g_mix, *w_in, *w_a2, *b_a, *g_gla_norm, *g_gmlp_ln, *b_gmlp_ln, *w_s, *b_s,
        *g_gmlp_out, *w_out, *g_ffn, *w_ffn_in, *w_ffn_out, *w_ple, *g_ple, *g_ple_gate, *w_ple_gate, *g_final;
    float* out;
    unsigned char* ws;
};

__device__ __forceinline__ unsigned pk2(float lo, float hi) { return pg8::cvt_pk_bf16(lo, hi); }
__device__ __forceinline__ bf16_t f2bf(float f) { return (bf16_t)(pk2(f, 0.f) & 0xffffu); }
__device__ __forceinline__ float bf2f(bf16_t b) { return __uint_as_float(((unsigned)b) << 16); }
__device__ __forceinline__ float bflo(unsigned w) { return __uint_as_float(w << 16); }
__device__ __forceinline__ float bfhi(unsigned w) { return __uint_as_float(w & 0xffff0000u); }
__device__ __forceinline__ f32x4 unpack4(u32x2 w) { return (f32x4){bflo(w.x), bfhi(w.x), bflo(w.y), bfhi(w.y)}; }
template <int CTRL> __device__ __forceinline__ float dpp_f(float v) { return __int_as_float(__builtin_amdgcn_update_dpp(0, __float_as_int(v), CTRL, 0xf, 0xf, true)); }
__device__ __forceinline__ float row16_sum(float v) {
    v += dpp_f<0xB1>(v); v += dpp_f<0x4E>(v); v += dpp_f<0x141>(v); v += dpp_f<0x140>(v); return v;
}
__device__ __forceinline__ float wave_sum(float v) {
    v = row16_sum(v);
    return (__int_as_float(__builtin_amdgcn_readlane(__float_as_int(v), 0)) + __int_as_float(__builtin_amdgcn_readlane(__float_as_int(v), 16))) + (__int_as_float(__builtin_amdgcn_readlane(__float_as_int(v), 32)) + __int_as_float(__builtin_amdgcn_readlane(__float_as_int(v), 48)));
}
__device__ __forceinline__ float sigmoid_f(float x) { return __builtin_amdgcn_rcpf(1.f + __expf(-x)); }
__device__ __forceinline__ float silu_f(float x) { return x * __builtin_amdgcn_rcpf(1.f + __expf(-x)); }
__device__ __forceinline__ float gelu_f(float x) { const float u = 1.5957691216f * (x + 0.044715f * x * x * x); return x * __builtin_amdgcn_rcpf(1.f + __expf(-u)); }
__device__ __forceinline__ float logsigmoid_f(float x) { return fminf(x, 0.f) - __logf(1.f + __expf(-fabsf(x))); }
template <class T> __device__ __forceinline__ T* opaque(T* p) { return p; }
__device__ __forceinline__ const f32x4* row_mid(const float* row, int lane) { return opaque((const f32x4*)row + lane + 256); }
__device__ __forceinline__ f32x4* row_mid(float* row, int lane) { return opaque((f32x4*)row + lane + 256); }
__device__ __forceinline__ int otid() { int t = threadIdx.x; asm volatile("" : "+v"(t)); return t; }
template <class T> __device__ __forceinline__ T ldnt(const T* p) { return __builtin_nontemporal_load(p); }
template <class T> __device__ __forceinline__ void stnt(T* p, T v) { __builtin_nontemporal_store(v, p); }
__device__ __forceinline__ void lds_wait() { asm volatile("s_waitcnt lgkmcnt(0)" ::: "memory"); }

struct EpiIn {
    static constexpr bool PERM = true, AFTER_DRAIN = false;
    bf16_t* Z; float* alow;
    __device__ __forceinline__ void operator()(const f32x4 (&acc)[2][2][4][2], const Unit& u, int wr, int wc, int fr, int fq) const {
        const int row0 = u.pm * 256 + wr * 64 + fr, pn = u.pn;
        if (pn == 20) {
            if (wc == 0 && fq < 2) {
#pragma unroll
                for (int ai = 0; ai < 2; ++ai)
#pragma unroll
                    for (int m = 0; m < 4; ++m) { float* p = alow + (size_t)(row0 + ai * 128 + m * 16) * 16 + 8 * fq; *(f32x4*)p = acc[ai][0][m][0]; *(f32x4*)(p + 4) = acc[ai][0][m][1]; }
            }
            return;
        }
        const int kind = pn < 8 ? 0 : (pn < 12 ? 1 : 2); const float qs = pn < 2 ? 0.08838834764831845f : 1.f;
#pragma unroll
        for (int ai = 0; ai < 2; ++ai)
#pragma unroll
            for (int m = 0; m < 4; ++m) { bf16_t* rowp = Z + (size_t)(row0 + ai * 128 + m * 16) * NZ + pn * 256 + wc * 32 + 8 * fq;
#pragma unroll
                for (int bj = 0; bj < 2; ++bj) { f32x4 v0 = acc[ai][bj][m][0], v1 = acc[ai][bj][m][1];
                    if (kind == 0) { v0 *= qs; v1 *= qs; }
                    else if (kind == 1) {
#pragma unroll
                        for (int j = 0; j < 4; ++j) { v0[j] = silu_f(v0[j]); v1[j] = silu_f(v1[j]); } }
                    else {
#pragma unroll
                        for (int j = 0; j < 4; ++j) { v0[j] = gelu_f(v0[j]); v1[j] = gelu_f(v1[j]); } }
                    u32x4 w; w.x = pk2(v0[0], v0[1]); w.y = pk2(v0[2], v0[3]); w.z = pk2(v1[0], v1[1]); w.w = pk2(v1[2], v1[3]);
                    *(u32x4*)(rowp + bj * 128) = w; } }
    }
};
struct EpiRes {
    static constexpr bool PERM = false, AFTER_DRAIN = false;
    const float* res_p; const float* res_s; float* out;
    __device__ __forceinline__ void operator()(const f32x4 (&acc)[2][2][4][2], const Unit& u, int wr, int wc, int fr, int fq) const {
        const int row0 = u.pm * 256 + wr * 64 + fr, col0 = u.pn * 256 + wc * 32 + 4 * fq;
#pragma unroll
        for (int ai = 0; ai < 2; ++ai)
#pragma unroll
            for (int m = 0; m < 4; ++m) { const int row = row0 + ai * 128 + m * 16;
                const float* rp = (row < MP ? res_p + (size_t)row * DM : res_s + (size_t)(row - MP) * DM) + col0; float* op = out + (size_t)row * DM + col0;
#pragma unroll
                for (int bj = 0; bj < 2; ++bj)
#pragma unroll
                    for (int n = 0; n < 2; ++n) { const f32x4 r = *(const f32x4*)(rp + bj * 128 + n * 16); *(f32x4*)(op + bj * 128 + n * 16) = acc[ai][bj][m][n] + r; } }
    }
};
struct EpiSwiglu {
    static constexpr bool PERM = true, AFTER_DRAIN = false;
    bf16_t* act;
    __device__ __forceinline__ void operator()(const f32x4 (&acc)[2][2][4][2], const Unit& u, int wr, int wc, int fr, int fq) const {
        const int row0 = u.pm * 256 + wr * 64 + fr, col0 = u.pn * 128 + wc * 32 + 8 * fq;
#pragma unroll
        for (int ai = 0; ai < 2; ++ai)
#pragma unroll
            for (int m = 0; m < 4; ++m) { float a[8];
#pragma unroll
                for (int n = 0; n < 2; ++n)
#pragma unroll
                    for (int j = 0; j < 4; ++j) a[n * 4 + j] = silu_f(acc[ai][0][m][n][j]) * acc[ai][1][m][n][j];
                u32x4 w; w.x = pk2(a[0], a[1]); w.y = pk2(a[2], a[3]); w.z = pk2(a[4], a[5]); w.w = pk2(a[6], a[7]);
                *(u32x4*)(act + (size_t)(row0 + ai * 128 + m * 16) * DFF + col0) = w; }
    }
};
struct EpiBfN {
    static constexpr bool PERM = true, AFTER_DRAIN = false;
    bf16_t* out;
    __device__ __forceinline__ void operator()(const f32x4 (&acc)[2][2][4][2], const Unit& u, int wr, int wc, int fr, int fq) const {
        const int row0 = u.pm * 256 + wr * 64 + fr, col0 = u.pn * 256 + wc * 32 + 8 * fq;
#pragma unroll
        for (int ai = 0; ai < 2; ++ai)
#pragma unroll
            for (int m = 0; m < 4; ++m) { bf16_t* op = out + (size_t)(row0 + ai * 128 + m * 16) * DM + col0;
#pragma unroll
                for (int bj = 0; bj < 2; ++bj) { const f32x4 v0 = acc[ai][bj][m][0], v1 = acc[ai][bj][m][1];
                    u32x4 w; w.x = pk2(v0[0], v0[1]); w.y = pk2(v0[2], v0[3]); w.z = pk2(v1[0], v1[1]); w.w = pk2(v1[2], v1[3]); *(u32x4*)(op + bj * 128) = w; } }
    }
};
struct EpiPlain {
    static constexpr bool PERM = false, AFTER_DRAIN = false;
    float* out;
    __device__ __forceinline__ void operator()(const f32x4 (&acc)[2][2][4][2], const Unit& u, int wr, int wc, int fr, int fq) const {
        const int row0 = u.pm * 256 + wr * 64 + fr, col0 = u.pn * 256 + wc * 32 + 4 * fq;
#pragma unroll
        for (int ai = 0; ai < 2; ++ai)
#pragma unroll
            for (int m = 0; m < 4; ++m) { float* op = out + (size_t)(row0 + ai * 128 + m * 16) * DM + col0;
#pragma unroll
                for (int bj = 0; bj < 2; ++bj)
#pragma unroll
                    for (int n = 0; n < 2; ++n) *(f32x4*)(op + bj * 128 + n * 16) = acc[ai][bj][m][n]; }
    }
};

template <class Epi> __device__ __forceinline__ void run_gemm(LAS unsigned char* lds, const bf16_t* A, const bf16_t* Bt, int M, int N, int K, const Epi& E) {
    pg8::Gemm g; g.A = A; g.Bt = Bt; g.M = M; g.N = N; g.K = K; g.Klen = K;
    pg8::StaticOrder S; S.init(M, N, (int)gridDim.x, (int)blockIdx.x);
    pg8::gemm_phase<Epi, pg8::StaticOrder, false>(lds, g, S, E, nullptr);
}
struct SplitOrderK {
    int nN, G, c, klen, ns, kbase, ksoff;
    __device__ __forceinline__ bool next(int i, Unit& u) const { const int L = i * G + c; if (L >= 4 * ns * nN) return false;
        const int sp = L % ns, tile = L / ns; u.ks = ksoff + sp; u.pn = tile % nN; u.pm = 32 + tile / nN; u.koff = kbase + sp * klen; return true; }
    __device__ __forceinline__ void a_ready(const Unit&) const {}
    __device__ __forceinline__ void done(const Unit&) const {}
};
struct EpiPart {
    static constexpr bool PERM = true, AFTER_DRAIN = false;
    bf16_t* part;
    __device__ __forceinline__ void operator()(const f32x4 (&acc)[2][2][4][2], const Unit& u, int wr, int wc, int fr, int fq) const {
        const int row0 = (u.pm - 32) * 256 + wr * 64 + fr, col0 = u.pn * 256 + wc * 32 + 8 * fq; bf16_t* pb = part + (size_t)u.ks * MS * DM;
#pragma unroll
        for (int ai = 0; ai < 2; ++ai)
#pragma unroll
            for (int m = 0; m < 4; ++m) { bf16_t* op = pb + (size_t)(row0 + ai * 128 + m * 16) * DM + col0;
#pragma unroll
                for (int bj = 0; bj < 2; ++bj) { const f32x4 v0 = acc[ai][bj][m][0], v1 = acc[ai][bj][m][1];
                    u32x4 w; w.x = pk2(v0[0], v0[1]); w.y = pk2(v0[2], v0[3]); w.z = pk2(v1[0], v1[1]); w.w = pk2(v1[2], v1[3]); *(u32x4*)(op + bj * 128) = w; } }
    }
};
__device__ __forceinline__ void run_split(LAS unsigned char* lds, const bf16_t* A, const bf16_t* Bt, int K, bf16_t* part, int ns, int klen, int kbase, int ksoff, int c) {
    pg8::Gemm g; g.A = A; g.Bt = Bt; g.M = MT; g.N = DM; g.K = K; g.Klen = klen;
    SplitOrderK S; S.nN = DM / 256; S.G = (int)gridDim.x; S.c = c; S.klen = klen; S.ns = ns; S.kbase = kbase; S.ksoff = ksoff;
    EpiPart P; P.part = part;
    pg8::gemm_phase<EpiPart, SplitOrderK, false>(lds, g, S, P, nullptr);
}
template <class Epi> __device__ __forceinline__ void run_gemm_n2048(LAS unsigned char* lds, const bf16_t* A, const bf16_t* Bt, int K, const Epi& E, bf16_t* part) {
    run_gemm(lds, A, Bt, MP, DM, K, E);
    run_split(lds, A, Bt, K, part, 8, K / 8, 0, 0, (int)blockIdx.x);
}

__device__ __forceinline__ void transpose_item(const float* W, int N, bf16_t* WT, int K, int k0, int n0_dst, int n0_src, int nvalid, LAS float* scr, int lane) {
    if (nvalid == 32) {
        const int c4 = (lane & 7) * 4, kr = lane >> 3; f32x4 v[8];
#pragma unroll
        for (int i = 0; i < 8; ++i) v[i] = ldnt((const f32x4*)(W + (size_t)(k0 + 8 * i + kr) * N + n0_src + c4));
#pragma unroll
        for (int i = 0; i < 8; ++i) { LAS float* d = scr + (8 * i + kr) * 33 + c4; d[0] = v[i][0]; d[1] = v[i][1]; d[2] = v[i][2]; d[3] = v[i][3]; }
    } else {
        const int j = lane & 31;
#pragma unroll 8
        for (int i = 0; i < 32; ++i) { const int kk = 2 * i + (lane >> 5); scr[kk * 33 + j] = (j < nvalid) ? ldnt(W + (size_t)(k0 + kk) * N + n0_src + j) : 0.f; }
    }
    lds_wait();
    const int c = lane & 7;
#pragma unroll
    for (int q = 0; q < 4; ++q) { const int n = (lane >> 3) + 8 * q; const LAS float* s = scr + (8 * c) * 33 + n;
        u32x4 o; o.x = pk2(s[0 * 33], s[1 * 33]); o.y = pk2(s[2 * 33], s[3 * 33]); o.z = pk2(s[4 * 33], s[5 * 33]); o.w = pk2(s[6 * 33], s[7 * 33]);
        *(u32x4*)(WT + (size_t)(n0_dst + n) * K + k0 + 8 * c) = o; }
    lds_wait();
}
struct Row8 { f32x4 v[8]; };
__device__ __forceinline__ void row_load_nt(Row8& a, const float* src, int lane) { const f32x4* sm = row_mid(src, lane);
#pragma unroll
    for (int j = 0; j < 8; ++j) a.v[j] = ldnt(sm + 64 * (j - 4)); }
__device__ __forceinline__ void row_load(Row8& a, const float* src, int lane) { const f32x4* sm = row_mid(src, lane);
#pragma unroll
    for (int j = 0; j < 8; ++j) a.v[j] = sm[64 * (j - 4)]; }
__device__ __forceinline__ void rms_finish_bf16(const Row8& a, const float* gain, bf16_t* dst, int lane) {
    float s = 0.f;
#pragma unroll
    for (int j = 0; j < 8; ++j) s += (a.v[j][0] * a.v[j][0] + a.v[j][1] * a.v[j][1]) + (a.v[j][2] * a.v[j][2] + a.v[j][3] * a.v[j][3]);
    const float rinv = rsqrtf(wave_sum(s) * (1.f / DM) + 1e-6f);
    const f32x4* gm = row_mid(gain, lane); u32x2* dm = (u32x2*)dst + lane;
#pragma unroll
    for (int j = 0; j < 8; ++j) { const f32x4 g = gm[64 * (j - 4)]; u32x2 o; o.x = pk2(a.v[j][0] * rinv * g[0], a.v[j][1] * rinv * g[1]); o.y = pk2(a.v[j][2] * rinv * g[2], a.v[j][3] * rinv * g[3]);
        dm[64 * j] = o; }
}
__device__ __forceinline__ void rms_row_bf16(const float* src, const float* gain, bf16_t* dst, int lane) { Row8 a; row_load(a, src, lane); rms_finish_bf16(a, gain, dst, lane); }
namespace cv { constexpr int I_IN = (DM / 64) * (NINP / 32), I_OUT = (DM / 64) * (DM / 32), I_FI = (DM / 64) * (2 * DFF / 32), I_FO = (DFF / 64) * (DM / 32), I_PLE = (PLE / 64) * (DM / 32), I_GT = I_OUT;
    constexpr int E_IN = I_IN, E_OUT = E_IN + I_OUT, E_FI = E_OUT + I_FI, E_FO = E_FI + I_FO, E_PLE = E_FO + I_PLE, E_GT = E_PLE + I_GT; }
__device__ __forceinline__ void convert_range(const Params& p, LAS unsigned char* lds, int lo, int hi, int gw, int NGW) {
    const int tid = otid(), lane = tid & 63, wave = tid >> 6;
    LAS float* scr = (LAS float*)(lds + wave * 8448);
    bf16_t* win = (bf16_t*)(p.ws + OFF_WIN); bf16_t* wout = (bf16_t*)(p.ws + OFF_WOUT); bf16_t* wfi = (bf16_t*)(p.ws + OFF_WFI);
    bf16_t* wfo = (bf16_t*)(p.ws + OFF_WFO); bf16_t* wple = (bf16_t*)(p.ws + OFF_WPLE); bf16_t* wgt = (bf16_t*)(p.ws + OFF_WGT);
    for (int it = lo + gw; it < hi; it += NGW) {
        int r = it;
        if (r < cv::E_IN) { const int nblk = NINP / 32, kb = r / nblk, nb = r % nblk, n0d = nb * 32; int src, nv;
            if (n0d < 3072) { src = n0d; nv = 32; } else if (n0d < 5120) { src = n0d + 16; nv = 32; } else if (n0d == 5120) { src = 3072; nv = 16; } else { src = 0; nv = 0; }
            transpose_item(p.w_in, 5136, win, DM, kb * 64, n0d, src, nv, scr, lane); continue; }
        if (r < cv::E_OUT) { r -= cv::E_IN; const int nblk = DM / 32, kb = r / nblk, nb = r % nblk; transpose_item(p.w_out, DM, wout, DM, kb * 64, nb * 32, nb * 32, 32, scr, lane); continue; }
        if (r < cv::E_FI) { r -= cv::E_OUT; const int nblk = 2 * DFF / 32, kb = r / nblk, nb = r % nblk, n0d = nb * 32, jb = n0d >> 8, within = n0d & 255, up = within >> 7, j0 = jb * 128 + (within & 127);
            transpose_item(p.w_ffn_in, 2 * DFF, wfi, DM, kb * 64, n0d, up * DFF + j0, 32, scr, lane); continue; }
        if (r < cv::E_FO) { r -= cv::E_FI; const int nblk = DM / 32, kb = r / nblk, nb = r % nblk; transpose_item(p.w_ffn_out, DM, wfo, DFF, kb * 64, nb * 32, nb * 32, 32, scr, lane); continue; }
        if (r < cv::E_PLE) { r -= cv::E_FO; const int nblk = DM / 32, kb = r / nblk, nb = r % nblk; transpose_item(p.w_ple, DM, wple, PLE, kb * 64, nb * 32, nb * 32, 32, scr, lane); continue; }
        { r -= cv::E_PLE; const int nblk = DM / 32, kb = r / nblk, nb = r % nblk; transpose_item(p.w_ple_gate, DM, wgt, DM, kb * 64, nb * 32, nb * 32, 32, scr, lane); }
    }
}
__device__ __forceinline__ void phase0(const Params& p, LAS unsigned char* lds) {
    const int tid = otid(), lane = tid & 63, wave = tid >> 6;
    const int gw = blockIdx.x * 8 + wave, NGW = gridDim.x * 8;
    convert_range(p, lds, 0, cv::E_IN, gw, NGW);
    bf16_t* a0 = (bf16_t*)(p.ws + OFF_A0); bf16_t* pb = (bf16_t*)(p.ws + OFF_PB);
    for (int r = gw; r < MT; r += 2 * NGW) {
        const int r2 = r + NGW; const bool has2 = r2 < MT; const int q2 = has2 ? r2 : r;
        const float* x1 = r < MP ? p.x_prompt + (size_t)r * DM : p.x_sample + (size_t)(r - MP) * DM; const float* x2 = q2 < MP ? p.x_prompt + (size_t)q2 * DM : p.x_sample + (size_t)(q2 - MP) * DM;
        const float* p1 = r < MP ? p.p_prompt + (size_t)r * PLE : p.p_sample + (size_t)(r - MP) * PLE; const float* p2 = q2 < MP ? p.p_prompt + (size_t)q2 * PLE : p.p_sample + (size_t)(q2 - MP) * PLE;
        Row8 a, b; row_load_nt(a, x1, lane); row_load_nt(b, x2, lane);
        const f32x4 pv1 = ldnt((const f32x4*)p1 + lane), pv2 = ldnt((const f32x4*)p2 + lane);
        rms_finish_bf16(a, p.g_mix, a0 + (size_t)r * DM, lane);
        { u32x2 o; o.x = pk2(pv1[0], pv1[1]); o.y = pk2(pv1[2], pv1[3]); ((u32x2*)(pb + (size_t)r * PLE))[lane] = o; }
        if (has2) { rms_finish_bf16(b, p.g_mix, a0 + (size_t)r2 * DM, lane);
            u32x2 o; o.x = pk2(pv2[0], pv2[1]); o.y = pk2(pv2[2], pv2[3]); ((u32x2*)(pb + (size_t)r2 * PLE))[lane] = o; }
    }
}

__device__ __forceinline__ f32x16 mfma32(bf16x8 a, bf16x8 b, f32x16 c) { return __builtin_amdgcn_mfma_f32_32x32x16_bf16(a, b, c, 0, 0, 0); }
__device__ __forceinline__ void mma32(f32x16& acc, const LAS bf16_t* A, int lda, const LAS bf16_t* B, int ldb, int kk, int lane) {
    const int r = lane & 31, h = lane >> 5; const LAS bf16_t* ap = A + r * lda + 8 * h; const LAS bf16_t* bp = B + r * ldb + 8 * h;
    for (int k = 0; k < kk; k += 16) { const bf16x8 a = *(const LAS bf16x8*)(ap + k); const bf16x8 b = *(const LAS bf16x8*)(bp + k); acc = mfma32(a, b, acc); }
}
constexpr int LQ = 136, LS = 72;
constexpr int R_QE = 0, R_KLT = 17408, R_ATT = 35840, R_DEC = 45056, IMG_BYTES = 45568, R_VT = 45568, R_QM = 82432, R_KM = 99840, R_ALOW = 117248, R_GSUM = 121344, R_BMID = 123392;
constexpr int IMG_V4 = IMG_BYTES / 16;

__device__ __forceinline__ void gla_prep(const Params& p, LAS unsigned char* lds, int rb, int h, int T) {
    const int tid = otid(), lane = tid & 63, wave = tid >> 6;
    const bf16_t* Z = (const bf16_t*)(p.ws + OFF_Z); const float* alowg = (const float*)(p.ws + OFF_ALOW);
    LAS bf16_t* Qe = (LAS bf16_t*)(lds + R_QE); LAS bf16_t* Qm = (LAS bf16_t*)(lds + R_QM); LAS bf16_t* Km = (LAS bf16_t*)(lds + R_KM);
    LAS bf16_t* KlT = (LAS bf16_t*)(lds + R_KLT); LAS bf16_t* ATT = (LAS bf16_t*)(lds + R_ATT); LAS float* DEC = (LAS float*)(lds + R_DEC);
    LAS float* alowL = (LAS float*)(lds + R_ALOW); LAS float* gsum = (LAS float*)(lds + R_GSUM); LAS float* bmidL = (LAS float*)(lds + R_BMID);
    const int c = tid & 127, tg = tid >> 7;
    float wa[16];
#pragma unroll
    for (int j = 0; j < 16; ++j) wa[j] = p.w_a2[j * 512 + h * 128 + c];
    const float ba = p.b_a[h * 128 + c];
    for (int idx = tid; idx < 1024; idx += 512) { const int t = idx >> 4; alowL[idx] = (t < T) ? alowg[(size_t)(rb + t) * 16 + (idx & 15)] : 0.f; }
    { const int row = tid >> 3, cs = (tid & 7) * 16; const bool ok = row < T; const bf16_t* zr = Z + (size_t)(rb + row) * NZ + h * 128 + cs; const u32x4 z4 = (u32x4){0u, 0u, 0u, 0u};
        const u32x4 q0 = ok ? *(const u32x4*)zr : z4, q1 = ok ? *(const u32x4*)(zr + 8) : z4, k0 = ok ? *(const u32x4*)(zr + 512) : z4, k1 = ok ? *(const u32x4*)(zr + 520) : z4;
        *(LAS u32x4*)(Qm + row * LQ + cs) = q0; *(LAS u32x4*)(Qm + row * LQ + cs + 8) = q1; *(LAS u32x4*)(Km + row * LQ + cs) = k0; *(LAS u32x4*)(Km + row * LQ + cs + 8) = k1; }
    __syncthreads();
    float qv[16], kv[16];
#pragma unroll
    for (int i = 0; i < 16; ++i) { const int t = tg * 16 + i; qv[i] = bf2f(Qm[t * LQ + c]); kv[i] = bf2f(Km[t * LQ + c]); }
    float b[16]; float run = 0.f;
#pragma unroll
    for (int i = 0; i < 16; ++i) { const int t = tg * 16 + i; float pre = ba;
#pragma unroll
        for (int j4 = 0; j4 < 4; ++j4) { const f32x4 a4 = *(const LAS f32x4*)(alowL + t * 16 + j4 * 4); pre += a4[0] * wa[j4 * 4] + a4[1] * wa[j4 * 4 + 1] + a4[2] * wa[j4 * 4 + 2] + a4[3] * wa[j4 * 4 + 3]; }
        const float la = (t < T) ? logsigmoid_f(pre) * 0.0625f : 0.f; run += la; b[i] = run; }
    gsum[tg * 128 + c] = run;
    __syncthreads();
    const float g0 = gsum[c], g1 = gsum[128 + c], g2 = gsum[256 + c], g3 = gsum[384 + c];
    const float pref = tg == 0 ? 0.f : (tg == 1 ? g0 : (tg == 2 ? g0 + g1 : g0 + g1 + g2));
    const float blast = ((g0 + g1) + g2) + g3;
#pragma unroll
    for (int i = 0; i < 16; ++i) b[i] += pref;
    if (tg == 2) bmidL[c] = b[0];
    if (tg == 0) DEC[c] = __expf(blast);
    __syncthreads();
    const float bm = bmidL[c];
    {
        unsigned klp[8];
#pragma unroll
        for (int i = 0; i < 16; i += 2) {
            const int t = tg * 16 + i;
            Qe[t * LQ + c] = f2bf(qv[i] * __expf(b[i])); Qe[(t + 1) * LQ + c] = f2bf(qv[i + 1] * __expf(b[i + 1]));
            Qm[t * LQ + c] = f2bf(qv[i] * __expf(b[i] - bm)); Qm[(t + 1) * LQ + c] = f2bf(qv[i + 1] * __expf(b[i + 1] - bm));
            Km[t * LQ + c] = f2bf(kv[i] * __expf(bm - b[i])); Km[(t + 1) * LQ + c] = f2bf(kv[i + 1] * __expf(bm - b[i + 1]));
            klp[i >> 1] = pk2(kv[i] * __expf(blast - b[i]), kv[i + 1] * __expf(blast - b[i + 1]));
        }
        LAS u32x4* kd = (LAS u32x4*)(KlT + c * LS + tg * 16);
        kd[0] = (u32x4){klp[0], klp[1], klp[2], klp[3]}; kd[1] = (u32x4){klp[4], klp[5], klp[6], klp[7]};
    }
    __syncthreads();
    if (wave < 3) {
        const int si = wave >> 1, ti = wave == 0 ? 0 : 1, l31 = lane & 31, hh = lane >> 5;
        f32x16 o;
#pragma unroll
        for (int i = 0; i < 16; ++i) o[i] = 0.f;
        mma32(o, Km + si * 32 * LQ, LQ, Qm + ti * 32 * LQ, LQ, 128, lane);
        const int tl = ti * 32 + l31;
#pragma unroll
        for (int g = 0; g < 4; ++g) { const int s0 = si * 32 + 8 * g + 4 * hh; float a0 = o[4 * g], a1 = o[4 * g + 1], a2 = o[4 * g + 2], a3 = o[4 * g + 3];
            a0 = (s0 <= tl) ? a0 : 0.f; a1 = (s0 + 1 <= tl) ? a1 : 0.f; a2 = (s0 + 2 <= tl) ? a2 : 0.f; a3 = (s0 + 3 <= tl) ? a3 : 0.f;
            u32x2 w; w.x = pk2(a0, a1); w.y = pk2(a2, a3); *(LAS u32x2*)(ATT + tl * LS + s0) = w; }
    }
    __syncthreads();
}
struct VRegs { u32x4 r[4]; };
__device__ __forceinline__ void v_load(const Params& p, VRegs& v, int rb, int h, int T) {
    const int tid = otid(), s = tid & 63, vg = tid >> 6; const bf16_t* Z = (const bf16_t*)(p.ws + OFF_Z);
#pragma unroll
    for (int k = 0; k < 4; ++k) v.r[k] = (s < T) ? *(const u32x4*)(Z + (size_t)(rb + s) * NZ + 1024 + h * 256 + vg * 32 + 8 * k) : (u32x4){0u, 0u, 0u, 0u};
}
__device__ __forceinline__ void v_store_t(LAS unsigned char* lds, const VRegs& v) {
    const int tid = otid(), s = tid & 63, vg = tid >> 6; LAS bf16_t* VT = (LAS bf16_t*)(lds + R_VT) + (vg * 32) * LS + s;
#pragma unroll
    for (int k = 0; k < 4; ++k) {
        VT[(8 * k + 0) * LS] = (bf16_t)(v.r[k].x & 0xffffu); VT[(8 * k + 1) * LS] = (bf16_t)(v.r[k].x >> 16);
        VT[(8 * k + 2) * LS] = (bf16_t)(v.r[k].y & 0xffffu); VT[(8 * k + 3) * LS] = (bf16_t)(v.r[k].y >> 16);
        VT[(8 * k + 4) * LS] = (bf16_t)(v.r[k].z & 0xffffu); VT[(8 * k + 5) * LS] = (bf16_t)(v.r[k].z >> 16);
        VT[(8 * k + 6) * LS] = (bf16_t)(v.r[k].w & 0xffffu); VT[(8 * k + 7) * LS] = (bf16_t)(v.r[k].w >> 16); }
}
__device__ __forceinline__ void gla_step(const Params& p, LAS unsigned char* lds, f32x16 (&S)[4], int rb, int h, int T, int vb, int vtrow) {
    const int lane = otid() & 63, l31 = lane & 31, hh = lane >> 5;
    LAS bf16_t* Qe = (LAS bf16_t*)(lds + R_QE); LAS bf16_t* KlT = (LAS bf16_t*)(lds + R_KLT); LAS bf16_t* ATT = (LAS bf16_t*)(lds + R_ATT); LAS float* DEC = (LAS float*)(lds + R_DEC);
    LAS bf16_t* VT = (LAS bf16_t*)(lds + R_VT);
    bf16_t* oraw = (bf16_t*)(p.ws + OFF_ORAW);
    f32x16 Za[2], Zb[2];
#pragma unroll
    for (int tt = 0; tt < 2; ++tt)
#pragma unroll
        for (int i = 0; i < 16; ++i) { Za[tt][i] = 0.f; Zb[tt][i] = 0.f; }
    bf16x8 sa[4][2];
#pragma unroll
    for (int cb = 0; cb < 4; ++cb)
#pragma unroll
        for (int s = 0; s < 2; ++s) { u32x4 aw; aw.x = pk2(S[cb][8 * s], S[cb][8 * s + 1]); aw.y = pk2(S[cb][8 * s + 2], S[cb][8 * s + 3]); aw.z = pk2(S[cb][8 * s + 4], S[cb][8 * s + 5]); aw.w = pk2(S[cb][8 * s + 6], S[cb][8 * s + 7]);
            sa[cb][s] = __builtin_bit_cast(bf16x8, aw); }
    bf16x8 vt[4];
    const LAS bf16_t* vp = VT + (vtrow + l31) * LS + 8 * hh;
#pragma unroll
    for (int ks = 0; ks < 4; ++ks) vt[ks] = *(const LAS bf16x8*)(vp + 16 * ks);
#pragma unroll
    for (int cb = 0; cb < 4; ++cb)
#pragma unroll
        for (int g = 0; g < 4; ++g) { const f32x4 d = *(const LAS f32x4*)(DEC + cb * 32 + 8 * g + 4 * hh);
            S[cb][4 * g] *= d[0]; S[cb][4 * g + 1] *= d[1]; S[cb][4 * g + 2] *= d[2]; S[cb][4 * g + 3] *= d[3]; }
#pragma unroll
    for (int ks = 0; ks < 4; ++ks)
#pragma unroll
        for (int cb = 0; cb < 4; ++cb) { const bf16x8 a = *(const LAS bf16x8*)(KlT + (32 * cb + l31) * LS + 16 * ks + 8 * hh); S[cb] = mfma32(a, vt[ks], S[cb]); }
#pragma unroll
    for (int cb = 0; cb < 4; ++cb)
#pragma unroll
        for (int s = 0; s < 2; ++s)
#pragma unroll
            for (int tt = 0; tt < 2; ++tt) { const LAS bf16_t* qp = Qe + (32 * tt + l31) * LQ + 32 * cb + 16 * s + 4 * hh;
                const u32x2 q0 = *(const LAS u32x2*)qp, q1 = *(const LAS u32x2*)(qp + 8); const u32x4 bw = (u32x4){q0.x, q0.y, q1.x, q1.y};
                Za[tt] = mfma32(sa[cb][s], __builtin_bit_cast(bf16x8, bw), Za[tt]); }
#pragma unroll
    for (int ks = 0; ks < 4; ++ks)
#pragma unroll
        for (int tt = 0; tt < 2; ++tt) if (ks < 2 * (tt + 1)) { const bf16x8 bq = *(const LAS bf16x8*)(ATT + (32 * tt + l31) * LS + 16 * ks + 8 * hh); Zb[tt] = mfma32(vt[ks], bq, Zb[tt]); }
#pragma unroll
    for (int tt = 0; tt < 2; ++tt) { const int t = 32 * tt + l31;
        if (t < T) { bf16_t* op = oraw + (size_t)(rb + t) * 1024 + h * 256 + 32 * vb + 4 * hh;
#pragma unroll
            for (int g = 0; g < 4; ++g) { u32x2 w; w.x = pk2(Za[tt][4 * g] + Zb[tt][4 * g], Za[tt][4 * g + 1] + Zb[tt][4 * g + 1]); w.y = pk2(Za[tt][4 * g + 2] + Zb[tt][4 * g + 2], Za[tt][4 * g + 3] + Zb[tt][4 * g + 3]); *(u32x2*)(op + 8 * g) = w; } } }
}
__device__ __forceinline__ size_t s_index(int cb, int i, int hh, int wave, int l31) { return (size_t)(cb * 32 + (i & 3) + 8 * (i >> 2) + 4 * hh) * 256 + 32 * wave + l31; }

__device__ __forceinline__ void gla_prep_item(const Params& p, LAS unsigned char* lds, int chain, int ch) {
    const int b = chain >> 2, h = chain & 3;
    gla_prep(p, lds, b * 2048 + ch * 64, h, 64);
    u32x4* img = (u32x4*)(p.ws + OFF_IMG + (size_t)(chain * 32 + ch) * IMG_BYTES);
    for (int i = otid(); i < IMG_V4; i += 512) img[i] = ((const LAS u32x4*)lds)[i];
    __syncthreads();
}
constexpr int SG_TAB = 0, SG_ALOW = 20480, SG_PART = 24576;
__device__ __forceinline__ void gla_sample_pair(const Params& p, LAS unsigned char* lds, int item) {
    const int tid = otid(), lane = tid & 63, wave = tid >> 6, q = wave & 3, grp = wave >> 2, chain = item * 2 + grp;
    const int b = chain >> 2, h = chain & 3, rb = MP + b * 8;
    LAS float* tab = (LAS float*)(lds + SG_TAB + wave * 2560); LAS float* alw = (LAS float*)(lds + SG_ALOW + wave * 512); LAS float* part = (LAS float*)(lds + SG_PART);
    const bf16_t* Z = (const bf16_t*)(p.ws + OFF_Z); const float* alowg = (const float*)(p.ws + OFF_ALOW); bf16_t* oraw = (bf16_t*)(p.ws + OFF_ORAW);
    alw[lane] = alowg[(size_t)rb * 16 + lane]; alw[lane + 64] = alowg[(size_t)rb * 16 + 64 + lane];
    float qe[8][2], kv[8][2]; f32x4 V[8];
#pragma unroll
    for (int t = 0; t < 8; ++t) { const bf16_t* zr = Z + (size_t)(rb + t) * NZ; const unsigned qw = *(const unsigned*)(zr + h * 128 + 2 * lane), kw = *(const unsigned*)(zr + 512 + h * 128 + 2 * lane);
        const u32x2 vw = *(const u32x2*)(zr + 1024 + h * 256 + 4 * lane);
        qe[t][0] = bflo(qw); qe[t][1] = bfhi(qw); kv[t][0] = bflo(kw); kv[t][1] = bfhi(kw); V[t] = (f32x4){bflo(vw.x), bfhi(vw.x), bflo(vw.y), bfhi(vw.y)}; }
    float bc[8][2];
    {   f32x2 wa[16];
#pragma unroll
        for (int j = 0; j < 16; ++j) wa[j] = *(const f32x2*)(p.w_a2 + j * 512 + h * 128 + 2 * lane);
        const f32x2 ba = *(const f32x2*)(p.b_a + h * 128 + 2 * lane);
        lds_wait();
        float run0 = 0.f, run1 = 0.f;
#pragma unroll
        for (int t = 0; t < 8; ++t) { float p0 = ba.x, p1 = ba.y;
#pragma unroll
            for (int j4 = 0; j4 < 4; ++j4) { const f32x4 a4 = *(const LAS f32x4*)(alw + t * 16 + 4 * j4);
#pragma unroll
                for (int k = 0; k < 4; ++k) { p0 += a4[k] * wa[4 * j4 + k].x; p1 += a4[k] * wa[4 * j4 + k].y; } }
            run0 += logsigmoid_f(p0) * 0.0625f; run1 += logsigmoid_f(p1) * 0.0625f; bc[t][0] = run0; bc[t][1] = run1; } }
    float ki[8][2];
#pragma unroll
    for (int t = 0; t < 8; ++t) { qe[t][0] *= __expf(bc[t][0]); qe[t][1] *= __expf(bc[t][1]); ki[t][0] = kv[t][0] * __expf(-bc[t][0]); ki[t][1] = kv[t][1] * __expf(-bc[t][1]); }
    lds_wait();
#pragma unroll
    for (int t = 0; t < 8; ++t)
#pragma unroll
        for (int s = 0; s <= t; ++s) { const float a = wave_sum(qe[t][0] * ki[s][0] + qe[t][1] * ki[s][1]); if (lane == 0) alw[t * (t + 1) / 2 + s] = a; }
    if ((lane >> 4) == q) { const float e0 = __expf(bc[7][0]), e1 = __expf(bc[7][1]); LAS float* r0 = tab + (2 * lane - 32 * q) * 20; LAS float* r1 = r0 + 20;
        *(LAS f32x4*)(r0) = (f32x4){qe[0][0], qe[1][0], qe[2][0], qe[3][0]}; *(LAS f32x4*)(r0 + 4) = (f32x4){qe[4][0], qe[5][0], qe[6][0], qe[7][0]};
        *(LAS f32x4*)(r1) = (f32x4){qe[0][1], qe[1][1], qe[2][1], qe[3][1]}; *(LAS f32x4*)(r1 + 4) = (f32x4){qe[4][1], qe[5][1], qe[6][1], qe[7][1]};
        *(LAS f32x4*)(r0 + 8) = (f32x4){ki[0][0] * e0, ki[1][0] * e0, ki[2][0] * e0, ki[3][0] * e0}; *(LAS f32x4*)(r0 + 12) = (f32x4){ki[4][0] * e0, ki[5][0] * e0, ki[6][0] * e0, ki[7][0] * e0};
        *(LAS f32x4*)(r1 + 8) = (f32x4){ki[0][1] * e1, ki[1][1] * e1, ki[2][1] * e1, ki[3][1] * e1}; *(LAS f32x4*)(r1 + 12) = (f32x4){ki[4][1] * e1, ki[5][1] * e1, ki[6][1] * e1, ki[7][1] * e1};
        r0[16] = e0; r1[16] = e1; }
    lds_wait();
    f32x4 o[8];
#pragma unroll
    for (int t = 0; t < 8; ++t) o[t] = (f32x4){0.f, 0.f, 0.f, 0.f};
    const f32x4* S0 = (const f32x4*)(p.state_gla + (size_t)chain * 32768 + (size_t)(32 * q) * 256) + lane; f32x4* So = (f32x4*)(p.out + OUT_SS + (size_t)chain * 32768 + (size_t)(32 * q) * 256) + lane;
#pragma unroll 1
    for (int cc = 0; cc < 32; cc += 16) { f32x4 s[16];
#pragma unroll
        for (int u = 0; u < 16; ++u) s[u] = ldnt(S0 + (cc + u) * 64);
#pragma unroll
        for (int u = 0; u < 16; ++u) { const LAS float* row = tab + (cc + u) * 20; const f32x4 qa = *(const LAS f32x4*)row, qb = *(const LAS f32x4*)(row + 4), ka = *(const LAS f32x4*)(row + 8), kb = *(const LAS f32x4*)(row + 12); const float d = row[16];
            o[0] += qa[0] * s[u]; o[1] += qa[1] * s[u]; o[2] += qa[2] * s[u]; o[3] += qa[3] * s[u]; o[4] += qb[0] * s[u]; o[5] += qb[1] * s[u]; o[6] += qb[2] * s[u]; o[7] += qb[3] * s[u];
            f32x4 sn = d * s[u]; sn += ka[0] * V[0]; sn += ka[1] * V[1]; sn += ka[2] * V[2]; sn += ka[3] * V[3]; sn += kb[0] * V[4]; sn += kb[1] * V[5]; sn += kb[2] * V[6]; sn += kb[3] * V[7];
            stnt(So + (cc + u) * 64, sn); } }
#pragma unroll
    for (int t = 0; t < 8; ++t) *(LAS f32x4*)(part + (wave * 8 + t) * 256 + 4 * lane) = o[t];
    __syncthreads();
#pragma unroll
    for (int tt = 0; tt < 2; ++tt) { const int t = 2 * q + tt; f32x4 acc = (f32x4){0.f, 0.f, 0.f, 0.f};
#pragma unroll
        for (int w = 0; w < 4; ++w) acc += *(const LAS f32x4*)(part + ((grp * 4 + w) * 8 + t) * 256 + 4 * lane);
#pragma unroll
        for (int s = 0; s < 8; ++s) { const float a = (s <= t) ? alw[t * (t + 1) / 2 + s] : 0.f; acc += a * V[s]; }
        { u32x2 w; w.x = pk2(acc[0], acc[1]); w.y = pk2(acc[2], acc[3]); *(u32x2*)(oraw + (size_t)(rb + t) * 1024 + h * 256 + 4 * lane) = w; } }
    __syncthreads();
}
struct VRegs2 { u32x4 r[2]; };
__device__ __forceinline__ void v_load_half(const Params& p, VRegs2& v, int rb, int h, int vhalf) {
    const int tid = otid(), s = tid & 63, vg = tid >> 6; const bf16_t* Z = (const bf16_t*)(p.ws + OFF_Z);
#pragma unroll
    for (int k = 0; k < 2; ++k) v.r[k] = *(const u32x4*)(Z + (size_t)(rb + s) * NZ + 1024 + h * 256 + vhalf * 128 + vg * 16 + 8 * k);
}
__device__ __forceinline__ void v_store_half_t(LAS unsigned char* lds, const VRegs2& v) {
    const int tid = otid(), s = tid & 63, vg = tid >> 6; LAS bf16_t* VT = (LAS bf16_t*)(lds + R_VT) + (vg * 16) * LS + s;
#pragma unroll
    for (int k = 0; k < 2; ++k) {
        VT[(8 * k + 0) * LS] = (bf16_t)(v.r[k].x & 0xffffu); VT[(8 * k + 1) * LS] = (bf16_t)(v.r[k].x >> 16);
        VT[(8 * k + 2) * LS] = (bf16_t)(v.r[k].y & 0xffffu); VT[(8 * k + 3) * LS] = (bf16_t)(v.r[k].y >> 16);
        VT[(8 * k + 4) * LS] = (bf16_t)(v.r[k].z & 0xffffu); VT[(8 * k + 5) * LS] = (bf16_t)(v.r[k].z >> 16);
        VT[(8 * k + 6) * LS] = (bf16_t)(v.r[k].w & 0xffffu); VT[(8 * k + 7) * LS] = (bf16_t)(v.r[k].w >> 16); }
}
constexpr int CH_BUF = 64000;
template <int NTHR> __device__ __forceinline__ void chain_stage(const Params& p, LAS unsigned char* buf, const u32x4* img, int rb, int h, int vhalf, int t) {
    const bf16_t* Z = (const bf16_t*)(p.ws + OFF_Z);
    constexpr int NI = (IMG_V4 + NTHR - 1) / NTHR, NV = 512 / NTHR;
    u32x4 im[NI], v0[NV], v1[NV];
#pragma unroll
    for (int k = 0; k < NI; ++k) { const int i = t + NTHR * k; im[k] = (i < IMG_V4) ? img[i] : (u32x4){0u, 0u, 0u, 0u}; }
#pragma unroll
    for (int k = 0; k < NV; ++k) { const int e = t + NTHR * k, s = e & 63, vg = e >> 6; const bf16_t* zp = Z + (size_t)(rb + s) * NZ + 1024 + h * 256 + vhalf * 128 + vg * 16; v0[k] = *(const u32x4*)zp; v1[k] = *(const u32x4*)(zp + 8); }
#pragma unroll
    for (int k = 0; k < NI; ++k) { const int i = t + NTHR * k; if (i < IMG_V4) ((LAS u32x4*)buf)[i] = im[k]; }
#pragma unroll
    for (int k = 0; k < NV; ++k) { const int e = t + NTHR * k, s = e & 63, vg = e >> 6; const u32x4 r0 = v0[k], r1 = v1[k];
        LAS bf16_t* VT = (LAS bf16_t*)(buf + R_VT) + (vg * 16) * LS + s;
        VT[0 * LS] = (bf16_t)(r0.x & 0xffffu); VT[1 * LS] = (bf16_t)(r0.x >> 16); VT[2 * LS] = (bf16_t)(r0.y & 0xffffu); VT[3 * LS] = (bf16_t)(r0.y >> 16);
        VT[4 * LS] = (bf16_t)(r0.z & 0xffffu); VT[5 * LS] = (bf16_t)(r0.z >> 16); VT[6 * LS] = (bf16_t)(r0.w & 0xffffu); VT[7 * LS] = (bf16_t)(r0.w >> 16);
        VT[8 * LS] = (bf16_t)(r1.x & 0xffffu); VT[9 * LS] = (bf16_t)(r1.x >> 16); VT[10 * LS] = (bf16_t)(r1.y & 0xffffu); VT[11 * LS] = (bf16_t)(r1.y >> 16);
        VT[12 * LS] = (bf16_t)(r1.z & 0xffffu); VT[13 * LS] = (bf16_t)(r1.z >> 16); VT[14 * LS] = (bf16_t)(r1.w & 0xffffu); VT[15 * LS] = (bf16_t)(r1.w >> 16); }
}
__device__ __forceinline__ void gla_chain_item(const Params& p, LAS unsigned char* lds, int chain, int vhalf) {
    const int tid = otid(), lane = tid & 63, wave = tid >> 6, l31 = lane & 31, hh = lane >> 5;
    const int b = chain >> 2, h = chain & 3, vb = vhalf * 4 + (wave & 3);
    f32x16 S[4];
#pragma unroll
    for (int cb = 0; cb < 4; ++cb)
#pragma unroll
        for (int i = 0; i < 16; ++i) S[cb][i] = 0.f;
    const u32x4* img = (const u32x4*)(p.ws + OFF_IMG + (size_t)(chain * 32) * IMG_BYTES);
    chain_stage<512>(p, lds, img, b * 2048, h, vhalf, tid);
    __syncthreads();
#pragma unroll 1
    for (int ch = 0; ch < 32; ++ch) {
        const int rb = b * 2048 + ch * 64;
        if (wave >= 4) { if (ch + 1 < 32) chain_stage<256>(p, lds + ((ch + 1) & 1) * CH_BUF, img + (size_t)(ch + 1) * IMG_V4, rb + 64, h, vhalf, tid - 256); }
        else gla_step(p, lds + (ch & 1) * CH_BUF, S, rb, h, 64, vb, 32 * wave);
        __syncthreads();
    }
    if (wave < 4) {
        float* Sout = p.out + OUT_SP + (size_t)chain * 32768;
#pragma unroll
        for (int cb = 0; cb < 4; ++cb)
#pragma unroll
            for (int i = 0; i < 16; ++i) Sout[s_index(cb, i, hh, vb, l31)] = S[cb][i];
    }
}

constexpr int M_W = 0, M_V = 34816, M_STAT = 69632;
__device__ __forceinline__ void gmlp_item(const Params& p, LAS unsigned char* lds, int rowbase, int T, int g, float* vs_out) {
    const int tid = otid(), lane = tid & 63, wave = tid >> 6;
    const bf16_t* Z = (const bf16_t*)(p.ws + OFF_Z); bf16_t* mraw = (bf16_t*)(p.ws + OFF_MRAW);
    LAS bf16_t* LW = (LAS bf16_t*)(lds + M_W); LAS bf16_t* LV = (LAS bf16_t*)(lds + M_V); LAS float* stat = (LAS float*)(lds + M_STAT);
    if (tid < 128) { const f32x2 st = (tid < T) ? *(const f32x2*)((const float*)(p.ws + OFF_STAT) + (size_t)(rowbase + tid) * 2) : (f32x2){0.f, 0.f}; stat[2 * tid] = st.x; stat[2 * tid + 1] = st.y; }
    for (int idx = tid; idx < 4096; idx += 512) { const int t = idx >> 5, s4 = (idx & 31) * 4; const f32x4 w = *(const f32x4*)(p.w_s + ((size_t)g * 128 + t) * 128 + s4);
        u32x2 o; o.x = pk2(s4 <= t ? w[0] : 0.f, s4 + 1 <= t ? w[1] : 0.f); o.y = pk2(s4 + 2 <= t ? w[2] : 0.f, s4 + 3 <= t ? w[3] : 0.f);
        *(LAS u32x2*)(LW + t * LQ + s4) = o; }
    __syncthreads();
    { const int s = tid & 127, dq = tid >> 7; const float mean = stat[2 * s], rstd = stat[2 * s + 1];
#pragma unroll
        for (int ps = 0; ps < 4; ++ps) { const int d8 = (dq * 4 + ps) * 8; float vn[8];
            if (s < T) { const u32x4 r = *(const u32x4*)(Z + (size_t)(rowbase + s) * NZ + 4096 + g * 128 + d8);
                const float x[8] = {bflo(r.x), bfhi(r.x), bflo(r.y), bfhi(r.y), bflo(r.z), bfhi(r.z), bflo(r.w), bfhi(r.w)};
                const f32x4 ga = *(const f32x4*)(p.g_gmlp_ln + g * 128 + d8), gb = *(const f32x4*)(p.g_gmlp_ln + g * 128 + d8 + 4);
                const f32x4 ba = *(const f32x4*)(p.b_gmlp_ln + g * 128 + d8), bb = *(const f32x4*)(p.b_gmlp_ln + g * 128 + d8 + 4);
#pragma unroll
                for (int j = 0; j < 4; ++j) { vn[j] = (x[j] - mean) * rstd * ga[j] + ba[j]; vn[4 + j] = (x[4 + j] - mean) * rstd * gb[j] + bb[j]; }
                if (vs_out) { float* vp = vs_out + (size_t)s * 1024 + g * 128 + d8; *(f32x4*)vp = (f32x4){vn[0], vn[1], vn[2], vn[3]}; *(f32x4*)(vp + 4) = (f32x4){vn[4], vn[5], vn[6], vn[7]}; }
            } else {
#pragma unroll
                for (int j = 0; j < 8; ++j) vn[j] = 0.f;
            }
#pragma unroll
            for (int j = 0; j < 8; ++j) LV[(d8 + j) * LQ + s] = f2bf(vn[j]); } }
    __syncthreads();
#pragma unroll 1
    for (int q = 0; q < 2; ++q) { const int id = wave * 2 + q, ti = id >> 2, di = id & 3;
        if (ti * 32 < T) { f32x16 acc;
#pragma unroll
            for (int i = 0; i < 16; ++i) acc[i] = 0.f;
            mma32(acc, LW + ti * 32 * LQ, LQ, LV + di * 32 * LQ, LQ, (ti + 1) * 32, lane);
            const int d = di * 32 + (lane & 31);
#pragma unroll
            for (int i = 0; i < 16; ++i) { const int t = ti * 32 + (i & 3) + 8 * (i >> 2) + 4 * (lane >> 5);
                if (t < T) { const float uval = bf2f(Z[(size_t)(rowbase + t) * NZ + 3072 + g * 128 + d]);
                    mraw[(size_t)(rowbase + t) * 1024 + g * 128 + d] = f2bf(uval * (acc[i] + p.b_s[g * 128 + t])); } } } }
    __syncthreads();
}

__device__ __forceinline__ void gmlp_sample_item(const Params& p, int b) {
    const int tid = otid(), d2 = tid * 2, g = __builtin_amdgcn_readfirstlane(tid >> 6), rb = MP + b * 8;
    const bf16_t* Z = (const bf16_t*)(p.ws + OFF_Z); bf16_t* mraw = (bf16_t*)(p.ws + OFF_MRAW); const float* st = (const float*)(p.ws + OFF_STAT) + (size_t)rb * 2;
    float* vs_out = p.out + OUT_VS + (size_t)b * 8 * 1024;
    const f32x2 ga = *(const f32x2*)(p.g_gmlp_ln + d2), be = *(const f32x2*)(p.b_gmlp_ln + d2);
    unsigned xv[8], uv[8];
#pragma unroll
    for (int s_ = 0; s_ < 8; ++s_) { xv[s_] = *(const unsigned*)(Z + (size_t)(rb + s_) * NZ + 4096 + d2); uv[s_] = *(const unsigned*)(Z + (size_t)(rb + s_) * NZ + 3072 + d2); }
    float v0[8], v1[8];
#pragma unroll
    for (int s_ = 0; s_ < 8; ++s_) { const float mean = st[2 * s_], rstd = st[2 * s_ + 1];
        v0[s_] = (bflo(xv[s_]) - mean) * rstd * ga.x + be.x; v1[s_] = (bfhi(xv[s_]) - mean) * rstd * ga.y + be.y;
        *(f32x2*)(vs_out + (size_t)s_ * 1024 + d2) = (f32x2){v0[s_], v1[s_]}; }
    const float* wg = p.w_s + (size_t)g * 128 * 128; const float* bs = p.b_s + g * 128;
#pragma unroll
    for (int t = 0; t < 8; ++t) { float m0 = bs[t], m1 = m0;
#pragma unroll
        for (int s_ = 0; s_ <= t; ++s_) { const float w = wg[t * 128 + s_]; m0 += w * v0[s_]; m1 += w * v1[s_]; }
        *(unsigned*)(mraw + (size_t)(rb + t) * 1024 + d2) = pk2(bflo(uv[t]) * m0, bfhi(uv[t]) * m1); }
}
__device__ __forceinline__ void phase2a(const Params& p, LAS unsigned char* lds) {
    {   const int tid = otid(), lane = tid & 63, gw = blockIdx.x * 8 + (tid >> 6), NGW = gridDim.x * 8;
        const bf16_t* Z = (const bf16_t*)(p.ws + OFF_Z); float* st = (float*)(p.ws + OFF_STAT);
        for (int r = gw; r < MT; r += NGW) {
            const bf16_t* zr = Z + (size_t)r * NZ + 4096; const u32x4 r0 = *(const u32x4*)(zr + lane * 8), r1 = *(const u32x4*)(zr + 512 + lane * 8);
            const float x[16] = {bflo(r0.x), bfhi(r0.x), bflo(r0.y), bfhi(r0.y), bflo(r0.z), bfhi(r0.z), bflo(r0.w), bfhi(r0.w), bflo(r1.x), bfhi(r1.x), bflo(r1.y), bfhi(r1.y), bflo(r1.z), bfhi(r1.z), bflo(r1.w), bfhi(r1.w)};
            float s = 0.f;
#pragma unroll
            for (int j = 0; j < 16; ++j) s += x[j];
            const float mean = wave_sum(s) * (1.f / 1024.f); float q = 0.f;
#pragma unroll
            for (int j = 0; j < 16; ++j) { const float d = x[j] - mean; q += d * d; }
            const float rstd = rsqrtf(wave_sum(q) * (1.f / 1024.f) + 1e-6f);
            if (lane == 0) *(f32x2*)(st + (size_t)r * 2) = (f32x2){mean, rstd};
        }
    }
    for (int j = blockIdx.x; j < 512; j += gridDim.x) gla_prep_item(p, lds, j >> 5, j & 31);
    for (int j = blockIdx.x; j < 256; j += gridDim.x) gla_sample_pair(p, lds, j);
    { const int gw = blockIdx.x * 8 + (otid() >> 6), NGW = gridDim.x * 8; convert_range(p, lds, cv::E_IN, cv::E_OUT, gw, NGW); convert_range(p, lds, cv::E_FO, cv::E_PLE, gw, NGW); }
}
__device__ __forceinline__ void phase2c(const Params& p, LAS unsigned char* lds) {
    const int nb = gridDim.x, bid = blockIdx.x;
    constexpr int NCH = 32, N_GP = 512, N_GS = 0, N_MS = 128;
    const int nlb = nb > 2 * NCH ? NCH : (nb > 1 ? nb / 2 : 0);
    if (bid < nlb || nlb == 0) { for (int j = (nlb ? bid : 0); j < NCH; j += (nlb ? nlb : 1)) gla_chain_item(p, lds, j >> 1, j & 1); }
    if (bid >= nlb) {
        const int ob = bid - nlb, onb = nb - nlb;
        for (int j = ob; j < N_GP + N_GS + N_MS; j += onb) {
            if (j < N_GP) gmlp_item(p, lds, (j >> 3) * 128, 128, j & 7, nullptr);
            else gmlp_sample_item(p, j - N_GP - N_GS);
        }
        __syncthreads();
        convert_range(p, lds, cv::E_OUT, cv::E_FI, ob * 8 + (otid() >> 6), onb * 8);
    }
}

struct Mix10 { f32x4 o[4], m[4]; u32x4 r0, r1; };
__device__ __forceinline__ void mix_load(Mix10& a, const Params& p, int r, int col) {
    const bf16_t* Z = (const bf16_t*)(p.ws + OFF_Z); const bf16_t* oraw = (const bf16_t*)(p.ws + OFF_ORAW); const bf16_t* mraw = (const bf16_t*)(p.ws + OFF_MRAW);
#pragma unroll
    for (int j = 0; j < 2; ++j) { const u32x4 ow = ldnt((const u32x4*)(oraw + (size_t)r * 1024 + col + 8 * j)), mw = ldnt((const u32x4*)(mraw + (size_t)r * 1024 + col + 8 * j));
        a.o[2 * j] = (f32x4){bflo(ow.x), bfhi(ow.x), bflo(ow.y), bfhi(ow.y)}; a.o[2 * j + 1] = (f32x4){bflo(ow.z), bfhi(ow.z), bflo(ow.w), bfhi(ow.w)};
        a.m[2 * j] = (f32x4){bflo(mw.x), bfhi(mw.x), bflo(mw.y), bfhi(mw.y)}; a.m[2 * j + 1] = (f32x4){bflo(mw.z), bfhi(mw.z), bflo(mw.w), bfhi(mw.w)}; }
    a.r0 = ldnt((const u32x4*)(Z + (size_t)r * NZ + 2048 + col)); a.r1 = ldnt((const u32x4*)(Z + (size_t)r * NZ + 2048 + col + 8));
}
__device__ __forceinline__ void mix_finish(const Mix10& a, const Params& p, int r, int col) {
    bf16_t* cat = (bf16_t*)(p.ws + OFF_A0);
    { float s = 0.f;
#pragma unroll
        for (int j = 0; j < 4; ++j) s += (a.o[j][0] * a.o[j][0] + a.o[j][1] * a.o[j][1]) + (a.o[j][2] * a.o[j][2] + a.o[j][3] * a.o[j][3]);
        s = row16_sum(s);
        const float rinv = rsqrtf(s * (1.f / 256.f) + 1e-6f);
        const float sr[16] = {bflo(a.r0.x), bfhi(a.r0.x), bflo(a.r0.y), bfhi(a.r0.y), bflo(a.r0.z), bfhi(a.r0.z), bflo(a.r0.w), bfhi(a.r0.w), bflo(a.r1.x), bfhi(a.r1.x), bflo(a.r1.y), bfhi(a.r1.y), bflo(a.r1.z), bfhi(a.r1.z), bflo(a.r1.w), bfhi(a.r1.w)};
        unsigned w[8];
#pragma unroll
        for (int j = 0; j < 4; ++j) { const f32x4 g = *(const f32x4*)(p.g_gla_norm + col + 4 * j);
            w[2 * j] = pk2(a.o[j][0] * rinv * g[0] * sr[4 * j], a.o[j][1] * rinv * g[1] * sr[4 * j + 1]); w[2 * j + 1] = pk2(a.o[j][2] * rinv * g[2] * sr[4 * j + 2], a.o[j][3] * rinv * g[3] * sr[4 * j + 3]); }
        u32x4* dp = (u32x4*)(cat + (size_t)r * DM + col); dp[0] = (u32x4){w[0], w[1], w[2], w[3]}; dp[1] = (u32x4){w[4], w[5], w[6], w[7]}; }
    { float s = 0.f;
#pragma unroll
        for (int j = 0; j < 4; ++j) s += (a.m[j][0] * a.m[j][0] + a.m[j][1] * a.m[j][1]) + (a.m[j][2] * a.m[j][2] + a.m[j][3] * a.m[j][3]);
        const float rinv = rsqrtf(wave_sum(s) * (1.f / 1024.f) + 1e-6f);
        unsigned w[8];
#pragma unroll
        for (int j = 0; j < 4; ++j) { const f32x4 g = *(const f32x4*)(p.g_gmlp_out + col + 4 * j);
            w[2 * j] = pk2(a.m[j][0] * rinv * g[0], a.m[j][1] * rinv * g[1]); w[2 * j + 1] = pk2(a.m[j][2] * rinv * g[2], a.m[j][3] * rinv * g[3]); }
        u32x4* dp = (u32x4*)(cat + (size_t)r * DM + 1024 + col); dp[0] = (u32x4){w[0], w[1], w[2], w[3]}; dp[1] = (u32x4){w[4], w[5], w[6], w[7]}; }
}
__device__ __forceinline__ void phase2b(const Params& p) {
    const int lane = otid() & 63, gw = blockIdx.x * 8 + (otid() >> 6), NGW = gridDim.x * 8, col = lane * 16;
    for (int r = gw; r < MT; r += 2 * NGW) {
        const int r2 = r + NGW; const bool has2 = r2 < MT;
        Mix10 a, b; mix_load(a, p, r, col); mix_load(b, p, has2 ? r2 : r, col);
        mix_finish(a, p, r, col);
        if (has2) mix_finish(b, p, r2, col);
    }
}
template <int NS> __device__ __forceinline__ void phase_norm(const Params& p, const float* gain, const float* base_s) {
    const int lane = otid() & 63, gw = blockIdx.x * 8 + (otid() >> 6), NGW = gridDim.x * 8; bf16_t* a0 = (bf16_t*)(p.ws + OFF_A0); const bf16_t* part = (const bf16_t*)(p.ws + OFF_IMG);
    for (int r = gw; r < MP; r += 4 * NGW) {
        const bool bal = NGW == 2048, low = gw < 1024;
        const int r2 = r + NGW, r3 = r + 2 * NGW, r4 = (bal && !low) ? r + 3 * NGW : r + 3 * NGW; const bool h2 = r2 < MP, h3 = r3 < MP && !(bal && low), h4 = r4 < MP && !(bal && low);
        Row8 a, b, c4, d; row_load_nt(a, p.out + OUT_Y + (size_t)r * DM, lane); row_load_nt(b, p.out + OUT_Y + (size_t)(h2 ? r2 : r) * DM, lane);
        row_load_nt(c4, p.out + OUT_Y + (size_t)(h3 ? r3 : r) * DM, lane); row_load_nt(d, p.out + OUT_Y + (size_t)(h4 ? r4 : r) * DM, lane);
        rms_finish_bf16(a, gain, a0 + (size_t)r * DM, lane);
        if (h2) rms_finish_bf16(b, gain, a0 + (size_t)r2 * DM, lane);
        if (h3) rms_finish_bf16(c4, gain, a0 + (size_t)r3 * DM, lane);
        if (h4) rms_finish_bf16(d, gain, a0 + (size_t)r4 * DM, lane);
        if (bal && !low) { const int rx = (gw - 1024) + 2 * NGW, ry = rx + NGW; Row8 e, f; row_load_nt(e, p.out + OUT_Y + (size_t)rx * DM, lane); row_load_nt(f, p.out + OUT_Y + (size_t)ry * DM, lane);
            rms_finish_bf16(e, gain, a0 + (size_t)rx * DM, lane); rms_finish_bf16(f, gain, a0 + (size_t)ry * DM, lane); }
    }
    for (int r = MP + gw; r < MT; r += NGW) {
        f32x4 v[8]; float s = 0.f; const f32x4* sm = row_mid(base_s + (size_t)(r - MP) * DM, lane); const f32x4* gm = row_mid(gain, lane);
        const u32x2* pm0 = (const u32x2*)(part + (size_t)(r - MP) * DM) + lane; f32x4* om = row_mid(p.out + OUT_Y + (size_t)r * DM, lane);
#pragma unroll
        for (int j = 0; j < 8; ++j) v[j] = sm[64 * (j - 4)];
#pragma unroll 4
        for (int k = 0; k < NS; ++k) { const u32x2* pk = pm0 + (size_t)k * (MS * DM / 4);
#pragma unroll
            for (int j = 0; j < 8; ++j) v[j] += unpack4(pk[64 * j]); }
#pragma unroll
        for (int j = 0; j < 8; ++j) { om[64 * (j - 4)] = v[j]; s += (v[j][0] * v[j][0] + v[j][1] * v[j][1]) + (v[j][2] * v[j][2] + v[j][3] * v[j][3]); }
        const float rinv = rsqrtf(wave_sum(s) * (1.f / DM) + 1e-6f);
        u32x2* dm = (u32x2*)(a0 + (size_t)r * DM) + lane;
#pragma unroll
        for (int j = 0; j < 8; ++j) { const f32x4 g = gm[64 * (j - 4)]; u32x2 o; o.x = pk2(v[j][0] * rinv * g[0], v[j][1] * rinv * g[1]); o.y = pk2(v[j][2] * rinv * g[2], v[j][3] * rinv * g[3]);
            dm[64 * j] = o; }
    }
}
#define P7_TAIL() \
        float s = 0.f; \
        _Pragma("unroll") for (int j = 0; j < 8; ++j) s += (v.v[j][0] * v.v[j][0] + v.v[j][1] * v.v[j][1]) + (v.v[j][2] * v.v[j][2] + v.v[j][3] * v.v[j][3]); \
        const float rp = rsqrtf(wave_sum(s) * (1.f / DM) + 1e-6f); float s3 = 0.f; \
        const f32x4* gpm = row_mid(p.g_ple, lane); \
        _Pragma("unroll") for (int j = 0; j < 8; ++j) { const f32x4 g = gpm[64 * (j - 4)]; \
            _Pragma("unroll") for (int k = 0; k < 4; ++k) { const float h3 = hh.v[j][k] + v.v[j][k] * rp * g[k] * sigmoid_f(z.v[j][k]); v.v[j][k] = h3; s3 += h3 * h3; } } \
        const float r3 = rsqrtf(wave_sum(s3) * (1.f / DM) + 1e-6f); \
        const f32x4* gfm = row_mid(p.g_final, lane); \
        _Pragma("unroll") for (int j = 0; j < 8; ++j) { const f32x4 g = gfm[64 * (j - 4)]; stnt(om + 64 * (j - 4), (f32x4){v.v[j][0] * r3 * g[0], v.v[j][1] * r3 * g[1], v.v[j][2] * r3 * g[2], v.v[j][3] * r3 * g[3]}); }
__device__ __forceinline__ void phase7(const Params& p) {
    const int lane = otid() & 63, gw = blockIdx.x * 8 + (otid() >> 6), NGW = gridDim.x * 8;
    const bf16_t* gz = (const bf16_t*)(p.ws + OFF_GATEZ); const bf16_t* pz = (const bf16_t*)(p.ws + OFF_PZ);
    const bool bal7 = NGW == 2048, low7 = gw < 1024; const int nk7 = bal7 ? (low7 ? 3 : 5) : (MP - gw + NGW - 1) / NGW;
#pragma unroll 1
    for (int k7 = 0; k7 < nk7; ++k7) { const int r = (k7 < 4) ? gw + k7 * NGW : (gw - 1024) + 3 * NGW;
        f32x4* om = row_mid(p.out + OUT_Y + (size_t)r * DM, lane);
        const u32x2* pzr = (const u32x2*)(pz + (size_t)r * DM) + lane; const u32x2* zb = (const u32x2*)(gz + (size_t)r * DM) + lane;
        Row8 v, hh, z;
#pragma unroll
        for (int j = 0; j < 8; ++j) { const u32x2 w = ldnt(pzr + 64 * j), zw = ldnt(zb + 64 * j); v.v[j] = (f32x4){bflo(w.x), bfhi(w.x), bflo(w.y), bfhi(w.y)}; z.v[j] = (f32x4){bflo(zw.x), bfhi(zw.x), bflo(zw.y), bfhi(zw.y)}; hh.v[j] = ldnt(om + 64 * (j - 4)); }
        P7_TAIL()
    }
#pragma unroll 1
    for (int r = MP + gw; r < MT; r += NGW) {
        f32x4* om = row_mid(p.out + OUT_Y + (size_t)r * DM, lane);
        const u32x2* pzr = (const u32x2*)(pz + (size_t)r * DM) + lane; const u32x2* zm = (const u32x2*)((const bf16_t*)(p.ws + OFF_IMG) + (size_t)(r - MP) * DM) + lane;
        Row8 v, hh, z;
#pragma unroll
        for (int j = 0; j < 8; ++j) { const u32x2 w = ldnt(pzr + 64 * j); v.v[j] = unpack4(w); hh.v[j] = ldnt(om + 64 * (j - 4)); z.v[j] = (f32x4){0.f, 0.f, 0.f, 0.f}; }
#pragma unroll 4
        for (int k = 0; k < 8; ++k) { const u32x2* pk = zm + (size_t)k * (MS * DM / 4);
#pragma unroll
            for (int j = 0; j < 8; ++j) z.v[j] += unpack4(ldnt(pk + 64 * j)); }
        P7_TAIL()
    }
}
#undef P7_TAIL

__global__ void __launch_bounds__(512, 2) fwd_kernel(Params p) {
    extern __shared__ __attribute__((aligned(16))) unsigned char shm[];
    LAS unsigned char* lds = (LAS unsigned char*)shm;
    cg::grid_group grid = cg::this_grid();
    if (threadIdx.x == 0) { *(volatile LAS unsigned*)(lds + 131072) = 0u; *(volatile LAS unsigned*)(lds + 131076) = 0u; }
    __syncthreads();
    const XcdBarrier xb = xcd_barrier_post((unsigned*)(p.ws + OFF_BAR), (volatile LAS unsigned*)(lds + 131072));
    bf16_t* a0 = (bf16_t*)(p.ws + OFF_A0);
    phase0(p, lds);
    if (p.ws == nullptr) grid.sync();
    xcd_barrier(xb);
    { EpiIn E; E.Z = (bf16_t*)(p.ws + OFF_Z); E.alow = (float*)(p.ws + OFF_ALOW); run_gemm(lds, a0, (const bf16_t*)(p.ws + OFF_WIN), MT, NINP, DM, E); }
    xcd_barrier(xb);
    phase2a(p, lds);
    xcd_barrier(xb);
    phase2c(p, lds);
    xcd_barrier(xb);
    phase2b(p);
    xcd_barrier(xb);
    bf16_t* part = (bf16_t*)(p.ws + OFF_IMG);
    { EpiRes E; E.res_p = p.x_prompt; E.res_s = p.x_sample; E.out = p.out + OUT_Y; run_gemm_n2048(lds, a0, (const bf16_t*)(p.ws + OFF_WOUT), DM, E, part); }
    xcd_barrier(xb);
    phase_norm<8>(p, p.g_ffn, p.x_sample);
    xcd_barrier(xb);
    { EpiSwiglu E; E.act = (bf16_t*)(p.ws + OFF_ACT); run_gemm(lds, a0, (const bf16_t*)(p.ws + OFF_WFI), MT, 2 * DFF, DM, E); }
    {
        const int G = (int)gridDim.x, extra = ((MT / 256) * (2 * DFF / 256)) % G, cb = (int)blockIdx.x;
        if (extra == 0 || cb >= extra) { EpiBfN E; E.out = (bf16_t*)(p.ws + OFF_PZ); pg8::Gemm g; g.A = (const bf16_t*)(p.ws + OFF_PB); g.Bt = (const bf16_t*)(p.ws + OFF_WPLE); g.M = MT; g.N = DM; g.K = PLE; g.Klen = PLE;
            pg8::StaticOrder S; S.init(MT, DM, extra ? G - extra : G, extra ? cb - extra : cb); pg8::gemm_phase<EpiBfN, pg8::StaticOrder, false>(lds, g, S, E, nullptr);
            { const int ob = extra ? cb - extra : cb, onb = extra ? G - extra : G, gw = ob * 8 + (otid() >> 6); convert_range(p, lds, cv::E_FI, cv::E_FO, gw, onb * 8); convert_range(p, lds, cv::E_PLE, cv::E_GT, gw, onb * 8); } }
    }
    xcd_barrier(xb);
    { EpiRes E; E.res_p = p.out + OUT_Y; E.res_s = p.out + OUT_Y + (size_t)MP * DM; E.out = p.out + OUT_Y;
      const bf16_t* A = (const bf16_t*)(p.ws + OFF_ACT); const bf16_t* Bt = (const bf16_t*)(p.ws + OFF_WFO); const int G = (int)gridDim.x, hb = (int)((blockIdx.x + G / 2) % G);
      run_gemm(lds, A, Bt, MP, DM, DFF, E);
      run_split(lds, A, Bt, DFF, part, 4, 768, 0, 0, hb);
      run_split(lds, A, Bt, DFF, part, 4, 640, 3072, 4, (int)blockIdx.x); }
    xcd_barrier(xb);
    phase_norm<8>(p, p.g_ple_gate, p.out + OUT_Y + (size_t)MP * DM);
    xcd_barrier(xb);
    { EpiBfN E; E.out = (bf16_t*)(p.ws + OFF_GATEZ); run_gemm_n2048(lds, a0, (const bf16_t*)(p.ws + OFF_WGT), DM, E, part); }
    xcd_barrier(xb);
    phase7(p);
}

extern "C" void kernel_launch(void* const* d_in, const int* in_sizes, int n_in, void* d_out, int out_size, void* d_ws, size_t ws_size, hipStream_t stream) {
    static int grid = 0;
    if (grid == 0) {
        if (n_in != 24 || ws_size < WS_END) { fprintf(stderr, "kernel_launch: unexpected n_in %d or ws_size %zu (< %zu)\n", n_in, ws_size, (size_t)WS_END); grid = -1; return; }
        int dev = 0, cus = 0, per_cu = 0;
        if (hipGetDevice(&dev) != hipSuccess || hipDeviceGetAttribute(&cus, hipDeviceAttributeMultiprocessorCount, dev) != hipSuccess) { grid = -1; return; }
        if (hipFuncSetAttribute((const void*)fwd_kernel, hipFuncAttributeMaxDynamicSharedMemorySize, LDS_BYTES) != hipSuccess) { fprintf(stderr, "kernel_launch: hipFuncSetAttribute failed\n"); grid = -1; return; }
        if (hipOccupancyMaxActiveBlocksPerMultiprocessor(&per_cu, (const void*)fwd_kernel, 512, LDS_BYTES) != hipSuccess || per_cu < 1) { fprintf(stderr, "kernel_launch: occupancy query says %d blocks per CU\n", per_cu); grid = -1; (void)hipGetLastError(); return; }
        grid = cus;
    }
    if (grid < 0) return;
    if (hipMemsetAsync(d_ws, 0, XCD_BAR_WORDS * sizeof(unsigned), stream) != hipSuccess) { fprintf(stderr, "kernel_launch: memset failed\n"); return; }
    Params p{};
    const float** f = (const float**)&p;
    for (int i = 0; i < 24; ++i) f[i] = (const float*)d_in[i];
    p.out = (float*)d_out; p.ws = (unsigned char*)d_ws;
    void* args[] = {&p};
    hipError_t e = hipLaunchCooperativeKernel((const void*)fwd_kernel, dim3(grid), dim3(512), args, LDS_BYTES, stream);
    if (e != hipSuccess) fprintf(stderr, "cooperative launch failed: %s (grid %d)\n", hipGetErrorString(e), grid);
}
```
